# Optimizing an MI355X kernel written in HIP

```python
import math
import jax, jax.numpy as jnp
from jax import lax
import numpy as np

D_MODEL = 1024
BATCH = 4
SEQ = 4096
DEPTH = 1

MEM_LEN = 256
MEM_HEADS = 4
MEM_HEAD_DIM = D_MODEL // 16
MEM_WIDTH = MEM_HEADS * MEM_HEAD_DIM
DIFF_HEADS = 4
DIFF_HEAD_DIM = D_MODEL // 16
DIFF_WIDTH = DIFF_HEADS * 2 * DIFF_HEAD_DIM
FOURIER_GROUPS = 4
FOURIER_GROUP_DIM = D_MODEL // 16
FOURIER_WIDTH = FOURIER_GROUPS * FOURIER_GROUP_DIM
D_MIX = DIFF_WIDTH + FOURIER_WIDTH + MEM_WIDTH
IN_COLS = 3 * DIFF_WIDTH + FOURIER_WIDTH + MEM_WIDTH
N_BUCKETS = 32
MAX_DISTANCE = 128
Q_BLOCK = 128
N_GROUPS = 4
EXPERTS_PER_GROUP = 8
N_EXPERTS = N_GROUPS * EXPERTS_PER_GROUP
TOP_K = 2
D_EXPERT = D_MODEL // 4
LN_EPS = 1e-5
DEEPNORM_ALPHA = (2.0 * DEPTH) ** 0.25
DEEPNORM_BETA = (8.0 * DEPTH) ** -0.25

kernel_name = "hymba_diff_fnet_hmoe_encoder"

F32 = jnp.float32


def layer_norm(x, g, b):
    xf = x.astype(F32)
    mu = jnp.mean(xf, axis=-1, keepdims=True)
    xc = xf - mu
    var = jnp.mean(xc * xc, axis=-1, keepdims=True)
    return (xc * lax.rsqrt(var + LN_EPS) * g.astype(F32) + b.astype(F32)).astype(x.dtype)


def t5_bucket(rel):
    nb = N_BUCKETS // 2
    max_exact = nb // 2
    ret = (rel > 0).astype(jnp.int32) * nb
    n = jnp.abs(rel)
    nf = jnp.maximum(n, 1).astype(F32)
    large = max_exact + (jnp.log(nf / max_exact) / math.log(MAX_DISTANCE / max_exact)
                         * (nb - max_exact)).astype(jnp.int32)
    large = jnp.minimum(large, nb - 1)
    return ret + jnp.where(n < max_exact, n, large)


def diff_attention(q, k, v, lam, lam_init, subln_g, rel_bias):
    B, S = q.shape[0], q.shape[1]
    nblk = S // Q_BLOCK
    scale = DIFF_HEAD_DIM ** -0.5
    kf = k.astype(F32)
    vf = v.astype(F32)
    qb = (q.astype(F32) * scale).reshape(B, nblk, Q_BLOCK, DIFF_HEADS, 2, DIFF_HEAD_DIM)
    qb = qb.transpose(1, 0, 2, 3, 4, 5)
    starts = jnp.arange(nblk, dtype=jnp.int32) * Q_BLOCK
    kpos = jnp.arange(S, dtype=jnp.int32)
    table = rel_bias.astype(F32)

    def block(args):
        qblk, start = args
        qpos = start + jnp.arange(Q_BLOCK, dtype=jnp.int32)
        bucket = t5_bucket(kpos[None, :] - qpos[:, None])
        bias = jnp.take(table, bucket, axis=0).transpose(2, 0, 1)
        s = jnp.einsum('bqhcd,bkhcd->bchqk', qblk, kf) + bias[None, None]
        p = jax.nn.softmax(s, axis=-1)
        a = p[:, 0] - lam * p[:, 1]
        return jnp.einsum('bhqk,bkhe->bqhe', a, vf)

    o = lax.map(block, (qb, starts))
    o = o.transpose(1, 0, 2, 3, 4).reshape(B, S, DIFF_HEADS, 2 * DIFF_HEAD_DIM)
    o = o * lax.rsqrt(jnp.mean(o * o, axis=-1, keepdims=True) + LN_EPS) * subln_g.astype(F32)
    o = o * (1.0 - lam_init)
    return o.reshape(B, S, DIFF_WIDTH).astype(q.dtype)


def fourier_mix(u, w_f):
    B, S = u.shape[0], u.shape[1]
    ug = u.astype(F32).reshape(B, S, FOURIER_GROUPS, FOURIER_GROUP_DIM)
    spec = jnp.fft.fft2(ug, axes=(1, 3), norm="ortho").real
    out = jnp.einsum('bsgc,gcd->bsgd', spec, w_f.astype(F32))
    return out.reshape(B, S, FOURIER_WIDTH).astype(u.dtype)


def memory_attention(mq, mem, w_mem_kv):
    B, S = mq.shape[0], mq.shape[1]
    kv = mem @ w_mem_kv
    mk, mv = jnp.split(kv, 2, axis=-1)
    qh = mq.reshape(B, S, MEM_HEADS, MEM_HEAD_DIM).astype(F32) * (MEM_HEAD_DIM ** -0.5)
    kh = mk.reshape(B, -1, MEM_HEADS, MEM_HEAD_DIM).astype(F32)
    vh = mv.reshape(B, -1, MEM_HEADS, MEM_HEAD_DIM).astype(F32)
    p = jax.nn.softmax(jnp.einsum('bshd,bmhd->bhsm', qh, kh), axis=-1)
    o = jnp.einsum('bhsm,bmhd->bshd', p, vh)
    return o.reshape(B, S, MEM_WIDTH).astype(mq.dtype)


def hybrid_mixer(h, mem, w_in, w_mem_kv, w_fourier, lambda_q1, lambda_k1, lambda_q2, lambda_k2,
                 subln_g, w_out, rel_bias, lam_init):
    B, S = h.shape[0], h.shape[1]
    proj = h @ w_in
    q, k, v, f_in, mq = jnp.split(
        proj, [DIFF_WIDTH, 2 * DIFF_WIDTH, 3 * DIFF_WIDTH, 3 * DIFF_WIDTH + FOURIER_WIDTH], axis=-1)
    q = q.reshape(B, S, DIFF_HEADS, 2, DIFF_HEAD_DIM)
    k = k.reshape(B, S, DIFF_HEADS, 2, DIFF_HEAD_DIM)
    v = v.reshape(B, S, DIFF_HEADS, 2 * DIFF_HEAD_DIM)
    lam = (jnp.exp(jnp.sum(lambda_q1.astype(F32) * lambda_k1.astype(F32)))
           - jnp.exp(jnp.sum(lambda_q2.astype(F32) * lambda_k2.astype(F32))) + lam_init)
    o_diff = diff_attention(q, k, v, lam, lam_init, subln_g, rel_bias)
    o_four = fourier_mix(f_in, w_fourier)
    o_mem = memory_attention(mq, mem, w_mem_kv)
    o = jnp.concatenate([o_diff, o_four, o_mem], axis=-1)
    return o @ w_out


def hier_moe(h, w_group, b_group, w_router, b_router, w1, w3, w2):
    B, S, D = h.shape
    N = B * S
    t = h.reshape(N, D)
    tf = t.astype(F32)
    g_logits = tf @ w_group.astype(F32) + b_group.astype(F32)
    g_prob = jax.nn.softmax(g_logits, axis=-1)
    g_sel = jnp.argmax(g_logits, axis=-1)
    g_gate = jnp.take_along_axis(g_prob, g_sel[:, None], axis=-1)
    e_logits = (tf @ w_router.astype(F32) + b_router.astype(F32)).reshape(N, N_GROUPS, EXPERTS_PER_GROUP)
    e_in_group = jnp.take_along_axis(e_logits, g_sel[:, None, None], axis=1)[:, 0]
    top_val, top_idx = lax.top_k(e_in_group, TOP_K)
    top_w = jax.nn.softmax(top_val, axis=-1) * g_gate
    expert_id = g_sel[:, None] * EXPERTS_PER_GROUP + top_idx
    gates = jnp.sum(jax.nn.one_hot(expert_id, N_EXPERTS, dtype=F32) * top_w[..., None], axis=1)
    out = jnp.zeros((N, D), F32)
    for e in range(N_EXPERTS):
        hid = jax.nn.silu(t @ w1[e]) * (t @ w3[e])
        out = out + gates[:, e:e + 1] * (hid @ w2[e]).astype(F32)
    return out.reshape(B, S, D).astype(h.dtype)


def setup_inputs(seed: int = 0) -> dict:
    key = jax.random.key(seed)
    ks = jax.random.split(key, 32)

    def nrm(k, shape, s):
        return jax.random.normal(k, shape, jnp.float32) * s

    D = D_MODEL
    x = nrm(ks[0], (BATCH, SEQ, D), 1.0)
    mem = nrm(ks[1], (BATCH, MEM_LEN, D), 1.0)
    ln0_g = 1.0 + nrm(ks[2], (D,), 0.02)
    ln0_b = nrm(ks[3], (D,), 0.02)
    rel_bias = nrm(ks[4], (N_BUCKETS, DIFF_HEADS), 0.5)
    col_scale = jnp.concatenate([
        jnp.ones((2 * DIFF_WIDTH,), jnp.float32),
        jnp.full((DIFF_WIDTH,), DEEPNORM_BETA, jnp.float32),
        jnp.ones((FOURIER_WIDTH + MEM_WIDTH,), jnp.float32)])
    w_in = nrm(ks[5], (DEPTH, D, IN_COLS), D ** -0.5) * col_scale
    mem_scale = jnp.concatenate([jnp.ones((MEM_WIDTH,), jnp.float32),
                                 jnp.full((MEM_WIDTH,), DEEPNORM_BETA, jnp.float32)])
    w_mem_kv = nrm(ks[6], (DEPTH, D, 2 * MEM_WIDTH), D ** -0.5) * mem_scale
    w_fourier = nrm(ks[7], (DEPTH, FOURIER_GROUPS, FOURIER_GROUP_DIM, FOURIER_GROUP_DIM), FOURIER_GROUP_DIM ** -0.5)
    lambda_q1 = nrm(ks[8], (DEPTH, DIFF_HEAD_DIM), 0.1)
    lambda_k1 = nrm(ks[9], (DEPTH, DIFF_HEAD_DIM), 0.1)
    lambda_q2 = nrm(ks[10], (DEPTH, DIFF_HEAD_DIM), 0.1)
    lambda_k2 = nrm(ks[11], (DEPTH, DIFF_HEAD_DIM), 0.1)
    subln_g = 1.0 + nrm(ks[12], (DEPTH, 2 * DIFF_HEAD_DIM), 0.02)
    w_out = nrm(ks[13], (DEPTH, D_MIX, D), D_MIX ** -0.5 * DEEPNORM_BETA)
    ln1_g = 1.0 + nrm(ks[14], (DEPTH, D), 0.02)
    ln1_b = nrm(ks[15], (DEPTH, D), 0.02)
    w_group = nrm(ks[16], (DEPTH, D, N_GROUPS), D ** -0.5)
    b_group = nrm(ks[17], (DEPTH, N_GROUPS), 0.01)
    w_router = nrm(ks[18], (DEPTH, D, N_EXPERTS), D ** -0.5)
    b_router = nrm(ks[19], (DEPTH, N_EXPERTS), 0.01)
    w1 = nrm(ks[20], (DEPTH, N_EXPERTS, D, D_EXPERT), D ** -0.5)
    w3 = nrm(ks[21], (DEPTH, N_EXPERTS, D, D_EXPERT), D ** -0.5)
    w2 = nrm(ks[22], (DEPTH, N_EXPERTS, D_EXPERT, D), D_EXPERT ** -0.5 * DEEPNORM_BETA)
    ln2_g = 1.0 + nrm(ks[23], (DEPTH, D), 0.02)
    ln2_b = nrm(ks[24], (DEPTH, D), 0.02)
    return {"x": x, "mem": mem, "ln0_g": ln0_g, "ln0_b": ln0_b, "rel_bias": rel_bias,
            "w_in": w_in, "w_mem_kv": w_mem_kv, "w_fourier": w_fourier,
            "lambda_q1": lambda_q1, "lambda_k1": lambda_k1, "lambda_q2": lambda_q2, "lambda_k2": lambda_k2,
            "subln_g": subln_g, "w_out": w_out, "ln1_g": ln1_g, "ln1_b": ln1_b,
            "w_group": w_group, "b_group": b_group, "w_router": w_router, "b_router": b_router,
            "w1": w1, "w3": w3, "w2": w2, "ln2_g": ln2_g, "ln2_b": ln2_b}


def reference(x, mem, ln0_g, ln0_b, rel_bias, w_in, w_mem_kv, w_fourier,
              lambda_q1, lambda_k1, lambda_q2, lambda_k2, subln_g, w_out, ln1_g, ln1_b,
              w_group, b_group, w_router, b_router, w1, w3, w2, ln2_g, ln2_b):
    h = layer_norm(x, ln0_g, ln0_b)
    for l in range(DEPTH):
        lam_init = 0.8 - 0.6 * math.exp(-0.3 * l)
        a = hybrid_mixer(h, mem, w_in[l], w_mem_kv[l], w_fourier[l],
                         lambda_q1[l], lambda_k1[l], lambda_q2[l], lambda_k2[l],
                         subln_g[l], w_out[l], rel_bias, lam_init)
        h = layer_norm(DEEPNORM_ALPHA * h + a, ln1_g[l], ln1_b[l])
        f = hier_moe(h, w_group[l], b_group[l], w_router[l], b_router[l], w1[l], w3[l], w2[l])
        h = layer_norm(DEEPNORM_ALPHA * h + f, ln2_g[l], ln2_b[l])
    return h
```

```cpp
#include <hip/hip_runtime.h>
#include <stdint.h>

#define DI __device__ __forceinline__
typedef unsigned short bf16_t;
typedef float f32x4 __attribute__((ext_vector_type(4)));
typedef unsigned u32x4 __attribute__((ext_vector_type(4)));
typedef unsigned u32x2 __attribute__((ext_vector_type(2)));

constexpr int NB = 4, SEQ = 4096, DM = 1024, NTOK = NB * SEQ;
constexpr int NEXP = 32, DEXP = 256, MEMLEN = 256;
constexpr int NIN = 2304;
constexpr float LOG2E = 1.4426950408889634f;
constexpr float C2 = 0.125f * LOG2E;
constexpr float ALPHA = 1.189207115002721f;
constexpr float LN_EPS = 1e-5f;
constexpr float LAM_INIT = 0.2f;

constexpr size_t MiB = 1u << 20;
constexpr size_t WS_CTL = 0, CTL_BYTES = 1 * MiB;
constexpr size_t WS_WINT = 1 * MiB;
constexpr size_t WS_WOT = 6 * MiB;
constexpr size_t WS_WMT = 8 * MiB;
constexpr size_t WS_MEMB = 9 * MiB;
constexpr size_t WS_WR = 11 * MiB;
constexpr size_t WS_COSTAB = 11 * MiB + 256 * 1024;
constexpr size_t WS_STATS0 = 11 * MiB + 512 * 1024;
constexpr size_t WS_MKV = 12 * MiB;
constexpr size_t WS_TOKINFO = 13 * MiB;
constexpr size_t WS_LIST = 14 * MiB;
constexpr size_t WS_W13T = 16 * MiB;
constexpr size_t WS_W2T = 48 * MiB;
constexpr size_t WS_XN = 64 * MiB;
constexpr size_t WS_OB = 96 * MiB;
constexpr size_t WS_QB = 128 * MiB, WS_KB = 144 * MiB, WS_VB = 160 * MiB, WS_MQB = 176 * MiB, WS_ZB = 184 * MiB;
constexpr size_t WS_AOUT = 128 * MiB;
constexpr size_t WS_Y = 128 * MiB;
constexpr int CW_CNT = 64;

struct Params {
    const float* in[25];
    float* out;
    unsigned char* ws;
};
enum { I_X = 0, I_MEM, I_LN0G, I_LN0B, I_RELB, I_WIN, I_WMKV, I_WF, I_LQ1, I_LK1, I_LQ2, I_LK2, I_SUBG, I_WOUT, I_LN1G, I_LN1B,
       I_WG, I_BG, I_WRT, I_BRT, I_W1, I_W3, I_W2, I_LN2G, I_LN2B };

DI float bf2f(bf16_t v) { return __uint_as_float(((unsigned)v) << 16); }
DI unsigned f2bf(float f) { unsigned u = __float_as_uint(f); return (u + 0x7fffu + ((u >> 16) & 1u)) >> 16; }
DI unsigned pk2(float lo, float hi) { return f2bf(lo) | (f2bf(hi) << 16); }
DI float wave_sum(float v) {
#pragma unroll
    for (int o = 1; o < 64; o <<= 1) v += __shfl_xor(v, o);
    return v;
}
DI int t5_bucket(int rel) {
    const int n = rel < 0 ? -rel : rel;
    int b;
    if (n < 8) b = n; else if (n < 12) b = 8; else if (n < 16) b = 9; else if (n < 23) b = 10; else if (n < 32) b = 11;
    else if (n < 46) b = 12; else if (n < 64) b = 13; else if (n < 91) b = 14; else b = 15;
    return b + (rel > 0 ? 16 : 0);
}

DI void transpose_item(const float* W, int ldw, bf16_t* WT, int ldt, float scale, float* scr, int k0, int n0, int lane) {
#pragma unroll 8
    for (int i = 0; i < 32; ++i) { const int kk = 2 * i + (lane >> 5); scr[kk * 33 + (lane & 31)] = W[(size_t)(k0 + kk) * ldw + n0 + (lane & 31)] * scale; }
    asm volatile("s_waitcnt lgkmcnt(0)" ::: "memory");
    const int c = lane & 7;
#pragma unroll
    for (int j = 0; j < 4; ++j) { const int n = (lane >> 3) + 8 * j; const float* s = scr + (8 * c) * 33 + n;
        u32x4 o; o.x = pk2(s[0 * 33], s[1 * 33]); o.y = pk2(s[2 * 33], s[3 * 33]); o.z = pk2(s[4 * 33], s[5 * 33]); o.w = pk2(s[6 * 33], s[7 * 33]);
        *(u32x4*)(WT + (size_t)n * ldt + k0 + 8 * c) = o; }
    asm volatile("s_waitcnt lgkmcnt(0)" ::: "memory");
}

DI void p0_prologue(const Params& p, float* lds, int gw, int NGW, int wave, int lane) {
    unsigned char* ws = p.ws;
    bf16_t* WinT = (bf16_t*)(ws + WS_WINT); bf16_t* WoT = (bf16_t*)(ws + WS_WOT); bf16_t* WmT = (bf16_t*)(ws + WS_WMT);
    bf16_t* W13T = (bf16_t*)(ws + WS_W13T); bf16_t* W2T = (bf16_t*)(ws + WS_W2T);
    float* scr = lds + wave * (64 * 33);
    const float* w_in = p.in[I_WIN];
    constexpr int S0 = 256, S1 = 512, S2 = 768, S3 = 896, S4 = 1408, S5 = 1664, S6 = S5 + 4096, S7 = S6 + 4096, S8 = S7 + 4096;
    for (int it = gw; it < S8; it += NGW) {
        if (it < S3) {
            int seg, r;
            if (it < S0) { seg = 0; r = it; } else if (it < S1) { seg = 1; r = it - S0; } else if (it < S2) { seg = 2; r = it - S1; } else { seg = 3; r = it - S2; }
            const int ncb = (seg == 3) ? 8 : 16;
            const int kb = r / ncb, nb = r % ncb;
            const int coff = (seg == 3) ? 1792 : seg * 512, roff = (seg == 3) ? 1536 : seg * 512;
            const float sc = (seg == 0 || seg == 3) ? C2 : 1.0f;
            transpose_item(w_in + coff, 2048, WinT + (size_t)(roff + nb * 32) * 1024, 1024, sc, scr, kb * 64, nb * 32, lane);
        } else if (it < S4) { const int r = it - S3, kb = r / 32, nb = r % 32;
            transpose_item(p.in[I_WOUT], 1024, WoT + (size_t)(nb * 32) * 1024, 1024, 1.f, scr, kb * 64, nb * 32, lane);
        } else if (it < S5) { const int r = it - S4, kb = r / 16, nb = r % 16;
            transpose_item(p.in[I_WMKV], 512, WmT + (size_t)(nb * 32) * 1024, 1024, 1.f, scr, kb * 64, nb * 32, lane);
        } else if (it < S7) { const bool is3 = it >= S6; const int r = it - (is3 ? S6 : S5), e = r / 128, q = r % 128, kb = q / 8, nb = q % 8, n0 = nb * 32;
            const float* W = (is3 ? p.in[I_W3] : p.in[I_W1]) + (size_t)e * 1024 * 256;
            const int drow = e * 512 + (n0 >> 7) * 256 + (is3 ? 128 : 0) + (n0 & 127);
            transpose_item(W, 256, W13T + (size_t)drow * 1024, 1024, 1.f, scr, kb * 64, n0, lane);
        } else { const int r = it - S7, e = r / 128, q = r % 128, kb = q / 32, nb = q % 32;
            const float* W = p.in[I_W2] + (size_t)e * 256 * 1024;
            transpose_item(W, 1024, W2T + (size_t)(e * 1024 + nb * 32) * 256, 256, 1.f, scr, kb * 64, nb * 32, lane);
        }
    }
    {
        bf16_t* XN = (bf16_t*)(ws + WS_XN); float* st = (float*)(ws + WS_STATS0);
        const f32x4* g4 = (const f32x4*)p.in[I_LN0G] + lane; const f32x4* b4 = (const f32x4*)p.in[I_LN0B] + lane;
        for (int m = gw; m < NTOK; m += NGW) {
            const f32x4* xr = (const f32x4*)(p.in[I_X] + (size_t)m * DM) + lane;
            f32x4 v[4]; float s = 0.f;
#pragma unroll
            for (int j = 0; j < 4; ++j) { v[j] = xr[64 * j]; s += (v[j].x + v[j].y) + (v[j].z + v[j].w); }
            const float mean = wave_sum(s) * (1.f / DM); float s2 = 0.f;
#pragma unroll
            for (int j = 0; j < 4; ++j) { v[j] = v[j] - mean; s2 += (v[j].x * v[j].x + v[j].y * v[j].y) + (v[j].z * v[j].z + v[j].w * v[j].w); }
            const float rstd = 1.f / sqrtf(wave_sum(s2) * (1.f / DM) + LN_EPS);
            if (lane == 0) { st[2 * m] = mean; st[2 * m + 1] = rstd; }
            u32x2* o8 = (u32x2*)(XN + (size_t)m * DM) + lane;
#pragma unroll
            for (int j = 0; j < 4; ++j) { const f32x4 g = g4[64 * j], b = b4[64 * j]; const f32x4 y = v[j] * rstd * g + b; u32x2 w; w.x = pk2(y.x, y.y); w.y = pk2(y.z, y.w); o8[64 * j] = w; }
        }
    }
    {
        bf16_t* MB = (bf16_t*)(ws + WS_MEMB);
        for (int m = gw; m < NB * MEMLEN; m += NGW) {
            const f32x4* xr = (const f32x4*)(p.in[I_MEM] + (size_t)m * DM) + lane; u32x2* o8 = (u32x2*)(MB + (size_t)m * DM) + lane;
#pragma unroll
            for (int j = 0; j < 4; ++j) { const f32x4 y = xr[64 * j]; u32x2 w; w.x = pk2(y.x, y.y); w.y = pk2(y.z, y.w); o8[64 * j] = w; }
        }
    }
    {
        const float* wf = p.in[I_WF];
        for (int it = gw; it < 1024 * 4; it += NGW) {
            const int k = it >> 2, g = it & 3;
            const float wv = w_in[(size_t)k * 2048 + 1536 + g * 64 + lane];
            float ta = 0.f, tb = 0.f;
            for (int c = 0; c < 64; ++c) { const float wc = __shfl(wv, c); const float ang = (float)((c * lane) & 63) * (1.0f / 32.0f); ta += wc * cospif(ang); tb += wc * sinpif(ang); }
            float orr = 0.f, oi = 0.f;
            for (int c = 0; c < 64; ++c) { const float w = wf[(size_t)(g * 64 + c) * 64 + lane]; orr += __shfl(ta, c) * w; oi += __shfl(tb, c) * w; }
            WinT[(size_t)(1792 + g * 64 + lane) * 1024 + k] = (bf16_t)f2bf(orr * (1.0f / 512.0f));
            WinT[(size_t)(2048 + g * 64 + lane) * 1024 + k] = (bf16_t)f2bf(oi * (1.0f / 512.0f));
        }
    }
    {
        float* WR = (float*)(ws + WS_WR); float* ct = (float*)(ws + WS_COSTAB);
        const int gt = gw * 64 + lane, NGT = NGW * 64;
        for (int i = gt; i < 36 * 1024; i += NGT) { const int e = i >> 10, k = i & 1023; WR[i] = e < 4 ? p.in[I_WG][k * 4 + e] : p.in[I_WRT][k * 32 + (e - 4)]; }
        for (int i = gt; i < 4096; i += NGT) ct[i] = cospif((float)i * (1.0f / 2048.0f));
    }
}
__global__ void __launch_bounds__(256) k_p0(Params p) {
    __shared__ float lds[4 * 64 * 33];
    const int wave = threadIdx.x >> 6, lane = threadIdx.x & 63;
    p0_prologue(p, lds, blockIdx.x * 4 + wave, gridDim.x * 4, wave, lane);
}

template <bool DUAL, bool BKN, class LA, class LB, class EP>
DI void ngemm_tile(float* As, float* Bs, float* Bs2, int K, const LA& la, const LB& lb, const LB& lb2, const EP& ep) {
    const int tid = threadIdx.x, ty = tid >> 4, tx = tid & 15;
    float acc[4][4], acc2[4][4];
#pragma unroll
    for (int i = 0; i < 4; ++i)
#pragma unroll
        for (int j = 0; j < 4; ++j) { acc[i][j] = 0.f; acc2[i][j] = 0.f; }
    for (int kc = 0; kc < K; kc += 32) {
        __syncthreads();
#pragma unroll
        for (int j = 0; j < 8; ++j) { const int i = tid + 512 * j, k = i & 31, r = i >> 5; As[k * 132 + r] = la(r, kc + k); }
#pragma unroll
        for (int j = 0; j < 4; ++j) { const int i = tid + 512 * j; int k, n; if (BKN) { n = i & 63; k = i >> 6; } else { k = i & 31; n = i >> 5; }
            Bs[k * 68 + n] = lb(kc + k, n); if (DUAL) Bs2[k * 68 + n] = lb2(kc + k, n); }
        __syncthreads();
#pragma unroll 8
        for (int k = 0; k < 32; ++k) {
            const f32x4 a = *(const f32x4*)&As[k * 132 + ty * 4]; const f32x4 b = *(const f32x4*)&Bs[k * 68 + tx * 4];
#pragma unroll
            for (int i = 0; i < 4; ++i)
#pragma unroll
                for (int j = 0; j < 4; ++j) acc[i][j] += a[i] * b[j];
            if (DUAL) { const f32x4 b2 = *(const f32x4*)&Bs2[k * 68 + tx * 4];
#pragma unroll
                for (int i = 0; i < 4; ++i)
#pragma unroll
                    for (int j = 0; j < 4; ++j) acc2[i][j] += a[i] * b2[j]; }
        }
    }
#pragma unroll
    for (int i = 0; i < 4; ++i)
#pragma unroll
        for (int j = 0; j < 4; ++j) ep(ty * 4 + i, tx * 4 + j, acc[i][j], acc2[i][j]);
}

struct LA_bf { const bf16_t* A; int lda; DI float operator()(int r, int k) const { return bf2f(A[(size_t)r * lda + k]); } };
struct LB_bf { const bf16_t* B; int ldb; DI float operator()(int k, int n) const { return bf2f(B[(size_t)n * ldb + k]); } };
struct EP_inproj { unsigned char* ws; int m0, n0;
    DI void operator()(int r, int n, float v, float) const { const int row = m0 + r, c = n0 + n; bf16_t* dst;
        if (c < 512) dst = (bf16_t*)(ws + WS_QB) + (size_t)row * 512 + c; else if (c < 1024) dst = (bf16_t*)(ws + WS_KB) + (size_t)row * 512 + (c - 512);
        else if (c < 1536) dst = (bf16_t*)(ws + WS_VB) + (size_t)row * 512 + (c - 1024); else if (c < 1792) dst = (bf16_t*)(ws + WS_MQB) + (size_t)row * 256 + (c - 1536);
        else dst = (bf16_t*)(ws + WS_ZB) + (size_t)row * 512 + (c - 1792);
        *dst = (bf16_t)f2bf(v); } };
struct EP_bf { bf16_t* C; int ldc; int m0, n0; DI void operator()(int r, int n, float v, float) const { C[(size_t)(m0 + r) * ldc + n0 + n] = (bf16_t)f2bf(v); } };
struct EP_f32 { float* C; int ldc; int m0, n0; DI void operator()(int r, int n, float v, float) const { C[(size_t)(m0 + r) * ldc + n0 + n] = v; } };

__global__ void __launch_bounds__(512) k_ngemm(Params p, int mode) {
    __shared__ float As[32 * 132]; __shared__ float Bs[32 * 68];
    unsigned char* ws = p.ws;
    const bf16_t* A; const bf16_t* Bt; int M, N;
    if (mode == 0) { A = (const bf16_t*)(ws + WS_XN); Bt = (const bf16_t*)(ws + WS_WINT); M = NTOK; N = NIN; }
    else if (mode == 1) { A = (const bf16_t*)(ws + WS_MEMB); Bt = (const bf16_t*)(ws + WS_WMT); M = NB * MEMLEN; N = 512; }
    else { A = (const bf16_t*)(ws + WS_OB); Bt = (const bf16_t*)(ws + WS_WOT); M = NTOK; N = DM; }
    const int nN = N / 64, nT = (M / 128) * nN;
    for (int t = blockIdx.x; t < nT; t += gridDim.x) {
        const int m0 = (t / nN) * 128, n0 = (t % nN) * 64;
        LA_bf la{A + (size_t)m0 * 1024, 1024}; LB_bf lb{Bt + (size_t)n0 * 1024, 1024};
        if (mode == 0) { EP_inproj ep{ws, m0, n0}; ngemm_tile<false, false>(As, Bs, Bs, 1024, la, lb, lb, ep); }
        else if (mode == 1) { EP_bf ep{(bf16_t*)(ws + WS_MKV), 512, m0, n0}; ngemm_tile<false, false>(As, Bs, Bs, 1024, la, lb, lb, ep); }
        else { EP_f32 ep{(float*)(ws + WS_AOUT), 1024, m0, n0}; ngemm_tile<false, false>(As, Bs, Bs, 1024, la, lb, lb, ep); }
    }
}

struct LA_dft { const float* ct; int s0; DI float operator()(int r, int k) const { const int sp = s0 + r, s = k & 4095; const int idx = (s * sp) & 4095;
    return (k < 4096) ? ct[idx] : -ct[(idx - 1024) & 4095]; } };
struct LB_z { const bf16_t* Z; int n0; DI float operator()(int k, int n) const { return bf2f(Z[(size_t)(k & 4095) * 512 + (k >> 12) * 256 + n0 + n]); } };
struct EP_ob { bf16_t* O; int row0, col0; DI void operator()(int r, int n, float v, float) const { O[(size_t)(row0 + r) * 1024 + col0 + n] = (bf16_t)f2bf(v); } };
__global__ void __launch_bounds__(512) k_nfourier(Params p) {
    __shared__ float As[32 * 132]; __shared__ float Bs[32 * 68];
    unsigned char* ws = p.ws; const float* ct = (const float*)(ws + WS_COSTAB);
    const int nT = NB * 32 * 4;
    for (int t = blockIdx.x; t < nT; t += gridDim.x) {
        const int b = t / 128, q = t % 128, s0 = (q / 4) * 128, n0 = (q % 4) * 64;
        LA_dft la{ct, s0}; LB_z lb{(const bf16_t*)(ws + WS_ZB) + (size_t)b * SEQ * 512, n0}; EP_ob ep{(bf16_t*)(ws + WS_OB), b * SEQ + s0, 512 + n0};
        ngemm_tile<false, true>(As, Bs, Bs, 8192, la, lb, lb, ep);
    }
}

template <int NCOMP, int DV, bool DIFF>
__global__ void __launch_bounds__(256) k_nattn(Params p) {
    __shared__ float qs[NCOMP * 16 * 64]; __shared__ float ks[NCOMP * 32 * 65]; __shared__ float vs[32 * DV]; __shared__ float as_[4 * 4 * 32]; __shared__ float sh_lam; __shared__ float sh_rb[128];
    unsigned char* ws = p.ws;
    const int tid = threadIdx.x, wave = tid >> 6, lane = tid & 63, key = lane & 31, rh = lane >> 5;
    const int row0 = blockIdx.x * 16, h = blockIdx.y, b = row0 / SEQ;
    const bf16_t *Q, *Kp, *Vp; int qpitch, kpitch, vpitch, NK, ocol; size_t kbase;
    if (DIFF) { Q = (const bf16_t*)(ws + WS_QB) + h * 128; qpitch = 512; Kp = (const bf16_t*)(ws + WS_KB) + h * 128; kpitch = 512; Vp = (const bf16_t*)(ws + WS_VB) + h * 128; vpitch = 512; NK = SEQ; ocol = h * 128; kbase = (size_t)b * SEQ; }
    else { Q = (const bf16_t*)(ws + WS_MQB) + h * 64; qpitch = 256; Kp = (const bf16_t*)(ws + WS_MKV) + h * 64; kpitch = 512; Vp = (const bf16_t*)(ws + WS_MKV) + 256 + h * 64; vpitch = 512; NK = MEMLEN; ocol = 768 + h * 64; kbase = (size_t)b * MEMLEN; }
    if (tid == 0) { float s1 = 0.f, s2 = 0.f; for (int i = 0; i < 64; ++i) { s1 += p.in[I_LQ1][i] * p.in[I_LK1][i]; s2 += p.in[I_LQ2][i] * p.in[I_LK2][i]; } sh_lam = expf(s1) - expf(s2) + LAM_INIT; }
    if (tid < 128) sh_rb[tid] = p.in[I_RELB][tid] * LOG2E;
    for (int i = tid; i < NCOMP * 16 * 64; i += 256) { const int c = i / 1024, r = (i >> 6) & 15, d = i & 63; qs[i] = bf2f(Q[(size_t)(row0 + r) * qpitch + c * 64 + d]); }
    __syncthreads();
    const float lam = sh_lam;
    float m[2][NCOMP], l[2][NCOMP];
#pragma unroll
    for (int rr = 0; rr < 2; ++rr)
#pragma unroll
        for (int c = 0; c < NCOMP; ++c) { m[rr][c] = -1e30f; l[rr][c] = 0.f; }
    const int NT = NK / 32;
    for (int t = 0; t < NT; ++t) {
        __syncthreads();
        for (int i = tid; i < NCOMP * 32 * 64; i += 256) { const int c = i / 2048, kk = (i >> 6) & 31, d = i & 63; ks[(c * 32 + kk) * 65 + d] = bf2f(Kp[(kbase + t * 32 + kk) * kpitch + c * 64 + d]); }
        __syncthreads();
#pragma unroll
        for (int rr = 0; rr < 2; ++rr) {
            const int r = wave * 4 + rh * 2 + rr;
            float bias = 0.f; if (DIFF) { const int qpos = (row0 + r) & (SEQ - 1), kpos = t * 32 + key; bias = sh_rb[t5_bucket(kpos - qpos) * 4 + h]; }
#pragma unroll
            for (int c = 0; c < NCOMP; ++c) {
                float s = 0.f; const float* qv = qs + (c * 16 + r) * 64; const float* kv = ks + (c * 32 + key) * 65;
#pragma unroll 16
                for (int d = 0; d < 64; ++d) s += qv[d] * kv[d];
                s += bias;
                const float mn = fmaxf(m[rr][c], s); l[rr][c] = l[rr][c] * exp2f(m[rr][c] - mn) + exp2f(s - mn); m[rr][c] = mn;
            }
        }
    }
#pragma unroll
    for (int rr = 0; rr < 2; ++rr)
#pragma unroll
        for (int c = 0; c < NCOMP; ++c)
#pragma unroll
            for (int o = 1; o < 32; o <<= 1) { const float m2 = __shfl_xor(m[rr][c], o), l2 = __shfl_xor(l[rr][c], o); const float mn = fmaxf(m[rr][c], m2);
                l[rr][c] = l[rr][c] * exp2f(m[rr][c] - mn) + l2 * exp2f(m2 - mn); m[rr][c] = mn; }
    float o[4][DV / 64];
#pragma unroll
    for (int r = 0; r < 4; ++r)
#pragma unroll
        for (int j = 0; j < DV / 64; ++j) o[r][j] = 0.f;
    for (int t = 0; t < NT; ++t) {
        __syncthreads();
        for (int i = tid; i < NCOMP * 32 * 64; i += 256) { const int c = i / 2048, kk = (i >> 6) & 31, d = i & 63; ks[(c * 32 + kk) * 65 + d] = bf2f(Kp[(kbase + t * 32 + kk) * kpitch + c * 64 + d]); }
        for (int i = tid; i < 32 * DV; i += 256) { const int kk = i / DV, d = i % DV; vs[i] = bf2f(Vp[(kbase + t * 32 + kk) * vpitch + d]); }
        __syncthreads();
#pragma unroll
        for (int rr = 0; rr < 2; ++rr) {
            const int r = wave * 4 + rh * 2 + rr;
            float bias = 0.f; if (DIFF) { const int qpos = (row0 + r) & (SEQ - 1), kpos = t * 32 + key; bias = sh_rb[t5_bucket(kpos - qpos) * 4 + h]; }
            float a = 0.f;
#pragma unroll
            for (int c = 0; c < NCOMP; ++c) {
                float s = 0.f; const float* qv = qs + (c * 16 + r) * 64; const float* kv = ks + (c * 32 + key) * 65;
#pragma unroll 16
                for (int d = 0; d < 64; ++d) s += qv[d] * kv[d];
                s += bias;
                const float pr = exp2f(s - m[rr][c]) / l[rr][c];
                a += (c == 0) ? pr : -lam * pr;
            }
            as_[(wave * 4 + rh * 2 + rr) * 32 + key] = a;
        }
        asm volatile("s_waitcnt lgkmcnt(0)" ::: "memory");
#pragma unroll
        for (int r = 0; r < 4; ++r) {
            const float* ar = as_ + (wave * 4 + r) * 32;
#pragma unroll 8
            for (int kk = 0; kk < 32; ++kk) { const float a = ar[kk];
#pragma unroll
                for (int j = 0; j < DV / 64; ++j) o[r][j] += a * vs[kk * DV + lane + 64 * j]; }
        }
        asm volatile("s_waitcnt lgkmcnt(0)" ::: "memory");
    }
    bf16_t* Ob = (bf16_t*)(ws + WS_OB);
#pragma unroll
    for (int r = 0; r < 4; ++r) {
        const int row = row0 + wave * 4 + r;
        if (DIFF) {
            float ss = 0.f;
#pragma unroll
            for (int j = 0; j < DV / 64; ++j) ss += o[r][j] * o[r][j];
            ss = wave_sum(ss);
            const float rn = 1.0f / sqrtf(ss * (1.0f / DV) + LN_EPS) * (1.0f - LAM_INIT);
#pragma unroll
            for (int j = 0; j < DV / 64; ++j) Ob[(size_t)row * 1024 + ocol + lane + 64 * j] = (bf16_t)f2bf(o[r][j] * rn * p.in[I_SUBG][lane + 64 * j]);
        } else {
#pragma unroll
            for (int j = 0; j < DV / 64; ++j) Ob[(size_t)row * 1024 + ocol + lane + 64 * j] = (bf16_t)f2bf(o[r][j]);
        }
    }
}

DI void p4_ln1_router(const Params& p, float* lds  , int gw, int NGW, int wave, int lane) {
    unsigned char* ws = p.ws;
    const float* Aout = (const float*)(ws + WS_AOUT); const float* st0 = (const float*)(ws + WS_STATS0); bf16_t* H1 = (bf16_t*)(ws + WS_XN);
    const float* WR = (const float*)(ws + WS_WR); unsigned* cnt = (unsigned*)(ws + WS_CTL) + CW_CNT; int* info = (int*)(ws + WS_TOKINFO); int* list = (int*)(ws + WS_LIST);
    float* lg = lds + wave * (8 * 36);
    for (int grp = gw; grp < NTOK / 8; grp += NGW) {
        f32x4 hv[8][4];
#pragma unroll
        for (int r = 0; r < 8; ++r) {
            const int row = grp * 8 + r;
            const float mu0 = st0[2 * row], rs0 = st0[2 * row + 1];
            const f32x4* xr = (const f32x4*)(p.in[I_X] + (size_t)row * DM) + lane; const f32x4* ar = (const f32x4*)(Aout + (size_t)row * DM) + lane;
            float s = 0.f;
#pragma unroll
            for (int j = 0; j < 4; ++j) { const f32x4 g = ((const f32x4*)p.in[I_LN0G])[lane + 64 * j], bb = ((const f32x4*)p.in[I_LN0B])[lane + 64 * j];
                const f32x4 h0 = (xr[64 * j] - mu0) * rs0 * g + bb; hv[r][j] = h0 * ALPHA + ar[64 * j]; s += (hv[r][j].x + hv[r][j].y) + (hv[r][j].z + hv[r][j].w); }
            const float mean = wave_sum(s) * (1.f / DM); float s2 = 0.f;
#pragma unroll
            for (int j = 0; j < 4; ++j) { hv[r][j] = hv[r][j] - mean; s2 += (hv[r][j].x * hv[r][j].x + hv[r][j].y * hv[r][j].y) + (hv[r][j].z * hv[r][j].z + hv[r][j].w * hv[r][j].w); }
            const float rstd = 1.f / sqrtf(wave_sum(s2) * (1.f / DM) + LN_EPS);
            u32x2* o8 = (u32x2*)(H1 + (size_t)row * DM) + lane;
#pragma unroll
            for (int j = 0; j < 4; ++j) { const f32x4 g = ((const f32x4*)p.in[I_LN1G])[lane + 64 * j], bb = ((const f32x4*)p.in[I_LN1B])[lane + 64 * j];
                hv[r][j] = hv[r][j] * rstd * g + bb; u32x2 w; w.x = pk2(hv[r][j].x, hv[r][j].y); w.y = pk2(hv[r][j].z, hv[r][j].w); o8[64 * j] = w; }
        }
#pragma unroll 1
        for (int e = 0; e < 36; ++e) {
            const f32x4* wr = (const f32x4*)(WR + (size_t)e * 1024) + lane;
            const f32x4 w0 = wr[0], w1 = wr[64], w2 = wr[128], w3 = wr[192];
#pragma unroll
            for (int r = 0; r < 8; ++r) {
                f32x4 t = hv[r][0] * w0 + hv[r][1] * w1 + hv[r][2] * w2 + hv[r][3] * w3;
                float s = wave_sum((t.x + t.y) + (t.z + t.w));
                if (lane == 0) lg[r * 36 + e] = s;
            }
        }
        asm volatile("s_waitcnt lgkmcnt(0)" ::: "memory");
        if (lane < 8) {
            const int row = grp * 8 + lane; const float* L = lg + lane * 36;
            float gl[4]; int gs = 0; float gm;
#pragma unroll
            for (int j = 0; j < 4; ++j) gl[j] = L[j] + p.in[I_BG][j];
            gm = gl[0];
#pragma unroll
            for (int j = 1; j < 4; ++j) if (gl[j] > gm) { gm = gl[j]; gs = j; }
            float den = 0.f;
#pragma unroll
            for (int j = 0; j < 4; ++j) den += expf(gl[j] - gm);
            const float gate = 1.0f / den;
            float v0 = -1e30f, v1 = -1e30f; int i0 = 0, i1 = 0;
#pragma unroll
            for (int j = 0; j < 8; ++j) { const float v = L[4 + gs * 8 + j] + p.in[I_BRT][gs * 8 + j];
                if (v > v0) { v1 = v0; i1 = i0; v0 = v; i0 = j; } else if (v > v1) { v1 = v; i1 = j; } }
            const float ex = expf(v1 - v0); const float w0 = gate / (1.f + ex), w1 = gate * ex / (1.f + ex);
            const int e0 = gs * 8 + i0, e1 = gs * 8 + i1;
            const unsigned p0 = atomicAdd(cnt + e0, 1u), p1 = atomicAdd(cnt + e1, 1u);
            list[e0 * NTOK + p0] = row; list[e1 * NTOK + p1] = row;
            int* ii = info + (size_t)row * 8; ii[0] = e0; ii[1] = (int)p0; ii[2] = __float_as_int(w0); ii[3] = e1; ii[4] = (int)p1; ii[5] = __float_as_int(w1);
        }
        asm volatile("s_waitcnt lgkmcnt(0)" ::: "memory");
    }
}
__global__ void __launch_bounds__(512) k_p4(Params p) {
    __shared__ float lds[8 * 8 * 36];
    const int wave = threadIdx.x >> 6, lane = threadIdx.x & 63;
    p4_ln1_router(p, lds, blockIdx.x * 8 + wave, gridDim.x * 8, wave, lane);
}

struct LA_gather { const bf16_t* H; const int* tok; DI float operator()(int r, int k) const { return bf2f(H[(size_t)tok[r] * 1024 + k]); } };
struct EP_hid { bf16_t* HID; int slot0, nvalid, n0; DI void operator()(int r, int n, float v1, float v3) const { if (r < nvalid) { const float s = v1 / (1.0f + expf(-v1)); HID[(size_t)(slot0 + r) * 256 + n0 + n] = (bf16_t)f2bf(s * v3); } } };
struct EP_y { bf16_t* Y; int slot0, nvalid, n0; DI void operator()(int r, int n, float v, float) const { if (r < nvalid) Y[(size_t)(slot0 + r) * 1024 + n0 + n] = (bf16_t)f2bf(v); } };
__global__ void __launch_bounds__(512) k_nmoe(Params p, int which) {
    __shared__ float As[32 * 132]; __shared__ float Bs[32 * 68]; __shared__ float Bs2[32 * 68]; __shared__ int s_tok[128]; __shared__ int s_cnt[32], s_tpre[33], s_base[33];
    unsigned char* ws = p.ws; const unsigned* cnt = (const unsigned*)(ws + WS_CTL) + CW_CNT; const int* list = (const int*)(ws + WS_LIST);
    const int tid = threadIdx.x;
    if (tid == 0) { int tp = 0, bs = 0; for (int e = 0; e < 32; ++e) { const int c = (int)cnt[e]; s_cnt[e] = c; s_tpre[e] = tp; s_base[e] = bs; tp += (c + 127) >> 7; bs += (c + 255) & ~255; } s_tpre[32] = tp; s_base[32] = bs; }
    __syncthreads();
    const int NT = which == 0 ? 4 : 16, total = s_tpre[32] * NT;
    for (int u = blockIdx.x; u < total; u += gridDim.x) {
        const int T = u / NT, nt = u % NT; int e = 0; while (s_tpre[e + 1] <= T) ++e;
        const int mt = T - s_tpre[e], nvalid = min(128, s_cnt[e] - mt * 128), slot0 = s_base[e] + mt * 128;
        if (which == 0) {
            __syncthreads();
            if (tid < 128) s_tok[tid] = (tid < nvalid) ? list[e * NTOK + mt * 128 + tid] : 0;
            __syncthreads();
            const int j0 = nt * 64;
            const int r1 = e * 512 + (j0 >> 7) * 256 + (j0 & 127);
            LA_gather la{(const bf16_t*)(ws + WS_XN), s_tok}; LB_bf lb{(const bf16_t*)(ws + WS_W13T) + (size_t)r1 * 1024, 1024}; LB_bf lb2{(const bf16_t*)(ws + WS_W13T) + (size_t)(r1 + 128) * 1024, 1024};
            EP_hid ep{(bf16_t*)(ws + WS_OB), slot0, nvalid, j0};
            ngemm_tile<true, false>(As, Bs, Bs2, 1024, la, lb, lb2, ep);
        } else {
            LA_bf la{(const bf16_t*)(ws + WS_OB) + (size_t)slot0 * 256, 256}; LB_bf lb{(const bf16_t*)(ws + WS_W2T) + (size_t)(e * 1024 + nt * 64) * 256, 256};
            EP_y ep{(bf16_t*)(ws + WS_Y), slot0, nvalid, nt * 64};
            ngemm_tile<false, false>(As, Bs, Bs, 256, la, lb, lb, ep);
        }
    }
}

DI void p7_final(const Params& p, int gw, int NGW, int lane) {
    unsigned char* ws = p.ws; const unsigned* cnt = (const unsigned*)(ws + WS_CTL) + CW_CNT; const int* info = (const int*)(ws + WS_TOKINFO);
    const bf16_t* H1 = (const bf16_t*)(ws + WS_XN); const bf16_t* Y = (const bf16_t*)(ws + WS_Y);
    int base;
    { const int c = lane < 32 ? (int)cnt[lane] : 0; const int r = (c + 255) & ~255; int inc = r;
#pragma unroll
      for (int o = 1; o < 32; o <<= 1) { const int t = __shfl_up(inc, o); if ((lane & 31) >= o) inc += t; }
      base = inc - r; }
    for (int row = gw; row < NTOK; row += NGW) {
        const int* ii = info + (size_t)row * 8;
        const int e0 = ii[0], p0 = ii[1], e1 = ii[3], p1 = ii[4]; const float w0 = __int_as_float(ii[2]), w1 = __int_as_float(ii[5]);
        const size_t s0 = (size_t)(__shfl(base, e0) + p0), s1 = (size_t)(__shfl(base, e1) + p1);
        const u32x2* h8 = (const u32x2*)(H1 + (size_t)row * DM) + lane; const u32x2* y0 = (const u32x2*)(Y + s0 * DM) + lane; const u32x2* y1 = (const u32x2*)(Y + s1 * DM) + lane;
        f32x4 v[4]; float s = 0.f;
#pragma unroll
        for (int j = 0; j < 4; ++j) { const u32x2 a = h8[64 * j], b = y0[64 * j], c = y1[64 * j];
            v[j].x = ALPHA * __uint_as_float(a.x << 16) + w0 * __uint_as_float(b.x << 16) + w1 * __uint_as_float(c.x << 16);
            v[j].y = ALPHA * __uint_as_float(a.x & 0xffff0000u) + w0 * __uint_as_float(b.x & 0xffff0000u) + w1 * __uint_as_float(c.x & 0xffff0000u);
            v[j].z = ALPHA * __uint_as_float(a.y << 16) + w0 * __uint_as_float(b.y << 16) + w1 * __uint_as_float(c.y << 16);
            v[j].w = ALPHA * __uint_as_float(a.y & 0xffff0000u) + w0 * __uint_as_float(b.y & 0xffff0000u) + w1 * __uint_as_float(c.y & 0xffff0000u);
            s += (v[j].x + v[j].y) + (v[j].z + v[j].w); }
        const float mean = wave_sum(s) * (1.f / DM); float s2 = 0.f;
#pragma unroll
        for (int j = 0; j < 4; ++j) { v[j] = v[j] - mean; s2 += (v[j].x * v[j].x + v[j].y * v[j].y) + (v[j].z * v[j].z + v[j].w * v[j].w); }
        const float rstd = 1.f / sqrtf(wave_sum(s2) * (1.f / DM) + LN_EPS);
        f32x4* o = (f32x4*)(p.out + (size_t)row * DM) + lane;
#pragma unroll
        for (int j = 0; j < 4; ++j) { const f32x4 g = ((const f32x4*)p.in[I_LN2G])[lane + 64 * j], bb = ((const f32x4*)p.in[I_LN2B])[lane + 64 * j]; o[64 * j] = v[j] * rstd * g + bb; }
    }
}
__global__ void __launch_bounds__(512) k_p7(Params p) { p7_final(p, blockIdx.x * 8 + (threadIdx.x >> 6), gridDim.x * 8, threadIdx.x & 63); }

extern "C" void kernel_launch(void* const* d_in, const int* in_sizes, int n_in, void* d_out, int out_size, void* d_ws, size_t ws_size, hipStream_t stream) {
    Params p{};
    for (int i = 0; i < 25; ++i) p.in[i] = (const float*)d_in[i];
    p.out = (float*)d_out; p.ws = (unsigned char*)d_ws;
    (void)hipMemsetAsync((char*)d_ws + WS_CTL, 0, CTL_BYTES, stream);
    k_p0<<<1024, 256, 0, stream>>>(p);
    k_ngemm<<<2048, 512, 0, stream>>>(p, 0);
    k_ngemm<<<64, 512, 0, stream>>>(p, 1);
    k_nattn<2, 128, true><<<dim3(NTOK / 16, 4), 256, 0, stream>>>(p);
    k_nattn<1, 64, false><<<dim3(NTOK / 16, 4), 256, 0, stream>>>(p);
    k_nfourier<<<512, 512, 0, stream>>>(p);
    k_ngemm<<<2048, 512, 0, stream>>>(p, 2);
    k_p4<<<256, 512, 0, stream>>>(p);
    k_nmoe<<<1024, 512, 0, stream>>>(p, 0);
    k_nmoe<<<2048, 512, 0, stream>>>(p, 1);
    k_p7<<<512, 512, 0, stream>>>(p);
}
```

```cpp
#include <hip/hip_runtime.h>
#include <stdint.h>

#define DI __device__ __forceinline__
typedef unsigned short bf16_t;
typedef float f32x4 __attribute__((ext_vector_type(4)));
typedef unsigned u32x4 __attribute__((ext_vector_type(4)));
typedef unsigned u32x2 __attribute__((ext_vector_type(2)));

constexpr int NB = 4, SEQ = 4096, DM = 1024, NTOK = NB * SEQ;
constexpr int NEXP = 32, DEXP = 256, MEMLEN = 256;
constexpr int NIN = 2304;
constexpr float LOG2E = 1.4426950408889634f;
constexpr float C2 = 0.125f * LOG2E;
constexpr float ALPHA = 1.189207115002721f;
constexpr float LN_EPS = 1e-5f;
constexpr float LAM_INIT = 0.2f;

constexpr size_t MiB = 1u << 20;
constexpr size_t WS_CTL = 0, CTL_BYTES = 1 * MiB;
constexpr size_t WS_WINT = 1 * MiB;
constexpr size_t WS_WOT = 6 * MiB;
constexpr size_t WS_WMT = 8 * MiB;
constexpr size_t WS_MEMB = 9 * MiB;
constexpr size_t WS_WR = 11 * MiB;
constexpr size_t WS_COSTAB = 11 * MiB + 256 * 1024;
constexpr size_t WS_STATS0 = 11 * MiB + 512 * 1024;
constexpr size_t WS_MKV = 12 * MiB;
constexpr size_t WS_TOKINFO = 13 * MiB;
constexpr size_t WS_LIST = 14 * MiB;
constexpr size_t WS_W13T = 16 * MiB;
constexpr size_t WS_W2T = 48 * MiB;
constexpr size_t WS_XN = 64 * MiB;
constexpr size_t WS_OB = 96 * MiB;
constexpr size_t WS_QB = 128 * MiB, WS_KB = 144 * MiB, WS_VB = 160 * MiB, WS_MQB = 176 * MiB, WS_ZB = 184 * MiB;
constexpr size_t WS_AOUT = 128 * MiB;
constexpr size_t WS_Y = 128 * MiB;
constexpr int CW_CNT = 64;

struct Params {
    const float* in[25];
    float* out;
    unsigned char* ws;
};
enum { I_X = 0, I_MEM, I_LN0G, I_LN0B, I_RELB, I_WIN, I_WMKV, I_WF, I_LQ1, I_LK1, I_LQ2, I_LK2, I_SUBG, I_WOUT, I_LN1G, I_LN1B,
       I_WG, I_BG, I_WRT, I_BRT, I_W1, I_W3, I_W2, I_LN2G, I_LN2B };

DI float bf2f(bf16_t v) { return __uint_as_float(((unsigned)v) << 16); }
DI unsigned f2bf(float f) { unsigned u = __float_as_uint(f); return (u + 0x7fffu + ((u >> 16) & 1u)) >> 16; }
DI unsigned pk2(float lo, float hi) { return f2bf(lo) | (f2bf(hi) << 16); }
DI float wave_sum(float v) {
#pragma unroll
    for (int o = 1; o < 64; o <<= 1) v += __shfl_xor(v, o);
    return v;
}
DI int t5_bucket(int rel) {
    const int n = rel < 0 ? -rel : rel;
    int b;
    if (n < 8) b = n; else if (n < 12) b = 8; else if (n < 16) b = 9; else if (n < 23) b = 10; else if (n < 32) b = 11;
    else if (n < 46) b = 12; else if (n < 64) b = 13; else if (n < 91) b = 14; else b = 15;
    return b + (rel > 0 ? 16 : 0);
}


namespace pg8 {
#define PG8_LAS __attribute__((address_space(3)))
typedef unsigned short bf16_t;
typedef short bf16x8 __attribute__((ext_vector_type(8)));
typedef float f32x4 __attribute__((ext_vector_type(4)));
typedef unsigned u32x4 __attribute__((ext_vector_type(4)));
constexpr int BM = 256, BK = 64, HALF = 128, HTB = HALF * BK * 2  , STAGE_BYTES = 8 * HTB, NXCD = 8, WGM = 8;

__host__ __device__ __forceinline__ int lds_byte(int r, int c) { const int st = (r >> 4) * 2 + (c >> 5), rr = r & 15, cc = c & 31, ob = rr * 64 + cc * 2; return st * 1024 + (ob ^ (((ob >> 9) & 1) << 5)); }
__host__ __device__ __forceinline__ void stage_rc(int b, int& R, int& C) { const int st = b / 1024, sb = b % 1024, swz = sb ^ (((sb >> 9) & 1) << 5); R = (st >> 1) * 16 + swz / 64; C = (st & 1) * 32 + (swz % 64) / 2; }
__host__ __device__ __forceinline__ int perm32(int rho) { const int n = rho >> 4, i = rho & 15; return 8 * (i >> 2) + 4 * n + (i & 3); }

struct Unit { int pm, pn; };
struct Gemm { const bf16_t* A; const bf16_t* Bt; int M, N, K; };

struct StaticOrder {
    int nM, nN, nwg, G, c;
    __host__ __device__ void init(int M, int N, int G_, int c_) { nM = M / BM; nN = N / BM; nwg = nM * nN; G = G_; c = c_; }
    __host__ __device__ bool next(int i, Unit& u) const {
        const long L = (long)i * G + c; if (L >= nwg) return false;
        int wgid = (int)L; { const int q = nwg / NXCD, r = nwg % NXCD, xcd = wgid % NXCD, off = wgid / NXCD; wgid = (xcd < r ? xcd * (q + 1) : r * (q + 1) + (xcd - r) * q) + off; }
        const int nig = WGM * nN, gid = wgid / nig, fm = gid * WGM, gsz = (nM - fm) < WGM ? (nM - fm) : WGM;
        u.pm = fm + ((wgid % nig) % gsz); u.pn = (wgid % nig) / gsz; return true;
    }
    __device__ __forceinline__ void a_ready(const Unit&) const {}
    __device__ __forceinline__ void done(const Unit&) const {}
};

__device__ __forceinline__ unsigned cvt_pk_bf16(float lo, float hi) { unsigned r; asm volatile("v_cvt_pk_bf16_f32 %0, %1, %2" : "=v"(r) : "v"(lo), "v"(hi)); return r; }
typedef float f32x2 __attribute__((ext_vector_type(2)));
__device__ __forceinline__ f32x2 gelu_pk(f32x2 v) {
    const f32x2 av = __builtin_elementwise_abs(v), d = av * 0.2316418882f + 1.0f;
    f32x2 t; t.x = __builtin_amdgcn_rcpf(d.x); t.y = __builtin_amdgcn_rcpf(d.y);
    f32x2 q = t * 0.5307027145f + (-0.7265760135f); q = q * t + 0.7107068705f; q = q * t + (-0.142248368f); q = q * t + 0.127414796f; q = q * t;
    const f32x2 s = (v * v) * (-0.72134752044f);
    f32x2 e; e.x = __builtin_amdgcn_exp2f(s.x); e.y = __builtin_amdgcn_exp2f(s.y);
    const f32x2 m = v * (q * e), r = v - m;
    f32x2 o; o.x = v.x < 0.f ? m.x : r.x; o.y = v.y < 0.f ? m.y : r.y; return o;
}

template <int ACT  > struct EpiBf16 {
    static constexpr bool PERM = true, AFTER_DRAIN = false; static_assert(ACT == 0 || ACT == 1, "EpiBf16: ACT is 0 (none) or 1 (gelu_pk)");
    bf16_t* O; int ldc; const float* bias; int split_cols; size_t split_stride; float scale0;
    __device__ __forceinline__ void operator()(const f32x4 (&acc)[2][2][4][2], const Unit& u, int wr, int wc, int fr, int fq) const {
        const int row0 = u.pm * BM + wr * 64 + fr; int colt = u.pn * BM; bf16_t* base = O;
        float sc = 1.f; if (split_cols) { const int t = colt / split_cols; base += (size_t)t * split_stride; colt -= t * split_cols; if (t == 0) sc = scale0; }
        const int col0 = colt + wc * 32 + 8 * fq, bcol0 = u.pn * BM + wc * 32 + 8 * fq;
        f32x4 bv[2][2];
#pragma unroll
        for (int bj = 0; bj < 2; ++bj)
#pragma unroll
            for (int n = 0; n < 2; ++n) bv[bj][n] = bias ? *(const f32x4*)(bias + bcol0 + bj * HALF + 4 * n) : (f32x4){0.f, 0.f, 0.f, 0.f};
#pragma unroll
        for (int ai = 0; ai < 2; ++ai)
#pragma unroll
            for (int m = 0; m < 4; ++m) { bf16_t* rowp = base + (size_t)(row0 + ai * HALF + m * 16) * ldc + col0;
#pragma unroll
                for (int bj = 0; bj < 2; ++bj) { f32x4 v0 = acc[ai][bj][m][0] + bv[bj][0], v1 = acc[ai][bj][m][1] + bv[bj][1];
                    if (ACT == 1) { f32x2 a = gelu_pk((f32x2){v0[0], v0[1]}), b = gelu_pk((f32x2){v0[2], v0[3]}), c = gelu_pk((f32x2){v1[0], v1[1]}), d = gelu_pk((f32x2){v1[2], v1[3]});
                        v0 = (f32x4){a.x, a.y, b.x, b.y}; v1 = (f32x4){c.x, c.y, d.x, d.y}; }
                    v0 = v0 * sc; v1 = v1 * sc; u32x4 w; w.x = cvt_pk_bf16(v0[0], v0[1]); w.y = cvt_pk_bf16(v0[2], v0[3]); w.z = cvt_pk_bf16(v1[0], v1[1]); w.w = cvt_pk_bf16(v1[2], v1[3]);
                    *(u32x4*)(rowp + bj * HALF) = w; } }
    }
};

struct PanelStats {
    unsigned* xbuf;
    unsigned* cnt;
    unsigned* tmo;
    int ntn; float eps;
    unsigned code;
    __device__ __forceinline__ bool run(const f32x4 (&v)[2][2][4][2], const Unit& u, int wr, int wc, int fr, int fq, PG8_LAS unsigned char* lds, int wid, int lane) const {
        typedef float f32x2v __attribute__((ext_vector_type(2)));
        PG8_LAS f32x2v* P = (PG8_LAS f32x2v*)lds;
        PG8_LAS f32x2v* S = (PG8_LAS f32x2v*)(lds + 8192);
        PG8_LAS unsigned* flag = (PG8_LAS unsigned*)(lds + 8192 + 2048);
#pragma unroll
        for (int ai = 0; ai < 2; ++ai)
#pragma unroll
            for (int m = 0; m < 4; ++m) {
                float s = 0.f;
#pragma unroll
                for (int bj = 0; bj < 2; ++bj)
#pragma unroll
                    for (int n = 0; n < 2; ++n) { const f32x4 x = v[ai][bj][m][n]; s += (x[0] + x[1]) + (x[2] + x[3]); }
                s += __shfl_xor(s, 16); s += __shfl_xor(s, 32);
                const float mw = s * (1.0f / 64.0f); float q = 0.f;
#pragma unroll
                for (int bj = 0; bj < 2; ++bj)
#pragma unroll
                    for (int n = 0; n < 2; ++n) { const f32x4 d = v[ai][bj][m][n] - mw; q += (d[0] * d[0] + d[1] * d[1]) + (d[2] * d[2] + d[3] * d[3]); }
                q += __shfl_xor(q, 16); q += __shfl_xor(q, 32);
                if (fq == 0) P[(ai * HALF + wr * 64 + m * 16 + fr) * 4 + wc] = (f32x2v){mw, q};
            }
        asm volatile("s_waitcnt lgkmcnt(0)" ::: "memory"); __builtin_amdgcn_s_barrier(); asm volatile("" ::: "memory");
#if defined(BROKEN_EXCHANGE_NO_WAIT)
#warning BROKEN CONTROL BUILD: the row-statistics exchange does not wait; results are wrong by design
        if (blockIdx.x >= 64) { const long long t0_ = clock64(); while (clock64() - t0_ < 60000) __builtin_amdgcn_s_sleep(8); }
#endif
        const int row = wid * 32 + (lane & 31);
        if (lane < 32) {
            const f32x2v a = P[row * 4 + 0], b = P[row * 4 + 1], c = P[row * 4 + 2], d = P[row * 4 + 3];
            const float mt = (a.x + b.x + c.x + d.x) * 0.25f;
            const float da = a.x - mt, db = b.x - mt, dc = c.x - mt, dd = d.x - mt;
            const float m2 = (a.y + b.y) + (c.y + d.y) + 64.0f * ((da * da + db * db) + (dc * dc + dd * dd));
            unsigned long long* slot = (unsigned long long*)xbuf + ((size_t)(u.pm * BM + row) * 4 + u.pn);
            __hip_atomic_store(slot, ((unsigned long long)__float_as_uint(m2) << 32) | __float_as_uint(mt), __ATOMIC_RELAXED, __HIP_MEMORY_SCOPE_AGENT);
        }
        asm volatile("s_waitcnt vmcnt(0)" ::: "memory");
        if (lane == 0) __hip_atomic_fetch_add(cnt + 64 * u.pm, 1u, __ATOMIC_RELAXED, __HIP_MEMORY_SCOPE_AGENT);
        if (wid == 0) {
            bool dead = false; const unsigned long long t0 = __builtin_amdgcn_s_memrealtime(); const unsigned want = 8u * (unsigned)ntn;
            for (;;) {
#if defined(BROKEN_EXCHANGE_NO_WAIT)
                break;
#endif
                if ((unsigned)__builtin_amdgcn_readfirstlane(__hip_atomic_load(cnt + 64 * u.pm, __ATOMIC_RELAXED, __HIP_MEMORY_SCOPE_AGENT)) >= want) break;
                if (__builtin_amdgcn_s_memrealtime() - t0 > 2000000ull) {
                    if (lane == 0) { unsigned expect = 0u; __hip_atomic_compare_exchange_strong(tmo + 1, &expect, code | (unsigned)(u.pm & 0xff), __ATOMIC_RELAXED, __ATOMIC_RELAXED, __HIP_MEMORY_SCOPE_AGENT);
                                     __hip_atomic_store(tmo, 1u, __ATOMIC_RELAXED, __HIP_MEMORY_SCOPE_AGENT); }
                    dead = true; break; }
                __builtin_amdgcn_s_sleep(2);
            }
            __builtin_amdgcn_fence(__ATOMIC_ACQUIRE, "agent");
            if (lane == 0) flag[0] = dead ? 1u : 0u;
        }
        asm volatile("s_waitcnt vmcnt(0) lgkmcnt(0)" ::: "memory"); __builtin_amdgcn_s_barrier(); asm volatile("" ::: "memory");
        const bool bad = flag[0] != 0u;
        if (lane < 32) {
            const unsigned long long* slot = (const unsigned long long*)xbuf + (size_t)(u.pm * BM + row) * 4; float mt[4], m2[4]; float ms = 0.f;
#pragma unroll
            for (int t = 0; t < 4; ++t) { if (t < ntn) { const unsigned long long w = __hip_atomic_load(slot + t, __ATOMIC_RELAXED, __HIP_MEMORY_SCOPE_AGENT); mt[t] = __uint_as_float((unsigned)w); m2[t] = __uint_as_float((unsigned)(w >> 32)); } else { mt[t] = 0.f; m2[t] = 0.f; } ms += mt[t]; }
            const float mean = ms / (float)ntn; float q = 0.f;
#pragma unroll
            for (int t = 0; t < 4; ++t) if (t < ntn) { const float dm = mt[t] - mean; q += m2[t] + 256.0f * dm * dm; }
            S[row] = (f32x2v){mean, 1.0f / sqrtf(q / (256.0f * (float)ntn) + eps)};
        }
        asm volatile("s_waitcnt lgkmcnt(0)" ::: "memory"); __builtin_amdgcn_s_barrier(); asm volatile("" ::: "memory");
        return bad;
    }
};
struct EpiLnRes {
    static constexpr bool PERM = false, AFTER_DRAIN = true;
    const float* base; float* out; int ldc; const float* bias; PanelStats st; unsigned poison;
    __device__ __forceinline__ void fused(f32x4 (&acc)[2][2][4][2], const Unit& u, int wr, int wc, int fr, int fq, PG8_LAS unsigned char* lds, int wid, int lane) const {
        typedef float f32x2v __attribute__((ext_vector_type(2)));
        const PG8_LAS f32x2v* S = (const PG8_LAS f32x2v*)(lds + 8192);
        const int col0 = u.pn * BM + wc * 32 + 4 * fq;
#pragma unroll
        for (int bj = 0; bj < 2; ++bj)
#pragma unroll
            for (int n = 0; n < 2; ++n) { const f32x4 bv = bias ? *(const f32x4*)(bias + col0 + bj * HALF + n * 16) : (f32x4){0.f, 0.f, 0.f, 0.f};
#pragma unroll
                for (int ai = 0; ai < 2; ++ai)
#pragma unroll
                    for (int m = 0; m < 4; ++m) acc[ai][bj][m][n] += bv; }
        f32x4 pre[4][2][2];
#pragma unroll
        for (int m = 0; m < 4; ++m) { const size_t off = (size_t)(u.pm * BM + wr * 64 + m * 16 + fr) * ldc + col0;
#pragma unroll
            for (int bj = 0; bj < 2; ++bj)
#pragma unroll
                for (int n = 0; n < 2; ++n) pre[m][bj][n] = *(const f32x4*)(base + off + bj * HALF + n * 16); }
        const bool bad = st.run(acc, u, wr, wc, fr, fq, lds, wid, lane) || poison != 0u;
        const float qnan = __builtin_nanf("");
#pragma unroll
        for (int ai = 0; ai < 2; ++ai)
#pragma unroll
            for (int m = 0; m < 4; ++m) { const int r = ai * HALF + wr * 64 + m * 16 + fr; const f32x2v sr = S[r]; const size_t off = (size_t)(u.pm * BM + r) * ldc + col0;
#pragma unroll
                for (int bj = 0; bj < 2; ++bj)
#pragma unroll
                    for (int n = 0; n < 2; ++n) { const f32x4 bs = ai == 0 ? pre[m][bj][n] : *(const f32x4*)(base + off + bj * HALF + n * 16); f32x4 o = bs + (acc[ai][bj][m][n] - sr.x) * sr.y;
                        if (bad) o = (f32x4){qnan, qnan, qnan, qnan}; *(f32x4*)(out + off + bj * HALF + n * 16) = o; }
                if (m & 1) asm volatile("" ::: "memory"); }
    }
};
struct EpiLnResLn {
    static constexpr bool PERM = false, AFTER_DRAIN = true;
    const float* base; float* out; bf16_t* xn; int ldc; const float* bias; PanelStats st1, st2; unsigned poison;
    __device__ __forceinline__ void fused(f32x4 (&acc)[2][2][4][2], const Unit& u, int wr, int wc, int fr, int fq, PG8_LAS unsigned char* lds, int wid, int lane) const {
        typedef float f32x2v __attribute__((ext_vector_type(2))); typedef unsigned u32x2v __attribute__((ext_vector_type(2)));
        const PG8_LAS f32x2v* S = (const PG8_LAS f32x2v*)(lds + 8192);
        const int col0 = u.pn * BM + wc * 32 + 4 * fq;
#pragma unroll
        for (int bj = 0; bj < 2; ++bj)
#pragma unroll
            for (int n = 0; n < 2; ++n) { const f32x4 bv = bias ? *(const f32x4*)(bias + col0 + bj * HALF + n * 16) : (f32x4){0.f, 0.f, 0.f, 0.f};
#pragma unroll
                for (int ai = 0; ai < 2; ++ai)
#pragma unroll
                    for (int m = 0; m < 4; ++m) acc[ai][bj][m][n] += bv; }
        bool bad = st1.run(acc, u, wr, wc, fr, fq, lds, wid, lane) || poison != 0u;
        const float qnan = __builtin_nanf("");
#pragma unroll
        for (int ai = 0; ai < 2; ++ai)
#pragma unroll
            for (int m = 0; m < 4; ++m) { const int r = ai * HALF + wr * 64 + m * 16 + fr; const f32x2v sr = S[r]; const size_t off = (size_t)(u.pm * BM + r) * ldc + col0;
#pragma unroll
                for (int bj = 0; bj < 2; ++bj)
#pragma unroll
                    for (int n = 0; n < 2; ++n) { const f32x4 bs = *(const f32x4*)(base + off + bj * HALF + n * 16); acc[ai][bj][m][n] = bs + (acc[ai][bj][m][n] - sr.x) * sr.y; }
                asm volatile("" : "+v"(acc[ai][0][m][0]), "+v"(acc[ai][0][m][1]), "+v"(acc[ai][1][m][0]), "+v"(acc[ai][1][m][1]));
                if (m & 1) asm volatile("" ::: "memory"); }
        const bool bad1 = bad;
        bad = st2.run(acc, u, wr, wc, fr, fq, lds, wid, lane) || bad;
#pragma unroll
        for (int ai = 0; ai < 2; ++ai)
#pragma unroll
            for (int m = 0; m < 4; ++m) { const int r = ai * HALF + wr * 64 + m * 16 + fr; const f32x2v sr = S[r]; const size_t off = (size_t)(u.pm * BM + r) * ldc + col0;
#pragma unroll
                for (int bj = 0; bj < 2; ++bj)
#pragma unroll
                    for (int n = 0; n < 2; ++n) { const f32x4 x1 = acc[ai][bj][m][n]; *(f32x4*)(out + off + bj * HALF + n * 16) = bad1 ? (f32x4){qnan, qnan, qnan, qnan} : x1;
                        const f32x4 o = (x1 - sr.x) * sr.y; u32x2v w; w.x = cvt_pk_bf16(o[0], o[1]); w.y = cvt_pk_bf16(o[2], o[3]);
                        if (bad) { w.x = 0x7fc07fc0u; w.y = 0x7fc07fc0u; } *(u32x2v*)(xn + off + bj * HALF + n * 16) = w; }
                asm volatile("" ::: "memory"); }
    }
};

template <class Epi, class Sched, bool ALIGN_EPI = false, bool SP2 = false>
__device__ __forceinline__ void gemm_phase(PG8_LAS unsigned char* lds, const Gemm g, const Sched& S, const Epi& E) {
    const int tid = threadIdx.x, wid = __builtin_amdgcn_readfirstlane(tid >> 6), lane = tid & 63, wr = wid >> 2, wc = wid & 3, fr = lane & 15, fq = lane >> 4;
    const int K = g.K, nt = K / BK;
    unsigned voffA[2], voffB[2];
#pragma unroll
    for (int i = 0; i < 2; ++i) { int R, C; stage_rc(tid * 16 + i * 8192, R, C); const int Rb = Epi::PERM ? ((R & ~31) + perm32(R & 31)) : R;
        voffA[i] = (unsigned)(R * K + C) * 2u; voffB[i] = (unsigned)(Rb * K + C) * 2u; }
    const size_t kstep = (size_t)(BK * 2);
    const size_t hstep = (size_t)HALF * K * 2;
    const size_t tstep = 2 * hstep;
    const unsigned ldsw = (unsigned)wid * 1024u;
    const int aoff = lds_byte(wr * 64 + fr, fq * 8), boff = lds_byte(wc * 32 + fr, fq * 8);
#define PG8_SA(b, h) (((b) * 2 + (h)) * HTB)
#define PG8_SB(b, h) ((4 + (b) * 2 + (h)) * HTB)
#define PG8_STAGE(bufoff, gbase, voff) do { _Pragma("unroll") for (int _i = 0; _i < 2; ++_i) \
        __builtin_amdgcn_global_load_lds((const unsigned*)((const char*)(gbase) + (voff)[_i]), (PG8_LAS unsigned*)(lds + (bufoff) + ldsw + _i * 8192), 16, 0, 0); } while (0)
#define PG8_LDA(dst, b, h) do { _Pragma("unroll") for (int m = 0; m < 4; ++m) _Pragma("unroll") for (int k = 0; k < 2; ++k) dst[m][k] = *(const PG8_LAS bf16x8*)(lds + PG8_SA(b, h) + aoff + m * 2048 + k * 1024); } while (0)
#define PG8_LDB(dst, b, h) do { _Pragma("unroll") for (int n = 0; n < 2; ++n) _Pragma("unroll") for (int k = 0; k < 2; ++k) dst[n][k] = *(const PG8_LAS bf16x8*)(lds + PG8_SB(b, h) + boff + n * 2048 + k * 1024); } while (0)
#define PG8_MMA(ai, bj, At, Bt) do { __builtin_amdgcn_s_setprio(1); _Pragma("unroll") for (int m = 0; m < 4; ++m) _Pragma("unroll") for (int n = 0; n < 2; ++n) _Pragma("unroll") for (int k = 0; k < 2; ++k) \
        acc[ai][bj][m][n] = __builtin_amdgcn_mfma_f32_16x16x32_bf16(Bt[n][k], At[m][k], acc[ai][bj][m][n], 0, 0, 0); __builtin_amdgcn_s_setprio(0); } while (0)
#define PG8_WAIT_V(n) asm volatile("s_waitcnt vmcnt(" #n ")" ::: "memory")
#define PG8_WAIT_L(n) asm volatile("s_waitcnt lgkmcnt(" #n ")" ::: "memory")
#define PG8_BAR __builtin_amdgcn_s_barrier()
#define PG8_SCHED __builtin_amdgcn_sched_barrier(0)
    Unit cur, nxt; int ui = 0;
    if (!S.next(0, cur)) return;
    f32x4 acc[2][2][4][2];
#pragma unroll
    for (int a = 0; a < 2; ++a)
#pragma unroll
        for (int b = 0; b < 2; ++b)
#pragma unroll
            for (int m = 0; m < 4; ++m)
#pragma unroll
                for (int n = 0; n < 2; ++n) acc[a][b][m][n] = (f32x4){0.f, 0.f, 0.f, 0.f};
    bf16x8 At[4][2], B0[2][2], B1[2][2];
    const char* cA = (const char*)g.A + (size_t)cur.pm * tstep; const char* cB = (const char*)g.Bt + (size_t)cur.pn * tstep;
    S.a_ready(cur);
    if constexpr (SP2) {
        PG8_STAGE(PG8_SB(0, 0), cB, voffB); PG8_STAGE(PG8_SB(0, 1), cB + hstep, voffB); PG8_STAGE(PG8_SA(0, 0), cA, voffA); PG8_STAGE(PG8_SA(0, 1), cA + hstep, voffA);
        if (wr == 1) PG8_BAR;
        PG8_WAIT_V(2); PG8_BAR;
        PG8_STAGE(PG8_SB(1, 0), cB + kstep, voffB); PG8_STAGE(PG8_SA(1, 0), cA + kstep, voffA); PG8_STAGE(PG8_SB(1, 1), cB + hstep + kstep, voffB);
        PG8_WAIT_V(6); PG8_BAR;
    } else {
        PG8_STAGE(PG8_SB(0, 0), cB, voffB); PG8_STAGE(PG8_SA(0, 0), cA, voffA); PG8_STAGE(PG8_SB(0, 1), cB + hstep, voffB); PG8_STAGE(PG8_SA(0, 1), cA + hstep, voffA);
        if (wr == 1) PG8_BAR;
        PG8_WAIT_V(4); PG8_BAR;
        PG8_STAGE(PG8_SB(1, 0), cB + kstep, voffB); PG8_STAGE(PG8_SA(1, 0), cA + kstep, voffA); PG8_STAGE(PG8_SB(1, 1), cB + hstep + kstep, voffB);
        PG8_WAIT_V(6); PG8_BAR;
    }
    for (;;) {
        const bool has_next = S.next(ui + 1, nxt);
        const char* nA = has_next ? (const char*)g.A + (size_t)nxt.pm * tstep : cA; const char* nB = has_next ? (const char*)g.Bt + (size_t)nxt.pn * tstep : cB;
        for (int t = 0; t < nt; t += 2) {
            const bool last = (t == nt - 2);
            const char* a1 = cA + (size_t)(t + 1) * kstep;
            const char* a2 = last ? nA : cA + (size_t)(t + 2) * kstep; const char* b2 = last ? nB : cB + (size_t)(t + 2) * kstep;
            const char* a3 = a2 + kstep; const char* b3 = b2 + kstep;
            if (last && has_next) S.a_ready(nxt);
            if constexpr (SP2) {
            PG8_LDB(B0, 0, 0); PG8_LDB(B1, 0, 1); PG8_SCHED; PG8_LDA(At, 0, 0); PG8_STAGE(PG8_SA(1, 1), a1 + hstep, voffA);
            PG8_WAIT_V(8); PG8_WAIT_L(0); PG8_BAR; PG8_MMA(0, 0, At, B0); PG8_MMA(0, 1, At, B1); PG8_BAR; PG8_SCHED;
            PG8_LDA(At, 0, 1); PG8_STAGE(PG8_SB(0, 0), b2, voffB); PG8_STAGE(PG8_SB(0, 1), b2 + hstep, voffB); PG8_STAGE(PG8_SA(0, 0), a2, voffA);
            PG8_WAIT_V(8); PG8_WAIT_L(0); PG8_BAR; PG8_MMA(1, 0, At, B0); PG8_MMA(1, 1, At, B1); PG8_BAR; PG8_SCHED;
            PG8_LDB(B0, 1, 0); PG8_LDB(B1, 1, 1); PG8_SCHED; PG8_LDA(At, 1, 0); PG8_STAGE(PG8_SA(0, 1), a2 + hstep, voffA);
            PG8_WAIT_V(8); PG8_WAIT_L(0); PG8_BAR; PG8_MMA(0, 0, At, B0); PG8_MMA(0, 1, At, B1); PG8_BAR; PG8_SCHED;
            PG8_LDA(At, 1, 1); PG8_STAGE(PG8_SB(1, 0), b3, voffB); PG8_STAGE(PG8_SB(1, 1), b3 + hstep, voffB); PG8_STAGE(PG8_SA(1, 0), a3, voffA);
            PG8_WAIT_V(8); PG8_WAIT_L(0); PG8_BAR; PG8_MMA(1, 0, At, B0); PG8_MMA(1, 1, At, B1); PG8_BAR; PG8_SCHED;
            } else {
            PG8_LDB(B0, 0, 0); PG8_SCHED; PG8_LDA(At, 0, 0); PG8_STAGE(PG8_SA(1, 1), a1 + hstep, voffA);
            PG8_WAIT_L(8); PG8_BAR; PG8_WAIT_L(0); PG8_MMA(0, 0, At, B0); PG8_BAR; PG8_SCHED;
            PG8_LDB(B1, 0, 1); PG8_STAGE(PG8_SB(0, 0), b2, voffB);
            PG8_BAR; PG8_WAIT_L(0); PG8_MMA(0, 1, At, B1); PG8_BAR;
            PG8_LDA(At, 0, 1); PG8_STAGE(PG8_SA(0, 0), a2, voffA);
            PG8_BAR; PG8_WAIT_L(0); PG8_MMA(1, 0, At, B0); PG8_BAR; PG8_SCHED;
            PG8_STAGE(PG8_SB(0, 1), b2 + hstep, voffB);
            PG8_WAIT_V(6); PG8_BAR; PG8_MMA(1, 1, At, B1); PG8_BAR;
            PG8_LDB(B0, 1, 0); PG8_SCHED; PG8_LDA(At, 1, 0); PG8_STAGE(PG8_SA(0, 1), a2 + hstep, voffA);
            PG8_WAIT_L(8); PG8_BAR; PG8_WAIT_L(0); PG8_MMA(0, 0, At, B0); PG8_BAR; PG8_SCHED;
            PG8_LDB(B1, 1, 1); PG8_STAGE(PG8_SB(1, 0), b3, voffB);
            PG8_BAR; PG8_WAIT_L(0); PG8_MMA(0, 1, At, B1); PG8_BAR;
            PG8_LDA(At, 1, 1); PG8_STAGE(PG8_SA(1, 0), a3, voffA);
            PG8_BAR; PG8_WAIT_L(0); PG8_MMA(1, 0, At, B0); PG8_BAR; PG8_SCHED;
            PG8_STAGE(PG8_SB(1, 1), b3 + hstep, voffB);
            PG8_WAIT_V(6); PG8_BAR; PG8_MMA(1, 1, At, B1); PG8_BAR;
            }
        }
        if constexpr (ALIGN_EPI) { if (wr == 0) PG8_BAR; }
        if constexpr (!Epi::AFTER_DRAIN) { E(acc, cur, wr, wc, fr, fq); S.done(cur); }
        if (!has_next) break;
#pragma unroll
        for (int a = 0; a < 2; ++a)
#pragma unroll
            for (int b = 0; b < 2; ++b)
#pragma unroll
                for (int m = 0; m < 4; ++m)
#pragma unroll
                    for (int n = 0; n < 2; ++n) acc[a][b][m][n] = (f32x4){0.f, 0.f, 0.f, 0.f};
        cur = nxt; cA = nA; cB = nB; ++ui;
        if constexpr (ALIGN_EPI) { if (wr == 1) PG8_BAR; }
    }
    PG8_WAIT_V(0);
    if constexpr (!ALIGN_EPI) { if (wr == 0) PG8_BAR; }
    PG8_BAR;
    if constexpr (Epi::AFTER_DRAIN) { E.fused(acc, cur, wr, wc, fr, fq, lds, wid, lane); S.done(cur); }
#undef PG8_SA
#undef PG8_SB
#undef PG8_STAGE
#undef PG8_LDA
#undef PG8_LDB
#undef PG8_MMA
#undef PG8_WAIT_V
#undef PG8_WAIT_L
#undef PG8_BAR
#undef PG8_SCHED
}
}

DI void transpose_item(const float* W, int ldw, bf16_t* WT, int ldt, float scale, float* scr, int k0, int n0, int lane) {
#pragma unroll 8
    for (int i = 0; i < 32; ++i) { const int kk = 2 * i + (lane >> 5); scr[kk * 33 + (lane & 31)] = W[(size_t)(k0 + kk) * ldw + n0 + (lane & 31)] * scale; }
    asm volatile("s_waitcnt lgkmcnt(0)" ::: "memory");
    const int c = lane & 7;
#pragma unroll
    for (int j = 0; j < 4; ++j) { const int n = (lane >> 3) + 8 * j; const float* s = scr + (8 * c) * 33 + n;
        u32x4 o; o.x = pk2(s[0 * 33], s[1 * 33]); o.y = pk2(s[2 * 33], s[3 * 33]); o.z = pk2(s[4 * 33], s[5 * 33]); o.w = pk2(s[6 * 33], s[7 * 33]);
        *(u32x4*)(WT + (size_t)n * ldt + k0 + 8 * c) = o; }
    asm volatile("s_waitcnt lgkmcnt(0)" ::: "memory");
}

DI void p0_prologue(const Params& p, float* lds, int gw, int NGW, int wave, int lane) {
    unsigned char* ws = p.ws;
    bf16_t* WinT = (bf16_t*)(ws + WS_WINT); bf16_t* WoT = (bf16_t*)(ws + WS_WOT); bf16_t* WmT = (bf16_t*)(ws + WS_WMT);
    bf16_t* W13T = (bf16_t*)(ws + WS_W13T); bf16_t* W2T = (bf16_t*)(ws + WS_W2T);
    float* scr = lds + wave * (64 * 33);
    const float* w_in = p.in[I_WIN];
    constexpr int S0 = 256, S1 = 512, S2 = 768, S3 = 896, S4 = 1408, S5 = 1664, S6 = S5 + 4096, S7 = S6 + 4096, S8 = S7 + 4096;
    for (int it = gw; it < S8; it += NGW) {
        if (it < S3) {
            int seg, r;
            if (it < S0) { seg = 0; r = it; } else if (it < S1) { seg = 1; r = it - S0; } else if (it < S2) { seg = 2; r = it - S1; } else { seg = 3; r = it - S2; }
            const int ncb = (seg == 3) ? 8 : 16;
            const int kb = r / ncb, nb = r % ncb;
            const int coff = (seg == 3) ? 1792 : seg * 512, roff = (seg == 3) ? 1536 : seg * 512;
            const float sc = (seg == 0 || seg == 3) ? C2 : 1.0f;
            transpose_item(w_in + coff, 2048, WinT + (size_t)(roff + nb * 32) * 1024, 1024, sc, scr, kb * 64, nb * 32, lane);
        } else if (it < S4) { const int r = it - S3, kb = r / 32, nb = r % 32;
            transpose_item(p.in[I_WOUT], 1024, WoT + (size_t)(nb * 32) * 1024, 1024, 1.f, scr, kb * 64, nb * 32, lane);
        } else if (it < S5) { const int r = it - S4, kb = r / 16, nb = r % 16;
            transpose_item(p.in[I_WMKV], 512, WmT + (size_t)(nb * 32) * 1024, 1024, 1.f, scr, kb * 64, nb * 32, lane);
        } else if (it < S7) { const bool is3 = it >= S6; const int r = it - (is3 ? S6 : S5), e = r / 128, q = r % 128, kb = q / 8, nb = q % 8, n0 = nb * 32;
            const float* W = (is3 ? p.in[I_W3] : p.in[I_W1]) + (size_t)e * 1024 * 256;
            const int drow = e * 512 + (n0 >> 7) * 256 + (is3 ? 128 : 0) + (n0 & 127);
            transpose_item(W, 256, W13T + (size_t)drow * 1024, 1024, 1.f, scr, kb * 64, n0, lane);
        } else { const int r = it - S7, e = r / 128, q = r % 128, kb = q / 32, nb = q % 32;
            const float* W = p.in[I_W2] + (size_t)e * 256 * 1024;
            transpose_item(W, 1024, W2T + (size_t)(e * 1024 + nb * 32) * 256, 256, 1.f, scr, kb * 64, nb * 32, lane);
        }
    }
    {
        bf16_t* XN = (bf16_t*)(ws + WS_XN); float* st = (float*)(ws + WS_STATS0);
        const f32x4* g4 = (const f32x4*)p.in[I_LN0G] + lane; const f32x4* b4 = (const f32x4*)p.in[I_LN0B] + lane;
        for (int m = gw; m < NTOK; m += NGW) {
            const f32x4* xr = (const f32x4*)(p.in[I_X] + (size_t)m * DM) + lane;
            f32x4 v[4]; float s = 0.f;
#pragma unroll
            for (int j = 0; j < 4; ++j) { v[j] = xr[64 * j]; s += (v[j].x + v[j].y) + (v[j].z + v[j].w); }
            const float mean = wave_sum(s) * (1.f / DM); float s2 = 0.f;
#pragma unroll
            for (int j = 0; j < 4; ++j) { v[j] = v[j] - mean; s2 += (v[j].x * v[j].x + v[j].y * v[j].y) + (v[j].z * v[j].z + v[j].w * v[j].w); }
            const float rstd = 1.f / sqrtf(wave_sum(s2) * (1.f / DM) + LN_EPS);
            if (lane == 0) { st[2 * m] = mean; st[2 * m + 1] = rstd; }
            u32x2* o8 = (u32x2*)(XN + (size_t)m * DM) + lane;
#pragma unroll
            for (int j = 0; j < 4; ++j) { const f32x4 g = g4[64 * j], b = b4[64 * j]; const f32x4 y = v[j] * rstd * g + b; u32x2 w; w.x = pk2(y.x, y.y); w.y = pk2(y.z, y.w); o8[64 * j] = w; }
        }
    }
    {
        bf16_t* MB = (bf16_t*)(ws + WS_MEMB);
        for (int m = gw; m < NB * MEMLEN; m += NGW) {
            const f32x4* xr = (const f32x4*)(p.in[I_MEM] + (size_t)m * DM) + lane; u32x2* o8 = (u32x2*)(MB + (size_t)m * DM) + lane;
#pragma unroll
            for (int j = 0; j < 4; ++j) { const f32x4 y = xr[64 * j]; u32x2 w; w.x = pk2(y.x, y.y); w.y = pk2(y.z, y.w); o8[64 * j] = w; }
        }
    }
    {
        const float* wf = p.in[I_WF];
        for (int it = gw; it < 1024 * 4; it += NGW) {
            const int k = it >> 2, g = it & 3;
            const float wv = w_in[(size_t)k * 2048 + 1536 + g * 64 + lane];
            float ta = 0.f, tb = 0.f;
            for (int c = 0; c < 64; ++c) { const float wc = __shfl(wv, c); const float ang = (float)((c * lane) & 63) * (1.0f / 32.0f); ta += wc * cospif(ang); tb += wc * sinpif(ang); }
            float orr = 0.f, oi = 0.f;
            for (int c = 0; c < 64; ++c) { const float w = wf[(size_t)(g * 64 + c) * 64 + lane]; orr += __shfl(ta, c) * w; oi += __shfl(tb, c) * w; }
            WinT[(size_t)(1792 + g * 64 + lane) * 1024 + k] = (bf16_t)f2bf(orr * (1.0f / 512.0f));
            WinT[(size_t)(2048 + g * 64 + lane) * 1024 + k] = (bf16_t)f2bf(oi * (1.0f / 512.0f));
        }
    }
    {
        float* WR = (float*)(ws + WS_WR); float* ct = (float*)(ws + WS_COSTAB);
        const int gt = gw * 64 + lane, NGT = NGW * 64;
        for (int i = gt; i < 36 * 1024; i += NGT) { const int e = i >> 10, k = i & 1023; WR[i] = e < 4 ? p.in[I_WG][k * 4 + e] : p.in[I_WRT][k * 32 + (e - 4)]; }
        for (int i = gt; i < 4096; i += NGT) ct[i] = cospif((float)i * (1.0f / 2048.0f));
    }
}

constexpr size_t WS_ZS1 = 200 * MiB;
constexpr size_t WS_O1 = 216 * MiB;
constexpr int CW_KMAX = 128;
constexpr int CW_KMAXM = 160;

namespace pg8 {
struct EpiInproj {
    static constexpr bool PERM = true, AFTER_DRAIN = false;
    unsigned char* ws;
    __device__ __forceinline__ void operator()(const f32x4 (&acc)[2][2][4][2], const Unit& u, int wr, int wc, int fr, int fq) const {
        const int pn = u.pn; bf16_t* base; int ldc, coff;
        if (pn < 6) { base = (bf16_t*)(ws + WS_QB + (size_t)(pn >> 1) * (16 * MiB)); ldc = 512; coff = (pn & 1) * 256; }
        else if (pn == 6) { base = (bf16_t*)(ws + WS_MQB); ldc = 256; coff = 0; }
        else { base = (bf16_t*)(ws + WS_ZB); ldc = 512; coff = (pn - 7) * 256; }
        const int row0 = u.pm * BM + wr * 64 + fr, col0 = coff + wc * 32 + 8 * fq;
#pragma unroll
        for (int ai = 0; ai < 2; ++ai)
#pragma unroll
            for (int m = 0; m < 4; ++m) { bf16_t* rowp = base + (size_t)(row0 + ai * HALF + m * 16) * ldc + col0;
#pragma unroll
                for (int bj = 0; bj < 2; ++bj) { const f32x4 v0 = acc[ai][bj][m][0], v1 = acc[ai][bj][m][1];
                    u32x4 w; w.x = cvt_pk_bf16(v0[0], v0[1]); w.y = cvt_pk_bf16(v0[2], v0[3]); w.z = cvt_pk_bf16(v1[0], v1[1]); w.w = cvt_pk_bf16(v1[2], v1[3]);
                    *(u32x4*)(rowp + bj * HALF) = w; } }
    }
};
struct EpiBf16Plain {
    static constexpr bool PERM = true, AFTER_DRAIN = false;
    bf16_t* O; int ldc;
    __device__ __forceinline__ void operator()(const f32x4 (&acc)[2][2][4][2], const Unit& u, int wr, int wc, int fr, int fq) const {
        const int row0 = u.pm * BM + wr * 64 + fr, col0 = u.pn * BM + wc * 32 + 8 * fq;
#pragma unroll
        for (int ai = 0; ai < 2; ++ai)
#pragma unroll
            for (int m = 0; m < 4; ++m) { bf16_t* rowp = O + (size_t)(row0 + ai * HALF + m * 16) * ldc + col0;
#pragma unroll
                for (int bj = 0; bj < 2; ++bj) { const f32x4 v0 = acc[ai][bj][m][0], v1 = acc[ai][bj][m][1];
                    u32x4 w; w.x = cvt_pk_bf16(v0[0], v0[1]); w.y = cvt_pk_bf16(v0[2], v0[3]); w.z = cvt_pk_bf16(v1[0], v1[1]); w.w = cvt_pk_bf16(v1[2], v1[3]);
                    *(u32x4*)(rowp + bj * HALF) = w; } }
    }
};
struct EpiF32Plain {
    static constexpr bool PERM = false, AFTER_DRAIN = false;
    float* C; int ldc;
    __device__ __forceinline__ void operator()(const f32x4 (&acc)[2][2][4][2], const Unit& u, int wr, int wc, int fr, int fq) const {
        const int row0 = u.pm * BM + wr * 64 + fr, col0 = u.pn * BM + wc * 32 + 4 * fq;
#pragma unroll
        for (int ai = 0; ai < 2; ++ai)
#pragma unroll
            for (int m = 0; m < 4; ++m) { float* rowp = C + (size_t)(row0 + ai * HALF + m * 16) * ldc + col0;
#pragma unroll
                for (int bj = 0; bj < 2; ++bj)
#pragma unroll
                    for (int n = 0; n < 2; ++n) *(f32x4*)(rowp + bj * HALF + n * 16) = acc[ai][bj][m][n]; }
    }
};
}

DI void kmax_phase(const Params& p, int gw, int NGW, int lane) {
    unsigned char* ws = p.ws; unsigned* ctl = (unsigned*)(ws + WS_CTL);
    const bf16_t* Kb = (const bf16_t*)(ws + WS_KB); const bf16_t* MKV = (const bf16_t*)(ws + WS_MKV);
    for (int grp = gw; grp < NTOK / 8; grp += NGW) {
        float mx = 0.f;
#pragma unroll
        for (int r = 0; r < 8; ++r) { const u32x4 v = *(const u32x4*)(Kb + (size_t)(grp * 8 + r) * 512 + lane * 8); float s = 0.f;
#pragma unroll
            for (int j = 0; j < 4; ++j) { const float a = __uint_as_float(v[j] << 16), b = __uint_as_float(v[j] & 0xffff0000u); s += a * a + b * b; }
            s += __shfl_xor(s, 1); s += __shfl_xor(s, 2); s += __shfl_xor(s, 4); mx = fmaxf(mx, s); }
        if ((lane & 7) == 0) atomicMax(ctl + CW_KMAX + ((grp * 8) / SEQ) * 8 + (lane >> 3), __float_as_uint(mx));
    }
    for (int grp = gw; grp < NB * MEMLEN / 8; grp += NGW) {
        float mx = 0.f;
#pragma unroll
        for (int r = 0; r < 8; ++r) { const u32x4 v = *(const u32x4*)(MKV + (size_t)(grp * 8 + r) * 512 + (lane & 31) * 8); float s = 0.f;
#pragma unroll
            for (int j = 0; j < 4; ++j) { const float a = __uint_as_float(v[j] << 16), b = __uint_as_float(v[j] & 0xffff0000u); s += a * a + b * b; }
            s += __shfl_xor(s, 1); s += __shfl_xor(s, 2); s += __shfl_xor(s, 4); mx = fmaxf(mx, s); }
        if (lane < 32 && (lane & 7) == 0) atomicMax(ctl + CW_KMAXM + ((grp * 8) / MEMLEN) * 4 + (lane >> 3), __float_as_uint(mx));
    }
}

namespace att {
#define ALAS __attribute__((address_space(3)))
typedef short bf16x8 __attribute__((ext_vector_type(8)));
typedef short s16x4 __attribute__((ext_vector_type(4)));
typedef short v4i16_t __attribute__((ext_vector_type(4)));
typedef float f32x16 __attribute__((ext_vector_type(16)));
typedef float f32x2_t __attribute__((ext_vector_type(2)));
typedef __bf16 bf16x2_t __attribute__((ext_vector_type(2)));
constexpr int KOFF = 0, VOFF = 16384, TOFF = 49152, ATT_LDS = TOFF + 1024;
DI unsigned cvtpk(float lo, float hi) { f32x2_t v = {lo, hi}; bf16x2_t b = __builtin_convertvector(v, bf16x2_t); return __builtin_bit_cast(unsigned, b); }
DI s16x4 vtr(const ALAS unsigned char* q) { return __builtin_bit_cast(s16x4, __builtin_amdgcn_ds_read_tr16_b64_v4i16((ALAS v4i16_t*)q)); }
#define ATT_MFMA(a, b, c) __builtin_amdgcn_mfma_f32_32x32x16_bf16((a), (b), (c), 0, 0, 0)

template <int NDT, bool BAND>
DI void tile(const ALAS unsigned char* kb, const ALAS unsigned char* vb, const bf16x8 (&qr)[4], const f32x16& cinit, f32x16 (&o)[NDT], float& lsum,
             const ALAS float* tbl, int relbase, float mrow) {
    f32x16 p0, p1;
#pragma unroll
    for (int d0 = 0; d0 < 4; ++d0) {
        const bf16x8 b0 = *(const ALAS bf16x8*)(kb + d0 * 2048), b1 = *(const ALAS bf16x8*)(kb + d0 * 2048 + 512);
        if (d0 == 0) { if (BAND) { const f32x16 z = {0.f,0.f,0.f,0.f,0.f,0.f,0.f,0.f,0.f,0.f,0.f,0.f,0.f,0.f,0.f,0.f}; p0 = ATT_MFMA(b0, qr[0], z); p1 = ATT_MFMA(b1, qr[0], z); }
                       else { p0 = ATT_MFMA(b0, qr[0], cinit); p1 = ATT_MFMA(b1, qr[0], cinit); } }
        else { p0 = ATT_MFMA(b0, qr[d0], p0); p1 = ATT_MFMA(b1, qr[d0], p1); }
    }
    if (BAND) {
#pragma unroll
        for (int r = 0; r < 16; ++r) {
            const int rel0 = relbase + (r & 3) + 8 * (r >> 2);
            const int i0 = min(max(rel0 + 128, 0), 255), i1 = min(max(rel0 + 160, 0), 255);
            p0[r] += tbl[i0] - mrow; p1[r] += tbl[i1] - mrow;
        }
    }
    float s = 0.f;
#pragma unroll
    for (int r = 0; r < 16; ++r) { p0[r] = __builtin_amdgcn_exp2f(p0[r]); p1[r] = __builtin_amdgcn_exp2f(p1[r]); s += p0[r] + p1[r]; }
    lsum += s;
    u32x4 w0, w1, w2, w3;
    w0.x = cvtpk(p0[0], p0[1]); w0.y = cvtpk(p0[2], p0[3]); w0.z = cvtpk(p0[4], p0[5]); w0.w = cvtpk(p0[6], p0[7]);
    w1.x = cvtpk(p0[8], p0[9]); w1.y = cvtpk(p0[10], p0[11]); w1.z = cvtpk(p0[12], p0[13]); w1.w = cvtpk(p0[14], p0[15]);
    w2.x = cvtpk(p1[0], p1[1]); w2.y = cvtpk(p1[2], p1[3]); w2.z = cvtpk(p1[4], p1[5]); w2.w = cvtpk(p1[6], p1[7]);
    w3.x = cvtpk(p1[8], p1[9]); w3.y = cvtpk(p1[10], p1[11]); w3.z = cvtpk(p1[12], p1[13]); w3.w = cvtpk(p1[14], p1[15]);
    const bf16x8 pb0 = __builtin_bit_cast(bf16x8, w0), pb1 = __builtin_bit_cast(bf16x8, w1), pb2 = __builtin_bit_cast(bf16x8, w2), pb3 = __builtin_bit_cast(bf16x8, w3);
#pragma unroll
    for (int dt = 0; dt < NDT; ++dt) {
        __builtin_amdgcn_sched_barrier(0);
#pragma unroll
        for (int ks = 0; ks < 4; ++ks) {
            const s16x4 lo = vtr(vb + (dt * 4 + ks) * 1024), hh = vtr(vb + (dt * 4 + ks) * 1024 + 512);
            const bf16x8 a = __builtin_shufflevector(lo, hh, 0, 1, 2, 3, 4, 5, 6, 7);
            o[dt] = ATT_MFMA(a, ks == 0 ? pb0 : ks == 1 ? pb1 : ks == 2 ? pb2 : pb3, o[dt]);
        }
    }
}

template <int DV, bool DIFF>
DI void attn_unit(ALAS unsigned char* lds, const Params& p, int unit, int wid, int lane) {
    unsigned char* ws = p.ws; const unsigned* ctl = (const unsigned*)(ws + WS_CTL);
    const int tid = threadIdx.x, r32 = lane & 31, hi = lane >> 5;
    constexpr int NDT = DV / 32, VBYTES = DV * 128, NCOMP = DIFF ? 2 : 1, NT = DIFF ? 64 : 4;
    int b, h, qb, qpitch, ocol; size_t kbase; const bf16_t *Qg, *Kg, *Vg;
    if (DIFF) { b = unit >> 6; h = (unit >> 4) & 3; qb = unit & 15; Qg = (const bf16_t*)(ws + WS_QB) + h * 128; qpitch = 512; Kg = (const bf16_t*)(ws + WS_KB) + h * 128;
        Vg = (const bf16_t*)(ws + WS_VB) + h * 128; kbase = (size_t)b * SEQ; ocol = h * 128; }
    else { const int qblk = unit >> 2; h = unit & 3; b = qblk >> 4; qb = qblk & 15; Qg = (const bf16_t*)(ws + WS_MQB) + h * 64; qpitch = 256; Kg = (const bf16_t*)(ws + WS_MKV) + h * 64;
        Vg = (const bf16_t*)(ws + WS_MKV) + 256 + h * 64; kbase = (size_t)b * MEMLEN; ocol = 768 + h * 64; }
    const int row0 = b * SEQ + qb * 256, qa = qb * 256 + wid * 32;
    const ALAS float* tbl = (const ALAS float*)(lds + TOFF);
    float bmax = 0.f, cL = 0.f, cR = 0.f, lam = 0.f;
    __syncthreads();
    if (DIFF) {
        const float* rb = p.in[I_RELB];
        if (tid < 256) ((ALAS float*)(lds + TOFF))[tid] = rb[t5_bucket(tid - 128) * 4 + h] * LOG2E;
        float bm = -1e30f;
        for (int i = 0; i < 32; ++i) bm = fmaxf(bm, rb[i * 4 + h]);
        bmax = bm * LOG2E; cL = rb[15 * 4 + h] * LOG2E; cR = rb[31 * 4 + h] * LOG2E;
        float s1 = 0.f, s2 = 0.f;
        for (int i = 0; i < 64; ++i) { s1 += p.in[I_LQ1][i] * p.in[I_LK1][i]; s2 += p.in[I_LQ2][i] * p.in[I_LK2][i]; }
        lam = expf(s1) - expf(s2) + LAM_INIT;
        __syncthreads();
    }
    const int tL = DIFF ? (qa >= 154 ? (qa - 154) / 64 + 1 : 0) : NT;
    const int tR = DIFF ? (qa + 185) / 64 : NT;
    const int vlane = (4 * hi + ((lane & 15) >> 2)) * 64 + ((lane >> 4) & 1) * 32 + (lane & 3) * 8;
#pragma unroll 1
    for (int c = 0; c < NCOMP; ++c) {
        const bf16_t* Qp = Qg + (size_t)(row0 + wid * 32 + r32) * qpitch + c * 64 + hi * 8;
        bf16x8 qr[4]; float qq = 0.f;
#pragma unroll
        for (int d0 = 0; d0 < 4; ++d0) { qr[d0] = *(const bf16x8*)(Qp + d0 * 16);
#pragma unroll
            for (int j = 0; j < 8; ++j) { const float f = __uint_as_float(((unsigned)(unsigned short)qr[d0][j]) << 16); qq += f * f; } }
        qq += __shfl_xor(qq, 32);
        const float kmx = sqrtf(__uint_as_float(DIFF ? ctl[CW_KMAX + b * 8 + h * 2 + c] : ctl[CW_KMAXM + b * 4 + h]));
        const float mrow = sqrtf(qq) * kmx * 1.0001f + bmax;
        f32x16 cinit;
#pragma unroll
        for (int r = 0; r < 16; ++r) cinit[r] = cL - mrow;
        f32x16 o[NDT];
#pragma unroll
        for (int dt = 0; dt < NDT; ++dt)
#pragma unroll
            for (int r = 0; r < 16; ++r) o[dt][r] = 0.f;
        float lsum = 0.f;
        const bf16_t* ksrc = Kg + (kbase + lane) * 512 + c * 64 + wid * 8;
#define ATT_DMA(t, buf) do { \
        __builtin_amdgcn_global_load_lds((const unsigned*)(ksrc + (size_t)(t) * 64 * 512), (ALAS unsigned*)(lds + KOFF + (buf) * 8192 + wid * 1024), 16, 0, 0); \
        _Pragma("unroll") for (int i_ = 0; i_ < DV / 64; ++i_) { const int pid_ = wid + 8 * i_; \
            __builtin_amdgcn_global_load_lds((const unsigned*)(Vg + (kbase + (size_t)(t) * 64 + 16 * (pid_ & 3) + (lane >> 2)) * 512 + 32 * (pid_ >> 2) + 8 * (lane & 3)), \
                                             (ALAS unsigned*)(lds + VOFF + (buf) * VBYTES + pid_ * 1024), 16, 0, 0); } } while (0)
        ATT_DMA(0, 0);
        asm volatile("s_waitcnt vmcnt(0)" ::: "memory");
        __syncthreads();
#pragma unroll 1
        for (int t = 0; t < NT; ++t) {
            const int buf = t & 1;
            if (t + 1 < NT) ATT_DMA(t + 1, buf ^ 1);
            if (DIFF && t == tR) {
#pragma unroll
                for (int r = 0; r < 16; ++r) cinit[r] = cR - mrow;
            }
            const ALAS unsigned char* kb = lds + KOFF + buf * 8192 + hi * 1024 + r32 * 16;
            const ALAS unsigned char* vb = lds + VOFF + buf * VBYTES + vlane;
            if (DIFF && t >= tL && t < tR) tile<NDT, true>(kb, vb, qr, cinit, o, lsum, tbl, t * 64 + 4 * hi - qa - r32, mrow);
            else tile<NDT, false>(kb, vb, qr, cinit, o, lsum, tbl, 0, 0.f);
            asm volatile("s_waitcnt vmcnt(0)" ::: "memory");
            __syncthreads();
        }
#undef ATT_DMA
        lsum += __shfl_xor(lsum, 32);
        const float inv = 1.0f / lsum;
        int lane2 = lane; asm volatile("" : "+v"(lane2));
        const int r32b = lane2 & 31, hib = lane2 >> 5;
        float* o1p = (float*)(ws + WS_O1) + ((size_t)(unit * 8 + wid) * 64 + lane2) * 64;
        if (DIFF && c == 0) {
#pragma unroll
            for (int dt = 0; dt < NDT; ++dt)
#pragma unroll
                for (int r = 0; r < 16; ++r) o1p[dt * 16 + r] = o[dt][r] * inv;
        } else {
            bf16_t* Ob = (bf16_t*)(ws + WS_OB) + (size_t)(row0 + wid * 32 + r32b) * 1024 + ocol + 4 * hib;
            if (DIFF) {
                float ss = 0.f;
#pragma unroll
                for (int dt = 0; dt < NDT; ++dt)
#pragma unroll
                    for (int r = 0; r < 16; ++r) { const float v = o1p[dt * 16 + r] - lam * (o[dt][r] * inv); o[dt][r] = v; ss += v * v; }
                ss += __shfl_xor(ss, 32);
                const float rn = (1.0f - LAM_INIT) / sqrtf(ss * (1.0f / 128.0f) + LN_EPS);
#pragma unroll
                for (int dt = 0; dt < NDT; ++dt)
#pragma unroll
                    for (int g4 = 0; g4 < 4; ++g4) { const int d0 = 32 * dt + 8 * g4; const f32x4 sg = *(const f32x4*)(p.in[I_SUBG] + d0 + 4 * hib);
                        u32x2 w; w.x = cvtpk(o[dt][4 * g4] * rn * sg.x, o[dt][4 * g4 + 1] * rn * sg.y); w.y = cvtpk(o[dt][4 * g4 + 2] * rn * sg.z, o[dt][4 * g4 + 3] * rn * sg.w);
                        *(u32x2*)(Ob + d0) = w; }
            } else {
#pragma unroll
                for (int dt = 0; dt < NDT; ++dt)
#pragma unroll
                    for (int g4 = 0; g4 < 4; ++g4) { const int d0 = 32 * dt + 8 * g4;
                        u32x2 w; w.x = cvtpk(o[dt][4 * g4] * inv, o[dt][4 * g4 + 1] * inv); w.y = cvtpk(o[dt][4 * g4 + 2] * inv, o[dt][4 * g4 + 3] * inv);
                        *(u32x2*)(Ob + d0) = w; }
            }
        }
    }
}
}

template <bool DUAL, bool BKN, class LA, class LB, class EP>
DI void ngemm_tile(float* As, float* Bs, float* Bs2, int K, const LA& la, const LB& lb, const LB& lb2, const EP& ep) {
    const int tid = threadIdx.x, ty = tid >> 4, tx = tid & 15;
    float acc[4][4], acc2[4][4];
#pragma unroll
    for (int i = 0; i < 4; ++i)
#pragma unroll
        for (int j = 0; j < 4; ++j) { acc[i][j] = 0.f; acc2[i][j] = 0.f; }
    for (int kc = 0; kc < K; kc += 32) {
        __syncthreads();
#pragma unroll
        for (int j = 0; j < 8; ++j) { const int i = tid + 512 * j, k = i & 31, r = i >> 5; As[k * 132 + r] = la(r, kc + k); }
#pragma unroll
        for (int j = 0; j < 4; ++j) { const int i = tid + 512 * j; int k, n; if (BKN) { n = i & 63; k = i >> 6; } else { k = i & 31; n = i >> 5; }
            Bs[k * 68 + n] = lb(kc + k, n); if (DUAL) Bs2[k * 68 + n] = lb2(kc + k, n); }
        __syncthreads();
#pragma unroll 8
        for (int k = 0; k < 32; ++k) {
            const f32x4 a = *(const f32x4*)&As[k * 132 + ty * 4]; const f32x4 b = *(const f32x4*)&Bs[k * 68 + tx * 4];
#pragma unroll
            for (int i = 0; i < 4; ++i)
#pragma unroll
                for (int j = 0; j < 4; ++j) acc[i][j] += a[i] * b[j];
            if (DUAL) { const f32x4 b2 = *(const f32x4*)&Bs2[k * 68 + tx * 4];
#pragma unroll
                for (int i = 0; i < 4; ++i)
#pragma unroll
                    for (int j = 0; j < 4; ++j) acc2[i][j] += a[i] * b2[j]; }
        }
    }
#pragma unroll
    for (int i = 0; i < 4; ++i)
#pragma unroll
        for (int j = 0; j < 4; ++j) ep(ty * 4 + i, tx * 4 + j, acc[i][j], acc2[i][j]);
}

struct LA_bf { const bf16_t* A; int lda; DI float operator()(int r, int k) const { return bf2f(A[(size_t)r * lda + k]); } };
struct LB_bf { const bf16_t* B; int ldb; DI float operator()(int k, int n) const { return bf2f(B[(size_t)n * ldb + k]); } };
struct EP_inproj { unsigned char* ws; int m0, n0;
    DI void operator()(int r, int n, float v, float) const { const int row = m0 + r, c = n0 + n; bf16_t* dst;
        if (c < 512) dst = (bf16_t*)(ws + WS_QB) + (size_t)row * 512 + c; else if (c < 1024) dst = (bf16_t*)(ws + WS_KB) + (size_t)row * 512 + (c - 512);
        else if (c < 1536) dst = (bf16_t*)(ws + WS_VB) + (size_t)row * 512 + (c - 1024); else if (c < 1792) dst = (bf16_t*)(ws + WS_MQB) + (size_t)row * 256 + (c - 1536);
        else dst = (bf16_t*)(ws + WS_ZB) + (size_t)row * 512 + (c - 1792);
        *dst = (bf16_t)f2bf(v); } };
struct EP_bf { bf16_t* C; int ldc; int m0, n0; DI void operator()(int r, int n, float v, float) const { C[(size_t)(m0 + r) * ldc + n0 + n] = (bf16_t)f2bf(v); } };
struct EP_f32 { float* C; int ldc; int m0, n0; DI void operator()(int r, int n, float v, float) const { C[(size_t)(m0 + r) * ldc + n0 + n] = v; } };

struct LA_dft { const float* ct; int s0; DI float operator()(int r, int k) const { const int sp = s0 + r, s = k & 4095; const int idx = (s * sp) & 4095;
    return (k < 4096) ? ct[idx] : -ct[(idx - 1024) & 4095]; } };
struct LB_z { const bf16_t* Z; int n0; DI float operator()(int k, int n) const { return bf2f(Z[(size_t)(k & 4095) * 512 + (k >> 12) * 256 + n0 + n]); } };
struct EP_ob { bf16_t* O; int row0, col0; DI void operator()(int r, int n, float v, float) const { O[(size_t)(row0 + r) * 1024 + col0 + n] = (bf16_t)f2bf(v); } };
DI void nfourier_phase(const Params& p, float* As, float* Bs, int bid, int nb) {
    unsigned char* ws = p.ws; const float* ct = (const float*)(ws + WS_COSTAB);
    const int nT = NB * 32 * 4;
    for (int t = bid; t < nT; t += nb) {
        const int b = t / 128, q = t % 128, s0 = (q / 4) * 128, n0 = (q % 4) * 64;
        LA_dft la{ct, s0}; LB_z lb{(const bf16_t*)(ws + WS_ZB) + (size_t)b * SEQ * 512, n0}; EP_ob ep{(bf16_t*)(ws + WS_OB), b * SEQ + s0, 512 + n0};
        ngemm_tile<false, true>(As, Bs, Bs, 8192, la, lb, lb, ep);
    }
}

DI void p4_ln1_router(const Params& p, float* lds  , int gw, int NGW, int wave, int lane) {
    unsigned char* ws = p.ws;
    const float* Aout = (const float*)(ws + WS_AOUT); const float* st0 = (const float*)(ws + WS_STATS0); bf16_t* H1 = (bf16_t*)(ws + WS_XN);
    const float* WR = (const float*)(ws + WS_WR); unsigned* cnt = (unsigned*)(ws + WS_CTL) + CW_CNT; int* info = (int*)(ws + WS_TOKINFO); int* list = (int*)(ws + WS_LIST);
    float* lg = lds + wave * (8 * 36);
    for (int grp = gw; grp < NTOK / 8; grp += NGW) {
        f32x4 hv[8][4];
#pragma unroll
        for (int r = 0; r < 8; ++r) {
            const int row = grp * 8 + r;
            const float mu0 = st0[2 * row], rs0 = st0[2 * row + 1];
            const f32x4* xr = (const f32x4*)(p.in[I_X] + (size_t)row * DM) + lane; const f32x4* ar = (const f32x4*)(Aout + (size_t)row * DM) + lane;
            float s = 0.f;
#pragma unroll
            for (int j = 0; j < 4; ++j) { const f32x4 g = ((const f32x4*)p.in[I_LN0G])[lane + 64 * j], bb = ((const f32x4*)p.in[I_LN0B])[lane + 64 * j];
                const f32x4 h0 = (xr[64 * j] - mu0) * rs0 * g + bb; hv[r][j] = h0 * ALPHA + ar[64 * j]; s += (hv[r][j].x + hv[r][j].y) + (hv[r][j].z + hv[r][j].w); }
            const float mean = wave_sum(s) * (1.f / DM); float s2 = 0.f;
#pragma unroll
            for (int j = 0; j < 4; ++j) { hv[r][j] = hv[r][j] - mean; s2 += (hv[r][j].x * hv[r][j].x + hv[r][j].y * hv[r][j].y) + (hv[r][j].z * hv[r][j].z + hv[r][j].w * hv[r][j].w); }
            const float rstd = 1.f / sqrtf(wave_sum(s2) * (1.f / DM) + LN_EPS);
            u32x2* o8 = (u32x2*)(H1 + (size_t)row * DM) + lane;
#pragma unroll
            for (int j = 0; j < 4; ++j) { const f32x4 g = ((const f32x4*)p.in[I_LN1G])[lane + 64 * j], bb = ((const f32x4*)p.in[I_LN1B])[lane + 64 * j];
                hv[r][j] = hv[r][j] * rstd * g + bb; u32x2 w; w.x = pk2(hv[r][j].x, hv[r][j].y); w.y = pk2(hv[r][j].z, hv[r][j].w); o8[64 * j] = w; }
        }
#pragma unroll 1
        for (int e = 0; e < 36; ++e) {
            const f32x4* wr = (const f32x4*)(WR + (size_t)e * 1024) + lane;
            const f32x4 w0 = wr[0], w1 = wr[64], w2 = wr[128], w3 = wr[192];
#pragma unroll
            for (int r = 0; r < 8; ++r) {
                f32x4 t = hv[r][0] * w0 + hv[r][1] * w1 + hv[r][2] * w2 + hv[r][3] * w3;
                float s = wave_sum((t.x + t.y) + (t.z + t.w));
                if (lane == 0) lg[r * 36 + e] = s;
            }
        }
        asm volatile("s_waitcnt lgkmcnt(0)" ::: "memory");
        if (lane < 8) {
            const int row = grp * 8 + lane; const float* L = lg + lane * 36;
            float gl[4]; int gs = 0; float gm;
#pragma unroll
            for (int j = 0; j < 4; ++j) gl[j] = L[j] + p.in[I_BG][j];
            gm = gl[0];
#pragma unroll
            for (int j = 1; j < 4; ++j) if (gl[j] > gm) { gm = gl[j]; gs = j; }
            float den = 0.f;
#pragma unroll
            for (int j = 0; j < 4; ++j) den += expf(gl[j] - gm);
            const float gate = 1.0f / den;
            float v0 = -1e30f, v1 = -1e30f; int i0 = 0, i1 = 0;
#pragma unroll
            for (int j = 0; j < 8; ++j) { const float v = L[4 + gs * 8 + j] + p.in[I_BRT][gs * 8 + j];
                if (v > v0) { v1 = v0; i1 = i0; v0 = v; i0 = j; } else if (v > v1) { v1 = v; i1 = j; } }
            const float ex = expf(v1 - v0); const float w0 = gate / (1.f + ex), w1 = gate * ex / (1.f + ex);
            const int e0 = gs * 8 + i0, e1 = gs * 8 + i1;
            const unsigned p0 = atomicAdd(cnt + e0, 1u), p1 = atomicAdd(cnt + e1, 1u);
            list[e0 * NTOK + p0] = row; list[e1 * NTOK + p1] = row;
            int* ii = info + (size_t)row * 8; ii[0] = e0; ii[1] = (int)p0; ii[2] = __float_as_int(w0); ii[3] = e1; ii[4] = (int)p1; ii[5] = __float_as_int(w1);
        }
        asm volatile("s_waitcnt lgkmcnt(0)" ::: "memory");
    }
}

struct LA_gather { const bf16_t* H; const int* tok; DI float operator()(int r, int k) const { return bf2f(H[(size_t)tok[r] * 1024 + k]); } };
struct EP_hid { bf16_t* HID; int slot0, nvalid, n0; DI void operator()(int r, int n, float v1, float v3) const { if (r < nvalid) { const float s = v1 / (1.0f + expf(-v1)); HID[(size_t)(slot0 + r) * 256 + n0 + n] = (bf16_t)f2bf(s * v3); } } };
struct EP_y { bf16_t* Y; int slot0, nvalid, n0; DI void operator()(int r, int n, float v, float) const { if (r < nvalid) Y[(size_t)(slot0 + r) * 1024 + n0 + n] = (bf16_t)f2bf(v); } };
DI void nmoe_phase(const Params& p, int which, float* ldsf, int bid, int nb) {
    float* As = ldsf; float* Bs = ldsf + 32 * 132; float* Bs2 = Bs + 32 * 68; int* s_tok = (int*)(Bs2 + 32 * 68); int* s_cnt = s_tok + 128; int* s_tpre = s_cnt + 32; int* s_base = s_tpre + 33;
    unsigned char* ws = p.ws; const unsigned* cnt = (const unsigned*)(ws + WS_CTL) + CW_CNT; const int* list = (const int*)(ws + WS_LIST);
    const int tid = threadIdx.x;
    if (tid == 0) { int tp = 0, bs = 0; for (int e = 0; e < 32; ++e) { const int c = (int)cnt[e]; s_cnt[e] = c; s_tpre[e] = tp; s_base[e] = bs; tp += (c + 127) >> 7; bs += (c + 255) & ~255; } s_tpre[32] = tp; s_base[32] = bs; }
    __syncthreads();
    const int NT = which == 0 ? 4 : 16, total = s_tpre[32] * NT;
    for (int u = bid; u < total; u += nb) {
        const int T = u / NT, nt = u % NT; int e = 0; while (s_tpre[e + 1] <= T) ++e;
        const int mt = T - s_tpre[e], nvalid = min(128, s_cnt[e] - mt * 128), slot0 = s_base[e] + mt * 128;
        if (which == 0) {
            __syncthreads();
            if (tid < 128) s_tok[tid] = (tid < nvalid) ? list[e * NTOK + mt * 128 + tid] : 0;
            __syncthreads();
            const int j0 = nt * 64;
            const int r1 = e * 512 + (j0 >> 7) * 256 + (j0 & 127);
            LA_gather la{(const bf16_t*)(ws + WS_XN), s_tok}; LB_bf lb{(const bf16_t*)(ws + WS_W13T) + (size_t)r1 * 1024, 1024}; LB_bf lb2{(const bf16_t*)(ws + WS_W13T) + (size_t)(r1 + 128) * 1024, 1024};
            EP_hid ep{(bf16_t*)(ws + WS_OB), slot0, nvalid, j0};
            ngemm_tile<true, false>(As, Bs, Bs2, 1024, la, lb, lb2, ep);
        } else {
            LA_bf la{(const bf16_t*)(ws + WS_OB) + (size_t)slot0 * 256, 256}; LB_bf lb{(const bf16_t*)(ws + WS_W2T) + (size_t)(e * 1024 + nt * 64) * 256, 256};
            EP_y ep{(bf16_t*)(ws + WS_Y), slot0, nvalid, nt * 64};
            ngemm_tile<false, false>(As, Bs, Bs, 256, la, lb, lb, ep);
        }
    }
}

DI void p7_final(const Params& p, int gw, int NGW, int lane) {
    unsigned char* ws = p.ws; const unsigned* cnt = (const unsigned*)(ws + WS_CTL) + CW_CNT; const int* info = (const int*)(ws + WS_TOKINFO);
    const bf16_t* H1 = (const bf16_t*)(ws + WS_XN); const bf16_t* Y = (const bf16_t*)(ws + WS_Y);
    int base;
    { const int c = lane < 32 ? (int)cnt[lane] : 0; const int r = (c + 255) & ~255; int inc = r;
#pragma unroll
      for (int o = 1; o < 32; o <<= 1) { const int t = __shfl_up(inc, o); if ((lane & 31) >= o) inc += t; }
      base = inc - r; }
    for (int row = gw; row < NTOK; row += NGW) {
        const int* ii = info + (size_t)row * 8;
        const int e0 = ii[0], p0 = ii[1], e1 = ii[3], p1 = ii[4]; const float w0 = __int_as_float(ii[2]), w1 = __int_as_float(ii[5]);
        const size_t s0 = (size_t)(__shfl(base, e0) + p0), s1 = (size_t)(__shfl(base, e1) + p1);
        const u32x2* h8 = (const u32x2*)(H1 + (size_t)row * DM) + lane; const u32x2* y0 = (const u32x2*)(Y + s0 * DM) + lane; const u32x2* y1 = (const u32x2*)(Y + s1 * DM) + lane;
        f32x4 v[4]; float s = 0.f;
#pragma unroll
        for (int j = 0; j < 4; ++j) { const u32x2 a = h8[64 * j], b = y0[64 * j], c = y1[64 * j];
            v[j].x = ALPHA * __uint_as_float(a.x << 16) + w0 * __uint_as_float(b.x << 16) + w1 * __uint_as_float(c.x << 16);
            v[j].y = ALPHA * __uint_as_float(a.x & 0xffff0000u) + w0 * __uint_as_float(b.x & 0xffff0000u) + w1 * __uint_as_float(c.x & 0xffff0000u);
            v[j].z = ALPHA * __uint_as_float(a.y << 16) + w0 * __uint_as_float(b.y << 16) + w1 * __uint_as_float(c.y << 16);
            v[j].w = ALPHA * __uint_as_float(a.y & 0xffff0000u) + w0 * __uint_as_float(b.y & 0xffff0000u) + w1 * __uint_as_float(c.y & 0xffff0000u);
            s += (v[j].x + v[j].y) + (v[j].z + v[j].w); }
        const float mean = wave_sum(s) * (1.f / DM); float s2 = 0.f;
#pragma unroll
        for (int j = 0; j < 4; ++j) { v[j] = v[j] - mean; s2 += (v[j].x * v[j].x + v[j].y * v[j].y) + (v[j].z * v[j].z + v[j].w * v[j].w); }
        const float rstd = 1.f / sqrtf(wave_sum(s2) * (1.f / DM) + LN_EPS);
        f32x4* o = (f32x4*)(p.out + (size_t)row * DM) + lane;
#pragma unroll
        for (int j = 0; j < 4; ++j) { const f32x4 g = ((const f32x4*)p.in[I_LN2G])[lane + 64 * j], bb = ((const f32x4*)p.in[I_LN2B])[lane + 64 * j]; o[64 * j] = v[j] * rstd * g + bb; }
    }
}


#define LAS __attribute__((address_space(3)))
#define XB_TMO      128
#define XB_XCNT(j)  (256  + 64 * (j))
#define XB_XSUB(j)  (1280 + 64 * (j))
#define XB_XGEN(j)  (2304 + 64 * (j))
#define XB_TOP      3328
#define XB_TOPGEN   3392
#define XCD_BAR_WORDS 3456
#define XB_SPIN_CAP (1u << 18)

__device__ __forceinline__ unsigned xb_ld(unsigned* p)              { return __hip_atomic_load(p, __ATOMIC_RELAXED, __HIP_MEMORY_SCOPE_AGENT); }
__device__ __forceinline__ unsigned xb_add(unsigned* p, unsigned v) { return __hip_atomic_fetch_add(p, v, __ATOMIC_RELAXED, __HIP_MEMORY_SCOPE_AGENT); }
__device__ __forceinline__ unsigned xb_xcc_id() { return (unsigned)__builtin_amdgcn_s_getreg((3 << 11) | 20) & 0xFu; }
#define XB_SPIN(cond, bar) do { unsigned _sp = 0; while (cond) { __builtin_amdgcn_s_sleep(1); \
    if ((++_sp & 255u) == 0u) { if (xb_ld(&(bar)[XB_TMO])) break; if (_sp > XB_SPIN_CAP) { atomicAdd(&(bar)[XB_TMO], 1u); break; } } } } while (0)

struct XcdBarrier {
    unsigned* bar; unsigned x;
    volatile LAS unsigned* st;
};

__device__ __forceinline__ XcdBarrier xcd_barrier_post(unsigned* bar, volatile LAS unsigned* st) {
    XcdBarrier b; b.bar = bar; b.x = xb_xcc_id(); b.st = st;
    if (threadIdx.x == 0) (void)xb_add(&bar[XB_XCNT(b.x)], 1u);
    return b;
}
__device__ __forceinline__ void xcd_barrier_complete(unsigned* bar, unsigned x, unsigned& nloc, unsigned& nx) {
    const unsigned G = gridDim.x * gridDim.y * gridDim.z;
    unsigned sum, cnt, mine, sp = 0u;
    for (;;) {
        sum = 0u; cnt = 0u; mine = 0u;
#pragma unroll
        for (unsigned j = 0; j < 16; ++j) { const unsigned c = xb_ld(&bar[XB_XCNT(j)]); sum += c; cnt += (c > 0u) ? 1u : 0u; mine = (j == x) ? c : mine; }
        if (sum == G) break;
        __builtin_amdgcn_s_sleep(1);
        if ((++sp & 255u) == 0u) { if (xb_ld(&bar[XB_TMO])) break; if (sp > XB_SPIN_CAP) { atomicAdd(&bar[XB_TMO], 1u); break; } }
    }
    nloc = mine > 0u ? mine : 1u; nx = cnt > 0u ? cnt : 1u;
}

__device__ __forceinline__ void xcd_barrier(const XcdBarrier& b) {
    asm volatile("s_waitcnt vmcnt(0)" ::: "memory");
    __syncthreads();
    if (threadIdx.x == 0) {
        unsigned* bar = b.bar;
        __builtin_amdgcn_s_waitcnt(0);
        unsigned nloc = b.st[0], nx = b.st[1];
        if (nloc == 0u) { xcd_barrier_complete(bar, b.x, nloc, nx); b.st[0] = nloc; b.st[1] = nx; }
        const unsigned old = xb_add(&bar[XB_XSUB(b.x)], 1u);
        const unsigned gen = old / nloc;
        if (old + 1u == (gen + 1u) * nloc) {
            __builtin_amdgcn_fence(__ATOMIC_RELEASE, "agent");
            asm volatile("s_waitcnt vmcnt(0)" ::: "memory");
            const unsigned og = xb_add(&bar[XB_TOP], 1u);
            const unsigned tg = og / nx;
            if (og + 1u == (tg + 1u) * nx) xb_add(&bar[XB_TOPGEN], 1u);
            else XB_SPIN(xb_ld(&bar[XB_TOPGEN]) == tg, bar);
            __builtin_amdgcn_fence(__ATOMIC_ACQUIRE, "agent");
            xb_add(&bar[XB_XGEN(b.x)], 1u);
            asm volatile("s_waitcnt vmcnt(0)" ::: "memory");
        } else {
            XB_SPIN(xb_ld(&bar[XB_XGEN(b.x)]) == gen, bar);
            __builtin_amdgcn_fence(__ATOMIC_ACQUIRE, "agent");
            asm volatile("s_waitcnt vmcnt(0)" ::: "memory");
        }
    }
    __syncthreads();
}

constexpr int LDS_BYTES = 147456;
constexpr int LDSCTL_OFF = 131072, MISC_OFF = LDSCTL_OFF + 320;
constexpr int CW_BAR = 4096;
struct Args { Params p; int ph_lo, ph_hi; };
__global__ void __launch_bounds__(512, 2) mk_fwd(Args a) {
    extern __shared__ __attribute__((aligned(16))) unsigned char smem[];
    LAS unsigned char* lds = (LAS unsigned char*)smem;
    const int tid = threadIdx.x, lane = tid & 63, wave = __builtin_amdgcn_readfirstlane(tid >> 6);
    const int G = gridDim.x, bx = blockIdx.x, vcu = (G % 8 == 0) ? (bx % 8) * (G / 8) + bx / 8 : bx;
    const int lo = a.ph_lo, hi = a.ph_hi;
    unsigned char* ws = a.p.ws;
    volatile LAS unsigned* MISC = (volatile LAS unsigned*)(lds + MISC_OFF);
    for (int u = tid; u < (LDS_BYTES - LDSCTL_OFF) / 4; u += 512) ((LAS unsigned*)(lds + LDSCTL_OFF))[u] = 0u;
    __syncthreads();
    XcdBarrier bar = xcd_barrier_post((unsigned*)(ws + WS_CTL) + CW_BAR, MISC + 8);
#ifndef PHMASK
#define PHMASK 0xffff
#endif
#define IN(k) (((PHMASK >> (k)) & 1) && lo <= (k) && (k) < hi)
#define SEAM(k) do { if (IN(k) && IN((k) + 1)) xcd_barrier(bar); } while (0)
    if (IN(0)) { p0_prologue(a.p, (float*)smem, vcu * 8 + wave, G * 8, wave, lane); }
    SEAM(0);
    if (IN(1)) {
        { pg8::Gemm g{(const bf16_t*)(ws + WS_XN), (const bf16_t*)(ws + WS_WINT), NTOK, NIN, DM}; pg8::StaticOrder S; S.init(NTOK, NIN, G, bx);
          pg8::EpiInproj E{ws}; pg8::gemm_phase<pg8::EpiInproj, pg8::StaticOrder, true, true>(lds, g, S, E); }
        { pg8::Gemm g{(const bf16_t*)(ws + WS_MEMB), (const bf16_t*)(ws + WS_WMT), NB * MEMLEN, 512, DM}; pg8::StaticOrder S; S.init(NB * MEMLEN, 512, G, bx);
          pg8::EpiBf16Plain E{(bf16_t*)(ws + WS_MKV), 512}; pg8::gemm_phase<pg8::EpiBf16Plain, pg8::StaticOrder, true, true>(lds, g, S, E); }
    }
    SEAM(1);
    if (IN(2)) { kmax_phase(a.p, vcu * 8 + wave, G * 8, lane); }
    SEAM(2);
    if (IN(3)) {
        for (int u = vcu; u < 256; u += G) att::attn_unit<128, true>(lds, a.p, u, wave, lane);
        { int lane_b = lane; asm volatile("" : "+v"(lane_b)); for (int u = vcu; u < 256; u += G) att::attn_unit<64, false>(lds, a.p, u, wave, lane_b); }
        __syncthreads();
        nfourier_phase(a.p, (float*)smem, (float*)smem + 32 * 132, bx, G);
        __syncthreads();
    }
    SEAM(3);
    if (IN(4)) {
        pg8::Gemm g{(const bf16_t*)(ws + WS_OB), (const bf16_t*)(ws + WS_WOT), NTOK, DM, DM}; pg8::StaticOrder S; S.init(NTOK, DM, G, bx);
        pg8::EpiF32Plain E{(float*)(ws + WS_AOUT), DM}; pg8::gemm_phase<pg8::EpiF32Plain, pg8::StaticOrder, true, true>(lds, g, S, E);
    }
    SEAM(4);
    if (IN(5)) { p4_ln1_router(a.p, (float*)smem, vcu * 8 + wave, G * 8, wave, lane); }
    SEAM(5);
    if (IN(6)) { nmoe_phase(a.p, 0, (float*)smem, bx, G); __syncthreads(); }
    SEAM(6);
    if (IN(7)) { nmoe_phase(a.p, 1, (float*)smem, bx, G); __syncthreads(); }
    SEAM(7);
    if (IN(8)) { p7_final(a.p, vcu * 8 + wave, G * 8, lane); }
#undef IN
#undef SEAM
}

#ifndef N_LAUNCH_SPLIT
#define N_LAUNCH_SPLIT 0
#endif
extern "C" void kernel_launch(void* const* d_in, const int* in_sizes, int n_in, void* d_out, int out_size, void* d_ws, size_t ws_size, hipStream_t stream) {
    Params p{};
    for (int i = 0; i < 25; ++i) p.in[i] = (const float*)d_in[i];
    p.out = (float*)d_out; p.ws = (unsigned char*)d_ws;
    static int grid = 0;
    if (!grid) {
        (void)hipFuncSetAttribute((const void*)mk_fwd, hipFuncAttributeMaxDynamicSharedMemorySize, LDS_BYTES);
        int dev = 0, cus = 0, per_cu = 0;
        (void)hipGetDevice(&dev); (void)hipDeviceGetAttribute(&cus, hipDeviceAttributeMultiprocessorCount, dev);
        (void)hipOccupancyMaxActiveBlocksPerMultiprocessor(&per_cu, (const void*)mk_fwd, 512, LDS_BYTES);
        if (per_cu < 1) per_cu = 1;
        grid = cus * 1;
        if (grid > 256) grid = 256;
        (void)hipGetLastError();
    }
    (void)hipMemsetAsync((char*)d_ws + WS_CTL, 0, CTL_BYTES, stream);
    Args a{}; a.p = p;
#if N_LAUNCH_SPLIT
    for (int k = 0; k < 9; ++k) { a.ph_lo = k; a.ph_hi = k + 1; hipLaunchKernelGGL(mk_fwd, dim3(grid), dim3(512), LDS_BYTES, stream, a); }
#else
    a.ph_lo = 0; a.ph_hi = 9;
    void* kargs[] = {&a};
    (void)hipLaunchCooperativeKernel((const void*)mk_fwd, dim3(grid), dim3(512), kargs, LDS_BYTES, stream);
#endif
}
```

```cpp
#include <hip/hip_runtime.h>
#include <stdint.h>

#define DI __device__ __forceinline__
typedef unsigned short bf16_t;
typedef float f32x4 __attribute__((ext_vector_type(4)));
typedef unsigned u32x4 __attribute__((ext_vector_type(4)));
typedef unsigned u32x2 __attribute__((ext_vector_type(2)));

constexpr int NB = 4, SEQ = 4096, DM = 1024, NTOK = NB * SEQ;
constexpr int NEXP = 32, DEXP = 256, MEMLEN = 256;
constexpr int NIN = 2304;
constexpr float LOG2E = 1.4426950408889634f;
constexpr float C2 = 0.125f * LOG2E;
constexpr float ALPHA = 1.189207115002721f;
constexpr float LN_EPS = 1e-5f;
constexpr float LAM_INIT = 0.2f;

constexpr size_t MiB = 1u << 20;
constexpr size_t WS_CTL = 0, CTL_BYTES = 1 * MiB;
constexpr size_t WS_WINT = 1 * MiB;
constexpr size_t WS_WOT = 6 * MiB;
constexpr size_t WS_WMT = 8 * MiB;
constexpr size_t WS_MEMB = 9 * MiB;
constexpr size_t WS_WR = 11 * MiB;
constexpr size_t WS_COSTAB = 11 * MiB + 256 * 1024;
constexpr size_t WS_STATS0 = 11 * MiB + 512 * 1024;
constexpr size_t WS_MKV = 12 * MiB;
constexpr size_t WS_TOKINFO = 13 * MiB;
constexpr size_t WS_LIST = 14 * MiB;
constexpr size_t WS_W13T = 16 * MiB;
constexpr size_t WS_W2T = 48 * MiB;
constexpr size_t WS_XN = 64 * MiB;
constexpr size_t WS_OB = 96 * MiB;
constexpr size_t WS_QB = 128 * MiB, WS_KB = 144 * MiB, WS_VB = 160 * MiB, WS_MQB = 176 * MiB, WS_ZB = 184 * MiB;
constexpr size_t WS_AOUT = 128 * MiB;
constexpr size_t WS_Y = 128 * MiB;
constexpr int CW_CNT = 64;

struct Params {
    const float* in[25];
    float* out;
    unsigned char* ws;
};
enum { I_X = 0, I_MEM, I_LN0G, I_LN0B, I_RELB, I_WIN, I_WMKV, I_WF, I_LQ1, I_LK1, I_LQ2, I_LK2, I_SUBG, I_WOUT, I_LN1G, I_LN1B,
       I_WG, I_BG, I_WRT, I_BRT, I_W1, I_W3, I_W2, I_LN2G, I_LN2B };

DI float bf2f(bf16_t v) { return __uint_as_float(((unsigned)v) << 16); }
DI unsigned f2bf(float f) { unsigned u = __float_as_uint(f); return (u + 0x7fffu + ((u >> 16) & 1u)) >> 16; }
DI unsigned pk2(float lo, float hi) { return f2bf(lo) | (f2bf(hi) << 16); }
DI float wave_sum(float v) {
#pragma unroll
    for (int o = 1; o < 64; o <<= 1) v += __shfl_xor(v, o);
    return v;
}
DI int t5_bucket(int rel) {
    const int n = rel < 0 ? -rel : rel;
    int b;
    if (n < 8) b = n; else if (n < 12) b = 8; else if (n < 16) b = 9; else if (n < 23) b = 10; else if (n < 32) b = 11;
    else if (n < 46) b = 12; else if (n < 64) b = 13; else if (n < 91) b = 14; else b = 15;
    return b + (rel > 0 ? 16 : 0);
}


namespace pg8 {
#define PG8_LAS __attribute__((address_space(3)))
typedef unsigned short bf16_t;
typedef short bf16x8 __attribute__((ext_vector_type(8)));
typedef float f32x4 __attribute__((ext_vector_type(4)));
typedef unsigned u32x4 __attribute__((ext_vector_type(4)));
constexpr int BM = 256, BK = 64, HALF = 128, HTB = HALF * BK * 2  , STAGE_BYTES = 8 * HTB, NXCD = 8, WGM = 8;

__host__ __device__ __forceinline__ int lds_byte(int r, int c) { const int st = (r >> 4) * 2 + (c >> 5), rr = r & 15, cc = c & 31, ob = rr * 64 + cc * 2; return st * 1024 + (ob ^ (((ob >> 9) & 1) << 5)); }
__host__ __device__ __forceinline__ void stage_rc(int b, int& R, int& C) { const int st = b / 1024, sb = b % 1024, swz = sb ^ (((sb >> 9) & 1) << 5); R = (st >> 1) * 16 + swz / 64; C = (st & 1) * 32 + (swz % 64) / 2; }
__host__ __device__ __forceinline__ int perm32(int rho) { const int n = rho >> 4, i = rho & 15; return 8 * (i >> 2) + 4 * n + (i & 3); }

struct Unit { int pm, pn; };
struct Gemm { const bf16_t* A; const bf16_t* Bt; int M, N, K; };

struct StaticOrder {
    int nM, nN, nwg, G, c;
    __host__ __device__ void init(int M, int N, int G_, int c_) { nM = M / BM; nN = N / BM; nwg = nM * nN; G = G_; c = c_; }
    __host__ __device__ bool next(int i, Unit& u) const {
        const long L = (long)i * G + c; if (L >= nwg) return false;
        int wgid = (int)L; { const int q = nwg / NXCD, r = nwg % NXCD, xcd = wgid % NXCD, off = wgid / NXCD; wgid = (xcd < r ? xcd * (q + 1) : r * (q + 1) + (xcd - r) * q) + off; }
        const int nig = WGM * nN, gid = wgid / nig, fm = gid * WGM, gsz = (nM - fm) < WGM ? (nM - fm) : WGM;
        u.pm = fm + ((wgid % nig) % gsz); u.pn = (wgid % nig) / gsz; return true;
    }
    __device__ __forceinline__ void a_ready(const Unit&) const {}
    __device__ __forceinline__ void done(const Unit&) const {}
};

__device__ __forceinline__ unsigned cvt_pk_bf16(float lo, float hi) { unsigned r; asm volatile("v_cvt_pk_bf16_f32 %0, %1, %2" : "=v"(r) : "v"(lo), "v"(hi)); return r; }
typedef float f32x2 __attribute__((ext_vector_type(2)));
__device__ __forceinline__ f32x2 gelu_pk(f32x2 v) {
    const f32x2 av = __builtin_elementwise_abs(v), d = av * 0.2316418882f + 1.0f;
    f32x2 t; t.x = __builtin_amdgcn_rcpf(d.x); t.y = __builtin_amdgcn_rcpf(d.y);
    f32x2 q = t * 0.5307027145f + (-0.7265760135f); q = q * t + 0.7107068705f; q = q * t + (-0.142248368f); q = q * t + 0.127414796f; q = q * t;
    const f32x2 s = (v * v) * (-0.72134752044f);
    f32x2 e; e.x = __builtin_amdgcn_exp2f(s.x); e.y = __builtin_amdgcn_exp2f(s.y);
    const f32x2 m = v * (q * e), r = v - m;
    f32x2 o; o.x = v.x < 0.f ? m.x : r.x; o.y = v.y < 0.f ? m.y : r.y; return o;
}

template <int ACT  > struct EpiBf16 {
    static constexpr bool PERM = true, AFTER_DRAIN = false; static_assert(ACT == 0 || ACT == 1, "EpiBf16: ACT is 0 (none) or 1 (gelu_pk)");
    bf16_t* O; int ldc; const float* bias; int split_cols; size_t split_stride; float scale0;
    __device__ __forceinline__ void operator()(const f32x4 (&acc)[2][2][4][2], const Unit& u, int wr, int wc, int fr, int fq) const {
        const int row0 = u.pm * BM + wr * 64 + fr; int colt = u.pn * BM; bf16_t* base = O;
        float sc = 1.f; if (split_cols) { const int t = colt / split_cols; base += (size_t)t * split_stride; colt -= t * split_cols; if (t == 0) sc = scale0; }
        const int col0 = colt + wc * 32 + 8 * fq, bcol0 = u.pn * BM + wc * 32 + 8 * fq;
        f32x4 bv[2][2];
#pragma unroll
        for (int bj = 0; bj < 2; ++bj)
#pragma unroll
            for (int n = 0; n < 2; ++n) bv[bj][n] = bias ? *(const f32x4*)(bias + bcol0 + bj * HALF + 4 * n) : (f32x4){0.f, 0.f, 0.f, 0.f};
#pragma unroll
        for (int ai = 0; ai < 2; ++ai)
#pragma unroll
            for (int m = 0; m < 4; ++m) { bf16_t* rowp = base + (size_t)(row0 + ai * HALF + m * 16) * ldc + col0;
#pragma unroll
                for (int bj = 0; bj < 2; ++bj) { f32x4 v0 = acc[ai][bj][m][0] + bv[bj][0], v1 = acc[ai][bj][m][1] + bv[bj][1];
                    if (ACT == 1) { f32x2 a = gelu_pk((f32x2){v0[0], v0[1]}), b = gelu_pk((f32x2){v0[2], v0[3]}), c = gelu_pk((f32x2){v1[0], v1[1]}), d = gelu_pk((f32x2){v1[2], v1[3]});
                        v0 = (f32x4){a.x, a.y, b.x, b.y}; v1 = (f32x4){c.x, c.y, d.x, d.y}; }
                    v0 = v0 * sc; v1 = v1 * sc; u32x4 w; w.x = cvt_pk_bf16(v0[0], v0[1]); w.y = cvt_pk_bf16(v0[2], v0[3]); w.z = cvt_pk_bf16(v1[0], v1[1]); w.w = cvt_pk_bf16(v1[2], v1[3]);
                    *(u32x4*)(rowp + bj * HALF) = w; } }
    }
};

struct PanelStats {
    unsigned* xbuf;
    unsigned* cnt;
    unsigned* tmo;
    int ntn; float eps;
    unsigned code;
    __device__ __forceinline__ bool run(const f32x4 (&v)[2][2][4][2], const Unit& u, int wr, int wc, int fr, int fq, PG8_LAS unsigned char* lds, int wid, int lane) const {
        typedef float f32x2v __attribute__((ext_vector_type(2)));
        PG8_LAS f32x2v* P = (PG8_LAS f32x2v*)lds;
        PG8_LAS f32x2v* S = (PG8_LAS f32x2v*)(lds + 8192);
        PG8_LAS unsigned* flag = (PG8_LAS unsigned*)(lds + 8192 + 2048);
#pragma unroll
        for (int ai = 0; ai < 2; ++ai)
#pragma unroll
            for (int m = 0; m < 4; ++m) {
                float s = 0.f;
#pragma unroll
                for (int bj = 0; bj < 2; ++bj)
#pragma unroll
                    for (int n = 0; n < 2; ++n) { const f32x4 x = v[ai][bj][m][n]; s += (x[0] + x[1]) + (x[2] + x[3]); }
                s += __shfl_xor(s, 16); s += __shfl_xor(s, 32);
                const float mw = s * (1.0f / 64.0f); float q = 0.f;
#pragma unroll
                for (int bj = 0; bj < 2; ++bj)
#pragma unroll
                    for (int n = 0; n < 2; ++n) { const f32x4 d = v[ai][bj][m][n] - mw; q += (d[0] * d[0] + d[1] * d[1]) + (d[2] * d[2] + d[3] * d[3]); }
                q += __shfl_xor(q, 16); q += __shfl_xor(q, 32);
                if (fq == 0) P[(ai * HALF + wr * 64 + m * 16 + fr) * 4 + wc] = (f32x2v){mw, q};
            }
        asm volatile("s_waitcnt lgkmcnt(0)" ::: "memory"); __builtin_amdgcn_s_barrier(); asm volatile("" ::: "memory");
#if defined(BROKEN_EXCHANGE_NO_WAIT)
#warning BROKEN CONTROL BUILD: the row-statistics exchange does not wait; results are wrong by design
        if (blockIdx.x >= 64) { const long long t0_ = clock64(); while (clock64() - t0_ < 60000) __builtin_amdgcn_s_sleep(8); }
#endif
        const int row = wid * 32 + (lane & 31);
        if (lane < 32) {
            const f32x2v a = P[row * 4 + 0], b = P[row * 4 + 1], c = P[row * 4 + 2], d = P[row * 4 + 3];
            const float mt = (a.x + b.x + c.x + d.x) * 0.25f;
            const float da = a.x - mt, db = b.x - mt, dc = c.x - mt, dd = d.x - mt;
            const float m2 = (a.y + b.y) + (c.y + d.y) + 64.0f * ((da * da + db * db) + (dc * dc + dd * dd));
            unsigned long long* slot = (unsigned long long*)xbuf + ((size_t)(u.pm * BM + row) * 4 + u.pn);
            __hip_atomic_store(slot, ((unsigned long long)__float_as_uint(m2) << 32) | __float_as_uint(mt), __ATOMIC_RELAXED, __HIP_MEMORY_SCOPE_AGENT);
        }
        asm volatile("s_waitcnt vmcnt(0)" ::: "memory");
        if (lane == 0) __hip_atomic_fetch_add(cnt + 64 * u.pm, 1u, __ATOMIC_RELAXED, __HIP_MEMORY_SCOPE_AGENT);
        if (wid == 0) {
            bool dead = false; const unsigned long long t0 = __builtin_amdgcn_s_memrealtime(); const unsigned want = 8u * (unsigned)ntn;
            for (;;) {
#if defined(BROKEN_EXCHANGE_NO_WAIT)
                break;
#endif
                if ((unsigned)__builtin_amdgcn_readfirstlane(__hip_atomic_load(cnt + 64 * u.pm, __ATOMIC_RELAXED, __HIP_MEMORY_SCOPE_AGENT)) >= want) break;
                if (__builtin_amdgcn_s_memrealtime() - t0 > 2000000ull) {
                    if (lane == 0) { unsigned expect = 0u; __hip_atomic_compare_exchange_strong(tmo + 1, &expect, code | (unsigned)(u.pm & 0xff), __ATOMIC_RELAXED, __ATOMIC_RELAXED, __HIP_MEMORY_SCOPE_AGENT);
                                     __hip_atomic_store(tmo, 1u, __ATOMIC_RELAXED, __HIP_MEMORY_SCOPE_AGENT); }
                    dead = true; break; }
                __builtin_amdgcn_s_sleep(2);
            }
            __builtin_amdgcn_fence(__ATOMIC_ACQUIRE, "agent");
            if (lane == 0) flag[0] = dead ? 1u : 0u;
        }
        asm volatile("s_waitcnt vmcnt(0) lgkmcnt(0)" ::: "memory"); __builtin_amdgcn_s_barrier(); asm volatile("" ::: "memory");
        const bool bad = flag[0] != 0u;
        if (lane < 32) {
            const unsigned long long* slot = (const unsigned long long*)xbuf + (size_t)(u.pm * BM + row) * 4; float mt[4], m2[4]; float ms = 0.f;
#pragma unroll
            for (int t = 0; t < 4; ++t) { if (t < ntn) { const unsigned long long w = __hip_atomic_load(slot + t, __ATOMIC_RELAXED, __HIP_MEMORY_SCOPE_AGENT); mt[t] = __uint_as_float((unsigned)w); m2[t] = __uint_as_float((unsigned)(w >> 32)); } else { mt[t] = 0.f; m2[t] = 0.f; } ms += mt[t]; }
            const float mean = ms / (float)ntn; float q = 0.f;
#pragma unroll
            for (int t = 0; t < 4; ++t) if (t < ntn) { const float dm = mt[t] - mean; q += m2[t] + 256.0f * dm * dm; }
            S[row] = (f32x2v){mean, 1.0f / sqrtf(q / (256.0f * (float)ntn) + eps)};
        }
        asm volatile("s_waitcnt lgkmcnt(0)" ::: "memory"); __builtin_amdgcn_s_barrier(); asm volatile("" ::: "memory");
        return bad;
    }
};
struct EpiLnRes {
    static constexpr bool PERM = false, AFTER_DRAIN = true;
    const float* base; float* out; int ldc; const float* bias; PanelStats st; unsigned poison;
    __device__ __forceinline__ void fused(f32x4 (&acc)[2][2][4][2], const Unit& u, int wr, int wc, int fr, int fq, PG8_LAS unsigned char* lds, int wid, int lane) const {
        typedef float f32x2v __attribute__((ext_vector_type(2)));
        const PG8_LAS f32x2v* S = (const PG8_LAS f32x2v*)(lds + 8192);
        const int col0 = u.pn * BM + wc * 32 + 4 * fq;
#pragma unroll
        for (int bj = 0; bj < 2; ++bj)
#pragma unroll
            for (int n = 0; n < 2; ++n) { const f32x4 bv = bias ? *(const f32x4*)(bias + col0 + bj * HALF + n * 16) : (f32x4){0.f, 0.f, 0.f, 0.f};
#pragma unroll
                for (int ai = 0; ai < 2; ++ai)
#pragma unroll
                    for (int m = 0; m < 4; ++m) acc[ai][bj][m][n] += bv; }
        f32x4 pre[4][2][2];
#pragma unroll
        for (int m = 0; m < 4; ++m) { const size_t off = (size_t)(u.pm * BM + wr * 64 + m * 16 + fr) * ldc + col0;
#pragma unroll
            for (int bj = 0; bj < 2; ++bj)
#pragma unroll
                for (int n = 0; n < 2; ++n) pre[m][bj][n] = *(const f32x4*)(base + off + bj * HALF + n * 16); }
        const bool bad = st.run(acc, u, wr, wc, fr, fq, lds, wid, lane) || poison != 0u;
        const float qnan = __builtin_nanf("");
#pragma unroll
        for (int ai = 0; ai < 2; ++ai)
#pragma unroll
            for (int m = 0; m < 4; ++m) { const int r = ai * HALF + wr * 64 + m * 16 + fr; const f32x2v sr = S[r]; const size_t off = (size_t)(u.pm * BM + r) * ldc + col0;
#pragma unroll
                for (int bj = 0; bj < 2; ++bj)
#pragma unroll
                    for (int n = 0; n < 2; ++n) { const f32x4 bs = ai == 0 ? pre[m][bj][n] : *(const f32x4*)(base + off + bj * HALF + n * 16); f32x4 o = bs + (acc[ai][bj][m][n] - sr.x) * sr.y;
                        if (bad) o = (f32x4){qnan, qnan, qnan, qnan}; *(f32x4*)(out + off + bj * HALF + n * 16) = o; }
                if (m & 1) asm volatile("" ::: "memory"); }
    }
};
struct EpiLnResLn {
    static constexpr bool PERM = false, AFTER_DRAIN = true;
    const float* base; float* out; bf16_t* xn; int ldc; const float* bias; PanelStats st1, st2; unsigned poison;
    __device__ __forceinline__ void fused(f32x4 (&acc)[2][2][4][2], const Unit& u, int wr, int wc, int fr, int fq, PG8_LAS unsigned char* lds, int wid, int lane) const {
        typedef float f32x2v __attribute__((ext_vector_type(2))); typedef unsigned u32x2v __attribute__((ext_vector_type(2)));
        const PG8_LAS f32x2v* S = (const PG8_LAS f32x2v*)(lds + 8192);
        const int col0 = u.pn * BM + wc * 32 + 4 * fq;
#pragma unroll
        for (int bj = 0; bj < 2; ++bj)
#pragma unroll
            for (int n = 0; n < 2; ++n) { const f32x4 bv = bias ? *(const f32x4*)(bias + col0 + bj * HALF + n * 16) : (f32x4){0.f, 0.f, 0.f, 0.f};
#pragma unroll
                for (int ai = 0; ai < 2; ++ai)
#pragma unroll
                    for (int m = 0; m < 4; ++m) acc[ai][bj][m][n] += bv; }
        bool bad = st1.run(acc, u, wr, wc, fr, fq, lds, wid, lane) || poison != 0u;
        const float qnan = __builtin_nanf("");
#pragma unroll
        for (int ai = 0; ai < 2; ++ai)
#pragma unroll
            for (int m = 0; m < 4; ++m) { const int r = ai * HALF + wr * 64 + m * 16 + fr; const f32x2v sr = S[r]; const size_t off = (size_t)(u.pm * BM + r) * ldc + col0;
#pragma unroll
                for (int bj = 0; bj < 2; ++bj)
#pragma unroll
                    for (int n = 0; n < 2; ++n) { const f32x4 bs = *(const f32x4*)(base + off + bj * HALF + n * 16); acc[ai][bj][m][n] = bs + (acc[ai][bj][m][n] - sr.x) * sr.y; }
                asm volatile("" : "+v"(acc[ai][0][m][0]), "+v"(acc[ai][0][m][1]), "+v"(acc[ai][1][m][0]), "+v"(acc[ai][1][m][1]));
                if (m & 1) asm volatile("" ::: "memory"); }
        const bool bad1 = bad;
        bad = st2.run(acc, u, wr, wc, fr, fq, lds, wid, lane) || bad;
#pragma unroll
        for (int ai = 0; ai < 2; ++ai)
#pragma unroll
            for (int m = 0; m < 4; ++m) { const int r = ai * HALF + wr * 64 + m * 16 + fr; const f32x2v sr = S[r]; const size_t off = (size_t)(u.pm * BM + r) * ldc + col0;
#pragma unroll
                for (int bj = 0; bj < 2; ++bj)
#pragma unroll
                    for (int n = 0; n < 2; ++n) { const f32x4 x1 = acc[ai][bj][m][n]; *(f32x4*)(out + off + bj * HALF + n * 16) = bad1 ? (f32x4){qnan, qnan, qnan, qnan} : x1;
                        const f32x4 o = (x1 - sr.x) * sr.y; u32x2v w; w.x = cvt_pk_bf16(o[0], o[1]); w.y = cvt_pk_bf16(o[2], o[3]);
                        if (bad) { w.x = 0x7fc07fc0u; w.y = 0x7fc07fc0u; } *(u32x2v*)(xn + off + bj * HALF + n * 16) = w; }
                asm volatile("" ::: "memory"); }
    }
};

template <class Epi, class Sched, bool ALIGN_EPI = false, bool SP2 = false, bool GATHER = false>
__device__ __forceinline__ void gemm_phase(PG8_LAS unsigned char* lds, const Gemm g, const Sched& S, const Epi& E) {
    const int tid = threadIdx.x, wid = __builtin_amdgcn_readfirstlane(tid >> 6), lane = tid & 63, wr = wid >> 2, wc = wid & 3, fr = lane & 15, fq = lane >> 4;
    const int K = g.K, nt = K / BK;
    static_assert(!GATHER || SP2, "GATHER is wired into the SP2 loop only");
    unsigned voffA[2], voffB[2]; int gR_[2], gC_[2];
#pragma unroll
    for (int i = 0; i < 2; ++i) { int R, C; stage_rc(tid * 16 + i * 8192, R, C); const int Rb = Epi::PERM ? ((R & ~31) + perm32(R & 31)) : R; gR_[i] = R; gC_[i] = C;
        voffA[i] = (unsigned)(R * K + C) * 2u; voffB[i] = (unsigned)(Rb * K + C) * 2u; }
    unsigned gvo[2][2] = {{0u, 0u}, {0u, 0u}}, gvn[2][2] = {{0u, 0u}, {0u, 0u}};
#define PG8_GOFF(dst, unit) do { _Pragma("unroll") for (int h_ = 0; h_ < 2; ++h_) _Pragma("unroll") for (int i_ = 0; i_ < 2; ++i_) \
        dst[h_][i_] = ((unsigned)S.a_row(unit, h_ * HALF + gR_[i_]) * (unsigned)K + (unsigned)gC_[i_]) * 2u; \
        asm volatile("" : "+v"(dst[0][0]), "+v"(dst[0][1]), "+v"(dst[1][0]), "+v"(dst[1][1])); } while (0)
    const size_t kstep = (size_t)(BK * 2);
    const size_t hstep = (size_t)HALF * K * 2;
    const size_t tstep = 2 * hstep;
    const unsigned ldsw = (unsigned)wid * 1024u;
    const int aoff = lds_byte(wr * 64 + fr, fq * 8), boff = lds_byte(wc * 32 + fr, fq * 8);
#define PG8_SA(b, h) (((b) * 2 + (h)) * HTB)
#define PG8_SB(b, h) ((4 + (b) * 2 + (h)) * HTB)
#define PG8_STAGE(bufoff, gbase, voff) do { _Pragma("unroll") for (int _i = 0; _i < 2; ++_i) \
        __builtin_amdgcn_global_load_lds((const unsigned*)((const char*)(gbase) + (voff)[_i]), (PG8_LAS unsigned*)(lds + (bufoff) + ldsw + _i * 8192), 16, 0, 0); } while (0)
#define PG8_STAGE_AH(bufoff, gbase, h, usen) do { _Pragma("unroll") for (int _i = 0; _i < 2; ++_i) { \
        const unsigned vo_ = GATHER ? ((usen) ? gvn[h][_i] : gvo[h][_i]) : voffA[_i]; \
        __builtin_amdgcn_global_load_lds((const unsigned*)((const char*)(gbase) + (GATHER ? (size_t)0 : (size_t)(h) * hstep) + vo_), (PG8_LAS unsigned*)(lds + (bufoff) + ldsw + _i * 8192), 16, 0, 0); } } while (0)
#define PG8_LDA(dst, b, h) do { _Pragma("unroll") for (int m = 0; m < 4; ++m) _Pragma("unroll") for (int k = 0; k < 2; ++k) dst[m][k] = *(const PG8_LAS bf16x8*)(lds + PG8_SA(b, h) + aoff + m * 2048 + k * 1024); } while (0)
#define PG8_LDB(dst, b, h) do { _Pragma("unroll") for (int n = 0; n < 2; ++n) _Pragma("unroll") for (int k = 0; k < 2; ++k) dst[n][k] = *(const PG8_LAS bf16x8*)(lds + PG8_SB(b, h) + boff + n * 2048 + k * 1024); } while (0)
#define PG8_MMA(ai, bj, At, Bt) do { __builtin_amdgcn_s_setprio(1); _Pragma("unroll") for (int m = 0; m < 4; ++m) _Pragma("unroll") for (int n = 0; n < 2; ++n) _Pragma("unroll") for (int k = 0; k < 2; ++k) \
        acc[ai][bj][m][n] = __builtin_amdgcn_mfma_f32_16x16x32_bf16(Bt[n][k], At[m][k], acc[ai][bj][m][n], 0, 0, 0); __builtin_amdgcn_s_setprio(0); } while (0)
#define PG8_WAIT_V(n) asm volatile("s_waitcnt vmcnt(" #n ")" ::: "memory")
#define PG8_WAIT_L(n) asm volatile("s_waitcnt lgkmcnt(" #n ")" ::: "memory")
#define PG8_BAR __builtin_amdgcn_s_barrier()
#define PG8_SCHED __builtin_amdgcn_sched_barrier(0)
    Unit cur, nxt; int ui = 0;
    if (!S.next(0, cur)) return;
    f32x4 acc[2][2][4][2];
#pragma unroll
    for (int a = 0; a < 2; ++a)
#pragma unroll
        for (int b = 0; b < 2; ++b)
#pragma unroll
            for (int m = 0; m < 4; ++m)
#pragma unroll
                for (int n = 0; n < 2; ++n) acc[a][b][m][n] = (f32x4){0.f, 0.f, 0.f, 0.f};
    bf16x8 At[4][2], B0[2][2], B1[2][2];
    const char* cA = (const char*)g.A + (GATHER ? (size_t)0 : (size_t)cur.pm * tstep); const char* cB = (const char*)g.Bt + (size_t)cur.pn * tstep;
    S.a_ready(cur);
    if constexpr (GATHER) { PG8_GOFF(gvo, cur); }
    if constexpr (SP2) {
        PG8_STAGE(PG8_SB(0, 0), cB, voffB); PG8_STAGE(PG8_SB(0, 1), cB + hstep, voffB); PG8_STAGE_AH(PG8_SA(0, 0), cA, 0, false); PG8_STAGE_AH(PG8_SA(0, 1), cA, 1, false);
        if (wr == 1) PG8_BAR;
        PG8_WAIT_V(2); PG8_BAR;
        PG8_STAGE(PG8_SB(1, 0), cB + kstep, voffB); PG8_STAGE_AH(PG8_SA(1, 0), cA + kstep, 0, false); PG8_STAGE(PG8_SB(1, 1), cB + hstep + kstep, voffB);
        PG8_WAIT_V(6); PG8_BAR;
    } else {
        PG8_STAGE(PG8_SB(0, 0), cB, voffB); PG8_STAGE(PG8_SA(0, 0), cA, voffA); PG8_STAGE(PG8_SB(0, 1), cB + hstep, voffB); PG8_STAGE(PG8_SA(0, 1), cA + hstep, voffA);
        if (wr == 1) PG8_BAR;
        PG8_WAIT_V(4); PG8_BAR;
        PG8_STAGE(PG8_SB(1, 0), cB + kstep, voffB); PG8_STAGE(PG8_SA(1, 0), cA + kstep, voffA); PG8_STAGE(PG8_SB(1, 1), cB + hstep + kstep, voffB);
        PG8_WAIT_V(6); PG8_BAR;
    }
    for (;;) {
        const bool has_next = S.next(ui + 1, nxt);
        const char* nA = has_next ? (const char*)g.A + (GATHER ? (size_t)0 : (size_t)nxt.pm * tstep) : cA; const char* nB = has_next ? (const char*)g.Bt + (size_t)nxt.pn * tstep : cB;
        if constexpr (GATHER) { if (has_next) { PG8_GOFF(gvn, nxt); } else { gvn[0][0] = gvo[0][0]; gvn[0][1] = gvo[0][1]; gvn[1][0] = gvo[1][0]; gvn[1][1] = gvo[1][1]; } }
        for (int t = 0; t < nt; t += 2) {
            const bool last = (t == nt - 2);
            const char* a1 = cA + (size_t)(t + 1) * kstep;
            const char* a2 = last ? nA : cA + (size_t)(t + 2) * kstep; const char* b2 = last ? nB : cB + (size_t)(t + 2) * kstep;
            const char* a3 = a2 + kstep; const char* b3 = b2 + kstep;
            if (last && has_next) S.a_ready(nxt);
            if constexpr (SP2) {
            PG8_LDB(B0, 0, 0); PG8_LDB(B1, 0, 1); PG8_SCHED; PG8_LDA(At, 0, 0); PG8_STAGE_AH(PG8_SA(1, 1), a1, 1, false);
            PG8_WAIT_V(8); PG8_WAIT_L(0); PG8_BAR; PG8_MMA(0, 0, At, B0); PG8_MMA(0, 1, At, B1); PG8_BAR; PG8_SCHED;
            PG8_LDA(At, 0, 1); PG8_STAGE(PG8_SB(0, 0), b2, voffB); PG8_STAGE(PG8_SB(0, 1), b2 + hstep, voffB); PG8_STAGE_AH(PG8_SA(0, 0), a2, 0, last);
            PG8_WAIT_V(8); PG8_WAIT_L(0); PG8_BAR; PG8_MMA(1, 0, At, B0); PG8_MMA(1, 1, At, B1); PG8_BAR; PG8_SCHED;
            PG8_LDB(B0, 1, 0); PG8_LDB(B1, 1, 1); PG8_SCHED; PG8_LDA(At, 1, 0); PG8_STAGE_AH(PG8_SA(0, 1), a2, 1, last);
            PG8_WAIT_V(8); PG8_WAIT_L(0); PG8_BAR; PG8_MMA(0, 0, At, B0); PG8_MMA(0, 1, At, B1); PG8_BAR; PG8_SCHED;
            PG8_LDA(At, 1, 1); PG8_STAGE(PG8_SB(1, 0), b3, voffB); PG8_STAGE(PG8_SB(1, 1), b3 + hstep, voffB); PG8_STAGE_AH(PG8_SA(1, 0), a3, 0, last);
            PG8_WAIT_V(8); PG8_WAIT_L(0); PG8_BAR; PG8_MMA(1, 0, At, B0); PG8_MMA(1, 1, At, B1); PG8_BAR; PG8_SCHED;
            } else {
            PG8_LDB(B0, 0, 0); PG8_SCHED; PG8_LDA(At, 0, 0); PG8_STAGE(PG8_SA(1, 1), a1 + hstep, voffA);
            PG8_WAIT_L(8); PG8_BAR; PG8_WAIT_L(0); PG8_MMA(0, 0, At, B0); PG8_BAR; PG8_SCHED;
            PG8_LDB(B1, 0, 1); PG8_STAGE(PG8_SB(0, 0), b2, voffB);
            PG8_BAR; PG8_WAIT_L(0); PG8_MMA(0, 1, At, B1); PG8_BAR;
            PG8_LDA(At, 0, 1); PG8_STAGE(PG8_SA(0, 0), a2, voffA);
            PG8_BAR; PG8_WAIT_L(0); PG8_MMA(1, 0, At, B0); PG8_BAR; PG8_SCHED;
            PG8_STAGE(PG8_SB(0, 1), b2 + hstep, voffB);
            PG8_WAIT_V(6); PG8_BAR; PG8_MMA(1, 1, At, B1); PG8_BAR;
            PG8_LDB(B0, 1, 0); PG8_SCHED; PG8_LDA(At, 1, 0); PG8_STAGE(PG8_SA(0, 1), a2 + hstep, voffA);
            PG8_WAIT_L(8); PG8_BAR; PG8_WAIT_L(0); PG8_MMA(0, 0, At, B0); PG8_BAR; PG8_SCHED;
            PG8_LDB(B1, 1, 1); PG8_STAGE(PG8_SB(1, 0), b3, voffB);
            PG8_BAR; PG8_WAIT_L(0); PG8_MMA(0, 1, At, B1); PG8_BAR;
            PG8_LDA(At, 1, 1); PG8_STAGE(PG8_SA(1, 0), a3, voffA);
            PG8_BAR; PG8_WAIT_L(0); PG8_MMA(1, 0, At, B0); PG8_BAR; PG8_SCHED;
            PG8_STAGE(PG8_SB(1, 1), b3 + hstep, voffB);
            PG8_WAIT_V(6); PG8_BAR; PG8_MMA(1, 1, At, B1); PG8_BAR;
            }
        }
        if constexpr (ALIGN_EPI) { if (wr == 0) PG8_BAR; }
        if constexpr (!Epi::AFTER_DRAIN) { E(acc, cur, wr, wc, fr, fq); S.done(cur); }
        if (!has_next) break;
#pragma unroll
        for (int a = 0; a < 2; ++a)
#pragma unroll
            for (int b = 0; b < 2; ++b)
#pragma unroll
                for (int m = 0; m < 4; ++m)
#pragma unroll
                    for (int n = 0; n < 2; ++n) acc[a][b][m][n] = (f32x4){0.f, 0.f, 0.f, 0.f};
        cur = nxt; cA = nA; cB = nB; ++ui;
        if constexpr (GATHER) { gvo[0][0] = gvn[0][0]; gvo[0][1] = gvn[0][1]; gvo[1][0] = gvn[1][0]; gvo[1][1] = gvn[1][1]; }
        if constexpr (ALIGN_EPI) { if (wr == 1) PG8_BAR; }
    }
    PG8_WAIT_V(0);
    if constexpr (!ALIGN_EPI) { if (wr == 0) PG8_BAR; }
    PG8_BAR;
    if constexpr (Epi::AFTER_DRAIN) { E.fused(acc, cur, wr, wc, fr, fq, lds, wid, lane); S.done(cur); }
#undef PG8_SA
#undef PG8_SB
#undef PG8_STAGE
#undef PG8_STAGE_AH
#undef PG8_GOFF
#undef PG8_LDA
#undef PG8_LDB
#undef PG8_MMA
#undef PG8_WAIT_V
#undef PG8_WAIT_L
#undef PG8_BAR
#undef PG8_SCHED
}
}

DI void transpose_item(const float* W, int ldw, bf16_t* WT, int ldt, float scale, float* scr, int k0, int n0, int lane) {
#pragma unroll 8
    for (int i = 0; i < 32; ++i) { const int kk = 2 * i + (lane >> 5); scr[kk * 33 + (lane & 31)] = W[(size_t)(k0 + kk) * ldw + n0 + (lane & 31)] * scale; }
    asm volatile("s_waitcnt lgkmcnt(0)" ::: "memory");
    const int c = lane & 7;
#pragma unroll
    for (int j = 0; j < 4; ++j) { const int n = (lane >> 3) + 8 * j; const float* s = scr + (8 * c) * 33 + n;
        u32x4 o; o.x = pk2(s[0 * 33], s[1 * 33]); o.y = pk2(s[2 * 33], s[3 * 33]); o.z = pk2(s[4 * 33], s[5 * 33]); o.w = pk2(s[6 * 33], s[7 * 33]);
        *(u32x4*)(WT + (size_t)n * ldt + k0 + 8 * c) = o; }
    asm volatile("s_waitcnt lgkmcnt(0)" ::: "memory");
}

DI void p0_prologue(const Params& p, float* lds, int gw, int NGW, int wave, int lane) {
    unsigned char* ws = p.ws;
    bf16_t* WinT = (bf16_t*)(ws + WS_WINT); bf16_t* WoT = (bf16_t*)(ws + WS_WOT); bf16_t* WmT = (bf16_t*)(ws + WS_WMT);
    bf16_t* W13T = (bf16_t*)(ws + WS_W13T); bf16_t* W2T = (bf16_t*)(ws + WS_W2T);
    float* scr = lds + wave * (64 * 33);
    const float* w_in = p.in[I_WIN];
    constexpr int S0 = 256, S1 = 512, S2 = 768, S3 = 896, S4 = 1408, S5 = 1664, S6 = S5 + 4096, S7 = S6 + 4096, S8 = S7 + 4096;
    for (int it = gw; it < S8; it += NGW) {
        if (it < S3) {
            int seg, r;
            if (it < S0) { seg = 0; r = it; } else if (it < S1) { seg = 1; r = it - S0; } else if (it < S2) { seg = 2; r = it - S1; } else { seg = 3; r = it - S2; }
            const int ncb = (seg == 3) ? 8 : 16;
            const int kb = r / ncb, nb = r % ncb;
            const int coff = (seg == 3) ? 1792 : seg * 512, roff = (seg == 3) ? 1536 : seg * 512;
            const float sc = (seg == 0 || seg == 3) ? C2 : 1.0f;
            transpose_item(w_in + coff, 2048, WinT + (size_t)(roff + nb * 32) * 1024, 1024, sc, scr, kb * 64, nb * 32, lane);
        } else if (it < S4) { const int r = it - S3, kb = r / 32, nb = r % 32;
            transpose_item(p.in[I_WOUT], 1024, WoT + (size_t)(nb * 32) * 1024, 1024, 1.f, scr, kb * 64, nb * 32, lane);
        } else if (it < S5) { const int r = it - S4, kb = r / 16, nb = r % 16;
            transpose_item(p.in[I_WMKV], 512, WmT + (size_t)(nb * 32) * 1024, 1024, 1.f, scr, kb * 64, nb * 32, lane);
        } else if (it < S7) { const bool is3 = it >= S6; const int r = it - (is3 ? S6 : S5), e = r / 128, q = r % 128, kb = q / 8, nb = q % 8, n0 = nb * 32;
            const float* W = (is3 ? p.in[I_W3] : p.in[I_W1]) + (size_t)e * 1024 * 256;
            const int drow = e * 512 + (n0 >> 7) * 256 + (is3 ? 128 : 0) + (n0 & 127);
            transpose_item(W, 256, W13T + (size_t)drow * 1024, 1024, 1.f, scr, kb * 64, n0, lane);
        } else { const int r = it - S7, e = r / 128, q = r % 128, kb = q / 32, nb = q % 32;
            const float* W = p.in[I_W2] + (size_t)e * 256 * 1024;
            transpose_item(W, 1024, W2T + (size_t)(e * 1024 + nb * 32) * 256, 256, 1.f, scr, kb * 64, nb * 32, lane);
        }
    }
    {
        bf16_t* XN = (bf16_t*)(ws + WS_XN); float* st = (float*)(ws + WS_STATS0);
        const f32x4* g4 = (const f32x4*)p.in[I_LN0G] + lane; const f32x4* b4 = (const f32x4*)p.in[I_LN0B] + lane;
        for (int m = gw; m < NTOK; m += NGW) {
            const f32x4* xr = (const f32x4*)(p.in[I_X] + (size_t)m * DM) + lane;
            f32x4 v[4]; float s = 0.f;
#pragma unroll
            for (int j = 0; j < 4; ++j) { v[j] = xr[64 * j]; s += (v[j].x + v[j].y) + (v[j].z + v[j].w); }
            const float mean = wave_sum(s) * (1.f / DM); float s2 = 0.f;
#pragma unroll
            for (int j = 0; j < 4; ++j) { v[j] = v[j] - mean; s2 += (v[j].x * v[j].x + v[j].y * v[j].y) + (v[j].z * v[j].z + v[j].w * v[j].w); }
            const float rstd = 1.f / sqrtf(wave_sum(s2) * (1.f / DM) + LN_EPS);
            if (lane == 0) { st[2 * m] = mean; st[2 * m + 1] = rstd; }
            u32x2* o8 = (u32x2*)(XN + (size_t)m * DM) + lane;
#pragma unroll
            for (int j = 0; j < 4; ++j) { const f32x4 g = g4[64 * j], b = b4[64 * j]; const f32x4 y = v[j] * rstd * g + b; u32x2 w; w.x = pk2(y.x, y.y); w.y = pk2(y.z, y.w); o8[64 * j] = w; }
        }
    }
    {
        bf16_t* MB = (bf16_t*)(ws + WS_MEMB);
        for (int m = gw; m < NB * MEMLEN; m += NGW) {
            const f32x4* xr = (const f32x4*)(p.in[I_MEM] + (size_t)m * DM) + lane; u32x2* o8 = (u32x2*)(MB + (size_t)m * DM) + lane;
#pragma unroll
            for (int j = 0; j < 4; ++j) { const f32x4 y = xr[64 * j]; u32x2 w; w.x = pk2(y.x, y.y); w.y = pk2(y.z, y.w); o8[64 * j] = w; }
        }
    }
    {
        const float* wf = p.in[I_WF];
        for (int it = gw; it < 1024 * 4; it += NGW) {
            const int k = it >> 2, g = it & 3;
            const float wv = w_in[(size_t)k * 2048 + 1536 + g * 64 + lane];
            float ta = 0.f, tb = 0.f;
            for (int c = 0; c < 64; ++c) { const float wc = __shfl(wv, c); const float ang = (float)((c * lane) & 63) * (1.0f / 32.0f); ta += wc * cospif(ang); tb += wc * sinpif(ang); }
            float orr = 0.f, oi = 0.f;
            for (int c = 0; c < 64; ++c) { const float w = wf[(size_t)(g * 64 + c) * 64 + lane]; orr += __shfl(ta, c) * w; oi += __shfl(tb, c) * w; }
            WinT[(size_t)(1792 + g * 64 + lane) * 1024 + k] = (bf16_t)f2bf(orr * (1.0f / 512.0f));
            WinT[(size_t)(2048 + g * 64 + lane) * 1024 + k] = (bf16_t)f2bf(oi * (1.0f / 512.0f));
        }
    }
    {
        float* WR = (float*)(ws + WS_WR); float* ct = (float*)(ws + WS_COSTAB);
        const int gt = gw * 64 + lane, NGT = NGW * 64;
        for (int i = gt; i < 36 * 1024; i += NGT) { const int e = i >> 10, k = i & 1023; WR[i] = e < 4 ? p.in[I_WG][k * 4 + e] : p.in[I_WRT][k * 32 + (e - 4)]; }
        for (int i = gt; i < 4096; i += NGT) ct[i] = cospif((float)i * (1.0f / 2048.0f));
    }
}

constexpr size_t WS_ZS1 = 200 * MiB;
constexpr size_t WS_O1 = 216 * MiB;
constexpr int CW_KMAX = 128;
constexpr int CW_KMAXM = 160;

namespace pg8 {
struct EpiInproj {
    static constexpr bool PERM = true, AFTER_DRAIN = false;
    unsigned char* ws;
    __device__ __forceinline__ void operator()(const f32x4 (&acc)[2][2][4][2], const Unit& u, int wr, int wc, int fr, int fq) const {
        const int pn = u.pn; bf16_t* base; int ldc, coff;
        if (pn < 6) { base = (bf16_t*)(ws + WS_QB + (size_t)(pn >> 1) * (16 * MiB)); ldc = 512; coff = (pn & 1) * 256; }
        else if (pn == 6) { base = (bf16_t*)(ws + WS_MQB); ldc = 256; coff = 0; }
        else { base = (bf16_t*)(ws + WS_ZB); ldc = 512; coff = (pn - 7) * 256; }
        const int row0 = u.pm * BM + wr * 64 + fr, col0 = coff + wc * 32 + 8 * fq;
#pragma unroll
        for (int ai = 0; ai < 2; ++ai)
#pragma unroll
            for (int m = 0; m < 4; ++m) { bf16_t* rowp = base + (size_t)(row0 + ai * HALF + m * 16) * ldc + col0;
#pragma unroll
                for (int bj = 0; bj < 2; ++bj) { const f32x4 v0 = acc[ai][bj][m][0], v1 = acc[ai][bj][m][1];
                    u32x4 w; w.x = cvt_pk_bf16(v0[0], v0[1]); w.y = cvt_pk_bf16(v0[2], v0[3]); w.z = cvt_pk_bf16(v1[0], v1[1]); w.w = cvt_pk_bf16(v1[2], v1[3]);
                    *(u32x4*)(rowp + bj * HALF) = w; } }
    }
};
struct EpiBf16Plain {
    static constexpr bool PERM = true, AFTER_DRAIN = false;
    bf16_t* O; int ldc;
    __device__ __forceinline__ void operator()(const f32x4 (&acc)[2][2][4][2], const Unit& u, int wr, int wc, int fr, int fq) const {
        const int row0 = u.pm * BM + wr * 64 + fr, col0 = u.pn * BM + wc * 32 + 8 * fq;
#pragma unroll
        for (int ai = 0; ai < 2; ++ai)
#pragma unroll
            for (int m = 0; m < 4; ++m) { bf16_t* rowp = O + (size_t)(row0 + ai * HALF + m * 16) * ldc + col0;
#pragma unroll
                for (int bj = 0; bj < 2; ++bj) { const f32x4 v0 = acc[ai][bj][m][0], v1 = acc[ai][bj][m][1];
                    u32x4 w; w.x = cvt_pk_bf16(v0[0], v0[1]); w.y = cvt_pk_bf16(v0[2], v0[3]); w.z = cvt_pk_bf16(v1[0], v1[1]); w.w = cvt_pk_bf16(v1[2], v1[3]);
                    *(u32x4*)(rowp + bj * HALF) = w; } }
    }
};
struct EpiF32Plain {
    static constexpr bool PERM = false, AFTER_DRAIN = false;
    float* C; int ldc;
    __device__ __forceinline__ void operator()(const f32x4 (&acc)[2][2][4][2], const Unit& u, int wr, int wc, int fr, int fq) const {
        const int row0 = u.pm * BM + wr * 64 + fr, col0 = u.pn * BM + wc * 32 + 4 * fq;
#pragma unroll
        for (int ai = 0; ai < 2; ++ai)
#pragma unroll
            for (int m = 0; m < 4; ++m) { float* rowp = C + (size_t)(row0 + ai * HALF + m * 16) * ldc + col0;
#pragma unroll
                for (int bj = 0; bj < 2; ++bj)
#pragma unroll
                    for (int n = 0; n < 2; ++n) *(f32x4*)(rowp + bj * HALF + n * 16) = acc[ai][bj][m][n]; }
    }
};
struct MoeOrder {
    const PG8_LAS int* tab; const int* list; int G, c, sh;
    __device__ __forceinline__ bool next(int i, Unit& u) const {
        const int L = i * G + c, total = tab[32] << sh; if (L >= total) return false;
        const int T = L >> sh, nt = L & ((1 << sh) - 1); int e = 0; while (tab[e + 1] <= T) ++e;
        u.pm = T; u.pn = (e << sh) + nt; return true; }
    __device__ __forceinline__ int a_row(const Unit& u, int r) const { const int e = u.pn >> sh; const int pos = (u.pm - tab[e]) * 256 + r; return pos < tab[33 + e] ? list[e * NTOK + pos] : 0; }
    __device__ __forceinline__ void a_ready(const Unit&) const {}
    __device__ __forceinline__ void done(const Unit&) const {}
};
struct EpiSwiglu {
    static constexpr bool PERM = true, AFTER_DRAIN = false;
    bf16_t* HID;
    __device__ __forceinline__ void operator()(const f32x4 (&acc)[2][2][4][2], const Unit& u, int wr, int wc, int fr, int fq) const {
        const int row0 = u.pm * BM + wr * 64 + fr, col0 = (u.pn & 1) * 128 + wc * 32 + 8 * fq;
#pragma unroll
        for (int ai = 0; ai < 2; ++ai)
#pragma unroll
            for (int m = 0; m < 4; ++m) { bf16_t* rowp = HID + (size_t)(row0 + ai * HALF + m * 16) * 256 + col0; float h[8];
#pragma unroll
                for (int n = 0; n < 2; ++n)
#pragma unroll
                    for (int j = 0; j < 4; ++j) { const float gte = acc[ai][0][m][n][j], up = acc[ai][1][m][n][j];
                        h[n * 4 + j] = gte * __builtin_amdgcn_rcpf(1.0f + __builtin_amdgcn_exp2f(-gte * 1.4426950408889634f)) * up; }
                u32x4 w; w.x = cvt_pk_bf16(h[0], h[1]); w.y = cvt_pk_bf16(h[2], h[3]); w.z = cvt_pk_bf16(h[4], h[5]); w.w = cvt_pk_bf16(h[6], h[7]);
                *(u32x4*)rowp = w; }
    }
};
struct EpiDown {
    static constexpr bool PERM = true, AFTER_DRAIN = false;
    bf16_t* Y;
    __device__ __forceinline__ void operator()(const f32x4 (&acc)[2][2][4][2], const Unit& u, int wr, int wc, int fr, int fq) const {
        const int row0 = u.pm * BM + wr * 64 + fr, col0 = (u.pn & 3) * BM + wc * 32 + 8 * fq;
#pragma unroll
        for (int ai = 0; ai < 2; ++ai)
#pragma unroll
            for (int m = 0; m < 4; ++m) { bf16_t* rowp = Y + (size_t)(row0 + ai * HALF + m * 16) * 1024 + col0;
#pragma unroll
                for (int bj = 0; bj < 2; ++bj) { const f32x4 v0 = acc[ai][bj][m][0], v1 = acc[ai][bj][m][1];
                    u32x4 w; w.x = cvt_pk_bf16(v0[0], v0[1]); w.y = cvt_pk_bf16(v0[2], v0[3]); w.z = cvt_pk_bf16(v1[0], v1[1]); w.w = cvt_pk_bf16(v1[2], v1[3]);
                    *(u32x4*)(rowp + bj * HALF) = w; } }
    }
};
}

DI void kmax_phase(const Params& p, int gw, int NGW, int lane) {
    unsigned char* ws = p.ws; unsigned* ctl = (unsigned*)(ws + WS_CTL);
    const bf16_t* Kb = (const bf16_t*)(ws + WS_KB); const bf16_t* MKV = (const bf16_t*)(ws + WS_MKV);
    for (int grp = gw; grp < NTOK / 8; grp += NGW) {
        float mx = 0.f;
#pragma unroll
        for (int r = 0; r < 8; ++r) { const u32x4 v = *(const u32x4*)(Kb + (size_t)(grp * 8 + r) * 512 + lane * 8); float s = 0.f;
#pragma unroll
            for (int j = 0; j < 4; ++j) { const float a = __uint_as_float(v[j] << 16), b = __uint_as_float(v[j] & 0xffff0000u); s += a * a + b * b; }
            s += __shfl_xor(s, 1); s += __shfl_xor(s, 2); s += __shfl_xor(s, 4); mx = fmaxf(mx, s); }
        if ((lane & 7) == 0) atomicMax(ctl + CW_KMAX + ((grp * 8) / SEQ) * 8 + (lane >> 3), __float_as_uint(mx));
    }
    for (int grp = gw; grp < NB * MEMLEN / 8; grp += NGW) {
        float mx = 0.f;
#pragma unroll
        for (int r = 0; r < 8; ++r) { const u32x4 v = *(const u32x4*)(MKV + (size_t)(grp * 8 + r) * 512 + (lane & 31) * 8); float s = 0.f;
#pragma unroll
            for (int j = 0; j < 4; ++j) { const float a = __uint_as_float(v[j] << 16), b = __uint_as_float(v[j] & 0xffff0000u); s += a * a + b * b; }
            s += __shfl_xor(s, 1); s += __shfl_xor(s, 2); s += __shfl_xor(s, 4); mx = fmaxf(mx, s); }
        if (lane < 32 && (lane & 7) == 0) atomicMax(ctl + CW_KMAXM + ((grp * 8) / MEMLEN) * 4 + (lane >> 3), __float_as_uint(mx));
    }
}

namespace att {
#define ALAS __attribute__((address_space(3)))
typedef short bf16x8 __attribute__((ext_vector_type(8)));
typedef short s16x4 __attribute__((ext_vector_type(4)));
typedef short v4i16_t __attribute__((ext_vector_type(4)));
typedef float f32x16 __attribute__((ext_vector_type(16)));
typedef float f32x2_t __attribute__((ext_vector_type(2)));
typedef __bf16 bf16x2_t __attribute__((ext_vector_type(2)));
constexpr int KOFF = 0, VOFF = 16384, TOFF = 49152, ATT_LDS = TOFF + 1024;
DI unsigned cvtpk(float lo, float hi) { f32x2_t v = {lo, hi}; bf16x2_t b = __builtin_convertvector(v, bf16x2_t); return __builtin_bit_cast(unsigned, b); }
DI s16x4 vtr(const ALAS unsigned char* q) { return __builtin_bit_cast(s16x4, __builtin_amdgcn_ds_read_tr16_b64_v4i16((ALAS v4i16_t*)q)); }
#define ATT_MFMA(a, b, c) __builtin_amdgcn_mfma_f32_32x32x16_bf16((a), (b), (c), 0, 0, 0)

template <int NDT, bool BAND>
DI void tile(const ALAS unsigned char* kb, const ALAS unsigned char* vb, const bf16x8 (&qr)[4], const f32x16& cinit, f32x16 (&o)[NDT], float& lsum,
             const ALAS float* tbl, int relbase, float mrow) {
    f32x16 p0, p1;
#pragma unroll
    for (int d0 = 0; d0 < 4; ++d0) {
        const bf16x8 b0 = *(const ALAS bf16x8*)(kb + d0 * 2048), b1 = *(const ALAS bf16x8*)(kb + d0 * 2048 + 512);
        if (d0 == 0) { if (BAND) { const f32x16 z = {0.f,0.f,0.f,0.f,0.f,0.f,0.f,0.f,0.f,0.f,0.f,0.f,0.f,0.f,0.f,0.f}; p0 = ATT_MFMA(b0, qr[0], z); p1 = ATT_MFMA(b1, qr[0], z); }
                       else { p0 = ATT_MFMA(b0, qr[0], cinit); p1 = ATT_MFMA(b1, qr[0], cinit); } }
        else { p0 = ATT_MFMA(b0, qr[d0], p0); p1 = ATT_MFMA(b1, qr[d0], p1); }
    }
    if (BAND) {
#pragma unroll
        for (int r = 0; r < 16; ++r) {
            const int rel0 = relbase + (r & 3) + 8 * (r >> 2);
            const int i0 = min(max(rel0 + 128, 0), 255), i1 = min(max(rel0 + 160, 0), 255);
            p0[r] += tbl[i0] - mrow; p1[r] += tbl[i1] - mrow;
        }
    }
    float s = 0.f;
#pragma unroll
    for (int r = 0; r < 16; ++r) { p0[r] = __builtin_amdgcn_exp2f(p0[r]); p1[r] = __builtin_amdgcn_exp2f(p1[r]); s += p0[r] + p1[r]; }
    lsum += s;
    u32x4 w0, w1, w2, w3;
    w0.x = cvtpk(p0[0], p0[1]); w0.y = cvtpk(p0[2], p0[3]); w0.z = cvtpk(p0[4], p0[5]); w0.w = cvtpk(p0[6], p0[7]);
    w1.x = cvtpk(p0[8], p0[9]); w1.y = cvtpk(p0[10], p0[11]); w1.z = cvtpk(p0[12], p0[13]); w1.w = cvtpk(p0[14], p0[15]);
    w2.x = cvtpk(p1[0], p1[1]); w2.y = cvtpk(p1[2], p1[3]); w2.z = cvtpk(p1[4], p1[5]); w2.w = cvtpk(p1[6], p1[7]);
    w3.x = cvtpk(p1[8], p1[9]); w3.y = cvtpk(p1[10], p1[11]); w3.z = cvtpk(p1[12], p1[13]); w3.w = cvtpk(p1[14], p1[15]);
    const bf16x8 pb0 = __builtin_bit_cast(bf16x8, w0), pb1 = __builtin_bit_cast(bf16x8, w1), pb2 = __builtin_bit_cast(bf16x8, w2), pb3 = __builtin_bit_cast(bf16x8, w3);
#pragma unroll
    for (int dt = 0; dt < NDT; ++dt) {
        __builtin_amdgcn_sched_barrier(0);
#pragma unroll
        for (int ks = 0; ks < 4; ++ks) {
            const s16x4 lo = vtr(vb + (dt * 4 + ks) * 1024), hh = vtr(vb + (dt * 4 + ks) * 1024 + 512);
            const bf16x8 a = __builtin_shufflevector(lo, hh, 0, 1, 2, 3, 4, 5, 6, 7);
            o[dt] = ATT_MFMA(a, ks == 0 ? pb0 : ks == 1 ? pb1 : ks == 2 ? pb2 : pb3, o[dt]);
        }
    }
}

template <int DV, bool DIFF>
DI void attn_unit(ALAS unsigned char* lds, const Params& p, int unit, int wid, int lane) {
    unsigned char* ws = p.ws; const unsigned* ctl = (const unsigned*)(ws + WS_CTL);
    const int tid = threadIdx.x, r32 = lane & 31, hi = lane >> 5;
    constexpr int NDT = DV / 32, VBYTES = DV * 128, NCOMP = DIFF ? 2 : 1, NT = DIFF ? 64 : 4;
    int b, h, qb, qpitch, ocol; size_t kbase; const bf16_t *Qg, *Kg, *Vg;
    if (DIFF) { b = unit >> 6; h = (unit >> 4) & 3; qb = unit & 15; Qg = (const bf16_t*)(ws + WS_QB) + h * 128; qpitch = 512; Kg = (const bf16_t*)(ws + WS_KB) + h * 128;
        Vg = (const bf16_t*)(ws + WS_VB) + h * 128; kbase = (size_t)b * SEQ; ocol = h * 128; }
    else { const int qblk = unit >> 2; h = unit & 3; b = qblk >> 4; qb = qblk & 15; Qg = (const bf16_t*)(ws + WS_MQB) + h * 64; qpitch = 256; Kg = (const bf16_t*)(ws + WS_MKV) + h * 64;
        Vg = (const bf16_t*)(ws + WS_MKV) + 256 + h * 64; kbase = (size_t)b * MEMLEN; ocol = 768 + h * 64; }
    const int row0 = b * SEQ + qb * 256, qa = qb * 256 + wid * 32;
    const ALAS float* tbl = (const ALAS float*)(lds + TOFF);
    float bmax = 0.f, cL = 0.f, cR = 0.f, lam = 0.f;
    __syncthreads();
    if (DIFF) {
        const float* rb = p.in[I_RELB];
        if (tid < 256) ((ALAS float*)(lds + TOFF))[tid] = rb[t5_bucket(tid - 128) * 4 + h] * LOG2E;
        float bm = -1e30f;
        for (int i = 0; i < 32; ++i) bm = fmaxf(bm, rb[i * 4 + h]);
        bmax = bm * LOG2E; cL = rb[15 * 4 + h] * LOG2E; cR = rb[31 * 4 + h] * LOG2E;
        float s1 = 0.f, s2 = 0.f;
        for (int i = 0; i < 64; ++i) { s1 += p.in[I_LQ1][i] * p.in[I_LK1][i]; s2 += p.in[I_LQ2][i] * p.in[I_LK2][i]; }
        lam = expf(s1) - expf(s2) + LAM_INIT;
        __syncthreads();
    }
    const int tL = DIFF ? (qa >= 154 ? (qa - 154) / 64 + 1 : 0) : NT;
    const int tR = DIFF ? (qa + 185) / 64 : NT;
    const int vlane = (4 * hi + ((lane & 15) >> 2)) * 64 + ((lane >> 4) & 1) * 32 + (lane & 3) * 8;
#pragma unroll 1
    for (int c = 0; c < NCOMP; ++c) {
        const bf16_t* Qp = Qg + (size_t)(row0 + wid * 32 + r32) * qpitch + c * 64 + hi * 8;
        bf16x8 qr[4]; float qq = 0.f;
#pragma unroll
        for (int d0 = 0; d0 < 4; ++d0) { qr[d0] = *(const bf16x8*)(Qp + d0 * 16);
#pragma unroll
            for (int j = 0; j < 8; ++j) { const float f = __uint_as_float(((unsigned)(unsigned short)qr[d0][j]) << 16); qq += f * f; } }
        qq += __shfl_xor(qq, 32);
        const float kmx = sqrtf(__uint_as_float(DIFF ? ctl[CW_KMAX + b * 8 + h * 2 + c] : ctl[CW_KMAXM + b * 4 + h]));
        const float mrow = sqrtf(qq) * kmx * 1.0001f + bmax;
        f32x16 cinit;
#pragma unroll
        for (int r = 0; r < 16; ++r) cinit[r] = cL - mrow;
        f32x16 o[NDT];
#pragma unroll
        for (int dt = 0; dt < NDT; ++dt)
#pragma unroll
            for (int r = 0; r < 16; ++r) o[dt][r] = 0.f;
        float lsum = 0.f;
        const bf16_t* ksrc = Kg + (kbase + lane) * 512 + c * 64 + wid * 8;
#define ATT_DMA(t, buf) do { \
        __builtin_amdgcn_global_load_lds((const unsigned*)(ksrc + (size_t)(t) * 64 * 512), (ALAS unsigned*)(lds + KOFF + (buf) * 8192 + wid * 1024), 16, 0, 0); \
        _Pragma("unroll") for (int i_ = 0; i_ < DV / 64; ++i_) { const int pid_ = wid + 8 * i_; \
            __builtin_amdgcn_global_load_lds((const unsigned*)(Vg + (kbase + (size_t)(t) * 64 + 16 * (pid_ & 3) + (lane >> 2)) * 512 + 32 * (pid_ >> 2) + 8 * (lane & 3)), \
                                             (ALAS unsigned*)(lds + VOFF + (buf) * VBYTES + pid_ * 1024), 16, 0, 0); } } while (0)
        ATT_DMA(0, 0);
        asm volatile("s_waitcnt vmcnt(0)" ::: "memory");
        __syncthreads();
#pragma unroll 1
        for (int t = 0; t < NT; ++t) {
            const int buf = t & 1;
            if (t + 1 < NT) ATT_DMA(t + 1, buf ^ 1);
            if (DIFF && t == tR) {
#pragma unroll
                for (int r = 0; r < 16; ++r) cinit[r] = cR - mrow;
            }
            const ALAS unsigned char* kb = lds + KOFF + buf * 8192 + hi * 1024 + r32 * 16;
            const ALAS unsigned char* vb = lds + VOFF + buf * VBYTES + vlane;
            if (DIFF && t >= tL && t < tR) tile<NDT, true>(kb, vb, qr, cinit, o, lsum, tbl, t * 64 + 4 * hi - qa - r32, mrow);
            else tile<NDT, false>(kb, vb, qr, cinit, o, lsum, tbl, 0, 0.f);
            asm volatile("s_waitcnt vmcnt(0)" ::: "memory");
            __syncthreads();
        }
#undef ATT_DMA
        lsum += __shfl_xor(lsum, 32);
        const float inv = 1.0f / lsum;
        int lane2 = lane; asm volatile("" : "+v"(lane2));
        const int r32b = lane2 & 31, hib = lane2 >> 5;
        float* o1p = (float*)(ws + WS_O1) + ((size_t)(unit * 8 + wid) * 64 + lane2) * 64;
        if (DIFF && c == 0) {
#pragma unroll
            for (int dt = 0; dt < NDT; ++dt)
#pragma unroll
                for (int r = 0; r < 16; ++r) o1p[dt * 16 + r] = o[dt][r] * inv;
        } else {
            bf16_t* Ob = (bf16_t*)(ws + WS_OB) + (size_t)(row0 + wid * 32 + r32b) * 1024 + ocol + 4 * hib;
            if (DIFF) {
                float ss = 0.f;
#pragma unroll
                for (int dt = 0; dt < NDT; ++dt)
#pragma unroll
                    for (int r = 0; r < 16; ++r) { const float v = o1p[dt * 16 + r] - lam * (o[dt][r] * inv); o[dt][r] = v; ss += v * v; }
                ss += __shfl_xor(ss, 32);
                const float rn = (1.0f - LAM_INIT) / sqrtf(ss * (1.0f / 128.0f) + LN_EPS);
#pragma unroll
                for (int dt = 0; dt < NDT; ++dt)
#pragma unroll
                    for (int g4 = 0; g4 < 4; ++g4) { const int d0 = 32 * dt + 8 * g4; const f32x4 sg = *(const f32x4*)(p.in[I_SUBG] + d0 + 4 * hib);
                        u32x2 w; w.x = cvtpk(o[dt][4 * g4] * rn * sg.x, o[dt][4 * g4 + 1] * rn * sg.y); w.y = cvtpk(o[dt][4 * g4 + 2] * rn * sg.z, o[dt][4 * g4 + 3] * rn * sg.w);
                        *(u32x2*)(Ob + d0) = w; }
            } else {
#pragma unroll
                for (int dt = 0; dt < NDT; ++dt)
#pragma unroll
                    for (int g4 = 0; g4 < 4; ++g4) { const int d0 = 32 * dt + 8 * g4;
                        u32x2 w; w.x = cvtpk(o[dt][4 * g4] * inv, o[dt][4 * g4 + 1] * inv); w.y = cvtpk(o[dt][4 * g4 + 2] * inv, o[dt][4 * g4 + 3] * inv);
                        *(u32x2*)(Ob + d0) = w; }
            }
        }
    }
}
}

template <bool DUAL, bool BKN, class LA, class LB, class EP>
DI void ngemm_tile(float* As, float* Bs, float* Bs2, int K, const LA& la, const LB& lb, const LB& lb2, const EP& ep) {
    const int tid = threadIdx.x, ty = tid >> 4, tx = tid & 15;
    float acc[4][4], acc2[4][4];
#pragma unroll
    for (int i = 0; i < 4; ++i)
#pragma unroll
        for (int j = 0; j < 4; ++j) { acc[i][j] = 0.f; acc2[i][j] = 0.f; }
    for (int kc = 0; kc < K; kc += 32) {
        __syncthreads();
#pragma unroll
        for (int j = 0; j < 8; ++j) { const int i = tid + 512 * j, k = i & 31, r = i >> 5; As[k * 132 + r] = la(r, kc + k); }
#pragma unroll
        for (int j = 0; j < 4; ++j) { const int i = tid + 512 * j; int k, n; if (BKN) { n = i & 63; k = i >> 6; } else { k = i & 31; n = i >> 5; }
            Bs[k * 68 + n] = lb(kc + k, n); if (DUAL) Bs2[k * 68 + n] = lb2(kc + k, n); }
        __syncthreads();
#pragma unroll 8
        for (int k = 0; k < 32; ++k) {
            const f32x4 a = *(const f32x4*)&As[k * 132 + ty * 4]; const f32x4 b = *(const f32x4*)&Bs[k * 68 + tx * 4];
#pragma unroll
            for (int i = 0; i < 4; ++i)
#pragma unroll
                for (int j = 0; j < 4; ++j) acc[i][j] += a[i] * b[j];
            if (DUAL) { const f32x4 b2 = *(const f32x4*)&Bs2[k * 68 + tx * 4];
#pragma unroll
                for (int i = 0; i < 4; ++i)
#pragma unroll
                    for (int j = 0; j < 4; ++j) acc2[i][j] += a[i] * b2[j]; }
        }
    }
#pragma unroll
    for (int i = 0; i < 4; ++i)
#pragma unroll
        for (int j = 0; j < 4; ++j) ep(ty * 4 + i, tx * 4 + j, acc[i][j], acc2[i][j]);
}

struct LA_bf { const bf16_t* A; int lda; DI float operator()(int r, int k) const { return bf2f(A[(size_t)r * lda + k]); } };
struct LB_bf { const bf16_t* B; int ldb; DI float operator()(int k, int n) const { return bf2f(B[(size_t)n * ldb + k]); } };
struct EP_inproj { unsigned char* ws; int m0, n0;
    DI void operator()(int r, int n, float v, float) const { const int row = m0 + r, c = n0 + n; bf16_t* dst;
        if (c < 512) dst = (bf16_t*)(ws + WS_QB) + (size_t)row * 512 + c; else if (c < 1024) dst = (bf16_t*)(ws + WS_KB) + (size_t)row * 512 + (c - 512);
        else if (c < 1536) dst = (bf16_t*)(ws + WS_VB) + (size_t)row * 512 + (c - 1024); else if (c < 1792) dst = (bf16_t*)(ws + WS_MQB) + (size_t)row * 256 + (c - 1536);
        else dst = (bf16_t*)(ws + WS_ZB) + (size_t)row * 512 + (c - 1792);
        *dst = (bf16_t)f2bf(v); } };
struct EP_bf { bf16_t* C; int ldc; int m0, n0; DI void operator()(int r, int n, float v, float) const { C[(size_t)(m0 + r) * ldc + n0 + n] = (bf16_t)f2bf(v); } };
struct EP_f32 { float* C; int ldc; int m0, n0; DI void operator()(int r, int n, float v, float) const { C[(size_t)(m0 + r) * ldc + n0 + n] = v; } };

struct LA_dft { const float* ct; int s0; DI float operator()(int r, int k) const { const int sp = s0 + r, s = k & 4095; const int idx = (s * sp) & 4095;
    return (k < 4096) ? ct[idx] : -ct[(idx - 1024) & 4095]; } };
struct LB_z { const bf16_t* Z; int n0; DI float operator()(int k, int n) const { return bf2f(Z[(size_t)(k & 4095) * 512 + (k >> 12) * 256 + n0 + n]); } };
struct EP_ob { bf16_t* O; int row0, col0; DI void operator()(int r, int n, float v, float) const { O[(size_t)(row0 + r) * 1024 + col0 + n] = (bf16_t)f2bf(v); } };
DI void nfourier_phase(const Params& p, float* As, float* Bs, int bid, int nb) {
    unsigned char* ws = p.ws; const float* ct = (const float*)(ws + WS_COSTAB);
    const int nT = NB * 32 * 4;
    for (int t = bid; t < nT; t += nb) {
        const int b = t / 128, q = t % 128, s0 = (q / 4) * 128, n0 = (q % 4) * 64;
        LA_dft la{ct, s0}; LB_z lb{(const bf16_t*)(ws + WS_ZB) + (size_t)b * SEQ * 512, n0}; EP_ob ep{(bf16_t*)(ws + WS_OB), b * SEQ + s0, 512 + n0};
        ngemm_tile<false, true>(As, Bs, Bs, 8192, la, lb, lb, ep);
    }
}

DI void p4_ln1_router(const Params& p, float* lds  , int gw, int NGW, int wave, int lane) {
    unsigned char* ws = p.ws;
    const float* Aout = (const float*)(ws + WS_AOUT); const float* st0 = (const float*)(ws + WS_STATS0); bf16_t* H1 = (bf16_t*)(ws + WS_XN);
    const float* WR = (const float*)(ws + WS_WR); unsigned* cnt = (unsigned*)(ws + WS_CTL) + CW_CNT; int* info = (int*)(ws + WS_TOKINFO); int* list = (int*)(ws + WS_LIST);
    float* lg = lds + wave * (8 * 36);
    for (int grp = gw; grp < NTOK / 8; grp += NGW) {
        f32x4 hv[8][4];
#pragma unroll
        for (int r = 0; r < 8; ++r) {
            const int row = grp * 8 + r;
            const float mu0 = st0[2 * row], rs0 = st0[2 * row + 1];
            const f32x4* xr = (const f32x4*)(p.in[I_X] + (size_t)row * DM) + lane; const f32x4* ar = (const f32x4*)(Aout + (size_t)row * DM) + lane;
            float s = 0.f;
#pragma unroll
            for (int j = 0; j < 4; ++j) { const f32x4 g = ((const f32x4*)p.in[I_LN0G])[lane + 64 * j], bb = ((const f32x4*)p.in[I_LN0B])[lane + 64 * j];
                const f32x4 h0 = (xr[64 * j] - mu0) * rs0 * g + bb; hv[r][j] = h0 * ALPHA + ar[64 * j]; s += (hv[r][j].x + hv[r][j].y) + (hv[r][j].z + hv[r][j].w); }
            const float mean = wave_sum(s) * (1.f / DM); float s2 = 0.f;
#pragma unroll
            for (int j = 0; j < 4; ++j) { hv[r][j] = hv[r][j] - mean; s2 += (hv[r][j].x * hv[r][j].x + hv[r][j].y * hv[r][j].y) + (hv[r][j].z * hv[r][j].z + hv[r][j].w * hv[r][j].w); }
            const float rstd = 1.f / sqrtf(wave_sum(s2) * (1.f / DM) + LN_EPS);
            u32x2* o8 = (u32x2*)(H1 + (size_t)row * DM) + lane;
#pragma unroll
            for (int j = 0; j < 4; ++j) { const f32x4 g = ((const f32x4*)p.in[I_LN1G])[lane + 64 * j], bb = ((const f32x4*)p.in[I_LN1B])[lane + 64 * j];
                hv[r][j] = hv[r][j] * rstd * g + bb; u32x2 w; w.x = pk2(hv[r][j].x, hv[r][j].y); w.y = pk2(hv[r][j].z, hv[r][j].w); o8[64 * j] = w; }
        }
#pragma unroll 1
        for (int e = 0; e < 36; ++e) {
            const f32x4* wr = (const f32x4*)(WR + (size_t)e * 1024) + lane;
            const f32x4 w0 = wr[0], w1 = wr[64], w2 = wr[128], w3 = wr[192];
#pragma unroll
            for (int r = 0; r < 8; ++r) {
                f32x4 t = hv[r][0] * w0 + hv[r][1] * w1 + hv[r][2] * w2 + hv[r][3] * w3;
                float s = wave_sum((t.x + t.y) + (t.z + t.w));
                if (lane == 0) lg[r * 36 + e] = s;
            }
        }
        asm volatile("s_waitcnt lgkmcnt(0)" ::: "memory");
        if (lane < 8) {
            const int row = grp * 8 + lane; const float* L = lg + lane * 36;
            float gl[4]; int gs = 0; float gm;
#pragma unroll
            for (int j = 0; j < 4; ++j) gl[j] = L[j] + p.in[I_BG][j];
            gm = gl[0];
#pragma unroll
            for (int j = 1; j < 4; ++j) if (gl[j] > gm) { gm = gl[j]; gs = j; }
            float den = 0.f;
#pragma unroll
            for (int j = 0; j < 4; ++j) den += expf(gl[j] - gm);
            const float gate = 1.0f / den;
            float v0 = -1e30f, v1 = -1e30f; int i0 = 0, i1 = 0;
#pragma unroll
            for (int j = 0; j < 8; ++j) { const float v = L[4 + gs * 8 + j] + p.in[I_BRT][gs * 8 + j];
                if (v > v0) { v1 = v0; i1 = i0; v0 = v; i0 = j; } else if (v > v1) { v1 = v; i1 = j; } }
            const float ex = expf(v1 - v0); const float w0 = gate / (1.f + ex), w1 = gate * ex / (1.f + ex);
            const int e0 = gs * 8 + i0, e1 = gs * 8 + i1;
            const unsigned p0 = atomicAdd(cnt + e0, 1u), p1 = atomicAdd(cnt + e1, 1u);
            list[e0 * NTOK + p0] = row; list[e1 * NTOK + p1] = row;
            int* ii = info + (size_t)row * 8; ii[0] = e0; ii[1] = (int)p0; ii[2] = __float_as_int(w0); ii[3] = e1; ii[4] = (int)p1; ii[5] = __float_as_int(w1);
        }
        asm volatile("s_waitcnt lgkmcnt(0)" ::: "memory");
    }
}

struct LA_gather { const bf16_t* H; const int* tok; DI float operator()(int r, int k) const { return bf2f(H[(size_t)tok[r] * 1024 + k]); } };
struct EP_hid { bf16_t* HID; int slot0, nvalid, n0; DI void operator()(int r, int n, float v1, float v3) const { if (r < nvalid) { const float s = v1 / (1.0f + expf(-v1)); HID[(size_t)(slot0 + r) * 256 + n0 + n] = (bf16_t)f2bf(s * v3); } } };
struct EP_y { bf16_t* Y; int slot0, nvalid, n0; DI void operator()(int r, int n, float v, float) const { if (r < nvalid) Y[(size_t)(slot0 + r) * 1024 + n0 + n] = (bf16_t)f2bf(v); } };
DI void nmoe_phase(const Params& p, int which, float* ldsf, int bid, int nb) {
    float* As = ldsf; float* Bs = ldsf + 32 * 132; float* Bs2 = Bs + 32 * 68; int* s_tok = (int*)(Bs2 + 32 * 68); int* s_cnt = s_tok + 128; int* s_tpre = s_cnt + 32; int* s_base = s_tpre + 33;
    unsigned char* ws = p.ws; const unsigned* cnt = (const unsigned*)(ws + WS_CTL) + CW_CNT; const int* list = (const int*)(ws + WS_LIST);
    const int tid = threadIdx.x;
    if (tid == 0) { int tp = 0, bs = 0; for (int e = 0; e < 32; ++e) { const int c = (int)cnt[e]; s_cnt[e] = c; s_tpre[e] = tp; s_base[e] = bs; tp += (c + 127) >> 7; bs += (c + 255) & ~255; } s_tpre[32] = tp; s_base[32] = bs; }
    __syncthreads();
    const int NT = which == 0 ? 4 : 16, total = s_tpre[32] * NT;
    for (int u = bid; u < total; u += nb) {
        const int T = u / NT, nt = u % NT; int e = 0; while (s_tpre[e + 1] <= T) ++e;
        const int mt = T - s_tpre[e], nvalid = min(128, s_cnt[e] - mt * 128), slot0 = s_base[e] + mt * 128;
        if (which == 0) {
            __syncthreads();
            if (tid < 128) s_tok[tid] = (tid < nvalid) ? list[e * NTOK + mt * 128 + tid] : 0;
            __syncthreads();
            const int j0 = nt * 64;
            const int r1 = e * 512 + (j0 >> 7) * 256 + (j0 & 127);
            LA_gather la{(const bf16_t*)(ws + WS_XN), s_tok}; LB_bf lb{(const bf16_t*)(ws + WS_W13T) + (size_t)r1 * 1024, 1024}; LB_bf lb2{(const bf16_t*)(ws + WS_W13T) + (size_t)(r1 + 128) * 1024, 1024};
            EP_hid ep{(bf16_t*)(ws + WS_OB), slot0, nvalid, j0};
            ngemm_tile<true, false>(As, Bs, Bs2, 1024, la, lb, lb2, ep);
        } else {
            LA_bf la{(const bf16_t*)(ws + WS_OB) + (size_t)slot0 * 256, 256}; LB_bf lb{(const bf16_t*)(ws + WS_W2T) + (size_t)(e * 1024 + nt * 64) * 256, 256};
            EP_y ep{(bf16_t*)(ws + WS_Y), slot0, nvalid, nt * 64};
            ngemm_tile<false, false>(As, Bs, Bs, 256, la, lb, lb, ep);
        }
    }
}

DI void p7_final(const Params& p, int gw, int NGW, int lane) {
    unsigned char* ws = p.ws; const unsigned* cnt = (const unsigned*)(ws + WS_CTL) + CW_CNT; const int* info = (const int*)(ws + WS_TOKINFO);
    const bf16_t* H1 = (const bf16_t*)(ws + WS_XN); const bf16_t* Y = (const bf16_t*)(ws + WS_Y);
    int base;
    { const int c = lane < 32 ? (int)cnt[lane] : 0; const int r = (c + 255) & ~255; int inc = r;
#pragma unroll
      for (int o = 1; o < 32; o <<= 1) { const int t = __shfl_up(inc, o); if ((lane & 31) >= o) inc += t; }
      base = inc - r; }
    for (int row = gw; row < NTOK; row += NGW) {
        const int* ii = info + (size_t)row * 8;
        const int e0 = ii[0], p0 = ii[1], e1 = ii[3], p1 = ii[4]; const float w0 = __int_as_float(ii[2]), w1 = __int_as_float(ii[5]);
        const size_t s0 = (size_t)(__shfl(base, e0) + p0), s1 = (size_t)(__shfl(base, e1) + p1);
        const u32x2* h8 = (const u32x2*)(H1 + (size_t)row * DM) + lane; const u32x2* y0 = (const u32x2*)(Y + s0 * DM) + lane; const u32x2* y1 = (const u32x2*)(Y + s1 * DM) + lane;
        f32x4 v[4]; float s = 0.f;
#pragma unroll
        for (int j = 0; j < 4; ++j) { const u32x2 a = h8[64 * j], b = y0[64 * j], c = y1[64 * j];
            v[j].x = ALPHA * __uint_as_float(a.x << 16) + w0 * __uint_as_float(b.x << 16) + w1 * __uint_as_float(c.x << 16);
            v[j].y = ALPHA * __uint_as_float(a.x & 0xffff0000u) + w0 * __uint_as_float(b.x & 0xffff0000u) + w1 * __uint_as_float(c.x & 0xffff0000u);
            v[j].z = ALPHA * __uint_as_float(a.y << 16) + w0 * __uint_as_float(b.y << 16) + w1 * __uint_as_float(c.y << 16);
            v[j].w = ALPHA * __uint_as_float(a.y & 0xffff0000u) + w0 * __uint_as_float(b.y & 0xffff0000u) + w1 * __uint_as_float(c.y & 0xffff0000u);
            s += (v[j].x + v[j].y) + (v[j].z + v[j].w); }
        const float mean = wave_sum(s) * (1.f / DM); float s2 = 0.f;
#pragma unroll
        for (int j = 0; j < 4; ++j) { v[j] = v[j] - mean; s2 += (v[j].x * v[j].x + v[j].y * v[j].y) + (v[j].z * v[j].z + v[j].w * v[j].w); }
        const float rstd = 1.f / sqrtf(wave_sum(s2) * (1.f / DM) + LN_EPS);
        f32x4* o = (f32x4*)(p.out + (size_t)row * DM) + lane;
#pragma unroll
        for (int j = 0; j < 4; ++j) { const f32x4 g = ((const f32x4*)p.in[I_LN2G])[lane + 64 * j], bb = ((const f32x4*)p.in[I_LN2B])[lane + 64 * j]; o[64 * j] = v[j] * rstd * g + bb; }
    }
}


#define LAS __attribute__((address_space(3)))
#define XB_TMO      128
#define XB_XCNT(j)  (256  + 64 * (j))
#define XB_XSUB(j)  (1280 + 64 * (j))
#define XB_XGEN(j)  (2304 + 64 * (j))
#define XB_TOP      3328
#define XB_TOPGEN   3392
#define XCD_BAR_WORDS 3456
#define XB_SPIN_CAP (1u << 18)

__device__ __forceinline__ unsigned xb_ld(unsigned* p)              { return __hip_atomic_load(p, __ATOMIC_RELAXED, __HIP_MEMORY_SCOPE_AGENT); }
__device__ __forceinline__ unsigned xb_add(unsigned* p, unsigned v) { return __hip_atomic_fetch_add(p, v, __ATOMIC_RELAXED, __HIP_MEMORY_SCOPE_AGENT); }
__device__ __forceinline__ unsigned xb_xcc_id() { return (unsigned)__builtin_amdgcn_s_getreg((3 << 11) | 20) & 0xFu; }
#define XB_SPIN(cond, bar) do { unsigned _sp = 0; while (cond) { __builtin_amdgcn_s_sleep(1); \
    if ((++_sp & 255u) == 0u) { if (xb_ld(&(bar)[XB_TMO])) break; if (_sp > XB_SPIN_CAP) { atomicAdd(&(bar)[XB_TMO], 1u); break; } } } } while (0)

struct XcdBarrier {
    unsigned* bar; unsigned x;
    volatile LAS unsigned* st;
};

__device__ __forceinline__ XcdBarrier xcd_barrier_post(unsigned* bar, volatile LAS unsigned* st) {
    XcdBarrier b; b.bar = bar; b.x = xb_xcc_id(); b.st = st;
    if (threadIdx.x == 0) (void)xb_add(&bar[XB_XCNT(b.x)], 1u);
    return b;
}
__device__ __forceinline__ void xcd_barrier_complete(unsigned* bar, unsigned x, unsigned& nloc, unsigned& nx) {
    const unsigned G = gridDim.x * gridDim.y * gridDim.z;
    unsigned sum, cnt, mine, sp = 0u;
    for (;;) {
        sum = 0u; cnt = 0u; mine = 0u;
#pragma unroll
        for (unsigned j = 0; j < 16; ++j) { const unsigned c = xb_ld(&bar[XB_XCNT(j)]); sum += c; cnt += (c > 0u) ? 1u : 0u; mine = (j == x) ? c : mine; }
        if (sum == G) break;
        __builtin_amdgcn_s_sleep(1);
        if ((++sp & 255u) == 0u) { if (xb_ld(&bar[XB_TMO])) break; if (sp > XB_SPIN_CAP) { atomicAdd(&bar[XB_TMO], 1u); break; } }
    }
    nloc = mine > 0u ? mine : 1u; nx = cnt > 0u ? cnt : 1u;
}

__device__ __forceinline__ void xcd_barrier(const XcdBarrier& b) {
    asm volatile("s_waitcnt vmcnt(0)" ::: "memory");
    __syncthreads();
    if (threadIdx.x == 0) {
        unsigned* bar = b.bar;
        __builtin_amdgcn_s_waitcnt(0);
        unsigned nloc = b.st[0], nx = b.st[1];
        if (nloc == 0u) { xcd_barrier_complete(bar, b.x, nloc, nx); b.st[0] = nloc; b.st[1] = nx; }
        const unsigned old = xb_add(&bar[XB_XSUB(b.x)], 1u);
        const unsigned gen = old / nloc;
        if (old + 1u == (gen + 1u) * nloc) {
            __builtin_amdgcn_fence(__ATOMIC_RELEASE, "agent");
            asm volatile("s_waitcnt vmcnt(0)" ::: "memory");
            const unsigned og = xb_add(&bar[XB_TOP], 1u);
            const unsigned tg = og / nx;
            if (og + 1u == (tg + 1u) * nx) xb_add(&bar[XB_TOPGEN], 1u);
            else XB_SPIN(xb_ld(&bar[XB_TOPGEN]) == tg, bar);
            __builtin_amdgcn_fence(__ATOMIC_ACQUIRE, "agent");
            xb_add(&bar[XB_XGEN(b.x)], 1u);
            asm volatile("s_waitcnt vmcnt(0)" ::: "memory");
        } else {
            XB_SPIN(xb_ld(&bar[XB_XGEN(b.x)]) == gen, bar);
            __builtin_amdgcn_fence(__ATOMIC_ACQUIRE, "agent");
            asm volatile("s_waitcnt vmcnt(0)" ::: "memory");
        }
    }
    __syncthreads();
}

constexpr int LDS_BYTES = 147456;
constexpr int LDSCTL_OFF = 131072, MISC_OFF = LDSCTL_OFF + 320;
constexpr int CW_BAR = 4096;
struct Args { Params p; int ph_lo, ph_hi; };
__global__ void __launch_bounds__(512, 2) mk_fwd(Args a) {
    extern __shared__ __attribute__((aligned(16))) unsigned char smem[];
    LAS unsigned char* lds = (LAS unsigned char*)smem;
    const int tid = threadIdx.x, lane = tid & 63, wave = __builtin_amdgcn_readfirstlane(tid >> 6);
    const int G = gridDim.x, bx = blockIdx.x, vcu = (G % 8 == 0) ? (bx % 8) * (G / 8) + bx / 8 : bx;
    const int lo = a.ph_lo, hi = a.ph_hi;
    unsigned char* ws = a.p.ws;
    volatile LAS unsigned* MISC = (volatile LAS unsigned*)(lds + MISC_OFF);
    for (int u = tid; u < (LDS_BYTES - LDSCTL_OFF) / 4; u += 512) ((LAS unsigned*)(lds + LDSCTL_OFF))[u] = 0u;
    __syncthreads();
    XcdBarrier bar = xcd_barrier_post((unsigned*)(ws + WS_CTL) + CW_BAR, MISC + 8);
#ifndef PHMASK
#define PHMASK 0xffff
#endif
#define IN(k) (((PHMASK >> (k)) & 1) && lo <= (k) && (k) < hi)
#define SEAM(k) do { if (IN(k) && IN((k) + 1)) xcd_barrier(bar); } while (0)
    int kDM = DM, kDE = DEXP; asm volatile("" : "+s"(kDM), "+s"(kDE));
    if (IN(0)) { p0_prologue(a.p, (float*)smem, vcu * 8 + wave, G * 8, wave, lane); }
    SEAM(0);
    if (IN(1)) {
        { pg8::Gemm g{(const bf16_t*)(ws + WS_XN), (const bf16_t*)(ws + WS_WINT), NTOK, NIN, kDM}; pg8::StaticOrder S; S.init(NTOK, NIN, G, bx);
          pg8::EpiInproj E{ws}; pg8::gemm_phase<pg8::EpiInproj, pg8::StaticOrder, true, true>(lds, g, S, E); }
        { pg8::Gemm g{(const bf16_t*)(ws + WS_MEMB), (const bf16_t*)(ws + WS_WMT), NB * MEMLEN, 512, kDM}; pg8::StaticOrder S; S.init(NB * MEMLEN, 512, G, bx);
          pg8::EpiBf16Plain E{(bf16_t*)(ws + WS_MKV), 512}; pg8::gemm_phase<pg8::EpiBf16Plain, pg8::StaticOrder, true, true>(lds, g, S, E); }
    }
    SEAM(1);
    if (IN(2)) { kmax_phase(a.p, vcu * 8 + wave, G * 8, lane); }
    SEAM(2);
    if (IN(3)) {
        for (int u = vcu; u < 256; u += G) att::attn_unit<128, true>(lds, a.p, u, wave, lane);
        { int lane_b = lane; asm volatile("" : "+v"(lane_b)); for (int u = vcu; u < 256; u += G) att::attn_unit<64, false>(lds, a.p, u, wave, lane_b); }
        __syncthreads();
        nfourier_phase(a.p, (float*)smem, (float*)smem + 32 * 132, bx, G);
        __syncthreads();
    }
    SEAM(3);
    if (IN(4)) {
        pg8::Gemm g{(const bf16_t*)(ws + WS_OB), (const bf16_t*)(ws + WS_WOT), NTOK, DM, kDM}; pg8::StaticOrder S; S.init(NTOK, DM, G, bx);
        pg8::EpiF32Plain E{(float*)(ws + WS_AOUT), DM}; pg8::gemm_phase<pg8::EpiF32Plain, pg8::StaticOrder, true, true>(lds, g, S, E);
    }
    SEAM(4);
    if (IN(5)) { p4_ln1_router(a.p, (float*)smem, vcu * 8 + wave, G * 8, wave, lane); }
    SEAM(5);
    LAS int* mtab = (LAS int*)(lds + LDSCTL_OFF + 1024);
    if (IN(6) || IN(7)) {
        if (tid == 0) { const unsigned* cnt = (const unsigned*)(ws + WS_CTL) + CW_CNT; int tp = 0;
            for (int e = 0; e < 32; ++e) { const int c = (int)cnt[e]; mtab[e] = tp; mtab[33 + e] = c; tp += (c + 255) >> 8; } mtab[32] = tp; }
        __syncthreads();
    }
    if (IN(6)) {
        pg8::Gemm g{(const bf16_t*)(ws + WS_XN), (const bf16_t*)(ws + WS_W13T), 0, 0, kDM}; pg8::MoeOrder S{mtab, (const int*)(ws + WS_LIST), G, bx, 1};
        pg8::EpiSwiglu E{(bf16_t*)(ws + WS_OB)}; pg8::gemm_phase<pg8::EpiSwiglu, pg8::MoeOrder, true, true, true>(lds, g, S, E);
    }
    SEAM(6);
    if (IN(7)) {
        pg8::Gemm g{(const bf16_t*)(ws + WS_OB), (const bf16_t*)(ws + WS_W2T), 0, 0, kDE}; pg8::MoeOrder S{mtab, (const int*)(ws + WS_LIST), G, bx, 2};
        pg8::EpiDown E{(bf16_t*)(ws + WS_Y)}; pg8::gemm_phase<pg8::EpiDown, pg8::MoeOrder, true, true, false>(lds, g, S, E);
    }
    SEAM(7);
    if (IN(8)) { p7_final(a.p, vcu * 8 + wave, G * 8, lane); }
#undef IN
#undef SEAM
}

#ifndef N_LAUNCH_SPLIT
#define N_LAUNCH_SPLIT 0
#endif
extern "C" void kernel_launch(void* const* d_in, const int* in_sizes, int n_in, void* d_out, int out_size, void* d_ws, size_t ws_size, hipStream_t stream) {
    Params p{};
    for (int i = 0; i < 25; ++i) p.in[i] = (const float*)d_in[i];
    p.out = (float*)d_out; p.ws = (unsigned char*)d_ws;
    static int grid = 0;
    if (!grid) {
        (void)hipFuncSetAttribute((const void*)mk_fwd, hipFuncAttributeMaxDynamicSharedMemorySize, LDS_BYTES);
        int dev = 0, cus = 0, per_cu = 0;
        (void)hipGetDevice(&dev); (void)hipDeviceGetAttribute(&cus, hipDeviceAttributeMultiprocessorCount, dev);
        (void)hipOccupancyMaxActiveBlocksPerMultiprocessor(&per_cu, (const void*)mk_fwd, 512, LDS_BYTES);
        if (per_cu < 1) per_cu = 1;
        grid = cus * 1;
        if (grid > 256) grid = 256;
        (void)hipGetLastError();
    }
    (void)hipMemsetAsync((char*)d_ws + WS_CTL, 0, CTL_BYTES, stream);
    Args a{}; a.p = p;
#if N_LAUNCH_SPLIT
    for (int k = 0; k < 9; ++k) { a.ph_lo = k; a.ph_hi = k + 1; hipLaunchKernelGGL(mk_fwd, dim3(grid), dim3(512), LDS_BYTES, stream, a); }
#else
    a.ph_lo = 0; a.ph_hi = 9;
    void* kargs[] = {&a};
    (void)hipLaunchCooperativeKernel((const void*)mk_fwd, dim3(grid), dim3(512), kargs, LDS_BYTES, stream);
#endif
}
```

```cpp
#include <hip/hip_runtime.h>
#include <stdint.h>

#define DI __device__ __forceinline__
typedef unsigned short bf16_t;
typedef float f32x4 __attribute__((ext_vector_type(4)));
typedef unsigned u32x4 __attribute__((ext_vector_type(4)));
typedef unsigned u32x2 __attribute__((ext_vector_type(2)));

constexpr int NB = 4, SEQ = 4096, DM = 1024, NTOK = NB * SEQ;
constexpr int NEXP = 32, DEXP = 256, MEMLEN = 256;
constexpr int NIN = 2304;
constexpr float LOG2E = 1.4426950408889634f;
constexpr float C2 = 0.125f * LOG2E;
constexpr float ALPHA = 1.189207115002721f;
constexpr float LN_EPS = 1e-5f;
constexpr float LAM_INIT = 0.2f;

constexpr size_t MiB = 1u << 20;
constexpr size_t WS_CTL = 0, CTL_BYTES = 1 * MiB;
constexpr size_t WS_WINT = 1 * MiB;
constexpr size_t WS_WOT = 6 * MiB;
constexpr size_t WS_WMT = 8 * MiB;
constexpr size_t WS_MEMB = 9 * MiB;
constexpr size_t WS_WR = 11 * MiB;
constexpr size_t WS_COSTAB = 11 * MiB + 256 * 1024;
constexpr size_t WS_STATS0 = 11 * MiB + 512 * 1024;
constexpr size_t WS_MKV = 12 * MiB;
constexpr size_t WS_TOKINFO = 13 * MiB;
constexpr size_t WS_LIST = 14 * MiB;
constexpr size_t WS_W13T = 16 * MiB;
constexpr size_t WS_W2T = 48 * MiB;
constexpr size_t WS_XN = 64 * MiB;
constexpr size_t WS_OB = 96 * MiB;
constexpr size_t WS_QB = 128 * MiB, WS_KB = 144 * MiB, WS_VB = 160 * MiB, WS_MQB = 176 * MiB, WS_ZB = 184 * MiB;
constexpr size_t WS_AOUT = 128 * MiB;
constexpr size_t WS_Y = 128 * MiB;
constexpr int CW_CNT = 64;

struct Params {
    const float* in[25];
    float* out;
    unsigned char* ws;
};
enum { I_X = 0, I_MEM, I_LN0G, I_LN0B, I_RELB, I_WIN, I_WMKV, I_WF, I_LQ1, I_LK1, I_LQ2, I_LK2, I_SUBG, I_WOUT, I_LN1G, I_LN1B,
       I_WG, I_BG, I_WRT, I_BRT, I_W1, I_W3, I_W2, I_LN2G, I_LN2B };

DI float bf2f(bf16_t v) { return __uint_as_float(((unsigned)v) << 16); }
DI unsigned f2bf(float f) { unsigned u = __float_as_uint(f); return (u + 0x7fffu + ((u >> 16) & 1u)) >> 16; }
DI unsigned pk2(float lo, float hi) { return f2bf(lo) | (f2bf(hi) << 16); }
DI float wave_sum(float v) {
#pragma unroll
    for (int o = 1; o < 64; o <<= 1) v += __shfl_xor(v, o);
    return v;
}
DI int t5_bucket(int rel) {
    const int n = rel < 0 ? -rel : rel;
    int b;
    if (n < 8) b = n; else if (n < 12) b = 8; else if (n < 16) b = 9; else if (n < 23) b = 10; else if (n < 32) b = 11;
    else if (n < 46) b = 12; else if (n < 64) b = 13; else if (n < 91) b = 14; else b = 15;
    return b + (rel > 0 ? 16 : 0);
}


namespace pg8 {
#define PG8_LAS __attribute__((address_space(3)))
typedef unsigned short bf16_t;
typedef short bf16x8 __attribute__((ext_vector_type(8)));
typedef float f32x4 __attribute__((ext_vector_type(4)));
typedef unsigned u32x4 __attribute__((ext_vector_type(4)));
constexpr int BM = 256, BK = 64, HALF = 128, HTB = HALF * BK * 2  , STAGE_BYTES = 8 * HTB, NXCD = 8, WGM = 8;

__host__ __device__ __forceinline__ int lds_byte(int r, int c) { const int st = (r >> 4) * 2 + (c >> 5), rr = r & 15, cc = c & 31, ob = rr * 64 + cc * 2; return st * 1024 + (ob ^ (((ob >> 9) & 1) << 5)); }
__host__ __device__ __forceinline__ void stage_rc(int b, int& R, int& C) { const int st = b / 1024, sb = b % 1024, swz = sb ^ (((sb >> 9) & 1) << 5); R = (st >> 1) * 16 + swz / 64; C = (st & 1) * 32 + (swz % 64) / 2; }
__host__ __device__ __forceinline__ int perm32(int rho) { const int n = rho >> 4, i = rho & 15; return 8 * (i >> 2) + 4 * n + (i & 3); }

struct Unit { int pm, pn; };
struct Gemm { const bf16_t* A; const bf16_t* Bt; int M, N, K; };

struct StaticOrder {
    int nM, nN, nwg, G, c;
    __host__ __device__ void init(int M, int N, int G_, int c_) { nM = M / BM; nN = N / BM; nwg = nM * nN; G = G_; c = c_; }
    __host__ __device__ bool next(int i, Unit& u) const {
        const long L = (long)i * G + c; if (L >= nwg) return false;
        int wgid = (int)L; { const int q = nwg / NXCD, r = nwg % NXCD, xcd = wgid % NXCD, off = wgid / NXCD; wgid = (xcd < r ? xcd * (q + 1) : r * (q + 1) + (xcd - r) * q) + off; }
        const int nig = WGM * nN, gid = wgid / nig, fm = gid * WGM, gsz = (nM - fm) < WGM ? (nM - fm) : WGM;
        u.pm = fm + ((wgid % nig) % gsz); u.pn = (wgid % nig) / gsz; return true;
    }
    __device__ __forceinline__ void a_ready(const Unit&) const {}
    __device__ __forceinline__ void done(const Unit&) const {}
};

__device__ __forceinline__ unsigned cvt_pk_bf16(float lo, float hi) { unsigned r; asm volatile("v_cvt_pk_bf16_f32 %0, %1, %2" : "=v"(r) : "v"(lo), "v"(hi)); return r; }
typedef float f32x2 __attribute__((ext_vector_type(2)));
__device__ __forceinline__ f32x2 gelu_pk(f32x2 v) {
    const f32x2 av = __builtin_elementwise_abs(v), d = av * 0.2316418882f + 1.0f;
    f32x2 t; t.x = __builtin_amdgcn_rcpf(d.x); t.y = __builtin_amdgcn_rcpf(d.y);
    f32x2 q = t * 0.5307027145f + (-0.7265760135f); q = q * t + 0.7107068705f; q = q * t + (-0.142248368f); q = q * t + 0.127414796f; q = q * t;
    const f32x2 s = (v * v) * (-0.72134752044f);
    f32x2 e; e.x = __builtin_amdgcn_exp2f(s.x); e.y = __builtin_amdgcn_exp2f(s.y);
    const f32x2 m = v * (q * e), r = v - m;
    f32x2 o; o.x = v.x < 0.f ? m.x : r.x; o.y = v.y < 0.f ? m.y : r.y; return o;
}

template <int ACT  > struct EpiBf16 {
    static constexpr bool PERM = true, AFTER_DRAIN = false; static_assert(ACT == 0 || ACT == 1, "EpiBf16: ACT is 0 (none) or 1 (gelu_pk)");
    bf16_t* O; int ldc; const float* bias; int split_cols; size_t split_stride; float scale0;
    __device__ __forceinline__ void operator()(const f32x4 (&acc)[2][2][4][2], const Unit& u, int wr, int wc, int fr, int fq) const {
        const int row0 = u.pm * BM + wr * 64 + fr; int colt = u.pn * BM; bf16_t* base = O;
        float sc = 1.f; if (split_cols) { const int t = colt / split_cols; base += (size_t)t * split_stride; colt -= t * split_cols; if (t == 0) sc = scale0; }
        const int col0 = colt + wc * 32 + 8 * fq, bcol0 = u.pn * BM + wc * 32 + 8 * fq;
        f32x4 bv[2][2];
#pragma unroll
        for (int bj = 0; bj < 2; ++bj)
#pragma unroll
            for (int n = 0; n < 2; ++n) bv[bj][n] = bias ? *(const f32x4*)(bias + bcol0 + bj * HALF + 4 * n) : (f32x4){0.f, 0.f, 0.f, 0.f};
#pragma unroll
        for (int ai = 0; ai < 2; ++ai)
#pragma unroll
            for (int m = 0; m < 4; ++m) { bf16_t* rowp = base + (size_t)(row0 + ai * HALF + m * 16) * ldc + col0;
#pragma unroll
                for (int bj = 0; bj < 2; ++bj) { f32x4 v0 = acc[ai][bj][m][0] + bv[bj][0], v1 = acc[ai][bj][m][1] + bv[bj][1];
                    if (ACT == 1) { f32x2 a = gelu_pk((f32x2){v0[0], v0[1]}), b = gelu_pk((f32x2){v0[2], v0[3]}), c = gelu_pk((f32x2){v1[0], v1[1]}), d = gelu_pk((f32x2){v1[2], v1[3]});
                        v0 = (f32x4){a.x, a.y, b.x, b.y}; v1 = (f32x4){c.x, c.y, d.x, d.y}; }
                    v0 = v0 * sc; v1 = v1 * sc; u32x4 w; w.x = cvt_pk_bf16(v0[0], v0[1]); w.y = cvt_pk_bf16(v0[2], v0[3]); w.z = cvt_pk_bf16(v1[0], v1[1]); w.w = cvt_pk_bf16(v1[2], v1[3]);
                    *(u32x4*)(rowp + bj * HALF) = w; } }
    }
};

struct PanelStats {
    unsigned* xbuf;
    unsigned* cnt;
    unsigned* tmo;
    int ntn; float eps;
    unsigned code;
    __device__ __forceinline__ bool run(const f32x4 (&v)[2][2][4][2], const Unit& u, int wr, int wc, int fr, int fq, PG8_LAS unsigned char* lds, int wid, int lane) const {
        typedef float f32x2v __attribute__((ext_vector_type(2)));
        PG8_LAS f32x2v* P = (PG8_LAS f32x2v*)lds;
        PG8_LAS f32x2v* S = (PG8_LAS f32x2v*)(lds + 8192);
        PG8_LAS unsigned* flag = (PG8_LAS unsigned*)(lds + 8192 + 2048);
#pragma unroll
        for (int ai = 0; ai < 2; ++ai)
#pragma unroll
            for (int m = 0; m < 4; ++m) {
                float s = 0.f;
#pragma unroll
                for (int bj = 0; bj < 2; ++bj)
#pragma unroll
                    for (int n = 0; n < 2; ++n) { const f32x4 x = v[ai][bj][m][n]; s += (x[0] + x[1]) + (x[2] + x[3]); }
                s += __shfl_xor(s, 16); s += __shfl_xor(s, 32);
                const float mw = s * (1.0f / 64.0f); float q = 0.f;
#pragma unroll
                for (int bj = 0; bj < 2; ++bj)
#pragma unroll
                    for (int n = 0; n < 2; ++n) { const f32x4 d = v[ai][bj][m][n] - mw; q += (d[0] * d[0] + d[1] * d[1]) + (d[2] * d[2] + d[3] * d[3]); }
                q += __shfl_xor(q, 16); q += __shfl_xor(q, 32);
                if (fq == 0) P[(ai * HALF + wr * 64 + m * 16 + fr) * 4 + wc] = (f32x2v){mw, q};
            }
        asm volatile("s_waitcnt lgkmcnt(0)" ::: "memory"); __builtin_amdgcn_s_barrier(); asm volatile("" ::: "memory");
#if defined(BROKEN_EXCHANGE_NO_WAIT)
#warning BROKEN CONTROL BUILD: the row-statistics exchange does not wait; results are wrong by design
        if (blockIdx.x >= 64) { const long long t0_ = clock64(); while (clock64() - t0_ < 60000) __builtin_amdgcn_s_sleep(8); }
#endif
        const int row = wid * 32 + (lane & 31);
        if (lane < 32) {
            const f32x2v a = P[row * 4 + 0], b = P[row * 4 + 1], c = P[row * 4 + 2], d = P[row * 4 + 3];
            const float mt = (a.x + b.x + c.x + d.x) * 0.25f;
            const float da = a.x - mt, db = b.x - mt, dc = c.x - mt, dd = d.x - mt;
            const float m2 = (a.y + b.y) + (c.y + d.y) + 64.0f * ((da * da + db * db) + (dc * dc + dd * dd));
            unsigned long long* slot = (unsigned long long*)xbuf + ((size_t)(u.pm * BM + row) * 4 + u.pn);
            __hip_atomic_store(slot, ((unsigned long long)__float_as_uint(m2) << 32) | __float_as_uint(mt), __ATOMIC_RELAXED, __HIP_MEMORY_SCOPE_AGENT);
        }
        asm volatile("s_waitcnt vmcnt(0)" ::: "memory");
        if (lane == 0) __hip_atomic_fetch_add(cnt + 64 * u.pm, 1u, __ATOMIC_RELAXED, __HIP_MEMORY_SCOPE_AGENT);
        if (wid == 0) {
            bool dead = false; const unsigned long long t0 = __builtin_amdgcn_s_memrealtime(); const unsigned want = 8u * (unsigned)ntn;
            for (;;) {
#if defined(BROKEN_EXCHANGE_NO_WAIT)
                break;
#endif
                if ((unsigned)__builtin_amdgcn_readfirstlane(__hip_atomic_load(cnt + 64 * u.pm, __ATOMIC_RELAXED, __HIP_MEMORY_SCOPE_AGENT)) >= want) break;
                if (__builtin_amdgcn_s_memrealtime() - t0 > 2000000ull) {
                    if (lane == 0) { unsigned expect = 0u; __hip_atomic_compare_exchange_strong(tmo + 1, &expect, code | (unsigned)(u.pm & 0xff), __ATOMIC_RELAXED, __ATOMIC_RELAXED, __HIP_MEMORY_SCOPE_AGENT);
                                     __hip_atomic_store(tmo, 1u, __ATOMIC_RELAXED, __HIP_MEMORY_SCOPE_AGENT); }
                    dead = true; break; }
                __builtin_amdgcn_s_sleep(2);
            }
            __builtin_amdgcn_fence(__ATOMIC_ACQUIRE, "agent");
            if (lane == 0) flag[0] = dead ? 1u : 0u;
        }
        asm volatile("s_waitcnt vmcnt(0) lgkmcnt(0)" ::: "memory"); __builtin_amdgcn_s_barrier(); asm volatile("" ::: "memory");
        const bool bad = flag[0] != 0u;
        if (lane < 32) {
            const unsigned long long* slot = (const unsigned long long*)xbuf + (size_t)(u.pm * BM + row) * 4; float mt[4], m2[4]; float ms = 0.f;
#pragma unroll
            for (int t = 0; t < 4; ++t) { if (t < ntn) { const unsigned long long w = __hip_atomic_load(slot + t, __ATOMIC_RELAXED, __HIP_MEMORY_SCOPE_AGENT); mt[t] = __uint_as_float((unsigned)w); m2[t] = __uint_as_float((unsigned)(w >> 32)); } else { mt[t] = 0.f; m2[t] = 0.f; } ms += mt[t]; }
            const float mean = ms / (float)ntn; float q = 0.f;
#pragma unroll
            for (int t = 0; t < 4; ++t) if (t < ntn) { const float dm = mt[t] - mean; q += m2[t] + 256.0f * dm * dm; }
            S[row] = (f32x2v){mean, 1.0f / sqrtf(q / (256.0f * (float)ntn) + eps)};
        }
        asm volatile("s_waitcnt lgkmcnt(0)" ::: "memory"); __builtin_amdgcn_s_barrier(); asm volatile("" ::: "memory");
        return bad;
    }
};
struct EpiLnRes {
    static constexpr bool PERM = false, AFTER_DRAIN = true;
    const float* base; float* out; int ldc; const float* bias; PanelStats st; unsigned poison;
    __device__ __forceinline__ void fused(f32x4 (&acc)[2][2][4][2], const Unit& u, int wr, int wc, int fr, int fq, PG8_LAS unsigned char* lds, int wid, int lane) const {
        typedef float f32x2v __attribute__((ext_vector_type(2)));
        const PG8_LAS f32x2v* S = (const PG8_LAS f32x2v*)(lds + 8192);
        const int col0 = u.pn * BM + wc * 32 + 4 * fq;
#pragma unroll
        for (int bj = 0; bj < 2; ++bj)
#pragma unroll
            for (int n = 0; n < 2; ++n) { const f32x4 bv = bias ? *(const f32x4*)(bias + col0 + bj * HALF + n * 16) : (f32x4){0.f, 0.f, 0.f, 0.f};
#pragma unroll
                for (int ai = 0; ai < 2; ++ai)
#pragma unroll
                    for (int m = 0; m < 4; ++m) acc[ai][bj][m][n] += bv; }
        f32x4 pre[4][2][2];
#pragma unroll
        for (int m = 0; m < 4; ++m) { const size_t off = (size_t)(u.pm * BM + wr * 64 + m * 16 + fr) * ldc + col0;
#pragma unroll
            for (int bj = 0; bj < 2; ++bj)
#pragma unroll
                for (int n = 0; n < 2; ++n) pre[m][bj][n] = *(const f32x4*)(base + off + bj * HALF + n * 16); }
        const bool bad = st.run(acc, u, wr, wc, fr, fq, lds, wid, lane) || poison != 0u;
        const float qnan = __builtin_nanf("");
#pragma unroll
        for (int ai = 0; ai < 2; ++ai)
#pragma unroll
            for (int m = 0; m < 4; ++m) { const int r = ai * HALF + wr * 64 + m * 16 + fr; const f32x2v sr = S[r]; const size_t off = (size_t)(u.pm * BM + r) * ldc + col0;
#pragma unroll
                for (int bj = 0; bj < 2; ++bj)
#pragma unroll
                    for (int n = 0; n < 2; ++n) { const f32x4 bs = ai == 0 ? pre[m][bj][n] : *(const f32x4*)(base + off + bj * HALF + n * 16); f32x4 o = bs + (acc[ai][bj][m][n] - sr.x) * sr.y;
                        if (bad) o = (f32x4){qnan, qnan, qnan, qnan}; *(f32x4*)(out + off + bj * HALF + n * 16) = o; }
                if (m & 1) asm volatile("" ::: "memory"); }
    }
};
struct EpiLnResLn {
    static constexpr bool PERM = false, AFTER_DRAIN = true;
    const float* base; float* out; bf16_t* xn; int ldc; const float* bias; PanelStats st1, st2; unsigned poison;
    __device__ __forceinline__ void fused(f32x4 (&acc)[2][2][4][2], const Unit& u, int wr, int wc, int fr, int fq, PG8_LAS unsigned char* lds, int wid, int lane) const {
        typedef float f32x2v __attribute__((ext_vector_type(2))); typedef unsigned u32x2v __attribute__((ext_vector_type(2)));
        const PG8_LAS f32x2v* S = (const PG8_LAS f32x2v*)(lds + 8192);
        const int col0 = u.pn * BM + wc * 32 + 4 * fq;
#pragma unroll
        for (int bj = 0; bj < 2; ++bj)
#pragma unroll
            for (int n = 0; n < 2; ++n) { const f32x4 bv = bias ? *(const f32x4*)(bias + col0 + bj * HALF + n * 16) : (f32x4){0.f, 0.f, 0.f, 0.f};
#pragma unroll
                for (int ai = 0; ai < 2; ++ai)
#pragma unroll
                    for (int m = 0; m < 4; ++m) acc[ai][bj][m][n] += bv; }
        bool bad = st1.run(acc, u, wr, wc, fr, fq, lds, wid, lane) || poison != 0u;
        const float qnan = __builtin_nanf("");
#pragma unroll
        for (int ai = 0; ai < 2; ++ai)
#pragma unroll
            for (int m = 0; m < 4; ++m) { const int r = ai * HALF + wr * 64 + m * 16 + fr; const f32x2v sr = S[r]; const size_t off = (size_t)(u.pm * BM + r) * ldc + col0;
#pragma unroll
                for (int bj = 0; bj < 2; ++bj)
#pragma unroll
                    for (int n = 0; n < 2; ++n) { const f32x4 bs = *(const f32x4*)(base + off + bj * HALF + n * 16); acc[ai][bj][m][n] = bs + (acc[ai][bj][m][n] - sr.x) * sr.y; }
                asm volatile("" : "+v"(acc[ai][0][m][0]), "+v"(acc[ai][0][m][1]), "+v"(acc[ai][1][m][0]), "+v"(acc[ai][1][m][1]));
                if (m & 1) asm volatile("" ::: "memory"); }
        const bool bad1 = bad;
        bad = st2.run(acc, u, wr, wc, fr, fq, lds, wid, lane) || bad;
#pragma unroll
        for (int ai = 0; ai < 2; ++ai)
#pragma unroll
            for (int m = 0; m < 4; ++m) { const int r = ai * HALF + wr * 64 + m * 16 + fr; const f32x2v sr = S[r]; const size_t off = (size_t)(u.pm * BM + r) * ldc + col0;
#pragma unroll
                for (int bj = 0; bj < 2; ++bj)
#pragma unroll
                    for (int n = 0; n < 2; ++n) { const f32x4 x1 = acc[ai][bj][m][n]; *(f32x4*)(out + off + bj * HALF + n * 16) = bad1 ? (f32x4){qnan, qnan, qnan, qnan} : x1;
                        const f32x4 o = (x1 - sr.x) * sr.y; u32x2v w; w.x = cvt_pk_bf16(o[0], o[1]); w.y = cvt_pk_bf16(o[2], o[3]);
                        if (bad) { w.x = 0x7fc07fc0u; w.y = 0x7fc07fc0u; } *(u32x2v*)(xn + off + bj * HALF + n * 16) = w; }
                asm volatile("" ::: "memory"); }
    }
};

template <class Epi, class Sched, bool ALIGN_EPI = false, bool SP2 = false, bool GATHER = false>
__device__ __forceinline__ void gemm_phase(PG8_LAS unsigned char* lds, const Gemm g, const Sched& S, const Epi& E) {
    const int tid = threadIdx.x, wid = __builtin_amdgcn_readfirstlane(tid >> 6), lane = tid & 63, wr = wid >> 2, wc = wid & 3, fr = lane & 15, fq = lane >> 4;
    const int K = g.K, nt = K / BK;
    static_assert(!GATHER || SP2, "GATHER is wired into the SP2 loop only");
    unsigned voffA[2], voffB[2]; int gR_[2], gC_[2];
#pragma unroll
    for (int i = 0; i < 2; ++i) { int R, C; stage_rc(tid * 16 + i * 8192, R, C); const int Rb = Epi::PERM ? ((R & ~31) + perm32(R & 31)) : R; gR_[i] = R; gC_[i] = C;
        voffA[i] = (unsigned)(R * K + C) * 2u; voffB[i] = (unsigned)(Rb * K + C) * 2u; }
    unsigned gvo[2][2] = {{0u, 0u}, {0u, 0u}}, gvn[2][2] = {{0u, 0u}, {0u, 0u}};
#define PG8_GOFF(dst, unit) do { _Pragma("unroll") for (int h_ = 0; h_ < 2; ++h_) _Pragma("unroll") for (int i_ = 0; i_ < 2; ++i_) \
        dst[h_][i_] = ((unsigned)S.a_row(unit, h_ * HALF + gR_[i_]) * (unsigned)K + (unsigned)gC_[i_]) * 2u; \
        asm volatile("" : "+v"(dst[0][0]), "+v"(dst[0][1]), "+v"(dst[1][0]), "+v"(dst[1][1])); } while (0)
    const size_t kstep = (size_t)(BK * 2);
    const size_t hstep = (size_t)HALF * K * 2;
    const size_t tstep = 2 * hstep;
    const unsigned ldsw = (unsigned)wid * 1024u;
    const int aoff = lds_byte(wr * 64 + fr, fq * 8), boff = lds_byte(wc * 32 + fr, fq * 8);
#define PG8_SA(b, h) (((b) * 2 + (h)) * HTB)
#define PG8_SB(b, h) ((4 + (b) * 2 + (h)) * HTB)
#define PG8_STAGE(bufoff, gbase, voff) do { _Pragma("unroll") for (int _i = 0; _i < 2; ++_i) \
        __builtin_amdgcn_global_load_lds((const unsigned*)((const char*)(gbase) + (voff)[_i]), (PG8_LAS unsigned*)(lds + (bufoff) + ldsw + _i * 8192), 16, 0, 0); } while (0)
#define PG8_STAGE_AH(bufoff, gbase, h, usen) do { _Pragma("unroll") for (int _i = 0; _i < 2; ++_i) { \
        const unsigned vo_ = GATHER ? ((usen) ? gvn[h][_i] : gvo[h][_i]) : voffA[_i]; \
        __builtin_amdgcn_global_load_lds((const unsigned*)((const char*)(gbase) + (GATHER ? (size_t)0 : (size_t)(h) * hstep) + vo_), (PG8_LAS unsigned*)(lds + (bufoff) + ldsw + _i * 8192), 16, 0, 0); } } while (0)
#define PG8_LDA(dst, b, h) do { _Pragma("unroll") for (int m = 0; m < 4; ++m) _Pragma("unroll") for (int k = 0; k < 2; ++k) dst[m][k] = *(const PG8_LAS bf16x8*)(lds + PG8_SA(b, h) + aoff + m * 2048 + k * 1024); } while (0)
#define PG8_LDB(dst, b, h) do { _Pragma("unroll") for (int n = 0; n < 2; ++n) _Pragma("unroll") for (int k = 0; k < 2; ++k) dst[n][k] = *(const PG8_LAS bf16x8*)(lds + PG8_SB(b, h) + boff + n * 2048 + k * 1024); } while (0)
#define PG8_MMA(ai, bj, At, Bt) do { __builtin_amdgcn_s_setprio(1); _Pragma("unroll") for (int m = 0; m < 4; ++m) _Pragma("unroll") for (int n = 0; n < 2; ++n) _Pragma("unroll") for (int k = 0; k < 2; ++k) \
        acc[ai][bj][m][n] = __builtin_amdgcn_mfma_f32_16x16x32_bf16(Bt[n][k], At[m][k], acc[ai][bj][m][n], 0, 0, 0); __builtin_amdgcn_s_setprio(0); } while (0)
#define PG8_WAIT_V(n) asm volatile("s_waitcnt vmcnt(" #n ")" ::: "memory")
#define PG8_WAIT_L(n) asm volatile("s_waitcnt lgkmcnt(" #n ")" ::: "memory")
#define PG8_BAR __builtin_amdgcn_s_barrier()
#define PG8_SCHED __builtin_amdgcn_sched_barrier(0)
    Unit cur, nxt; int ui = 0;
    if (!S.next(0, cur)) return;
    f32x4 acc[2][2][4][2];
#pragma unroll
    for (int a = 0; a < 2; ++a)
#pragma unroll
        for (int b = 0; b < 2; ++b)
#pragma unroll
            for (int m = 0; m < 4; ++m)
#pragma unroll
                for (int n = 0; n < 2; ++n) acc[a][b][m][n] = (f32x4){0.f, 0.f, 0.f, 0.f};
    bf16x8 At[4][2], B0[2][2], B1[2][2];
    const char* cA = (const char*)g.A + (GATHER ? (size_t)0 : (size_t)cur.pm * tstep); const char* cB = (const char*)g.Bt + (size_t)cur.pn * tstep;
    S.a_ready(cur);
    if constexpr (GATHER) { PG8_GOFF(gvo, cur); }
    if constexpr (SP2) {
        PG8_STAGE(PG8_SB(0, 0), cB, voffB); PG8_STAGE(PG8_SB(0, 1), cB + hstep, voffB); PG8_STAGE_AH(PG8_SA(0, 0), cA, 0, false); PG8_STAGE_AH(PG8_SA(0, 1), cA, 1, false);
        if (wr == 1) PG8_BAR;
        PG8_WAIT_V(2); PG8_BAR;
        PG8_STAGE(PG8_SB(1, 0), cB + kstep, voffB); PG8_STAGE_AH(PG8_SA(1, 0), cA + kstep, 0, false); PG8_STAGE(PG8_SB(1, 1), cB + hstep + kstep, voffB);
        PG8_WAIT_V(6); PG8_BAR;
    } else {
        PG8_STAGE(PG8_SB(0, 0), cB, voffB); PG8_STAGE(PG8_SA(0, 0), cA, voffA); PG8_STAGE(PG8_SB(0, 1), cB + hstep, voffB); PG8_STAGE(PG8_SA(0, 1), cA + hstep, voffA);
        if (wr == 1) PG8_BAR;
        PG8_WAIT_V(4); PG8_BAR;
        PG8_STAGE(PG8_SB(1, 0), cB + kstep, voffB); PG8_STAGE(PG8_SA(1, 0), cA + kstep, voffA); PG8_STAGE(PG8_SB(1, 1), cB + hstep + kstep, voffB);
        PG8_WAIT_V(6); PG8_BAR;
    }
    for (;;) {
        const bool has_next = S.next(ui + 1, nxt);
        const char* nA = has_next ? (const char*)g.A + (GATHER ? (size_t)0 : (size_t)nxt.pm * tstep) : cA; const char* nB = has_next ? (const char*)g.Bt + (size_t)nxt.pn * tstep : cB;
        if constexpr (GATHER) { if (has_next) { PG8_GOFF(gvn, nxt); } else { gvn[0][0] = gvo[0][0]; gvn[0][1] = gvo[0][1]; gvn[1][0] = gvo[1][0]; gvn[1][1] = gvo[1][1]; } }
        for (int t = 0; t < nt; t += 2) {
            const bool last = (t == nt - 2);
            const char* a1 = cA + (size_t)(t + 1) * kstep;
            const char* a2 = last ? nA : cA + (size_t)(t + 2) * kstep; const char* b2 = last ? nB : cB + (size_t)(t + 2) * kstep;
            const char* a3 = a2 + kstep; const char* b3 = b2 + kstep;
            if (last && has_next) S.a_ready(nxt);
            if constexpr (SP2) {
            PG8_LDB(B0, 0, 0); PG8_LDB(B1, 0, 1); PG8_SCHED; PG8_LDA(At, 0, 0); PG8_STAGE_AH(PG8_SA(1, 1), a1, 1, false);
            PG8_WAIT_V(8); PG8_WAIT_L(0); PG8_BAR; PG8_MMA(0, 0, At, B0); PG8_MMA(0, 1, At, B1); PG8_BAR; PG8_SCHED;
            PG8_LDA(At, 0, 1); PG8_STAGE(PG8_SB(0, 0), b2, voffB); PG8_STAGE(PG8_SB(0, 1), b2 + hstep, voffB); PG8_STAGE_AH(PG8_SA(0, 0), a2, 0, last);
            PG8_WAIT_V(8); PG8_WAIT_L(0); PG8_BAR; PG8_MMA(1, 0, At, B0); PG8_MMA(1, 1, At, B1); PG8_BAR; PG8_SCHED;
            PG8_LDB(B0, 1, 0); PG8_LDB(B1, 1, 1); PG8_SCHED; PG8_LDA(At, 1, 0); PG8_STAGE_AH(PG8_SA(0, 1), a2, 1, last);
            PG8_WAIT_V(8); PG8_WAIT_L(0); PG8_BAR; PG8_MMA(0, 0, At, B0); PG8_MMA(0, 1, At, B1); PG8_BAR; PG8_SCHED;
            PG8_LDA(At, 1, 1); PG8_STAGE(PG8_SB(1, 0), b3, voffB); PG8_STAGE(PG8_SB(1, 1), b3 + hstep, voffB); PG8_STAGE_AH(PG8_SA(1, 0), a3, 0, last);
            PG8_WAIT_V(8); PG8_WAIT_L(0); PG8_BAR; PG8_MMA(1, 0, At, B0); PG8_MMA(1, 1, At, B1); PG8_BAR; PG8_SCHED;
            } else {
            PG8_LDB(B0, 0, 0); PG8_SCHED; PG8_LDA(At, 0, 0); PG8_STAGE(PG8_SA(1, 1), a1 + hstep, voffA);
            PG8_WAIT_L(8); PG8_BAR; PG8_WAIT_L(0); PG8_MMA(0, 0, At, B0); PG8_BAR; PG8_SCHED;
            PG8_LDB(B1, 0, 1); PG8_STAGE(PG8_SB(0, 0), b2, voffB);
            PG8_BAR; PG8_WAIT_L(0); PG8_MMA(0, 1, At, B1); PG8_BAR;
            PG8_LDA(At, 0, 1); PG8_STAGE(PG8_SA(0, 0), a2, voffA);
            PG8_BAR; PG8_WAIT_L(0); PG8_MMA(1, 0, At, B0); PG8_BAR; PG8_SCHED;
            PG8_STAGE(PG8_SB(0, 1), b2 + hstep, voffB);
            PG8_WAIT_V(6); PG8_BAR; PG8_MMA(1, 1, At, B1); PG8_BAR;
            PG8_LDB(B0, 1, 0); PG8_SCHED; PG8_LDA(At, 1, 0); PG8_STAGE(PG8_SA(0, 1), a2 + hstep, voffA);
            PG8_WAIT_L(8); PG8_BAR; PG8_WAIT_L(0); PG8_MMA(0, 0, At, B0); PG8_BAR; PG8_SCHED;
            PG8_LDB(B1, 1, 1); PG8_STAGE(PG8_SB(1, 0), b3, voffB);
            PG8_BAR; PG8_WAIT_L(0); PG8_MMA(0, 1, At, B1); PG8_BAR;
            PG8_LDA(At, 1, 1); PG8_STAGE(PG8_SA(1, 0), a3, voffA);
            PG8_BAR; PG8_WAIT_L(0); PG8_MMA(1, 0, At, B0); PG8_BAR; PG8_SCHED;
            PG8_STAGE(PG8_SB(1, 1), b3 + hstep, voffB);
            PG8_WAIT_V(6); PG8_BAR; PG8_MMA(1, 1, At, B1); PG8_BAR;
            }
        }
        if constexpr (ALIGN_EPI) { if (wr == 0) PG8_BAR; }
        if constexpr (!Epi::AFTER_DRAIN) { E(acc, cur, wr, wc, fr, fq); S.done(cur); }
        if (!has_next) break;
#pragma unroll
        for (int a = 0; a < 2; ++a)
#pragma unroll
            for (int b = 0; b < 2; ++b)
#pragma unroll
                for (int m = 0; m < 4; ++m)
#pragma unroll
                    for (int n = 0; n < 2; ++n) acc[a][b][m][n] = (f32x4){0.f, 0.f, 0.f, 0.f};
        cur = nxt; cA = nA; cB = nB; ++ui;
        if constexpr (GATHER) { gvo[0][0] = gvn[0][0]; gvo[0][1] = gvn[0][1]; gvo[1][0] = gvn[1][0]; gvo[1][1] = gvn[1][1]; }
        if constexpr (ALIGN_EPI) { if (wr == 1) PG8_BAR; }
    }
    PG8_WAIT_V(0);
    if constexpr (!ALIGN_EPI) { if (wr == 0) PG8_BAR; }
    PG8_BAR;
    if constexpr (Epi::AFTER_DRAIN) { E.fused(acc, cur, wr, wc, fr, fq, lds, wid, lane); S.done(cur); }
#undef PG8_SA
#undef PG8_SB
#undef PG8_STAGE
#undef PG8_STAGE_AH
#undef PG8_GOFF
#undef PG8_LDA
#undef PG8_LDB
#undef PG8_MMA
#undef PG8_WAIT_V
#undef PG8_WAIT_L
#undef PG8_BAR
#undef PG8_SCHED
}
}

DI void transpose_item(const float* W, int ldw, bf16_t* WT, int ldt, float scale, float* scr, int k0, int n0, int lane) {
#pragma unroll 8
    for (int i = 0; i < 32; ++i) { const int kk = 2 * i + (lane >> 5); scr[kk * 33 + (lane & 31)] = W[(size_t)(k0 + kk) * ldw + n0 + (lane & 31)] * scale; }
    asm volatile("s_waitcnt lgkmcnt(0)" ::: "memory");
    const int c = lane & 7;
#pragma unroll
    for (int j = 0; j < 4; ++j) { const int n = (lane >> 3) + 8 * j; const float* s = scr + (8 * c) * 33 + n;
        u32x4 o; o.x = pk2(s[0 * 33], s[1 * 33]); o.y = pk2(s[2 * 33], s[3 * 33]); o.z = pk2(s[4 * 33], s[5 * 33]); o.w = pk2(s[6 * 33], s[7 * 33]);
        *(u32x4*)(WT + (size_t)n * ldt + k0 + 8 * c) = o; }
    asm volatile("s_waitcnt lgkmcnt(0)" ::: "memory");
}

DI void p0_prologue(const Params& p, float* lds, int gw, int NGW, int wave, int lane) {
    unsigned char* ws = p.ws;
    bf16_t* WinT = (bf16_t*)(ws + WS_WINT); bf16_t* WoT = (bf16_t*)(ws + WS_WOT); bf16_t* WmT = (bf16_t*)(ws + WS_WMT);
    bf16_t* W13T = (bf16_t*)(ws + WS_W13T); bf16_t* W2T = (bf16_t*)(ws + WS_W2T);
    float* scr = lds + wave * (64 * 33);
    const float* w_in = p.in[I_WIN];
    constexpr int S0 = 256, S1 = 512, S2 = 768, S3 = 896, S4 = 1408, S5 = 1664, S6 = S5 + 4096, S7 = S6 + 4096, S8 = S7 + 4096;
    for (int it = gw; it < S8; it += NGW) {
        if (it < S3) {
            int seg, r;
            if (it < S0) { seg = 0; r = it; } else if (it < S1) { seg = 1; r = it - S0; } else if (it < S2) { seg = 2; r = it - S1; } else { seg = 3; r = it - S2; }
            const int ncb = (seg == 3) ? 8 : 16;
            const int kb = r / ncb, nb = r % ncb;
            const int coff = (seg == 3) ? 1792 : seg * 512, roff = (seg == 3) ? 1536 : seg * 512;
            const float sc = (seg == 0 || seg == 3) ? C2 : 1.0f;
            transpose_item(w_in + coff, 2048, WinT + (size_t)(roff + nb * 32) * 1024, 1024, sc, scr, kb * 64, nb * 32, lane);
        } else if (it < S4) { const int r = it - S3, kb = r / 32, nb = r % 32;
            transpose_item(p.in[I_WOUT], 1024, WoT + (size_t)(nb * 32) * 1024, 1024, 1.f, scr, kb * 64, nb * 32, lane);
        } else if (it < S5) { const int r = it - S4, kb = r / 16, nb = r % 16;
            transpose_item(p.in[I_WMKV], 512, WmT + (size_t)(nb * 32) * 1024, 1024, 1.f, scr, kb * 64, nb * 32, lane);
        } else if (it < S7) { const bool is3 = it >= S6; const int r = it - (is3 ? S6 : S5), e = r / 128, q = r % 128, kb = q / 8, nb = q % 8, n0 = nb * 32;
            const float* W = (is3 ? p.in[I_W3] : p.in[I_W1]) + (size_t)e * 1024 * 256;
            const int drow = e * 512 + (n0 >> 7) * 256 + (is3 ? 128 : 0) + (n0 & 127);
            transpose_item(W, 256, W13T + (size_t)drow * 1024, 1024, 1.f, scr, kb * 64, n0, lane);
        } else { const int r = it - S7, e = r / 128, q = r % 128, kb = q / 32, nb = q % 32;
            const float* W = p.in[I_W2] + (size_t)e * 256 * 1024;
            transpose_item(W, 1024, W2T + (size_t)(e * 1024 + nb * 32) * 256, 256, 1.f, scr, kb * 64, nb * 32, lane);
        }
    }
    {
        bf16_t* XN = (bf16_t*)(ws + WS_XN); float* st = (float*)(ws + WS_STATS0);
        const f32x4* g4 = (const f32x4*)p.in[I_LN0G] + lane; const f32x4* b4 = (const f32x4*)p.in[I_LN0B] + lane;
        for (int m = gw; m < NTOK; m += NGW) {
            const f32x4* xr = (const f32x4*)(p.in[I_X] + (size_t)m * DM) + lane;
            f32x4 v[4]; float s = 0.f;
#pragma unroll
            for (int j = 0; j < 4; ++j) { v[j] = xr[64 * j]; s += (v[j].x + v[j].y) + (v[j].z + v[j].w); }
            const float mean = wave_sum(s) * (1.f / DM); float s2 = 0.f;
#pragma unroll
            for (int j = 0; j < 4; ++j) { v[j] = v[j] - mean; s2 += (v[j].x * v[j].x + v[j].y * v[j].y) + (v[j].z * v[j].z + v[j].w * v[j].w); }
            const float rstd = 1.f / sqrtf(wave_sum(s2) * (1.f / DM) + LN_EPS);
            if (lane == 0) { st[2 * m] = mean; st[2 * m + 1] = rstd; }
            u32x2* o8 = (u32x2*)(XN + (size_t)m * DM) + lane;
#pragma unroll
            for (int j = 0; j < 4; ++j) { const f32x4 g = g4[64 * j], b = b4[64 * j]; const f32x4 y = v[j] * rstd * g + b; u32x2 w; w.x = pk2(y.x, y.y); w.y = pk2(y.z, y.w); o8[64 * j] = w; }
        }
    }
    {
        bf16_t* MB = (bf16_t*)(ws + WS_MEMB);
        for (int m = gw; m < NB * MEMLEN; m += NGW) {
            const f32x4* xr = (const f32x4*)(p.in[I_MEM] + (size_t)m * DM) + lane; u32x2* o8 = (u32x2*)(MB + (size_t)m * DM) + lane;
#pragma unroll
            for (int j = 0; j < 4; ++j) { const f32x4 y = xr[64 * j]; u32x2 w; w.x = pk2(y.x, y.y); w.y = pk2(y.z, y.w); o8[64 * j] = w; }
        }
    }
    {
        const float* wf = p.in[I_WF];
        for (int it = gw; it < 1024 * 4; it += NGW) {
            const int k = it >> 2, g = it & 3;
            const float wv = w_in[(size_t)k * 2048 + 1536 + g * 64 + lane];
            float ta = 0.f, tb = 0.f;
            for (int c = 0; c < 64; ++c) { const float wc = __shfl(wv, c); const float ang = (float)((c * lane) & 63) * (1.0f / 32.0f); ta += wc * cospif(ang); tb += wc * sinpif(ang); }
            float orr = 0.f, oi = 0.f;
            for (int c = 0; c < 64; ++c) { const float w = wf[(size_t)(g * 64 + c) * 64 + lane]; orr += __shfl(ta, c) * w; oi += __shfl(tb, c) * w; }
            WinT[(size_t)(1792 + g * 64 + lane) * 1024 + k] = (bf16_t)f2bf(orr * (1.0f / 512.0f));
            WinT[(size_t)(2048 + g * 64 + lane) * 1024 + k] = (bf16_t)f2bf(oi * (1.0f / 512.0f));
        }
    }
    {
        float* WR = (float*)(ws + WS_WR); float* ct = (float*)(ws + WS_COSTAB);
        const int gt = gw * 64 + lane, NGT = NGW * 64;
        for (int i = gt; i < 36 * 1024; i += NGT) { const int e = i >> 10, k = i & 1023; WR[i] = e < 4 ? p.in[I_WG][k * 4 + e] : p.in[I_WRT][k * 32 + (e - 4)]; }
        for (int i = gt; i < 4096; i += NGT) ct[i] = cospif((float)i * (1.0f / 2048.0f));
    }
}

constexpr size_t WS_ZS1 = 200 * MiB;
constexpr size_t WS_O1 = 216 * MiB;
constexpr int CW_KMAX = 128;
constexpr int CW_KMAXM = 160;

namespace pg8 {
struct EpiInproj {
    static constexpr bool PERM = true, AFTER_DRAIN = false;
    unsigned char* ws;
    __device__ __forceinline__ void operator()(const f32x4 (&acc)[2][2][4][2], const Unit& u, int wr, int wc, int fr, int fq) const {
        const int pn = u.pn; bf16_t* base; int ldc, coff;
        if (pn < 6) { base = (bf16_t*)(ws + WS_QB + (size_t)(pn >> 1) * (16 * MiB)); ldc = 512; coff = (pn & 1) * 256; }
        else if (pn == 6) { base = (bf16_t*)(ws + WS_MQB); ldc = 256; coff = 0; }
        else { base = (bf16_t*)(ws + WS_ZB); ldc = 512; coff = (pn - 7) * 256; }
        const int row0 = u.pm * BM + wr * 64 + fr, col0 = coff + wc * 32 + 8 * fq;
#pragma unroll
        for (int ai = 0; ai < 2; ++ai)
#pragma unroll
            for (int m = 0; m < 4; ++m) { bf16_t* rowp = base + (size_t)(row0 + ai * HALF + m * 16) * ldc + col0;
#pragma unroll
                for (int bj = 0; bj < 2; ++bj) { const f32x4 v0 = acc[ai][bj][m][0], v1 = acc[ai][bj][m][1];
                    u32x4 w; w.x = cvt_pk_bf16(v0[0], v0[1]); w.y = cvt_pk_bf16(v0[2], v0[3]); w.z = cvt_pk_bf16(v1[0], v1[1]); w.w = cvt_pk_bf16(v1[2], v1[3]);
                    *(u32x4*)(rowp + bj * HALF) = w; } }
    }
};
struct EpiBf16Plain {
    static constexpr bool PERM = true, AFTER_DRAIN = false;
    bf16_t* O; int ldc;
    __device__ __forceinline__ void operator()(const f32x4 (&acc)[2][2][4][2], const Unit& u, int wr, int wc, int fr, int fq) const {
        const int row0 = u.pm * BM + wr * 64 + fr, col0 = u.pn * BM + wc * 32 + 8 * fq;
#pragma unroll
        for (int ai = 0; ai < 2; ++ai)
#pragma unroll
            for (int m = 0; m < 4; ++m) { bf16_t* rowp = O + (size_t)(row0 + ai * HALF + m * 16) * ldc + col0;
#pragma unroll
                for (int bj = 0; bj < 2; ++bj) { const f32x4 v0 = acc[ai][bj][m][0], v1 = acc[ai][bj][m][1];
                    u32x4 w; w.x = cvt_pk_bf16(v0[0], v0[1]); w.y = cvt_pk_bf16(v0[2], v0[3]); w.z = cvt_pk_bf16(v1[0], v1[1]); w.w = cvt_pk_bf16(v1[2], v1[3]);
                    *(u32x4*)(rowp + bj * HALF) = w; } }
    }
};
struct EpiF32Plain {
    static constexpr bool PERM = false, AFTER_DRAIN = false;
    float* C; int ldc;
    __device__ __forceinline__ void operator()(const f32x4 (&acc)[2][2][4][2], const Unit& u, int wr, int wc, int fr, int fq) const {
        const int row0 = u.pm * BM + wr * 64 + fr, col0 = u.pn * BM + wc * 32 + 4 * fq;
#pragma unroll
        for (int ai = 0; ai < 2; ++ai)
#pragma unroll
            for (int m = 0; m < 4; ++m) { float* rowp = C + (size_t)(row0 + ai * HALF + m * 16) * ldc + col0;
#pragma unroll
                for (int bj = 0; bj < 2; ++bj)
#pragma unroll
                    for (int n = 0; n < 2; ++n) *(f32x4*)(rowp + bj * HALF + n * 16) = acc[ai][bj][m][n]; }
    }
};
struct MoeOrder {
    const PG8_LAS int* tab; const int* list; int G, c, sh;
    __device__ __forceinline__ bool next(int i, Unit& u) const {
        const int L = i * G + c, total = tab[32] << sh; if (L >= total) return false;
        const int T = L >> sh, nt = L & ((1 << sh) - 1); int e = 0; while (tab[e + 1] <= T) ++e;
        u.pm = T; u.pn = (e << sh) + nt; return true; }
    __device__ __forceinline__ int a_row(const Unit& u, int r) const { const int e = u.pn >> sh; const int pos = (u.pm - tab[e]) * 256 + r; return pos < tab[33 + e] ? list[e * NTOK + pos] : 0; }
    __device__ __forceinline__ void a_ready(const Unit&) const {}
    __device__ __forceinline__ void done(const Unit&) const {}
};
struct EpiSwiglu {
    static constexpr bool PERM = true, AFTER_DRAIN = false;
    bf16_t* HID;
    __device__ __forceinline__ void operator()(const f32x4 (&acc)[2][2][4][2], const Unit& u, int wr, int wc, int fr, int fq) const {
        const int row0 = u.pm * BM + wr * 64 + fr, col0 = (u.pn & 1) * 128 + wc * 32 + 8 * fq;
#pragma unroll
        for (int ai = 0; ai < 2; ++ai)
#pragma unroll
            for (int m = 0; m < 4; ++m) { bf16_t* rowp = HID + (size_t)(row0 + ai * HALF + m * 16) * 256 + col0; float h[8];
#pragma unroll
                for (int n = 0; n < 2; ++n)
#pragma unroll
                    for (int j = 0; j < 4; ++j) { const float gte = acc[ai][0][m][n][j], up = acc[ai][1][m][n][j];
                        h[n * 4 + j] = gte * __builtin_amdgcn_rcpf(1.0f + __builtin_amdgcn_exp2f(-gte * 1.4426950408889634f)) * up; }
                u32x4 w; w.x = cvt_pk_bf16(h[0], h[1]); w.y = cvt_pk_bf16(h[2], h[3]); w.z = cvt_pk_bf16(h[4], h[5]); w.w = cvt_pk_bf16(h[6], h[7]);
                *(u32x4*)rowp = w; }
    }
};
struct EpiDown {
    static constexpr bool PERM = true, AFTER_DRAIN = false;
    bf16_t* Y;
    __device__ __forceinline__ void operator()(const f32x4 (&acc)[2][2][4][2], const Unit& u, int wr, int wc, int fr, int fq) const {
        const int row0 = u.pm * BM + wr * 64 + fr, col0 = (u.pn & 3) * BM + wc * 32 + 8 * fq;
#pragma unroll
        for (int ai = 0; ai < 2; ++ai)
#pragma unroll
            for (int m = 0; m < 4; ++m) { bf16_t* rowp = Y + (size_t)(row0 + ai * HALF + m * 16) * 1024 + col0;
#pragma unroll
                for (int bj = 0; bj < 2; ++bj) { const f32x4 v0 = acc[ai][bj][m][0], v1 = acc[ai][bj][m][1];
                    u32x4 w; w.x = cvt_pk_bf16(v0[0], v0[1]); w.y = cvt_pk_bf16(v0[2], v0[3]); w.z = cvt_pk_bf16(v1[0], v1[1]); w.w = cvt_pk_bf16(v1[2], v1[3]);
                    *(u32x4*)(rowp + bj * HALF) = w; } }
    }
};
}

DI void kmax_phase(const Params& p, int gw, int NGW, int lane) {
    unsigned char* ws = p.ws; unsigned* ctl = (unsigned*)(ws + WS_CTL);
    const bf16_t* Kb = (const bf16_t*)(ws + WS_KB); const bf16_t* MKV = (const bf16_t*)(ws + WS_MKV);
    for (int grp = gw; grp < NTOK / 8; grp += NGW) {
        float mx = 0.f;
#pragma unroll
        for (int r = 0; r < 8; ++r) { const u32x4 v = *(const u32x4*)(Kb + (size_t)(grp * 8 + r) * 512 + lane * 8); float s = 0.f;
#pragma unroll
            for (int j = 0; j < 4; ++j) { const float a = __uint_as_float(v[j] << 16), b = __uint_as_float(v[j] & 0xffff0000u); s += a * a + b * b; }
            s += __shfl_xor(s, 1); s += __shfl_xor(s, 2); s += __shfl_xor(s, 4); mx = fmaxf(mx, s); }
        if ((lane & 7) == 0) atomicMax(ctl + CW_KMAX + ((grp * 8) / SEQ) * 8 + (lane >> 3), __float_as_uint(mx));
    }
    for (int grp = gw; grp < NB * MEMLEN / 8; grp += NGW) {
        float mx = 0.f;
#pragma unroll
        for (int r = 0; r < 8; ++r) { const u32x4 v = *(const u32x4*)(MKV + (size_t)(grp * 8 + r) * 512 + (lane & 31) * 8); float s = 0.f;
#pragma unroll
            for (int j = 0; j < 4; ++j) { const float a = __uint_as_float(v[j] << 16), b = __uint_as_float(v[j] & 0xffff0000u); s += a * a + b * b; }
            s += __shfl_xor(s, 1); s += __shfl_xor(s, 2); s += __shfl_xor(s, 4); mx = fmaxf(mx, s); }
        if (lane < 32 && (lane & 7) == 0) atomicMax(ctl + CW_KMAXM + ((grp * 8) / MEMLEN) * 4 + (lane >> 3), __float_as_uint(mx));
    }
}

namespace att {
#define ALAS __attribute__((address_space(3)))
typedef short bf16x8 __attribute__((ext_vector_type(8)));
typedef short s16x4 __attribute__((ext_vector_type(4)));
typedef short v4i16_t __attribute__((ext_vector_type(4)));
typedef float f32x16 __attribute__((ext_vector_type(16)));
typedef float f32x2_t __attribute__((ext_vector_type(2)));
typedef __bf16 bf16x2_t __attribute__((ext_vector_type(2)));
constexpr int KOFF = 0, VOFF = 16384, TOFF = 49152, ATT_LDS = TOFF + 1024;
DI unsigned cvtpk(float lo, float hi) { f32x2_t v = {lo, hi}; bf16x2_t b = __builtin_convertvector(v, bf16x2_t); return __builtin_bit_cast(unsigned, b); }
DI s16x4 vtr(const ALAS unsigned char* q) { return __builtin_bit_cast(s16x4, __builtin_amdgcn_ds_read_tr16_b64_v4i16((ALAS v4i16_t*)q)); }
#define ATT_MFMA(a, b, c) __builtin_amdgcn_mfma_f32_32x32x16_bf16((a), (b), (c), 0, 0, 0)

template <int NDT, bool BAND>
DI void tile(const ALAS unsigned char* kb, const ALAS unsigned char* vb, const bf16x8 (&qr)[4], const f32x16& cinit, f32x16 (&o)[NDT], float& lsum,
             const ALAS float* tbl, int relbase, float mrow) {
    f32x16 p0, p1;
#pragma unroll
    for (int d0 = 0; d0 < 4; ++d0) {
        const bf16x8 b0 = *(const ALAS bf16x8*)(kb + d0 * 2048), b1 = *(const ALAS bf16x8*)(kb + d0 * 2048 + 512);
        if (d0 == 0) { if (BAND) { const f32x16 z = {0.f,0.f,0.f,0.f,0.f,0.f,0.f,0.f,0.f,0.f,0.f,0.f,0.f,0.f,0.f,0.f}; p0 = ATT_MFMA(b0, qr[0], z); p1 = ATT_MFMA(b1, qr[0], z); }
                       else { p0 = ATT_MFMA(b0, qr[0], cinit); p1 = ATT_MFMA(b1, qr[0], cinit); } }
        else { p0 = ATT_MFMA(b0, qr[d0], p0); p1 = ATT_MFMA(b1, qr[d0], p1); }
    }
    if (BAND) {
#pragma unroll
        for (int r = 0; r < 16; ++r) {
            const int rel0 = relbase + (r & 3) + 8 * (r >> 2);
            const int i0 = min(max(rel0 + 128, 0), 255), i1 = min(max(rel0 + 160, 0), 255);
            p0[r] += tbl[i0] - mrow; p1[r] += tbl[i1] - mrow;
        }
    }
    float s = 0.f;
#pragma unroll
    for (int r = 0; r < 16; ++r) { p0[r] = __builtin_amdgcn_exp2f(p0[r]); p1[r] = __builtin_amdgcn_exp2f(p1[r]); s += p0[r] + p1[r]; }
    lsum += s;
    u32x4 w0, w1, w2, w3;
    w0.x = cvtpk(p0[0], p0[1]); w0.y = cvtpk(p0[2], p0[3]); w0.z = cvtpk(p0[4], p0[5]); w0.w = cvtpk(p0[6], p0[7]);
    w1.x = cvtpk(p0[8], p0[9]); w1.y = cvtpk(p0[10], p0[11]); w1.z = cvtpk(p0[12], p0[13]); w1.w = cvtpk(p0[14], p0[15]);
    w2.x = cvtpk(p1[0], p1[1]); w2.y = cvtpk(p1[2], p1[3]); w2.z = cvtpk(p1[4], p1[5]); w2.w = cvtpk(p1[6], p1[7]);
    w3.x = cvtpk(p1[8], p1[9]); w3.y = cvtpk(p1[10], p1[11]); w3.z = cvtpk(p1[12], p1[13]); w3.w = cvtpk(p1[14], p1[15]);
    const bf16x8 pb0 = __builtin_bit_cast(bf16x8, w0), pb1 = __builtin_bit_cast(bf16x8, w1), pb2 = __builtin_bit_cast(bf16x8, w2), pb3 = __builtin_bit_cast(bf16x8, w3);
#pragma unroll
    for (int dt = 0; dt < NDT; ++dt) {
        __builtin_amdgcn_sched_barrier(0);
#pragma unroll
        for (int ks = 0; ks < 4; ++ks) {
            const s16x4 lo = vtr(vb + (dt * 4 + ks) * 1024), hh = vtr(vb + (dt * 4 + ks) * 1024 + 512);
            const bf16x8 a = __builtin_shufflevector(lo, hh, 0, 1, 2, 3, 4, 5, 6, 7);
            o[dt] = ATT_MFMA(a, ks == 0 ? pb0 : ks == 1 ? pb1 : ks == 2 ? pb2 : pb3, o[dt]);
        }
    }
}

template <int DV, bool DIFF>
DI void attn_unit(ALAS unsigned char* lds, const Params& p, int unit, int wid, int lane) {
    unsigned char* ws = p.ws; const unsigned* ctl = (const unsigned*)(ws + WS_CTL);
    const int tid = threadIdx.x, r32 = lane & 31, hi = lane >> 5;
    constexpr int NDT = DV / 32, VBYTES = DV * 128, NCOMP = DIFF ? 2 : 1, NT = DIFF ? 64 : 4;
    int b, h, qb, qpitch, ocol; size_t kbase; const bf16_t *Qg, *Kg, *Vg;
    if (DIFF) { b = unit >> 6; h = (unit >> 4) & 3; qb = unit & 15; Qg = (const bf16_t*)(ws + WS_QB) + h * 128; qpitch = 512; Kg = (const bf16_t*)(ws + WS_KB) + h * 128;
        Vg = (const bf16_t*)(ws + WS_VB) + h * 128; kbase = (size_t)b * SEQ; ocol = h * 128; }
    else { const int qblk = unit >> 2; h = unit & 3; b = qblk >> 4; qb = qblk & 15; Qg = (const bf16_t*)(ws + WS_MQB) + h * 64; qpitch = 256; Kg = (const bf16_t*)(ws + WS_MKV) + h * 64;
        Vg = (const bf16_t*)(ws + WS_MKV) + 256 + h * 64; kbase = (size_t)b * MEMLEN; ocol = 768 + h * 64; }
    const int row0 = b * SEQ + qb * 256, qa = qb * 256 + wid * 32;
    const ALAS float* tbl = (const ALAS float*)(lds + TOFF);
    float bmax = 0.f, cL = 0.f, cR = 0.f, lam = 0.f;
    __syncthreads();
    if (DIFF) {
        const float* rb = p.in[I_RELB];
        if (tid < 256) ((ALAS float*)(lds + TOFF))[tid] = rb[t5_bucket(tid - 128) * 4 + h] * LOG2E;
        float bm = -1e30f;
        for (int i = 0; i < 32; ++i) bm = fmaxf(bm, rb[i * 4 + h]);
        bmax = bm * LOG2E; cL = rb[15 * 4 + h] * LOG2E; cR = rb[31 * 4 + h] * LOG2E;
        float s1 = 0.f, s2 = 0.f;
        for (int i = 0; i < 64; ++i) { s1 += p.in[I_LQ1][i] * p.in[I_LK1][i]; s2 += p.in[I_LQ2][i] * p.in[I_LK2][i]; }
        lam = expf(s1) - expf(s2) + LAM_INIT;
        __syncthreads();
    }
    const int tL = DIFF ? (qa >= 154 ? (qa - 154) / 64 + 1 : 0) : NT;
    const int tR = DIFF ? (qa + 185) / 64 : NT;
    const int vlane = (4 * hi + ((lane & 15) >> 2)) * 64 + ((lane >> 4) & 1) * 32 + (lane & 3) * 8;
#pragma unroll 1
    for (int c = 0; c < NCOMP; ++c) {
        const bf16_t* Qp = Qg + (size_t)(row0 + wid * 32 + r32) * qpitch + c * 64 + hi * 8;
        bf16x8 qr[4]; float qq = 0.f;
#pragma unroll
        for (int d0 = 0; d0 < 4; ++d0) { qr[d0] = *(const bf16x8*)(Qp + d0 * 16);
#pragma unroll
            for (int j = 0; j < 8; ++j) { const float f = __uint_as_float(((unsigned)(unsigned short)qr[d0][j]) << 16); qq += f * f; } }
        qq += __shfl_xor(qq, 32);
        const float kmx = sqrtf(__uint_as_float(DIFF ? ctl[CW_KMAX + b * 8 + h * 2 + c] : ctl[CW_KMAXM + b * 4 + h]));
        const float mrow = sqrtf(qq) * kmx * 1.0001f + bmax;
        f32x16 cinit;
#pragma unroll
        for (int r = 0; r < 16; ++r) cinit[r] = cL - mrow;
        f32x16 o[NDT];
#pragma unroll
        for (int dt = 0; dt < NDT; ++dt)
#pragma unroll
            for (int r = 0; r < 16; ++r) o[dt][r] = 0.f;
        float lsum = 0.f;
        const bf16_t* ksrc = Kg + (kbase + lane) * 512 + c * 64 + wid * 8;
#define ATT_DMA(t, buf) do { \
        __builtin_amdgcn_global_load_lds((const unsigned*)(ksrc + (size_t)(t) * 64 * 512), (ALAS unsigned*)(lds + KOFF + (buf) * 8192 + wid * 1024), 16, 0, 0); \
        _Pragma("unroll") for (int i_ = 0; i_ < DV / 64; ++i_) { const int pid_ = wid + 8 * i_; \
            __builtin_amdgcn_global_load_lds((const unsigned*)(Vg + (kbase + (size_t)(t) * 64 + 16 * (pid_ & 3) + (lane >> 2)) * 512 + 32 * (pid_ >> 2) + 8 * (lane & 3)), \
                                             (ALAS unsigned*)(lds + VOFF + (buf) * VBYTES + pid_ * 1024), 16, 0, 0); } } while (0)
        ATT_DMA(0, 0);
        asm volatile("s_waitcnt vmcnt(0)" ::: "memory");
        __syncthreads();
#pragma unroll 1
        for (int t = 0; t < NT; ++t) {
            const int buf = t & 1;
            if (t + 1 < NT) ATT_DMA(t + 1, buf ^ 1);
            if (DIFF && t == tR) {
#pragma unroll
                for (int r = 0; r < 16; ++r) cinit[r] = cR - mrow;
            }
            const ALAS unsigned char* kb = lds + KOFF + buf * 8192 + hi * 1024 + r32 * 16;
            const ALAS unsigned char* vb = lds + VOFF + buf * VBYTES + vlane;
            if (DIFF && t >= tL && t < tR) tile<NDT, true>(kb, vb, qr, cinit, o, lsum, tbl, t * 64 + 4 * hi - qa - r32, mrow);
            else tile<NDT, false>(kb, vb, qr, cinit, o, lsum, tbl, 0, 0.f);
            asm volatile("s_waitcnt vmcnt(0)" ::: "memory");
            __syncthreads();
        }
#undef ATT_DMA
        lsum += __shfl_xor(lsum, 32);
        const float inv = 1.0f / lsum;
        int lane2 = lane; asm volatile("" : "+v"(lane2));
        const int r32b = lane2 & 31, hib = lane2 >> 5;
        float* o1p = (float*)(ws + WS_O1) + ((size_t)(unit * 8 + wid) * 64 + lane2) * 64;
        if (DIFF && c == 0) {
#pragma unroll
            for (int dt = 0; dt < NDT; ++dt)
#pragma unroll
                for (int r = 0; r < 16; ++r) o1p[dt * 16 + r] = o[dt][r] * inv;
        } else {
            bf16_t* Ob = (bf16_t*)(ws + WS_OB) + (size_t)(row0 + wid * 32 + r32b) * 1024 + ocol + 4 * hib;
            if (DIFF) {
                float ss = 0.f;
#pragma unroll
                for (int dt = 0; dt < NDT; ++dt)
#pragma unroll
                    for (int r = 0; r < 16; ++r) { const float v = o1p[dt * 16 + r] - lam * (o[dt][r] * inv); o[dt][r] = v; ss += v * v; }
                ss += __shfl_xor(ss, 32);
                const float rn = (1.0f - LAM_INIT) / sqrtf(ss * (1.0f / 128.0f) + LN_EPS);
#pragma unroll
                for (int dt = 0; dt < NDT; ++dt)
#pragma unroll
                    for (int g4 = 0; g4 < 4; ++g4) { const int d0 = 32 * dt + 8 * g4; const f32x4 sg = *(const f32x4*)(p.in[I_SUBG] + d0 + 4 * hib);
                        u32x2 w; w.x = cvtpk(o[dt][4 * g4] * rn * sg.x, o[dt][4 * g4 + 1] * rn * sg.y); w.y = cvtpk(o[dt][4 * g4 + 2] * rn * sg.z, o[dt][4 * g4 + 3] * rn * sg.w);
                        *(u32x2*)(Ob + d0) = w; }
            } else {
#pragma unroll
                for (int dt = 0; dt < NDT; ++dt)
#pragma unroll
                    for (int g4 = 0; g4 < 4; ++g4) { const int d0 = 32 * dt + 8 * g4;
                        u32x2 w; w.x = cvtpk(o[dt][4 * g4] * inv, o[dt][4 * g4 + 1] * inv); w.y = cvtpk(o[dt][4 * g4 + 2] * inv, o[dt][4 * g4 + 3] * inv);
                        *(u32x2*)(Ob + d0) = w; }
            }
        }
    }
}
}

template <bool DUAL, bool BKN, class LA, class LB, class EP>
DI void ngemm_tile(float* As, float* Bs, float* Bs2, int K, const LA& la, const LB& lb, const LB& lb2, const EP& ep) {
    const int tid = threadIdx.x, ty = tid >> 4, tx = tid & 15;
    float acc[4][4], acc2[4][4];
#pragma unroll
    for (int i = 0; i < 4; ++i)
#pragma unroll
        for (int j = 0; j < 4; ++j) { acc[i][j] = 0.f; acc2[i][j] = 0.f; }
    for (int kc = 0; kc < K; kc += 32) {
        __syncthreads();
#pragma unroll
        for (int j = 0; j < 8; ++j) { const int i = tid + 512 * j, k = i & 31, r = i >> 5; As[k * 132 + r] = la(r, kc + k); }
#pragma unroll
        for (int j = 0; j < 4; ++j) { const int i = tid + 512 * j; int k, n; if (BKN) { n = i & 63; k = i >> 6; } else { k = i & 31; n = i >> 5; }
            Bs[k * 68 + n] = lb(kc + k, n); if (DUAL) Bs2[k * 68 + n] = lb2(kc + k, n); }
        __syncthreads();
#pragma unroll 8
        for (int k = 0; k < 32; ++k) {
            const f32x4 a = *(const f32x4*)&As[k * 132 + ty * 4]; const f32x4 b = *(const f32x4*)&Bs[k * 68 + tx * 4];
#pragma unroll
            for (int i = 0; i < 4; ++i)
#pragma unroll
                for (int j = 0; j < 4; ++j) acc[i][j] += a[i] * b[j];
            if (DUAL) { const f32x4 b2 = *(const f32x4*)&Bs2[k * 68 + tx * 4];
#pragma unroll
                for (int i = 0; i < 4; ++i)
#pragma unroll
                    for (int j = 0; j < 4; ++j) acc2[i][j] += a[i] * b2[j]; }
        }
    }
#pragma unroll
    for (int i = 0; i < 4; ++i)
#pragma unroll
        for (int j = 0; j < 4; ++j) ep(ty * 4 + i, tx * 4 + j, acc[i][j], acc2[i][j]);
}

struct LA_bf { const bf16_t* A; int lda; DI float operator()(int r, int k) const { return bf2f(A[(size_t)r * lda + k]); } };
struct LB_bf { const bf16_t* B; int ldb; DI float operator()(int k, int n) const { return bf2f(B[(size_t)n * ldb + k]); } };
struct EP_inproj { unsigned char* ws; int m0, n0;
    DI void operator()(int r, int n, float v, float) const { const int row = m0 + r, c = n0 + n; bf16_t* dst;
        if (c < 512) dst = (bf16_t*)(ws + WS_QB) + (size_t)row * 512 + c; else if (c < 1024) dst = (bf16_t*)(ws + WS_KB) + (size_t)row * 512 + (c - 512);
        else if (c < 1536) dst = (bf16_t*)(ws + WS_VB) + (size_t)row * 512 + (c - 1024); else if (c < 1792) dst = (bf16_t*)(ws + WS_MQB) + (size_t)row * 256 + (c - 1536);
        else dst = (bf16_t*)(ws + WS_ZB) + (size_t)row * 512 + (c - 1792);
        *dst = (bf16_t)f2bf(v); } };
struct EP_bf { bf16_t* C; int ldc; int m0, n0; DI void operator()(int r, int n, float v, float) const { C[(size_t)(m0 + r) * ldc + n0 + n] = (bf16_t)f2bf(v); } };
struct EP_f32 { float* C; int ldc; int m0, n0; DI void operator()(int r, int n, float v, float) const { C[(size_t)(m0 + r) * ldc + n0 + n] = v; } };

struct LA_dft { const float* ct; int s0; DI float operator()(int r, int k) const { const int sp = s0 + r, s = k & 4095; const int idx = (s * sp) & 4095;
    return (k < 4096) ? ct[idx] : -ct[(idx - 1024) & 4095]; } };
struct LB_z { const bf16_t* Z; int n0; DI float operator()(int k, int n) const { return bf2f(Z[(size_t)(k & 4095) * 512 + (k >> 12) * 256 + n0 + n]); } };
struct EP_ob { bf16_t* O; int row0, col0; DI void operator()(int r, int n, float v, float) const { O[(size_t)(row0 + r) * 1024 + col0 + n] = (bf16_t)f2bf(v); } };
DI void nfourier_phase(const Params& p, float* As, float* Bs, int bid, int nb) {
    unsigned char* ws = p.ws; const float* ct = (const float*)(ws + WS_COSTAB);
    const int nT = NB * 32 * 4;
    for (int t = bid; t < nT; t += nb) {
        const int b = t / 128, q = t % 128, s0 = (q / 4) * 128, n0 = (q % 4) * 64;
        LA_dft la{ct, s0}; LB_z lb{(const bf16_t*)(ws + WS_ZB) + (size_t)b * SEQ * 512, n0}; EP_ob ep{(bf16_t*)(ws + WS_OB), b * SEQ + s0, 512 + n0};
        ngemm_tile<false, true>(As, Bs, Bs, 8192, la, lb, lb, ep);
    }
}

DI void p4_ln1_router(const Params& p, float* lds  , int gw, int NGW, int wave, int lane) {
    unsigned char* ws = p.ws;
    const float* Aout = (const float*)(ws + WS_AOUT); const float* st0 = (const float*)(ws + WS_STATS0); bf16_t* H1 = (bf16_t*)(ws + WS_XN);
    const float* WR = (const float*)(ws + WS_WR); unsigned* cnt = (unsigned*)(ws + WS_CTL) + CW_CNT; int* info = (int*)(ws + WS_TOKINFO); int* list = (int*)(ws + WS_LIST);
    float* lg = lds + wave * (8 * 36);
    for (int grp = gw; grp < NTOK / 8; grp += NGW) {
        f32x4 hv[8][4];
#pragma unroll
        for (int r = 0; r < 8; ++r) {
            const int row = grp * 8 + r;
            const float mu0 = st0[2 * row], rs0 = st0[2 * row + 1];
            const f32x4* xr = (const f32x4*)(p.in[I_X] + (size_t)row * DM) + lane; const f32x4* ar = (const f32x4*)(Aout + (size_t)row * DM) + lane;
            float s = 0.f;
#pragma unroll
            for (int j = 0; j < 4; ++j) { const f32x4 g = ((const f32x4*)p.in[I_LN0G])[lane + 64 * j], bb = ((const f32x4*)p.in[I_LN0B])[lane + 64 * j];
                const f32x4 h0 = (xr[64 * j] - mu0) * rs0 * g + bb; hv[r][j] = h0 * ALPHA + ar[64 * j]; s += (hv[r][j].x + hv[r][j].y) + (hv[r][j].z + hv[r][j].w); }
            const float mean = wave_sum(s) * (1.f / DM); float s2 = 0.f;
#pragma unroll
            for (int j = 0; j < 4; ++j) { hv[r][j] = hv[r][j] - mean; s2 += (hv[r][j].x * hv[r][j].x + hv[r][j].y * hv[r][j].y) + (hv[r][j].z * hv[r][j].z + hv[r][j].w * hv[r][j].w); }
            const float rstd = 1.f / sqrtf(wave_sum(s2) * (1.f / DM) + LN_EPS);
            u32x2* o8 = (u32x2*)(H1 + (size_t)row * DM) + lane;
#pragma unroll
            for (int j = 0; j < 4; ++j) { const f32x4 g = ((const f32x4*)p.in[I_LN1G])[lane + 64 * j], bb = ((const f32x4*)p.in[I_LN1B])[lane + 64 * j];
                hv[r][j] = hv[r][j] * rstd * g + bb; u32x2 w; w.x = pk2(hv[r][j].x, hv[r][j].y); w.y = pk2(hv[r][j].z, hv[r][j].w); o8[64 * j] = w; }
        }
#pragma unroll 1
        for (int e = 0; e < 36; ++e) {
            const f32x4* wr = (const f32x4*)(WR + (size_t)e * 1024) + lane;
            const f32x4 w0 = wr[0], w1 = wr[64], w2 = wr[128], w3 = wr[192];
#pragma unroll
            for (int r = 0; r < 8; ++r) {
                f32x4 t = hv[r][0] * w0 + hv[r][1] * w1 + hv[r][2] * w2 + hv[r][3] * w3;
                float s = wave_sum((t.x + t.y) + (t.z + t.w));
                if (lane == 0) lg[r * 36 + e] = s;
            }
        }
        asm volatile("s_waitcnt lgkmcnt(0)" ::: "memory");
        if (lane < 8) {
            const int row = grp * 8 + lane; const float* L = lg + lane * 36;
            float gl[4]; int gs = 0; float gm;
#pragma unroll
            for (int j = 0; j < 4; ++j) gl[j] = L[j] + p.in[I_BG][j];
            gm = gl[0];
#pragma unroll
            for (int j = 1; j < 4; ++j) if (gl[j] > gm) { gm = gl[j]; gs = j; }
            float den = 0.f;
#pragma unroll
            for (int j = 0; j < 4; ++j) den += expf(gl[j] - gm);
            const float gate = 1.0f / den;
            float v0 = -1e30f, v1 = -1e30f; int i0 = 0, i1 = 0;
#pragma unroll
            for (int j = 0; j < 8; ++j) { const float v = L[4 + gs * 8 + j] + p.in[I_BRT][gs * 8 + j];
                if (v > v0) { v1 = v0; i1 = i0; v0 = v; i0 = j; } else if (v > v1) { v1 = v; i1 = j; } }
            const float ex = expf(v1 - v0); const float w0 = gate / (1.f + ex), w1 = gate * ex / (1.f + ex);
            const int e0 = gs * 8 + i0, e1 = gs * 8 + i1;
            const unsigned p0 = atomicAdd(cnt + e0, 1u), p1 = atomicAdd(cnt + e1, 1u);
            list[e0 * NTOK + p0] = row; list[e1 * NTOK + p1] = row;
            int* ii = info + (size_t)row * 8; ii[0] = e0; ii[1] = (int)p0; ii[2] = __float_as_int(w0); ii[3] = e1; ii[4] = (int)p1; ii[5] = __float_as_int(w1);
        }
        asm volatile("s_waitcnt lgkmcnt(0)" ::: "memory");
    }
}

struct LA_gather { const bf16_t* H; const int* tok; DI float operator()(int r, int k) const { return bf2f(H[(size_t)tok[r] * 1024 + k]); } };
struct EP_hid { bf16_t* HID; int slot0, nvalid, n0; DI void operator()(int r, int n, float v1, float v3) const { if (r < nvalid) { const float s = v1 / (1.0f + expf(-v1)); HID[(size_t)(slot0 + r) * 256 + n0 + n] = (bf16_t)f2bf(s * v3); } } };
struct EP_y { bf16_t* Y; int slot0, nvalid, n0; DI void operator()(int r, int n, float v, float) const { if (r < nvalid) Y[(size_t)(slot0 + r) * 1024 + n0 + n] = (bf16_t)f2bf(v); } };
DI void nmoe_phase(const Params& p, int which, float* ldsf, int bid, int nb) {
    float* As = ldsf; float* Bs = ldsf + 32 * 132; float* Bs2 = Bs + 32 * 68; int* s_tok = (int*)(Bs2 + 32 * 68); int* s_cnt = s_tok + 128; int* s_tpre = s_cnt + 32; int* s_base = s_tpre + 33;
    unsigned char* ws = p.ws; const unsigned* cnt = (const unsigned*)(ws + WS_CTL) + CW_CNT; const int* list = (const int*)(ws + WS_LIST);
    const int tid = threadIdx.x;
    if (tid == 0) { int tp = 0, bs = 0; for (int e = 0; e < 32; ++e) { const int c = (int)cnt[e]; s_cnt[e] = c; s_tpre[e] = tp; s_base[e] = bs; tp += (c + 127) >> 7; bs += (c + 255) & ~255; } s_tpre[32] = tp; s_base[32] = bs; }
    __syncthreads();
    const int NT = which == 0 ? 4 : 16, total = s_tpre[32] * NT;
    for (int u = bid; u < total; u += nb) {
        const int T = u / NT, nt = u % NT; int e = 0; while (s_tpre[e + 1] <= T) ++e;
        const int mt = T - s_tpre[e], nvalid = min(128, s_cnt[e] - mt * 128), slot0 = s_base[e] + mt * 128;
        if (which == 0) {
            __syncthreads();
            if (tid < 128) s_tok[tid] = (tid < nvalid) ? list[e * NTOK + mt * 128 + tid] : 0;
            __syncthreads();
            const int j0 = nt * 64;
            const int r1 = e * 512 + (j0 >> 7) * 256 + (j0 & 127);
            LA_gather la{(const bf16_t*)(ws + WS_XN), s_tok}; LB_bf lb{(const bf16_t*)(ws + WS_W13T) + (size_t)r1 * 1024, 1024}; LB_bf lb2{(const bf16_t*)(ws + WS_W13T) + (size_t)(r1 + 128) * 1024, 1024};
            EP_hid ep{(bf16_t*)(ws + WS_OB), slot0, nvalid, j0};
            ngemm_tile<true, false>(As, Bs, Bs2, 1024, la, lb, lb2, ep);
        } else {
            LA_bf la{(const bf16_t*)(ws + WS_OB) + (size_t)slot0 * 256, 256}; LB_bf lb{(const bf16_t*)(ws + WS_W2T) + (size_t)(e * 1024 + nt * 64) * 256, 256};
            EP_y ep{(bf16_t*)(ws + WS_Y), slot0, nvalid, nt * 64};
            ngemm_tile<false, false>(As, Bs, Bs, 256, la, lb, lb, ep);
        }
    }
}

DI void p7_final(const Params& p, int gw, int NGW, int lane) {
    unsigned char* ws = p.ws; const unsigned* cnt = (const unsigned*)(ws + WS_CTL) + CW_CNT; const int* info = (const int*)(ws + WS_TOKINFO);
    const bf16_t* H1 = (const bf16_t*)(ws + WS_XN); const bf16_t* Y = (const bf16_t*)(ws + WS_Y);
    int base;
    { const int c = lane < 32 ? (int)cnt[lane] : 0; const int r = (c + 255) & ~255; int inc = r;
#pragma unroll
      for (int o = 1; o < 32; o <<= 1) { const int t = __shfl_up(inc, o); if ((lane & 31) >= o) inc += t; }
      base = inc - r; }
    for (int row = gw; row < NTOK; row += NGW) {
        const int* ii = info + (size_t)row * 8;
        const int e0 = ii[0], p0 = ii[1], e1 = ii[3], p1 = ii[4]; const float w0 = __int_as_float(ii[2]), w1 = __int_as_float(ii[5]);
        const size_t s0 = (size_t)(__shfl(base, e0) + p0), s1 = (size_t)(__shfl(base, e1) + p1);
        const u32x2* h8 = (const u32x2*)(H1 + (size_t)row * DM) + lane; const u32x2* y0 = (const u32x2*)(Y + s0 * DM) + lane; const u32x2* y1 = (const u32x2*)(Y + s1 * DM) + lane;
        f32x4 v[4]; float s = 0.f;
#pragma unroll
        for (int j = 0; j < 4; ++j) { const u32x2 a = h8[64 * j], b = y0[64 * j], c = y1[64 * j];
            v[j].x = ALPHA * __uint_as_float(a.x << 16) + w0 * __uint_as_float(b.x << 16) + w1 * __uint_as_float(c.x << 16);
            v[j].y = ALPHA * __uint_as_float(a.x & 0xffff0000u) + w0 * __uint_as_float(b.x & 0xffff0000u) + w1 * __uint_as_float(c.x & 0xffff0000u);
            v[j].z = ALPHA * __uint_as_float(a.y << 16) + w0 * __uint_as_float(b.y << 16) + w1 * __uint_as_float(c.y << 16);
            v[j].w = ALPHA * __uint_as_float(a.y & 0xffff0000u) + w0 * __uint_as_float(b.y & 0xffff0000u) + w1 * __uint_as_float(c.y & 0xffff0000u);
            s += (v[j].x + v[j].y) + (v[j].z + v[j].w); }
        const float mean = wave_sum(s) * (1.f / DM); float s2 = 0.f;
#pragma unroll
        for (int j = 0; j < 4; ++j) { v[j] = v[j] - mean; s2 += (v[j].x * v[j].x + v[j].y * v[j].y) + (v[j].z * v[j].z + v[j].w * v[j].w); }
        const float rstd = 1.f / sqrtf(wave_sum(s2) * (1.f / DM) + LN_EPS);
        f32x4* o = (f32x4*)(p.out + (size_t)row * DM) + lane;
#pragma unroll
        for (int j = 0; j < 4; ++j) { const f32x4 g = ((const f32x4*)p.in[I_LN2G])[lane + 64 * j], bb = ((const f32x4*)p.in[I_LN2B])[lane + 64 * j]; o[64 * j] = v[j] * rstd * g + bb; }
    }
}


#define LAS __attribute__((address_space(3)))
#define XB_TMO      128
#define XB_XCNT(j)  (256  + 64 * (j))
#define XB_XSUB(j)  (1280 + 64 * (j))
#define XB_XGEN(j)  (2304 + 64 * (j))
#define XB_TOP      3328
#define XB_TOPGEN   3392
#define XCD_BAR_WORDS 3456
#define XB_SPIN_CAP (1u << 18)

__device__ __forceinline__ unsigned xb_ld(unsigned* p)              { return __hip_atomic_load(p, __ATOMIC_RELAXED, __HIP_MEMORY_SCOPE_AGENT); }
__device__ __forceinline__ unsigned xb_add(unsigned* p, unsigned v) { return __hip_atomic_fetch_add(p, v, __ATOMIC_RELAXED, __HIP_MEMORY_SCOPE_AGENT); }
__device__ __forceinline__ unsigned xb_xcc_id() { return (unsigned)__builtin_amdgcn_s_getreg((3 << 11) | 20) & 0xFu; }
#define XB_SPIN(cond, bar) do { unsigned _sp = 0; while (cond) { __builtin_amdgcn_s_sleep(1); \
    if ((++_sp & 255u) == 0u) { if (xb_ld(&(bar)[XB_TMO])) break; if (_sp > XB_SPIN_CAP) { atomicAdd(&(bar)[XB_TMO], 1u); break; } } } } while (0)

struct XcdBarrier {
    unsigned* bar; unsigned x;
    volatile LAS unsigned* st;
};

__device__ __forceinline__ XcdBarrier xcd_barrier_post(unsigned* bar, volatile LAS unsigned* st) {
    XcdBarrier b; b.bar = bar; b.x = xb_xcc_id(); b.st = st;
    if (threadIdx.x == 0) (void)xb_add(&bar[XB_XCNT(b.x)], 1u);
    return b;
}
__device__ __forceinline__ void xcd_barrier_complete(unsigned* bar, unsigned x, unsigned& nloc, unsigned& nx) {
    const unsigned G = gridDim.x * gridDim.y * gridDim.z;
    unsigned sum, cnt, mine, sp = 0u;
    for (;;) {
        sum = 0u; cnt = 0u; mine = 0u;
#pragma unroll
        for (unsigned j = 0; j < 16; ++j) { const unsigned c = xb_ld(&bar[XB_XCNT(j)]); sum += c; cnt += (c > 0u) ? 1u : 0u; mine = (j == x) ? c : mine; }
        if (sum == G) break;
        __builtin_amdgcn_s_sleep(1);
        if ((++sp & 255u) == 0u) { if (xb_ld(&bar[XB_TMO])) break; if (sp > XB_SPIN_CAP) { atomicAdd(&bar[XB_TMO], 1u); break; } }
    }
    nloc = mine > 0u ? mine : 1u; nx = cnt > 0u ? cnt : 1u;
}

__device__ __forceinline__ void xcd_barrier(const XcdBarrier& b) {
    asm volatile("s_waitcnt vmcnt(0)" ::: "memory");
    __syncthreads();
    if (threadIdx.x == 0) {
        unsigned* bar = b.bar;
        __builtin_amdgcn_s_waitcnt(0);
        unsigned nloc = b.st[0], nx = b.st[1];
        if (nloc == 0u) { xcd_barrier_complete(bar, b.x, nloc, nx); b.st[0] = nloc; b.st[1] = nx; }
        const unsigned old = xb_add(&bar[XB_XSUB(b.x)], 1u);
        const unsigned gen = old / nloc;
        if (old + 1u == (gen + 1u) * nloc) {
            __builtin_amdgcn_fence(__ATOMIC_RELEASE, "agent");
            asm volatile("s_waitcnt vmcnt(0)" ::: "memory");
            const unsigned og = xb_add(&bar[XB_TOP], 1u);
            const unsigned tg = og / nx;
            if (og + 1u == (tg + 1u) * nx) xb_add(&bar[XB_TOPGEN], 1u);
            else XB_SPIN(xb_ld(&bar[XB_TOPGEN]) == tg, bar);
            __builtin_amdgcn_fence(__ATOMIC_ACQUIRE, "agent");
            xb_add(&bar[XB_XGEN(b.x)], 1u);
            asm volatile("s_waitcnt vmcnt(0)" ::: "memory");
        } else {
            XB_SPIN(xb_ld(&bar[XB_XGEN(b.x)]) == gen, bar);
            __builtin_amdgcn_fence(__ATOMIC_ACQUIRE, "agent");
            asm volatile("s_waitcnt vmcnt(0)" ::: "memory");
        }
    }
    __syncthreads();
}


namespace fft {
using att::bf16x8; using att::s16x4; using att::f32x16; using att::vtr; using att::cvtpk;
constexpr int XP = 1088, XOFF = 0, FOFF = 64 * XP;
template <int STAGE>
DI void fft_unit(ALAS unsigned char* lds, const Params& p, int unit, int wid, int lane) {
    constexpr int M = STAGE == 1 ? 128 : 64, MT = M / 32, CH = M * 16;
    unsigned char* ws = p.ws;
    const int tid = threadIdx.x, r32 = lane & 31, hi = lane >> 5;
    const int b = unit >> 6, u6 = unit & 63;
    __syncthreads();
    for (int idx = tid; idx < M * 128; idx += 512) {
        const int k = idx & 127, row = idx >> 7, part = k >> 6, kk = k & 63, rr = row & 63;
        const float ang = (float)((kk * rr) & 63) * (1.0f / 32.0f); const float c = cospif(ang), sn = sinpif(ang);
        float v;
        if (STAGE == 1) v = (row < 64) ? (part == 0 ? c : -sn) : (part == 0 ? -sn : -c);
        else v = part == 0 ? c : sn;
        *(ALAS bf16_t*)(lds + FOFF + (k >> 3) * CH + row * 16 + (k & 7) * 2) = (bf16_t)f2bf(v);
    }
    const bf16_t* src = STAGE == 1 ? (const bf16_t*)(ws + WS_ZB) + ((size_t)b * SEQ + u6) * 512 : (const bf16_t*)(ws + WS_ZS1) + ((size_t)(b * 64 + u6) * 64) * 512;
    const size_t rstride = STAGE == 1 ? (size_t)64 * 512 : (size_t)512;
#pragma unroll
    for (int i = 0; i < 8; ++i) { const int row = wid + 8 * i;
        __builtin_amdgcn_global_load_lds((const unsigned*)(src + row * rstride + lane * 8), (ALAS unsigned*)(lds + XOFF + row * XP), 16, 0, 0); }
    asm volatile("s_waitcnt vmcnt(0)" ::: "memory");
    __syncthreads();
    f32x16 acc[MT];
#pragma unroll
    for (int mt = 0; mt < MT; ++mt)
#pragma unroll
        for (int r = 0; r < 16; ++r) acc[mt][r] = 0.f;
    const ALAS unsigned char* xb = lds + XOFF + (8 * hi + ((lane & 15) >> 2)) * XP + (32 * wid + 16 * ((lane >> 4) & 1) + 4 * (lane & 3)) * 2;
    const ALAS unsigned char* fb = lds + FOFF + hi * CH + r32 * 16;
#pragma unroll
    for (int ks = 0; ks < 8; ++ks) {
        const ALAS unsigned char* bp = xb + (16 * (ks & 3)) * XP + (ks >> 2) * 512;
        const s16x4 lo = vtr(bp), hh = vtr(bp + 4 * XP);
        const bf16x8 bfr = __builtin_shufflevector(lo, hh, 0, 1, 2, 3, 4, 5, 6, 7);
#pragma unroll
        for (int mt = 0; mt < MT; ++mt) { const bf16x8 afr = *(const ALAS bf16x8*)(fb + (2 * ks) * CH + mt * 512); acc[mt] = ATT_MFMA(afr, bfr, acc[mt]); }
    }
    __syncthreads();
    const int col = 32 * wid + r32;
    if (STAGE == 1) {
#pragma unroll
        for (int mt = 0; mt < 2; ++mt)
#pragma unroll
            for (int r = 0; r < 16; ++r) { const int s1p = 32 * mt + (r & 3) + 8 * (r >> 2) + 4 * hi;
                const float x = (float)((s1p * u6) & 4095) * (1.0f / 4096.0f); const float ct = __builtin_amdgcn_cosf(x), st = __builtin_amdgcn_sinf(x);
                const float yr = acc[mt][r], yi = acc[mt + 2][r];
                *(ALAS bf16_t*)(lds + XOFF + s1p * 1024 + col * 2) = (bf16_t)f2bf(yr * ct + yi * st);
                *(ALAS bf16_t*)(lds + XOFF + s1p * 1024 + 512 + col * 2) = (bf16_t)f2bf(yi * ct - yr * st); }
        __syncthreads();
        bf16_t* dst = (bf16_t*)(ws + WS_ZS1);
#pragma unroll
        for (int i = 0; i < 8; ++i) { const int row = i * 8 + (tid >> 6), ch = tid & 63;
            const u32x4 v = *(const ALAS u32x4*)(lds + XOFF + row * 1024 + ch * 16);
            *(u32x4*)(dst + ((size_t)(b * 64 + row) * 64 + u6) * 512 + ch * 8) = v; }
    } else {
#pragma unroll
        for (int mt = 0; mt < 2; ++mt)
#pragma unroll
            for (int r = 0; r < 16; ++r) { const int s2p = 32 * mt + (r & 3) + 8 * (r >> 2) + 4 * hi;
                *(ALAS bf16_t*)(lds + XOFF + s2p * 512 + col * 2) = (bf16_t)f2bf(acc[mt][r]); }
        __syncthreads();
        bf16_t* dst = (bf16_t*)(ws + WS_OB);
#pragma unroll
        for (int i = 0; i < 4; ++i) { const int row = i * 16 + (tid >> 5), ch = tid & 31;
            const u32x4 v = *(const ALAS u32x4*)(lds + XOFF + row * 512 + ch * 16);
            *(u32x4*)(dst + ((size_t)b * SEQ + u6 + 64 * row) * 1024 + 512 + ch * 8) = v; }
    }
    __syncthreads();
}
}

constexpr int LDS_BYTES = 147456;
constexpr int LDSCTL_OFF = 131072, MISC_OFF = LDSCTL_OFF + 320;
constexpr int CW_BAR = 4096;
struct Args { Params p; int ph_lo, ph_hi; };
__global__ void __launch_bounds__(512, 2) mk_fwd(Args a) {
    extern __shared__ __attribute__((aligned(16))) unsigned char smem[];
    LAS unsigned char* lds = (LAS unsigned char*)smem;
    const int tid = threadIdx.x, lane = tid & 63, wave = __builtin_amdgcn_readfirstlane(tid >> 6);
    const int G = gridDim.x, bx = blockIdx.x, vcu = (G % 8 == 0) ? (bx % 8) * (G / 8) + bx / 8 : bx;
    const int lo = a.ph_lo, hi = a.ph_hi;
    unsigned char* ws = a.p.ws;
    volatile LAS unsigned* MISC = (volatile LAS unsigned*)(lds + MISC_OFF);
    for (int u = tid; u < (LDS_BYTES - LDSCTL_OFF) / 4; u += 512) ((LAS unsigned*)(lds + LDSCTL_OFF))[u] = 0u;
    __syncthreads();
    XcdBarrier bar = xcd_barrier_post((unsigned*)(ws + WS_CTL) + CW_BAR, MISC + 8);
#ifndef PHMASK
#define PHMASK 0xffff
#endif
#define IN(k) (((PHMASK >> (k)) & 1) && lo <= (k) && (k) < hi)
#define SEAM(k) do { if (IN(k) && IN((k) + 1)) xcd_barrier(bar); } while (0)
    int kDM = DM, kDE = DEXP; asm volatile("" : "+s"(kDM), "+s"(kDE));
    if (IN(0)) { p0_prologue(a.p, (float*)smem, vcu * 8 + wave, G * 8, wave, lane); }
    SEAM(0);
    if (IN(1)) {
        { pg8::Gemm g{(const bf16_t*)(ws + WS_XN), (const bf16_t*)(ws + WS_WINT), NTOK, NIN, kDM}; pg8::StaticOrder S; S.init(NTOK, NIN, G, bx);
          pg8::EpiInproj E{ws}; pg8::gemm_phase<pg8::EpiInproj, pg8::StaticOrder, true, true>(lds, g, S, E); }
        { pg8::Gemm g{(const bf16_t*)(ws + WS_MEMB), (const bf16_t*)(ws + WS_WMT), NB * MEMLEN, 512, kDM}; pg8::StaticOrder S; S.init(NB * MEMLEN, 512, G, bx);
          pg8::EpiBf16Plain E{(bf16_t*)(ws + WS_MKV), 512}; pg8::gemm_phase<pg8::EpiBf16Plain, pg8::StaticOrder, true, true>(lds, g, S, E); }
    }
    SEAM(1);
    if (IN(2)) { kmax_phase(a.p, vcu * 8 + wave, G * 8, lane); for (int u = vcu; u < 256; u += G) fft::fft_unit<1>(lds, a.p, u, wave, lane); }
    SEAM(2);
    if (IN(3)) {
        for (int u = vcu; u < 256; u += G) att::attn_unit<128, true>(lds, a.p, u, wave, lane);
        { int lane_b = lane; asm volatile("" : "+v"(lane_b)); for (int u = vcu; u < 256; u += G) att::attn_unit<64, false>(lds, a.p, u, wave, lane_b); }
        { int lane_c = lane; asm volatile("" : "+v"(lane_c)); for (int u = vcu; u < 256; u += G) fft::fft_unit<2>(lds, a.p, u, wave, lane_c); }
    }
    SEAM(3);
    if (IN(4)) {
        pg8::Gemm g{(const bf16_t*)(ws + WS_OB), (const bf16_t*)(ws + WS_WOT), NTOK, DM, kDM}; pg8::StaticOrder S; S.init(NTOK, DM, G, bx);
        pg8::EpiF32Plain E{(float*)(ws + WS_AOUT), DM}; pg8::gemm_phase<pg8::EpiF32Plain, pg8::StaticOrder, true, true>(lds, g, S, E);
    }
    SEAM(4);
    if (IN(5)) { p4_ln1_router(a.p, (float*)smem, vcu * 8 + wave, G * 8, wave, lane); }
    SEAM(5);
    LAS int* mtab = (LAS int*)(lds + LDSCTL_OFF + 1024);
    if (IN(6) || IN(7)) {
        if (tid == 0) { const unsigned* cnt = (const unsigned*)(ws + WS_CTL) + CW_CNT; int tp = 0;
            for (int e = 0; e < 32; ++e) { const int c = (int)cnt[e]; mtab[e] = tp; mtab[33 + e] = c; tp += (c + 255) >> 8; } mtab[32] = tp; }
        __syncthreads();
    }
    if (IN(6)) {
        pg8::Gemm g{(const bf16_t*)(ws + WS_XN), (const bf16_t*)(ws + WS_W13T), 0, 0, kDM}; pg8::MoeOrder S{mtab, (const int*)(ws + WS_LIST), G, bx, 1};
        pg8::EpiSwiglu E{(bf16_t*)(ws + WS_OB)}; pg8::gemm_phase<pg8::EpiSwiglu, pg8::MoeOrder, true, true, true>(lds, g, S, E);
    }
    SEAM(6);
    if (IN(7)) {
        pg8::Gemm g{(const bf16_t*)(ws + WS_OB), (const bf16_t*)(ws + WS_W2T), 0, 0, kDE}; pg8::MoeOrder S{mtab, (const int*)(ws + WS_LIST), G, bx, 2};
        pg8::EpiDown E{(bf16_t*)(ws + WS_Y)}; pg8::gemm_phase<pg8::EpiDown, pg8::MoeOrder, true, true, false>(lds, g, S, E);
    }
    SEAM(7);
    if (IN(8)) { p7_final(a.p, vcu * 8 + wave, G * 8, lane); }
#undef IN
#undef SEAM
}

#ifndef N_LAUNCH_SPLIT
#define N_LAUNCH_SPLIT 0
#endif
extern "C" void kernel_launch(void* const* d_in, const int* in_sizes, int n_in, void* d_out, int out_size, void* d_ws, size_t ws_size, hipStream_t stream) {
    Params p{};
    for (int i = 0; i < 25; ++i) p.in[i] = (const float*)d_in[i];
    p.out = (float*)d_out; p.ws = (unsigned char*)d_ws;
    static int grid = 0;
    if (!grid) {
        (void)hipFuncSetAttribute((const void*)mk_fwd, hipFuncAttributeMaxDynamicSharedMemorySize, LDS_BYTES);
        int dev = 0, cus = 0, per_cu = 0;
        (void)hipGetDevice(&dev); (void)hipDeviceGetAttribute(&cus, hipDeviceAttributeMultiprocessorCount, dev);
        (void)hipOccupancyMaxActiveBlocksPerMultiprocessor(&per_cu, (const void*)mk_fwd, 512, LDS_BYTES);
        if (per_cu < 1) per_cu = 1;
        grid = cus * 1;
        if (grid > 256) grid = 256;
        (void)hipGetLastError();
    }
    (void)hipMemsetAsync((char*)d_ws + WS_CTL, 0, CTL_BYTES, stream);
    Args a{}; a.p = p;
#if N_LAUNCH_SPLIT
    for (int k = 0; k < 9; ++k) { a.ph_lo = k; a.ph_hi = k + 1; hipLaunchKernelGGL(mk_fwd, dim3(grid), dim3(512), LDS_BYTES, stream, a); }
#else
    a.ph_lo = 0; a.ph_hi = 9;
    void* kargs[] = {&a};
    (void)hipLaunchCooperativeKernel((const void*)mk_fwd, dim3(grid), dim3(512), kargs, LDS_BYTES, stream);
#endif
}
```

```cpp
#include <hip/hip_runtime.h>
#include <stdint.h>

#define DI __device__ __forceinline__
typedef unsigned short bf16_t;
typedef float f32x4 __attribute__((ext_vector_type(4)));
typedef unsigned u32x4 __attribute__((ext_vector_type(4)));
typedef unsigned u32x2 __attribute__((ext_vector_type(2)));

constexpr int NB = 4, SEQ = 4096, DM = 1024, NTOK = NB * SEQ;
constexpr int NEXP = 32, DEXP = 256, MEMLEN = 256;
constexpr int NIN = 2304;
constexpr float LOG2E = 1.4426950408889634f;
constexpr float C2 = 0.125f * LOG2E;
constexpr float ALPHA = 1.189207115002721f;
constexpr float LN_EPS = 1e-5f;
constexpr float LAM_INIT = 0.2f;

constexpr size_t MiB = 1u << 20;
constexpr size_t WS_CTL = 0, CTL_BYTES = 1 * MiB;
constexpr size_t WS_WINT = 1 * MiB;
constexpr size_t WS_WOT = 6 * MiB;
constexpr size_t WS_WMT = 8 * MiB;
constexpr size_t WS_MEMB = 9 * MiB;
constexpr size_t WS_WR = 11 * MiB;
constexpr size_t WS_COSTAB = 11 * MiB + 256 * 1024;
constexpr size_t WS_STATS0 = 11 * MiB + 512 * 1024;
constexpr size_t WS_MKV = 12 * MiB;
constexpr size_t WS_TOKINFO = 13 * MiB;
constexpr size_t WS_LIST = 14 * MiB;
constexpr size_t WS_W13T = 16 * MiB;
constexpr size_t WS_W2T = 48 * MiB;
constexpr size_t WS_XN = 64 * MiB;
constexpr size_t WS_OB = 96 * MiB;
constexpr size_t WS_QB = 128 * MiB, WS_KB = 144 * MiB, WS_VB = 160 * MiB, WS_MQB = 176 * MiB, WS_ZB = 184 * MiB;
constexpr size_t WS_AOUT = 128 * MiB;
constexpr size_t WS_Y = 128 * MiB;
constexpr int CW_CNT = 64;

struct Params {
    const float* in[25];
    float* out;
    unsigned char* ws;
};
enum { I_X = 0, I_MEM, I_LN0G, I_LN0B, I_RELB, I_WIN, I_WMKV, I_WF, I_LQ1, I_LK1, I_LQ2, I_LK2, I_SUBG, I_WOUT, I_LN1G, I_LN1B,
       I_WG, I_BG, I_WRT, I_BRT, I_W1, I_W3, I_W2, I_LN2G, I_LN2B };

DI float bf2f(bf16_t v) { return __uint_as_float(((unsigned)v) << 16); }
DI unsigned f2bf(float f) { unsigned u = __float_as_uint(f); return (u + 0x7fffu + ((u >> 16) & 1u)) >> 16; }
DI unsigned pk2(float lo, float hi) { return f2bf(lo) | (f2bf(hi) << 16); }
DI float wave_sum(float v) {
#pragma unroll
    for (int o = 1; o < 64; o <<= 1) v += __shfl_xor(v, o);
    return v;
}
template <int CTRL> DI float dppf(float v) { return __int_as_float(__builtin_amdgcn_update_dpp(0, __float_as_int(v), CTRL, 0xF, 0xF, true)); }
DI float wave_sum2(float v) {
    v += dppf<0xB1>(v); v += dppf<0x4E>(v); v += dppf<0x141>(v); v += dppf<0x140>(v);
    { auto s = __builtin_amdgcn_permlane16_swap(__float_as_uint(v), __float_as_uint(v), false, false); v = __uint_as_float(s[0]) + __uint_as_float(s[1]); }
    { auto s = __builtin_amdgcn_permlane32_swap(__float_as_uint(v), __float_as_uint(v), false, false); v = __uint_as_float(s[0]) + __uint_as_float(s[1]); }
    return v;
}
DI int t5_bucket(int rel) {
    const int n = rel < 0 ? -rel : rel;
    int b;
    if (n < 8) b = n; else if (n < 12) b = 8; else if (n < 16) b = 9; else if (n < 23) b = 10; else if (n < 32) b = 11;
    else if (n < 46) b = 12; else if (n < 64) b = 13; else if (n < 91) b = 14; else b = 15;
    return b + (rel > 0 ? 16 : 0);
}


namespace pg8 {
#define PG8_LAS __attribute__((address_space(3)))
typedef unsigned short bf16_t;
typedef short bf16x8 __attribute__((ext_vector_type(8)));
typedef float f32x4 __attribute__((ext_vector_type(4)));
typedef unsigned u32x4 __attribute__((ext_vector_type(4)));
constexpr int BM = 256, BK = 64, HALF = 128, HTB = HALF * BK * 2  , STAGE_BYTES = 8 * HTB, NXCD = 8, WGM = 8;

__host__ __device__ __forceinline__ int lds_byte(int r, int c) { const int st = (r >> 4) * 2 + (c >> 5), rr = r & 15, cc = c & 31, ob = rr * 64 + cc * 2; return st * 1024 + (ob ^ (((ob >> 9) & 1) << 5)); }
__host__ __device__ __forceinline__ void stage_rc(int b, int& R, int& C) { const int st = b / 1024, sb = b % 1024, swz = sb ^ (((sb >> 9) & 1) << 5); R = (st >> 1) * 16 + swz / 64; C = (st & 1) * 32 + (swz % 64) / 2; }
__host__ __device__ __forceinline__ int perm32(int rho) { const int n = rho >> 4, i = rho & 15; return 8 * (i >> 2) + 4 * n + (i & 3); }

struct Unit { int pm, pn; };
struct Gemm { const bf16_t* A; const bf16_t* Bt; int M, N, K; };

struct StaticOrder {
    int nM, nN, nwg, G, c;
    __host__ __device__ void init(int M, int N, int G_, int c_) { nM = M / BM; nN = N / BM; nwg = nM * nN; G = G_; c = c_; }
    __host__ __device__ bool next(int i, Unit& u) const {
        const long L = (long)i * G + c; if (L >= nwg) return false;
        int wgid = (int)L; { const int q = nwg / NXCD, r = nwg % NXCD, xcd = wgid % NXCD, off = wgid / NXCD; wgid = (xcd < r ? xcd * (q + 1) : r * (q + 1) + (xcd - r) * q) + off; }
        const int nig = WGM * nN, gid = wgid / nig, fm = gid * WGM, gsz = (nM - fm) < WGM ? (nM - fm) : WGM;
        u.pm = fm + ((wgid % nig) % gsz); u.pn = (wgid % nig) / gsz; return true;
    }
    __device__ __forceinline__ void a_ready(const Unit&) const {}
    __device__ __forceinline__ void done(const Unit&) const {}
};

__device__ __forceinline__ unsigned cvt_pk_bf16(float lo, float hi) { unsigned r; asm volatile("v_cvt_pk_bf16_f32 %0, %1, %2" : "=v"(r) : "v"(lo), "v"(hi)); return r; }
typedef float f32x2 __attribute__((ext_vector_type(2)));
__device__ __forceinline__ f32x2 gelu_pk(f32x2 v) {
    const f32x2 av = __builtin_elementwise_abs(v), d = av * 0.2316418882f + 1.0f;
    f32x2 t; t.x = __builtin_amdgcn_rcpf(d.x); t.y = __builtin_amdgcn_rcpf(d.y);
    f32x2 q = t * 0.5307027145f + (-0.7265760135f); q = q * t + 0.7107068705f; q = q * t + (-0.142248368f); q = q * t + 0.127414796f; q = q * t;
    const f32x2 s = (v * v) * (-0.72134752044f);
    f32x2 e; e.x = __builtin_amdgcn_exp2f(s.x); e.y = __builtin_amdgcn_exp2f(s.y);
    const f32x2 m = v * (q * e), r = v - m;
    f32x2 o; o.x = v.x < 0.f ? m.x : r.x; o.y = v.y < 0.f ? m.y : r.y; return o;
}

template <int ACT  > struct EpiBf16 {
    static constexpr bool PERM = true, AFTER_DRAIN = false; static_assert(ACT == 0 || ACT == 1, "EpiBf16: ACT is 0 (none) or 1 (gelu_pk)");
    bf16_t* O; int ldc; const float* bias; int split_cols; size_t split_stride; float scale0;
    __device__ __forceinline__ void operator()(const f32x4 (&acc)[2][2][4][2], const Unit& u, int wr, int wc, int fr, int fq) const {
        const int row0 = u.pm * BM + wr * 64 + fr; int colt = u.pn * BM; bf16_t* base = O;
        float sc = 1.f; if (split_cols) { const int t = colt / split_cols; base += (size_t)t * split_stride; colt -= t * split_cols; if (t == 0) sc = scale0; }
        const int col0 = colt + wc * 32 + 8 * fq, bcol0 = u.pn * BM + wc * 32 + 8 * fq;
        f32x4 bv[2][2];
#pragma unroll
        for (int bj = 0; bj < 2; ++bj)
#pragma unroll
            for (int n = 0; n < 2; ++n) bv[bj][n] = bias ? *(const f32x4*)(bias + bcol0 + bj * HALF + 4 * n) : (f32x4){0.f, 0.f, 0.f, 0.f};
#pragma unroll
        for (int ai = 0; ai < 2; ++ai)
#pragma unroll
            for (int m = 0; m < 4; ++m) { bf16_t* rowp = base + (size_t)(row0 + ai * HALF + m * 16) * ldc + col0;
#pragma unroll
                for (int bj = 0; bj < 2; ++bj) { f32x4 v0 = acc[ai][bj][m][0] + bv[bj][0], v1 = acc[ai][bj][m][1] + bv[bj][1];
                    if (ACT == 1) { f32x2 a = gelu_pk((f32x2){v0[0], v0[1]}), b = gelu_pk((f32x2){v0[2], v0[3]}), c = gelu_pk((f32x2){v1[0], v1[1]}), d = gelu_pk((f32x2){v1[2], v1[3]});
                        v0 = (f32x4){a.x, a.y, b.x, b.y}; v1 = (f32x4){c.x, c.y, d.x, d.y}; }
                    v0 = v0 * sc; v1 = v1 * sc; u32x4 w; w.x = cvt_pk_bf16(v0[0], v0[1]); w.y = cvt_pk_bf16(v0[2], v0[3]); w.z = cvt_pk_bf16(v1[0], v1[1]); w.w = cvt_pk_bf16(v1[2], v1[3]);
                    *(u32x4*)(rowp + bj * HALF) = w; } }
    }
};

struct PanelStats {
    unsigned* xbuf;
    unsigned* cnt;
    unsigned* tmo;
    int ntn; float eps;
    unsigned code;
    __device__ __forceinline__ bool run(const f32x4 (&v)[2][2][4][2], const Unit& u, int wr, int wc, int fr, int fq, PG8_LAS unsigned char* lds, int wid, int lane) const {
        typedef float f32x2v __attribute__((ext_vector_type(2)));
        PG8_LAS f32x2v* P = (PG8_LAS f32x2v*)lds;
        PG8_LAS f32x2v* S = (PG8_LAS f32x2v*)(lds + 8192);
        PG8_LAS unsigned* flag = (PG8_LAS unsigned*)(lds + 8192 + 2048);
#pragma unroll
        for (int ai = 0; ai < 2; ++ai)
#pragma unroll
            for (int m = 0; m < 4; ++m) {
                float s = 0.f;
#pragma unroll
                for (int bj = 0; bj < 2; ++bj)
#pragma unroll
                    for (int n = 0; n < 2; ++n) { const f32x4 x = v[ai][bj][m][n]; s += (x[0] + x[1]) + (x[2] + x[3]); }
                s += __shfl_xor(s, 16); s += __shfl_xor(s, 32);
                const float mw = s * (1.0f / 64.0f); float q = 0.f;
#pragma unroll
                for (int bj = 0; bj < 2; ++bj)
#pragma unroll
                    for (int n = 0; n < 2; ++n) { const f32x4 d = v[ai][bj][m][n] - mw; q += (d[0] * d[0] + d[1] * d[1]) + (d[2] * d[2] + d[3] * d[3]); }
                q += __shfl_xor(q, 16); q += __shfl_xor(q, 32);
                if (fq == 0) P[(ai * HALF + wr * 64 + m * 16 + fr) * 4 + wc] = (f32x2v){mw, q};
            }
        asm volatile("s_waitcnt lgkmcnt(0)" ::: "memory"); __builtin_amdgcn_s_barrier(); asm volatile("" ::: "memory");
#if defined(BROKEN_EXCHANGE_NO_WAIT)
#warning BROKEN CONTROL BUILD: the row-statistics exchange does not wait; results are wrong by design
        if (blockIdx.x >= 64) { const long long t0_ = clock64(); while (clock64() - t0_ < 60000) __builtin_amdgcn_s_sleep(8); }
#endif
        const int row = wid * 32 + (lane & 31);
        if (lane < 32) {
            const f32x2v a = P[row * 4 + 0], b = P[row * 4 + 1], c = P[row * 4 + 2], d = P[row * 4 + 3];
            const float mt = (a.x + b.x + c.x + d.x) * 0.25f;
            const float da = a.x - mt, db = b.x - mt, dc = c.x - mt, dd = d.x - mt;
            const float m2 = (a.y + b.y) + (c.y + d.y) + 64.0f * ((da * da + db * db) + (dc * dc + dd * dd));
            unsigned long long* slot = (unsigned long long*)xbuf + ((size_t)(u.pm * BM + row) * 4 + u.pn);
            __hip_atomic_store(slot, ((unsigned long long)__float_as_uint(m2) << 32) | __float_as_uint(mt), __ATOMIC_RELAXED, __HIP_MEMORY_SCOPE_AGENT);
        }
        asm volatile("s_waitcnt vmcnt(0)" ::: "memory");
        if (lane == 0) __hip_atomic_fetch_add(cnt + 64 * u.pm, 1u, __ATOMIC_RELAXED, __HIP_MEMORY_SCOPE_AGENT);
        if (wid == 0) {
            bool dead = false; const unsigned long long t0 = __builtin_amdgcn_s_memrealtime(); const unsigned want = 8u * (unsigned)ntn;
            for (;;) {
#if defined(BROKEN_EXCHANGE_NO_WAIT)
                break;
#endif
                if ((unsigned)__builtin_amdgcn_readfirstlane(__hip_atomic_load(cnt + 64 * u.pm, __ATOMIC_RELAXED, __HIP_MEMORY_SCOPE_AGENT)) >= want) break;
                if (__builtin_amdgcn_s_memrealtime() - t0 > 2000000ull) {
                    if (lane == 0) { unsigned expect = 0u; __hip_atomic_compare_exchange_strong(tmo + 1, &expect, code | (unsigned)(u.pm & 0xff), __ATOMIC_RELAXED, __ATOMIC_RELAXED, __HIP_MEMORY_SCOPE_AGENT);
                                     __hip_atomic_store(tmo, 1u, __ATOMIC_RELAXED, __HIP_MEMORY_SCOPE_AGENT); }
                    dead = true; break; }
                __builtin_amdgcn_s_sleep(2);
            }
            __builtin_amdgcn_fence(__ATOMIC_ACQUIRE, "agent");
            if (lane == 0) flag[0] = dead ? 1u : 0u;
        }
        asm volatile("s_waitcnt vmcnt(0) lgkmcnt(0)" ::: "memory"); __builtin_amdgcn_s_barrier(); asm volatile("" ::: "memory");
        const bool bad = flag[0] != 0u;
        if (lane < 32) {
            const unsigned long long* slot = (const unsigned long long*)xbuf + (size_t)(u.pm * BM + row) * 4; float mt[4], m2[4]; float ms = 0.f;
#pragma unroll
            for (int t = 0; t < 4; ++t) { if (t < ntn) { const unsigned long long w = __hip_atomic_load(slot + t, __ATOMIC_RELAXED, __HIP_MEMORY_SCOPE_AGENT); mt[t] = __uint_as_float((unsigned)w); m2[t] = __uint_as_float((unsigned)(w >> 32)); } else { mt[t] = 0.f; m2[t] = 0.f; } ms += mt[t]; }
            const float mean = ms / (float)ntn; float q = 0.f;
#pragma unroll
            for (int t = 0; t < 4; ++t) if (t < ntn) { const float dm = mt[t] - mean; q += m2[t] + 256.0f * dm * dm; }
            S[row] = (f32x2v){mean, 1.0f / sqrtf(q / (256.0f * (float)ntn) + eps)};
        }
        asm volatile("s_waitcnt lgkmcnt(0)" ::: "memory"); __builtin_amdgcn_s_barrier(); asm volatile("" ::: "memory");
        return bad;
    }
};
struct EpiLnRes {
    static constexpr bool PERM = false, AFTER_DRAIN = true;
    const float* base; float* out; int ldc; const float* bias; PanelStats st; unsigned poison;
    __device__ __forceinline__ void fused(f32x4 (&acc)[2][2][4][2], const Unit& u, int wr, int wc, int fr, int fq, PG8_LAS unsigned char* lds, int wid, int lane) const {
        typedef float f32x2v __attribute__((ext_vector_type(2)));
        const PG8_LAS f32x2v* S = (const PG8_LAS f32x2v*)(lds + 8192);
        const int col0 = u.pn * BM + wc * 32 + 4 * fq;
#pragma unroll
        for (int bj = 0; bj < 2; ++bj)
#pragma unroll
            for (int n = 0; n < 2; ++n) { const f32x4 bv = bias ? *(const f32x4*)(bias + col0 + bj * HALF + n * 16) : (f32x4){0.f, 0.f, 0.f, 0.f};
#pragma unroll
                for (int ai = 0; ai < 2; ++ai)
#pragma unroll
                    for (int m = 0; m < 4; ++m) acc[ai][bj][m][n] += bv; }
        f32x4 pre[4][2][2];
#pragma unroll
        for (int m = 0; m < 4; ++m) { const size_t off = (size_t)(u.pm * BM + wr * 64 + m * 16 + fr) * ldc + col0;
#pragma unroll
            for (int bj = 0; bj < 2; ++bj)
#pragma unroll
                for (int n = 0; n < 2; ++n) pre[m][bj][n] = *(const f32x4*)(base + off + bj * HALF + n * 16); }
        const bool bad = st.run(acc, u, wr, wc, fr, fq, lds, wid, lane) || poison != 0u;
        const float qnan = __builtin_nanf("");
#pragma unroll
        for (int ai = 0; ai < 2; ++ai)
#pragma unroll
            for (int m = 0; m < 4; ++m) { const int r = ai * HALF + wr * 64 + m * 16 + fr; const f32x2v sr = S[r]; const size_t off = (size_t)(u.pm * BM + r) * ldc + col0;
#pragma unroll
                for (int bj = 0; bj < 2; ++bj)
#pragma unroll
                    for (int n = 0; n < 2; ++n) { const f32x4 bs = ai == 0 ? pre[m][bj][n] : *(const f32x4*)(base + off + bj * HALF + n * 16); f32x4 o = bs + (acc[ai][bj][m][n] - sr.x) * sr.y;
                        if (bad) o = (f32x4){qnan, qnan, qnan, qnan}; *(f32x4*)(out + off + bj * HALF + n * 16) = o; }
                if (m & 1) asm volatile("" ::: "memory"); }
    }
};
struct EpiLnResLn {
    static constexpr bool PERM = false, AFTER_DRAIN = true;
    const float* base; float* out; bf16_t* xn; int ldc; const float* bias; PanelStats st1, st2; unsigned poison;
    __device__ __forceinline__ void fused(f32x4 (&acc)[2][2][4][2], const Unit& u, int wr, int wc, int fr, int fq, PG8_LAS unsigned char* lds, int wid, int lane) const {
        typedef float f32x2v __attribute__((ext_vector_type(2))); typedef unsigned u32x2v __attribute__((ext_vector_type(2)));
        const PG8_LAS f32x2v* S = (const PG8_LAS f32x2v*)(lds + 8192);
        const int col0 = u.pn * BM + wc * 32 + 4 * fq;
#pragma unroll
        for (int bj = 0; bj < 2; ++bj)
#pragma unroll
            for (int n = 0; n < 2; ++n) { const f32x4 bv = bias ? *(const f32x4*)(bias + col0 + bj * HALF + n * 16) : (f32x4){0.f, 0.f, 0.f, 0.f};
#pragma unroll
                for (int ai = 0; ai < 2; ++ai)
#pragma unroll
                    for (int m = 0; m < 4; ++m) acc[ai][bj][m][n] += bv; }
        bool bad = st1.run(acc, u, wr, wc, fr, fq, lds, wid, lane) || poison != 0u;
        const float qnan = __builtin_nanf("");
#pragma unroll
        for (int ai = 0; ai < 2; ++ai)
#pragma unroll
            for (int m = 0; m < 4; ++m) { const int r = ai * HALF + wr * 64 + m * 16 + fr; const f32x2v sr = S[r]; const size_t off = (size_t)(u.pm * BM + r) * ldc + col0;
#pragma unroll
                for (int bj = 0; bj < 2; ++bj)
#pragma unroll
                    for (int n = 0; n < 2; ++n) { const f32x4 bs = *(const f32x4*)(base + off + bj * HALF + n * 16); acc[ai][bj][m][n] = bs + (acc[ai][bj][m][n] - sr.x) * sr.y; }
                asm volatile("" : "+v"(acc[ai][0][m][0]), "+v"(acc[ai][0][m][1]), "+v"(acc[ai][1][m][0]), "+v"(acc[ai][1][m][1]));
                if (m & 1) asm volatile("" ::: "memory"); }
        const bool bad1 = bad;
        bad = st2.run(acc, u, wr, wc, fr, fq, lds, wid, lane) || bad;
#pragma unroll
        for (int ai = 0; ai < 2; ++ai)
#pragma unroll
            for (int m = 0; m < 4; ++m) { const int r = ai * HALF + wr * 64 + m * 16 + fr; const f32x2v sr = S[r]; const size_t off = (size_t)(u.pm * BM + r) * ldc + col0;
#pragma unroll
                for (int bj = 0; bj < 2; ++bj)
#pragma unroll
                    for (int n = 0; n < 2; ++n) { const f32x4 x1 = acc[ai][bj][m][n]; *(f32x4*)(out + off + bj * HALF + n * 16) = bad1 ? (f32x4){qnan, qnan, qnan, qnan} : x1;
                        const f32x4 o = (x1 - sr.x) * sr.y; u32x2v w; w.x = cvt_pk_bf16(o[0], o[1]); w.y = cvt_pk_bf16(o[2], o[3]);
                        if (bad) { w.x = 0x7fc07fc0u; w.y = 0x7fc07fc0u; } *(u32x2v*)(xn + off + bj * HALF + n * 16) = w; }
                asm volatile("" ::: "memory"); }
    }
};

template <class Epi, class Sched, bool ALIGN_EPI = false, bool SP2 = false, bool GATHER = false>
__device__ __forceinline__ void gemm_phase(PG8_LAS unsigned char* lds, const Gemm g, const Sched& S, const Epi& E) {
    const int tid = threadIdx.x, wid = __builtin_amdgcn_readfirstlane(tid >> 6), lane = tid & 63, wr = wid >> 2, wc = wid & 3, fr = lane & 15, fq = lane >> 4;
    const int K = g.K, nt = K / BK;
    static_assert(!GATHER || SP2, "GATHER is wired into the SP2 loop only");
    unsigned voffA[2], voffB[2]; int gR_[2], gC_[2];
#pragma unroll
    for (int i = 0; i < 2; ++i) { int R, C; stage_rc(tid * 16 + i * 8192, R, C); const int Rb = Epi::PERM ? ((R & ~31) + perm32(R & 31)) : R; gR_[i] = R; gC_[i] = C;
        voffA[i] = (unsigned)(R * K + C) * 2u; voffB[i] = (unsigned)(Rb * K + C) * 2u; }
    unsigned gvo[2][2] = {{0u, 0u}, {0u, 0u}}, gvn[2][2] = {{0u, 0u}, {0u, 0u}};
#define PG8_GOFF(dst, unit) do { _Pragma("unroll") for (int h_ = 0; h_ < 2; ++h_) _Pragma("unroll") for (int i_ = 0; i_ < 2; ++i_) \
        dst[h_][i_] = ((unsigned)S.a_row(unit, h_ * HALF + gR_[i_]) * (unsigned)K + (unsigned)gC_[i_]) * 2u; \
        asm volatile("" : "+v"(dst[0][0]), "+v"(dst[0][1]), "+v"(dst[1][0]), "+v"(dst[1][1])); } while (0)
    const size_t kstep = (size_t)(BK * 2);
    const size_t hstep = (size_t)HALF * K * 2;
    const size_t tstep = 2 * hstep;
    const unsigned ldsw = (unsigned)wid * 1024u;
    const int aoff = lds_byte(wr * 64 + fr, fq * 8), boff = lds_byte(wc * 32 + fr, fq * 8);
#define PG8_SA(b, h) (((b) * 2 + (h)) * HTB)
#define PG8_SB(b, h) ((4 + (b) * 2 + (h)) * HTB)
#define PG8_STAGE(bufoff, gbase, voff) do { _Pragma("unroll") for (int _i = 0; _i < 2; ++_i) \
        __builtin_amdgcn_global_load_lds((const unsigned*)((const char*)(gbase) + (voff)[_i]), (PG8_LAS unsigned*)(lds + (bufoff) + ldsw + _i * 8192), 16, 0, 0); } while (0)
#define PG8_STAGE_AH(bufoff, gbase, h, usen) do { _Pragma("unroll") for (int _i = 0; _i < 2; ++_i) { \
        const unsigned vo_ = GATHER ? ((usen) ? gvn[h][_i] : gvo[h][_i]) : voffA[_i]; \
        __builtin_amdgcn_global_load_lds((const unsigned*)((const char*)(gbase) + (GATHER ? (size_t)0 : (size_t)(h) * hstep) + vo_), (PG8_LAS unsigned*)(lds + (bufoff) + ldsw + _i * 8192), 16, 0, 0); } } while (0)
#define PG8_LDA(dst, b, h) do { _Pragma("unroll") for (int m = 0; m < 4; ++m) _Pragma("unroll") for (int k = 0; k < 2; ++k) dst[m][k] = *(const PG8_LAS bf16x8*)(lds + PG8_SA(b, h) + aoff + m * 2048 + k * 1024); } while (0)
#define PG8_LDB(dst, b, h) do { _Pragma("unroll") for (int n = 0; n < 2; ++n) _Pragma("unroll") for (int k = 0; k < 2; ++k) dst[n][k] = *(const PG8_LAS bf16x8*)(lds + PG8_SB(b, h) + boff + n * 2048 + k * 1024); } while (0)
#define PG8_MMA(ai, bj, At, Bt) do { __builtin_amdgcn_s_setprio(1); _Pragma("unroll") for (int m = 0; m < 4; ++m) _Pragma("unroll") for (int n = 0; n < 2; ++n) _Pragma("unroll") for (int k = 0; k < 2; ++k) \
        acc[ai][bj][m][n] = __builtin_amdgcn_mfma_f32_16x16x32_bf16(Bt[n][k], At[m][k], acc[ai][bj][m][n], 0, 0, 0); __builtin_amdgcn_s_setprio(0); } while (0)
#define PG8_WAIT_V(n) asm volatile("s_waitcnt vmcnt(" #n ")" ::: "memory")
#define PG8_WAIT_L(n) asm volatile("s_waitcnt lgkmcnt(" #n ")" ::: "memory")
#define PG8_BAR __builtin_amdgcn_s_barrier()
#define PG8_SCHED __builtin_amdgcn_sched_barrier(0)
    Unit cur, nxt; int ui = 0;
    if (!S.next(0, cur)) return;
    f32x4 acc[2][2][4][2];
#pragma unroll
    for (int a = 0; a < 2; ++a)
#pragma unroll
        for (int b = 0; b < 2; ++b)
#pragma unroll
            for (int m = 0; m < 4; ++m)
#pragma unroll
                for (int n = 0; n < 2; ++n) acc[a][b][m][n] = (f32x4){0.f, 0.f, 0.f, 0.f};
    bf16x8 At[4][2], B0[2][2], B1[2][2];
    const char* cA = (const char*)g.A + (GATHER ? (size_t)0 : (size_t)cur.pm * tstep); const char* cB = (const char*)g.Bt + (size_t)cur.pn * tstep;
    S.a_ready(cur);
    if constexpr (GATHER) { PG8_GOFF(gvo, cur); }
    if constexpr (SP2) {
        PG8_STAGE(PG8_SB(0, 0), cB, voffB); PG8_STAGE(PG8_SB(0, 1), cB + hstep, voffB); PG8_STAGE_AH(PG8_SA(0, 0), cA, 0, false); PG8_STAGE_AH(PG8_SA(0, 1), cA, 1, false);
        if (wr == 1) PG8_BAR;
        PG8_WAIT_V(2); PG8_BAR;
        PG8_STAGE(PG8_SB(1, 0), cB + kstep, voffB); PG8_STAGE_AH(PG8_SA(1, 0), cA + kstep, 0, false); PG8_STAGE(PG8_SB(1, 1), cB + hstep + kstep, voffB);
        PG8_WAIT_V(6); PG8_BAR;
    } else {
        PG8_STAGE(PG8_SB(0, 0), cB, voffB); PG8_STAGE(PG8_SA(0, 0), cA, voffA); PG8_STAGE(PG8_SB(0, 1), cB + hstep, voffB); PG8_STAGE(PG8_SA(0, 1), cA + hstep, voffA);
        if (wr == 1) PG8_BAR;
        PG8_WAIT_V(4); PG8_BAR;
        PG8_STAGE(PG8_SB(1, 0), cB + kstep, voffB); PG8_STAGE(PG8_SA(1, 0), cA + kstep, voffA); PG8_STAGE(PG8_SB(1, 1), cB + hstep + kstep, voffB);
        PG8_WAIT_V(6); PG8_BAR;
    }
    for (;;) {
        const bool has_next = S.next(ui + 1, nxt);
        const char* nA = has_next ? (const char*)g.A + (GATHER ? (size_t)0 : (size_t)nxt.pm * tstep) : cA; const char* nB = has_next ? (const char*)g.Bt + (size_t)nxt.pn * tstep : cB;
        if constexpr (GATHER) { if (has_next) { PG8_GOFF(gvn, nxt); } else { gvn[0][0] = gvo[0][0]; gvn[0][1] = gvo[0][1]; gvn[1][0] = gvo[1][0]; gvn[1][1] = gvo[1][1]; } }
        for (int t = 0; t < nt; t += 2) {
            const bool last = (t == nt - 2);
            const char* a1 = cA + (size_t)(t + 1) * kstep;
            const char* a2 = last ? nA : cA + (size_t)(t + 2) * kstep; const char* b2 = last ? nB : cB + (size_t)(t + 2) * kstep;
            const char* a3 = a2 + kstep; const char* b3 = b2 + kstep;
            if (last && has_next) S.a_ready(nxt);
            if constexpr (SP2) {
            PG8_LDB(B0, 0, 0); PG8_LDB(B1, 0, 1); PG8_SCHED; PG8_LDA(At, 0, 0); PG8_STAGE_AH(PG8_SA(1, 1), a1, 1, false);
            PG8_WAIT_V(8); PG8_WAIT_L(0); PG8_BAR; PG8_MMA(0, 0, At, B0); PG8_MMA(0, 1, At, B1); PG8_BAR; PG8_SCHED;
            PG8_LDA(At, 0, 1); PG8_STAGE(PG8_SB(0, 0), b2, voffB); PG8_STAGE(PG8_SB(0, 1), b2 + hstep, voffB); PG8_STAGE_AH(PG8_SA(0, 0), a2, 0, last);
            PG8_WAIT_V(8); PG8_WAIT_L(0); PG8_BAR; PG8_MMA(1, 0, At, B0); PG8_MMA(1, 1, At, B1); PG8_BAR; PG8_SCHED;
            PG8_LDB(B0, 1, 0); PG8_LDB(B1, 1, 1); PG8_SCHED; PG8_LDA(At, 1, 0); PG8_STAGE_AH(PG8_SA(0, 1), a2, 1, last);
            PG8_WAIT_V(8); PG8_WAIT_L(0); PG8_BAR; PG8_MMA(0, 0, At, B0); PG8_MMA(0, 1, At, B1); PG8_BAR; PG8_SCHED;
            PG8_LDA(At, 1, 1); PG8_STAGE(PG8_SB(1, 0), b3, voffB); PG8_STAGE(PG8_SB(1, 1), b3 + hstep, voffB); PG8_STAGE_AH(PG8_SA(1, 0), a3, 0, last);
            PG8_WAIT_V(8); PG8_WAIT_L(0); PG8_BAR; PG8_MMA(1, 0, At, B0); PG8_MMA(1, 1, At, B1); PG8_BAR; PG8_SCHED;
            } else {
            PG8_LDB(B0, 0, 0); PG8_SCHED; PG8_LDA(At, 0, 0); PG8_STAGE(PG8_SA(1, 1), a1 + hstep, voffA);
            PG8_WAIT_L(8); PG8_BAR; PG8_WAIT_L(0); PG8_MMA(0, 0, At, B0); PG8_BAR; PG8_SCHED;
            PG8_LDB(B1, 0, 1); PG8_STAGE(PG8_SB(0, 0), b2, voffB);
            PG8_BAR; PG8_WAIT_L(0); PG8_MMA(0, 1, At, B1); PG8_BAR;
            PG8_LDA(At, 0, 1); PG8_STAGE(PG8_SA(0, 0), a2, voffA);
            PG8_BAR; PG8_WAIT_L(0); PG8_MMA(1, 0, At, B0); PG8_BAR; PG8_SCHED;
            PG8_STAGE(PG8_SB(0, 1), b2 + hstep, voffB);
            PG8_WAIT_V(6); PG8_BAR; PG8_MMA(1, 1, At, B1); PG8_BAR;
            PG8_LDB(B0, 1, 0); PG8_SCHED; PG8_LDA(At, 1, 0); PG8_STAGE(PG8_SA(0, 1), a2 + hstep, voffA);
            PG8_WAIT_L(8); PG8_BAR; PG8_WAIT_L(0); PG8_MMA(0, 0, At, B0); PG8_BAR; PG8_SCHED;
            PG8_LDB(B1, 1, 1); PG8_STAGE(PG8_SB(1, 0), b3, voffB);
            PG8_BAR; PG8_WAIT_L(0); PG8_MMA(0, 1, At, B1); PG8_BAR;
            PG8_LDA(At, 1, 1); PG8_STAGE(PG8_SA(1, 0), a3, voffA);
            PG8_BAR; PG8_WAIT_L(0); PG8_MMA(1, 0, At, B0); PG8_BAR; PG8_SCHED;
            PG8_STAGE(PG8_SB(1, 1), b3 + hstep, voffB);
            PG8_WAIT_V(6); PG8_BAR; PG8_MMA(1, 1, At, B1); PG8_BAR;
            }
        }
        if constexpr (ALIGN_EPI) { if (wr == 0) PG8_BAR; }
        if constexpr (!Epi::AFTER_DRAIN) { E(acc, cur, wr, wc, fr, fq); S.done(cur); }
        if (!has_next) break;
#pragma unroll
        for (int a = 0; a < 2; ++a)
#pragma unroll
            for (int b = 0; b < 2; ++b)
#pragma unroll
                for (int m = 0; m < 4; ++m)
#pragma unroll
                    for (int n = 0; n < 2; ++n) acc[a][b][m][n] = (f32x4){0.f, 0.f, 0.f, 0.f};
        cur = nxt; cA = nA; cB = nB; ++ui;
        if constexpr (GATHER) { gvo[0][0] = gvn[0][0]; gvo[0][1] = gvn[0][1]; gvo[1][0] = gvn[1][0]; gvo[1][1] = gvn[1][1]; }
        if constexpr (ALIGN_EPI) { if (wr == 1) PG8_BAR; }
    }
    PG8_WAIT_V(0);
    if constexpr (!ALIGN_EPI) { if (wr == 0) PG8_BAR; }
    PG8_BAR;
    if constexpr (Epi::AFTER_DRAIN) { E.fused(acc, cur, wr, wc, fr, fq, lds, wid, lane); S.done(cur); }
#undef PG8_SA
#undef PG8_SB
#undef PG8_STAGE
#undef PG8_STAGE_AH
#undef PG8_GOFF
#undef PG8_LDA
#undef PG8_LDB
#undef PG8_MMA
#undef PG8_WAIT_V
#undef PG8_WAIT_L
#undef PG8_BAR
#undef PG8_SCHED
}
}

DI void transpose_item(const float* W, int ldw, bf16_t* WT, int ldt, float scale, float* scr, int k0, int n0, int lane) {
#pragma unroll 8
    for (int i = 0; i < 32; ++i) { const int kk = 2 * i + (lane >> 5); scr[kk * 33 + (lane & 31)] = W[(size_t)(k0 + kk) * ldw + n0 + (lane & 31)] * scale; }
    asm volatile("s_waitcnt lgkmcnt(0)" ::: "memory");
    const int c = lane & 7;
#pragma unroll
    for (int j = 0; j < 4; ++j) { const int n = (lane >> 3) + 8 * j; const float* s = scr + (8 * c) * 33 + n;
        u32x4 o; o.x = pk2(s[0 * 33], s[1 * 33]); o.y = pk2(s[2 * 33], s[3 * 33]); o.z = pk2(s[4 * 33], s[5 * 33]); o.w = pk2(s[6 * 33], s[7 * 33]);
        *(u32x4*)(WT + (size_t)n * ldt + k0 + 8 * c) = o; }
    asm volatile("s_waitcnt lgkmcnt(0)" ::: "memory");
}

DI void p0_prologue(const Params& p, float* lds, int gw, int NGW, int wave, int lane) {
    unsigned char* ws = p.ws;
    bf16_t* WinT = (bf16_t*)(ws + WS_WINT); bf16_t* WoT = (bf16_t*)(ws + WS_WOT); bf16_t* WmT = (bf16_t*)(ws + WS_WMT);
    bf16_t* W13T = (bf16_t*)(ws + WS_W13T); bf16_t* W2T = (bf16_t*)(ws + WS_W2T);
    float* scr = lds + wave * (64 * 33);
    const float* w_in = p.in[I_WIN];
    constexpr int S0 = 256, S1 = 512, S2 = 768, S3 = 896, S4 = 1408, S5 = 1664, S6 = S5 + 4096, S7 = S6 + 4096, S8 = S7 + 4096;
    for (int it = gw; it < S8; it += NGW) {
        if (it < S3) {
            int seg, r;
            if (it < S0) { seg = 0; r = it; } else if (it < S1) { seg = 1; r = it - S0; } else if (it < S2) { seg = 2; r = it - S1; } else { seg = 3; r = it - S2; }
            const int ncb = (seg == 3) ? 8 : 16;
            const int kb = r / ncb, nb = r % ncb;
            const int coff = (seg == 3) ? 1792 : seg * 512, roff = (seg == 3) ? 1536 : seg * 512;
            const float sc = (seg == 0 || seg == 3) ? C2 : 1.0f;
            transpose_item(w_in + coff, 2048, WinT + (size_t)(roff + nb * 32) * 1024, 1024, sc, scr, kb * 64, nb * 32, lane);
        } else if (it < S4) { const int r = it - S3, kb = r / 32, nb = r % 32;
            transpose_item(p.in[I_WOUT], 1024, WoT + (size_t)(nb * 32) * 1024, 1024, 1.f, scr, kb * 64, nb * 32, lane);
        } else if (it < S5) { const int r = it - S4, kb = r / 16, nb = r % 16;
            transpose_item(p.in[I_WMKV], 512, WmT + (size_t)(nb * 32) * 1024, 1024, 1.f, scr, kb * 64, nb * 32, lane);
        } else if (it < S7) { const bool is3 = it >= S6; const int r = it - (is3 ? S6 : S5), e = r / 128, q = r % 128, kb = q / 8, nb = q % 8, n0 = nb * 32;
            const float* W = (is3 ? p.in[I_W3] : p.in[I_W1]) + (size_t)e * 1024 * 256;
            const int drow = e * 512 + (n0 >> 7) * 256 + (is3 ? 128 : 0) + (n0 & 127);
            transpose_item(W, 256, W13T + (size_t)drow * 1024, 1024, 1.f, scr, kb * 64, n0, lane);
        } else { const int r = it - S7, e = r / 128, q = r % 128, kb = q / 32, nb = q % 32;
            const float* W = p.in[I_W2] + (size_t)e * 256 * 1024;
            transpose_item(W, 1024, W2T + (size_t)(e * 1024 + nb * 32) * 256, 256, 1.f, scr, kb * 64, nb * 32, lane);
        }
    }
    {
        bf16_t* XN = (bf16_t*)(ws + WS_XN); float* st = (float*)(ws + WS_STATS0);
        const f32x4* g4 = (const f32x4*)p.in[I_LN0G] + lane; const f32x4* b4 = (const f32x4*)p.in[I_LN0B] + lane;
        for (int m = gw; m < NTOK; m += NGW) {
            const f32x4* xr = (const f32x4*)(p.in[I_X] + (size_t)m * DM) + lane;
            f32x4 v[4]; float s = 0.f;
#pragma unroll
            for (int j = 0; j < 4; ++j) { v[j] = xr[64 * j]; s += (v[j].x + v[j].y) + (v[j].z + v[j].w); }
            const float mean = wave_sum(s) * (1.f / DM); float s2 = 0.f;
#pragma unroll
            for (int j = 0; j < 4; ++j) { v[j] = v[j] - mean; s2 += (v[j].x * v[j].x + v[j].y * v[j].y) + (v[j].z * v[j].z + v[j].w * v[j].w); }
            const float rstd = 1.f / sqrtf(wave_sum(s2) * (1.f / DM) + LN_EPS);
            if (lane == 0) { st[2 * m] = mean; st[2 * m + 1] = rstd; }
            u32x2* o8 = (u32x2*)(XN + (size_t)m * DM) + lane;
#pragma unroll
            for (int j = 0; j < 4; ++j) { const f32x4 g = g4[64 * j], b = b4[64 * j]; const f32x4 y = v[j] * rstd * g + b; u32x2 w; w.x = pk2(y.x, y.y); w.y = pk2(y.z, y.w); o8[64 * j] = w; }
        }
    }
    {
        bf16_t* MB = (bf16_t*)(ws + WS_MEMB);
        for (int m = gw; m < NB * MEMLEN; m += NGW) {
            const f32x4* xr = (const f32x4*)(p.in[I_MEM] + (size_t)m * DM) + lane; u32x2* o8 = (u32x2*)(MB + (size_t)m * DM) + lane;
#pragma unroll
            for (int j = 0; j < 4; ++j) { const f32x4 y = xr[64 * j]; u32x2 w; w.x = pk2(y.x, y.y); w.y = pk2(y.z, y.w); o8[64 * j] = w; }
        }
    }
    {
        const float* wf = p.in[I_WF];
        for (int it = gw; it < 1024 * 4; it += NGW) {
            const int k = it >> 2, g = it & 3;
            const float wv = w_in[(size_t)k * 2048 + 1536 + g * 64 + lane];
            float ta = 0.f, tb = 0.f;
            for (int c = 0; c < 64; ++c) { const float wc = __shfl(wv, c); const float ang = (float)((c * lane) & 63) * (1.0f / 32.0f); ta += wc * cospif(ang); tb += wc * sinpif(ang); }
            float orr = 0.f, oi = 0.f;
            for (int c = 0; c < 64; ++c) { const float w = wf[(size_t)(g * 64 + c) * 64 + lane]; orr += __shfl(ta, c) * w; oi += __shfl(tb, c) * w; }
            WinT[(size_t)(1792 + g * 64 + lane) * 1024 + k] = (bf16_t)f2bf(orr * (1.0f / 512.0f));
            WinT[(size_t)(2048 + g * 64 + lane) * 1024 + k] = (bf16_t)f2bf(oi * (1.0f / 512.0f));
        }
    }
    {
        float* WR = (float*)(ws + WS_WR); float* ct = (float*)(ws + WS_COSTAB);
        const int gt = gw * 64 + lane, NGT = NGW * 64;
        for (int i = gt; i < 36 * 1024; i += NGT) { const int e = i >> 10, k = i & 1023; WR[i] = e < 4 ? p.in[I_WG][k * 4 + e] : p.in[I_WRT][k * 32 + (e - 4)]; }
        for (int i = gt; i < 4096; i += NGT) ct[i] = cospif((float)i * (1.0f / 2048.0f));
    }
}

constexpr size_t WS_ZS1 = 200 * MiB;
constexpr size_t WS_O1 = 216 * MiB;
constexpr int CW_KMAX = 128;
constexpr int CW_KMAXM = 160;

namespace pg8 {
struct EpiInproj {
    static constexpr bool PERM = true, AFTER_DRAIN = false;
    unsigned char* ws;
    __device__ __forceinline__ void operator()(const f32x4 (&acc)[2][2][4][2], const Unit& u, int wr, int wc, int fr, int fq) const {
        const int pn = u.pn; bf16_t* base; int ldc, coff;
        if (pn < 6) { base = (bf16_t*)(ws + WS_QB + (size_t)(pn >> 1) * (16 * MiB)); ldc = 512; coff = (pn & 1) * 256; }
        else if (pn == 6) { base = (bf16_t*)(ws + WS_MQB); ldc = 256; coff = 0; }
        else { base = (bf16_t*)(ws + WS_ZB); ldc = 512; coff = (pn - 7) * 256; }
        const int row0 = u.pm * BM + wr * 64 + fr, col0 = coff + wc * 32 + 8 * fq;
#pragma unroll
        for (int ai = 0; ai < 2; ++ai)
#pragma unroll
            for (int m = 0; m < 4; ++m) { bf16_t* rowp = base + (size_t)(row0 + ai * HALF + m * 16) * ldc + col0;
#pragma unroll
                for (int bj = 0; bj < 2; ++bj) { const f32x4 v0 = acc[ai][bj][m][0], v1 = acc[ai][bj][m][1];
                    u32x4 w; w.x = cvt_pk_bf16(v0[0], v0[1]); w.y = cvt_pk_bf16(v0[2], v0[3]); w.z = cvt_pk_bf16(v1[0], v1[1]); w.w = cvt_pk_bf16(v1[2], v1[3]);
                    *(u32x4*)(rowp + bj * HALF) = w; } }
    }
};
struct EpiBf16Plain {
    static constexpr bool PERM = true, AFTER_DRAIN = false;
    bf16_t* O; int ldc;
    __device__ __forceinline__ void operator()(const f32x4 (&acc)[2][2][4][2], const Unit& u, int wr, int wc, int fr, int fq) const {
        const int row0 = u.pm * BM + wr * 64 + fr, col0 = u.pn * BM + wc * 32 + 8 * fq;
#pragma unroll
        for (int ai = 0; ai < 2; ++ai)
#pragma unroll
            for (int m = 0; m < 4; ++m) { bf16_t* rowp = O + (size_t)(row0 + ai * HALF + m * 16) * ldc + col0;
#pragma unroll
                for (int bj = 0; bj < 2; ++bj) { const f32x4 v0 = acc[ai][bj][m][0], v1 = acc[ai][bj][m][1];
                    u32x4 w; w.x = cvt_pk_bf16(v0[0], v0[1]); w.y = cvt_pk_bf16(v0[2], v0[3]); w.z = cvt_pk_bf16(v1[0], v1[1]); w.w = cvt_pk_bf16(v1[2], v1[3]);
                    *(u32x4*)(rowp + bj * HALF) = w; } }
    }
};
struct EpiF32Plain {
    static constexpr bool PERM = false, AFTER_DRAIN = false;
    float* C; int ldc;
    __device__ __forceinline__ void operator()(const f32x4 (&acc)[2][2][4][2], const Unit& u, int wr, int wc, int fr, int fq) const {
        const int row0 = u.pm * BM + wr * 64 + fr, col0 = u.pn * BM + wc * 32 + 4 * fq;
#pragma unroll
        for (int ai = 0; ai < 2; ++ai)
#pragma unroll
            for (int m = 0; m < 4; ++m) { float* rowp = C + (size_t)(row0 + ai * HALF + m * 16) * ldc + col0;
#pragma unroll
                for (int bj = 0; bj < 2; ++bj)
#pragma unroll
                    for (int n = 0; n < 2; ++n) *(f32x4*)(rowp + bj * HALF + n * 16) = acc[ai][bj][m][n]; }
    }
};
struct MoeOrder {
    const PG8_LAS int* tab; const int* list; int G, c, sh;
    __device__ __forceinline__ bool next(int i, Unit& u) const {
        const int L = i * G + c, total = tab[32] << sh; if (L >= total) return false;
        const int T = L >> sh, nt = L & ((1 << sh) - 1); int e = 0; while (tab[e + 1] <= T) ++e;
        u.pm = T; u.pn = (e << sh) + nt; return true; }
    __device__ __forceinline__ int a_row(const Unit& u, int r) const { const int e = u.pn >> sh; const int pos = (u.pm - tab[e]) * 256 + r; return pos < tab[33 + e] ? list[e * NTOK + pos] : 0; }
    __device__ __forceinline__ void a_ready(const Unit&) const {}
    __device__ __forceinline__ void done(const Unit&) const {}
};
struct EpiSwiglu {
    static constexpr bool PERM = true, AFTER_DRAIN = false;
    bf16_t* HID;
    __device__ __forceinline__ void operator()(const f32x4 (&acc)[2][2][4][2], const Unit& u, int wr, int wc, int fr, int fq) const {
        const int row0 = u.pm * BM + wr * 64 + fr, col0 = (u.pn & 1) * 128 + wc * 32 + 8 * fq;
#pragma unroll
        for (int ai = 0; ai < 2; ++ai)
#pragma unroll
            for (int m = 0; m < 4; ++m) { bf16_t* rowp = HID + (size_t)(row0 + ai * HALF + m * 16) * 256 + col0; float h[8];
#pragma unroll
                for (int n = 0; n < 2; ++n)
#pragma unroll
                    for (int j = 0; j < 4; ++j) { const float gte = acc[ai][0][m][n][j], up = acc[ai][1][m][n][j];
                        h[n * 4 + j] = gte * __builtin_amdgcn_rcpf(1.0f + __builtin_amdgcn_exp2f(-gte * 1.4426950408889634f)) * up; }
                u32x4 w; w.x = cvt_pk_bf16(h[0], h[1]); w.y = cvt_pk_bf16(h[2], h[3]); w.z = cvt_pk_bf16(h[4], h[5]); w.w = cvt_pk_bf16(h[6], h[7]);
                *(u32x4*)rowp = w; }
    }
};
struct EpiDown {
    static constexpr bool PERM = true, AFTER_DRAIN = false;
    bf16_t* Y;
    __device__ __forceinline__ void operator()(const f32x4 (&acc)[2][2][4][2], const Unit& u, int wr, int wc, int fr, int fq) const {
        const int row0 = u.pm * BM + wr * 64 + fr, col0 = (u.pn & 3) * BM + wc * 32 + 8 * fq;
#pragma unroll
        for (int ai = 0; ai < 2; ++ai)
#pragma unroll
            for (int m = 0; m < 4; ++m) { bf16_t* rowp = Y + (size_t)(row0 + ai * HALF + m * 16) * 1024 + col0;
#pragma unroll
                for (int bj = 0; bj < 2; ++bj) { const f32x4 v0 = acc[ai][bj][m][0], v1 = acc[ai][bj][m][1];
                    u32x4 w; w.x = cvt_pk_bf16(v0[0], v0[1]); w.y = cvt_pk_bf16(v0[2], v0[3]); w.z = cvt_pk_bf16(v1[0], v1[1]); w.w = cvt_pk_bf16(v1[2], v1[3]);
                    *(u32x4*)(rowp + bj * HALF) = w; } }
    }
};
}

DI void kmax_phase(const Params& p, int gw, int NGW, int lane) {
    unsigned char* ws = p.ws; unsigned* ctl = (unsigned*)(ws + WS_CTL);
    const bf16_t* Kb = (const bf16_t*)(ws + WS_KB); const bf16_t* MKV = (const bf16_t*)(ws + WS_MKV);
    for (int grp = gw; grp < NTOK / 8; grp += NGW) {
        float mx = 0.f;
#pragma unroll
        for (int r = 0; r < 8; ++r) { const u32x4 v = *(const u32x4*)(Kb + (size_t)(grp * 8 + r) * 512 + lane * 8); float s = 0.f;
#pragma unroll
            for (int j = 0; j < 4; ++j) { const float a = __uint_as_float(v[j] << 16), b = __uint_as_float(v[j] & 0xffff0000u); s += a * a + b * b; }
            s += __shfl_xor(s, 1); s += __shfl_xor(s, 2); s += __shfl_xor(s, 4); mx = fmaxf(mx, s); }
        if ((lane & 7) == 0) atomicMax(ctl + CW_KMAX + ((grp * 8) / SEQ) * 8 + (lane >> 3), __float_as_uint(mx));
    }
    for (int grp = gw; grp < NB * MEMLEN / 8; grp += NGW) {
        float mx = 0.f;
#pragma unroll
        for (int r = 0; r < 8; ++r) { const u32x4 v = *(const u32x4*)(MKV + (size_t)(grp * 8 + r) * 512 + (lane & 31) * 8); float s = 0.f;
#pragma unroll
            for (int j = 0; j < 4; ++j) { const float a = __uint_as_float(v[j] << 16), b = __uint_as_float(v[j] & 0xffff0000u); s += a * a + b * b; }
            s += __shfl_xor(s, 1); s += __shfl_xor(s, 2); s += __shfl_xor(s, 4); mx = fmaxf(mx, s); }
        if (lane < 32 && (lane & 7) == 0) atomicMax(ctl + CW_KMAXM + ((grp * 8) / MEMLEN) * 4 + (lane >> 3), __float_as_uint(mx));
    }
}

namespace att {
#define ALAS __attribute__((address_space(3)))
typedef short bf16x8 __attribute__((ext_vector_type(8)));
typedef short s16x4 __attribute__((ext_vector_type(4)));
typedef short v4i16_t __attribute__((ext_vector_type(4)));
typedef float f32x16 __attribute__((ext_vector_type(16)));
typedef float f32x2_t __attribute__((ext_vector_type(2)));
typedef __bf16 bf16x2_t __attribute__((ext_vector_type(2)));
constexpr int KOFF = 0, VOFF = 16384, TOFF = 49152, ATT_LDS = TOFF + 1024;
DI unsigned cvtpk(float lo, float hi) { f32x2_t v = {lo, hi}; bf16x2_t b = __builtin_convertvector(v, bf16x2_t); return __builtin_bit_cast(unsigned, b); }
DI s16x4 vtr(const ALAS unsigned char* q) { return __builtin_bit_cast(s16x4, __builtin_amdgcn_ds_read_tr16_b64_v4i16((ALAS v4i16_t*)q)); }
#define ATT_MFMA(a, b, c) __builtin_amdgcn_mfma_f32_32x32x16_bf16((a), (b), (c), 0, 0, 0)

template <int NDT, bool BAND>
DI void tile(const ALAS unsigned char* kb, const ALAS unsigned char* vb, const bf16x8 (&qr)[4], const f32x16& cinit, f32x16 (&o)[NDT], float& lsum,
             const ALAS float* tbl, int relbase, float mrow) {
    f32x16 p0, p1;
#pragma unroll
    for (int d0 = 0; d0 < 4; ++d0) {
        const bf16x8 b0 = *(const ALAS bf16x8*)(kb + d0 * 2048), b1 = *(const ALAS bf16x8*)(kb + d0 * 2048 + 512);
        if (d0 == 0) { if (BAND) { const f32x16 z = {0.f,0.f,0.f,0.f,0.f,0.f,0.f,0.f,0.f,0.f,0.f,0.f,0.f,0.f,0.f,0.f}; p0 = ATT_MFMA(b0, qr[0], z); p1 = ATT_MFMA(b1, qr[0], z); }
                       else { p0 = ATT_MFMA(b0, qr[0], cinit); p1 = ATT_MFMA(b1, qr[0], cinit); } }
        else { p0 = ATT_MFMA(b0, qr[d0], p0); p1 = ATT_MFMA(b1, qr[d0], p1); }
    }
    if (BAND) {
#pragma unroll
        for (int r = 0; r < 16; ++r) {
            const int rel0 = relbase + (r & 3) + 8 * (r >> 2);
            const int i0 = min(max(rel0 + 128, 0), 255), i1 = min(max(rel0 + 160, 0), 255);
            p0[r] += tbl[i0] - mrow; p1[r] += tbl[i1] - mrow;
        }
    }
    float s = 0.f;
#pragma unroll
    for (int r = 0; r < 16; ++r) { p0[r] = __builtin_amdgcn_exp2f(p0[r]); p1[r] = __builtin_amdgcn_exp2f(p1[r]); s += p0[r] + p1[r]; }
    lsum += s;
    u32x4 w0, w1, w2, w3;
    w0.x = cvtpk(p0[0], p0[1]); w0.y = cvtpk(p0[2], p0[3]); w0.z = cvtpk(p0[4], p0[5]); w0.w = cvtpk(p0[6], p0[7]);
    w1.x = cvtpk(p0[8], p0[9]); w1.y = cvtpk(p0[10], p0[11]); w1.z = cvtpk(p0[12], p0[13]); w1.w = cvtpk(p0[14], p0[15]);
    w2.x = cvtpk(p1[0], p1[1]); w2.y = cvtpk(p1[2], p1[3]); w2.z = cvtpk(p1[4], p1[5]); w2.w = cvtpk(p1[6], p1[7]);
    w3.x = cvtpk(p1[8], p1[9]); w3.y = cvtpk(p1[10], p1[11]); w3.z = cvtpk(p1[12], p1[13]); w3.w = cvtpk(p1[14], p1[15]);
    const bf16x8 pb0 = __builtin_bit_cast(bf16x8, w0), pb1 = __builtin_bit_cast(bf16x8, w1), pb2 = __builtin_bit_cast(bf16x8, w2), pb3 = __builtin_bit_cast(bf16x8, w3);
#pragma unroll
    for (int dt = 0; dt < NDT; ++dt) {
        __builtin_amdgcn_sched_barrier(0);
#pragma unroll
        for (int ks = 0; ks < 4; ++ks) {
            const s16x4 lo = vtr(vb + (dt * 4 + ks) * 1024), hh = vtr(vb + (dt * 4 + ks) * 1024 + 512);
            const bf16x8 a = __builtin_shufflevector(lo, hh, 0, 1, 2, 3, 4, 5, 6, 7);
            o[dt] = ATT_MFMA(a, ks == 0 ? pb0 : ks == 1 ? pb1 : ks == 2 ? pb2 : pb3, o[dt]);
        }
    }
}

template <int DV, bool DIFF>
DI void attn_unit(ALAS unsigned char* lds, const Params& p, int unit, int wid, int lane) {
    unsigned char* ws = p.ws; const unsigned* ctl = (const unsigned*)(ws + WS_CTL);
    const int tid = threadIdx.x, r32 = lane & 31, hi = lane >> 5;
    constexpr int NDT = DV / 32, VBYTES = DV * 128, NCOMP = DIFF ? 2 : 1, NT = DIFF ? 64 : 4;
    int b, h, qb, qpitch, ocol; size_t kbase; const bf16_t *Qg, *Kg, *Vg;
    if (DIFF) { b = unit >> 6; h = (unit >> 4) & 3; qb = unit & 15; Qg = (const bf16_t*)(ws + WS_QB) + h * 128; qpitch = 512; Kg = (const bf16_t*)(ws + WS_KB) + h * 128;
        Vg = (const bf16_t*)(ws + WS_VB) + h * 128; kbase = (size_t)b * SEQ; ocol = h * 128; }
    else { const int qblk = unit >> 2; h = unit & 3; b = qblk >> 4; qb = qblk & 15; Qg = (const bf16_t*)(ws + WS_MQB) + h * 64; qpitch = 256; Kg = (const bf16_t*)(ws + WS_MKV) + h * 64;
        Vg = (const bf16_t*)(ws + WS_MKV) + 256 + h * 64; kbase = (size_t)b * MEMLEN; ocol = 768 + h * 64; }
    const int row0 = b * SEQ + qb * 256, qa = qb * 256 + wid * 32;
    const ALAS float* tbl = (const ALAS float*)(lds + TOFF);
    float bmax = 0.f, cL = 0.f, cR = 0.f, lam = 0.f;
    __syncthreads();
    if (DIFF) {
        const float* rb = p.in[I_RELB];
        if (tid < 256) ((ALAS float*)(lds + TOFF))[tid] = rb[t5_bucket(tid - 128) * 4 + h] * LOG2E;
        float bm = -1e30f;
        for (int i = 0; i < 32; ++i) bm = fmaxf(bm, rb[i * 4 + h]);
        bmax = bm * LOG2E; cL = rb[15 * 4 + h] * LOG2E; cR = rb[31 * 4 + h] * LOG2E;
        float s1 = 0.f, s2 = 0.f;
        for (int i = 0; i < 64; ++i) { s1 += p.in[I_LQ1][i] * p.in[I_LK1][i]; s2 += p.in[I_LQ2][i] * p.in[I_LK2][i]; }
        lam = expf(s1) - expf(s2) + LAM_INIT;
        __syncthreads();
    }
    const int tL = DIFF ? (qa >= 154 ? (qa - 154) / 64 + 1 : 0) : NT;
    const int tR = DIFF ? (qa + 185) / 64 : NT;
    const int vlane = (4 * hi + ((lane & 15) >> 2)) * 64 + ((lane >> 4) & 1) * 32 + (lane & 3) * 8;
#pragma unroll 1
    for (int c = 0; c < NCOMP; ++c) {
        const bf16_t* Qp = Qg + (size_t)(row0 + wid * 32 + r32) * qpitch + c * 64 + hi * 8;
        bf16x8 qr[4]; float qq = 0.f;
#pragma unroll
        for (int d0 = 0; d0 < 4; ++d0) { qr[d0] = *(const bf16x8*)(Qp + d0 * 16);
#pragma unroll
            for (int j = 0; j < 8; ++j) { const float f = __uint_as_float(((unsigned)(unsigned short)qr[d0][j]) << 16); qq += f * f; } }
        qq += __shfl_xor(qq, 32);
        const float kmx = sqrtf(__uint_as_float(DIFF ? ctl[CW_KMAX + b * 8 + h * 2 + c] : ctl[CW_KMAXM + b * 4 + h]));
        const float mrow = sqrtf(qq) * kmx * 1.0001f + bmax;
        f32x16 cinit;
#pragma unroll
        for (int r = 0; r < 16; ++r) cinit[r] = cL - mrow;
        f32x16 o[NDT];
#pragma unroll
        for (int dt = 0; dt < NDT; ++dt)
#pragma unroll
            for (int r = 0; r < 16; ++r) o[dt][r] = 0.f;
        float lsum = 0.f;
        const bf16_t* ksrc = Kg + (kbase + lane) * 512 + c * 64 + wid * 8;
#define ATT_DMA(t, buf) do { \
        __builtin_amdgcn_global_load_lds((const unsigned*)(ksrc + (size_t)(t) * 64 * 512), (ALAS unsigned*)(lds + KOFF + (buf) * 8192 + wid * 1024), 16, 0, 0); \
        _Pragma("unroll") for (int i_ = 0; i_ < DV / 64; ++i_) { const int pid_ = wid + 8 * i_; \
            __builtin_amdgcn_global_load_lds((const unsigned*)(Vg + (kbase + (size_t)(t) * 64 + 16 * (pid_ & 3) + (lane >> 2)) * 512 + 32 * (pid_ >> 2) + 8 * (lane & 3)), \
                                             (ALAS unsigned*)(lds + VOFF + (buf) * VBYTES + pid_ * 1024), 16, 0, 0); } } while (0)
        ATT_DMA(0, 0);
        asm volatile("s_waitcnt vmcnt(0)" ::: "memory");
        __syncthreads();
#pragma unroll 1
        for (int t = 0; t < NT; ++t) {
            const int buf = t & 1;
            if (t + 1 < NT) ATT_DMA(t + 1, buf ^ 1);
            if (DIFF && t == tR) {
                float dlt = cR - cL; asm volatile("" : "+v"(dlt));
#pragma unroll
                for (int r = 0; r < 16; ++r) cinit[r] += dlt;
            }
            const ALAS unsigned char* kb = lds + KOFF + buf * 8192 + hi * 1024 + r32 * 16;
            const ALAS unsigned char* vb = lds + VOFF + buf * VBYTES + vlane;
            if (DIFF && t >= tL && t < tR) tile<NDT, true>(kb, vb, qr, cinit, o, lsum, tbl, t * 64 + 4 * hi - qa - r32, mrow);
            else tile<NDT, false>(kb, vb, qr, cinit, o, lsum, tbl, 0, 0.f);
            asm volatile("s_waitcnt vmcnt(0)" ::: "memory");
            __syncthreads();
        }
#undef ATT_DMA
        lsum += __shfl_xor(lsum, 32);
        const float inv = 1.0f / lsum;
        int lane2 = lane; asm volatile("" : "+v"(lane2));
        const int r32b = lane2 & 31, hib = lane2 >> 5;
        float* o1p = (float*)(ws + WS_O1) + ((size_t)(unit * 8 + wid) * 64 + lane2) * 64;
        if (DIFF && c == 0) {
#pragma unroll
            for (int dt = 0; dt < NDT; ++dt)
#pragma unroll
                for (int r = 0; r < 16; ++r) o1p[dt * 16 + r] = o[dt][r] * inv;
        } else {
            bf16_t* Ob = (bf16_t*)(ws + WS_OB) + (size_t)(row0 + wid * 32 + r32b) * 1024 + ocol + 4 * hib;
            if (DIFF) {
                float ss = 0.f;
#pragma unroll
                for (int dt = 0; dt < NDT; ++dt)
#pragma unroll
                    for (int r = 0; r < 16; ++r) { const float v = o1p[dt * 16 + r] - lam * (o[dt][r] * inv); o[dt][r] = v; ss += v * v; }
                ss += __shfl_xor(ss, 32);
                const float rn = (1.0f - LAM_INIT) / sqrtf(ss * (1.0f / 128.0f) + LN_EPS);
#pragma unroll
                for (int dt = 0; dt < NDT; ++dt)
#pragma unroll
                    for (int g4 = 0; g4 < 4; ++g4) { const int d0 = 32 * dt + 8 * g4; const f32x4 sg = *(const f32x4*)(p.in[I_SUBG] + d0 + 4 * hib);
                        u32x2 w; w.x = cvtpk(o[dt][4 * g4] * rn * sg.x, o[dt][4 * g4 + 1] * rn * sg.y); w.y = cvtpk(o[dt][4 * g4 + 2] * rn * sg.z, o[dt][4 * g4 + 3] * rn * sg.w);
                        *(u32x2*)(Ob + d0) = w; }
            } else {
#pragma unroll
                for (int dt = 0; dt < NDT; ++dt)
#pragma unroll
                    for (int g4 = 0; g4 < 4; ++g4) { const int d0 = 32 * dt + 8 * g4;
                        u32x2 w; w.x = cvtpk(o[dt][4 * g4] * inv, o[dt][4 * g4 + 1] * inv); w.y = cvtpk(o[dt][4 * g4 + 2] * inv, o[dt][4 * g4 + 3] * inv);
                        *(u32x2*)(Ob + d0) = w; }
            }
        }
    }
}
}

template <bool DUAL, bool BKN, class LA, class LB, class EP>
DI void ngemm_tile(float* As, float* Bs, float* Bs2, int K, const LA& la, const LB& lb, const LB& lb2, const EP& ep) {
    const int tid = threadIdx.x, ty = tid >> 4, tx = tid & 15;
    float acc[4][4], acc2[4][4];
#pragma unroll
    for (int i = 0; i < 4; ++i)
#pragma unroll
        for (int j = 0; j < 4; ++j) { acc[i][j] = 0.f; acc2[i][j] = 0.f; }
    for (int kc = 0; kc < K; kc += 32) {
        __syncthreads();
#pragma unroll
        for (int j = 0; j < 8; ++j) { const int i = tid + 512 * j, k = i & 31, r = i >> 5; As[k * 132 + r] = la(r, kc + k); }
#pragma unroll
        for (int j = 0; j < 4; ++j) { const int i = tid + 512 * j; int k, n; if (BKN) { n = i & 63; k = i >> 6; } else { k = i & 31; n = i >> 5; }
            Bs[k * 68 + n] = lb(kc + k, n); if (DUAL) Bs2[k * 68 + n] = lb2(kc + k, n); }
        __syncthreads();
#pragma unroll 8
        for (int k = 0; k < 32; ++k) {
            const f32x4 a = *(const f32x4*)&As[k * 132 + ty * 4]; const f32x4 b = *(const f32x4*)&Bs[k * 68 + tx * 4];
#pragma unroll
            for (int i = 0; i < 4; ++i)
#pragma unroll
                for (int j = 0; j < 4; ++j) acc[i][j] += a[i] * b[j];
            if (DUAL) { const f32x4 b2 = *(const f32x4*)&Bs2[k * 68 + tx * 4];
#pragma unroll
                for (int i = 0; i < 4; ++i)
#pragma unroll
                    for (int j = 0; j < 4; ++j) acc2[i][j] += a[i] * b2[j]; }
        }
    }
#pragma unroll
    for (int i = 0; i < 4; ++i)
#pragma unroll
        for (int j = 0; j < 4; ++j) ep(ty * 4 + i, tx * 4 + j, acc[i][j], acc2[i][j]);
}

struct LA_bf { const bf16_t* A; int lda; DI float operator()(int r, int k) const { return bf2f(A[(size_t)r * lda + k]); } };
struct LB_bf { const bf16_t* B; int ldb; DI float operator()(int k, int n) const { return bf2f(B[(size_t)n * ldb + k]); } };
struct EP_inproj { unsigned char* ws; int m0, n0;
    DI void operator()(int r, int n, float v, float) const { const int row = m0 + r, c = n0 + n; bf16_t* dst;
        if (c < 512) dst = (bf16_t*)(ws + WS_QB) + (size_t)row * 512 + c; else if (c < 1024) dst = (bf16_t*)(ws + WS_KB) + (size_t)row * 512 + (c - 512);
        else if (c < 1536) dst = (bf16_t*)(ws + WS_VB) + (size_t)row * 512 + (c - 1024); else if (c < 1792) dst = (bf16_t*)(ws + WS_MQB) + (size_t)row * 256 + (c - 1536);
        else dst = (bf16_t*)(ws + WS_ZB) + (size_t)row * 512 + (c - 1792);
        *dst = (bf16_t)f2bf(v); } };
struct EP_bf { bf16_t* C; int ldc; int m0, n0; DI void operator()(int r, int n, float v, float) const { C[(size_t)(m0 + r) * ldc + n0 + n] = (bf16_t)f2bf(v); } };
struct EP_f32 { float* C; int ldc; int m0, n0; DI void operator()(int r, int n, float v, float) const { C[(size_t)(m0 + r) * ldc + n0 + n] = v; } };

struct LA_dft { const float* ct; int s0; DI float operator()(int r, int k) const { const int sp = s0 + r, s = k & 4095; const int idx = (s * sp) & 4095;
    return (k < 4096) ? ct[idx] : -ct[(idx - 1024) & 4095]; } };
struct LB_z { const bf16_t* Z; int n0; DI float operator()(int k, int n) const { return bf2f(Z[(size_t)(k & 4095) * 512 + (k >> 12) * 256 + n0 + n]); } };
struct EP_ob { bf16_t* O; int row0, col0; DI void operator()(int r, int n, float v, float) const { O[(size_t)(row0 + r) * 1024 + col0 + n] = (bf16_t)f2bf(v); } };
DI void nfourier_phase(const Params& p, float* As, float* Bs, int bid, int nb) {
    unsigned char* ws = p.ws; const float* ct = (const float*)(ws + WS_COSTAB);
    const int nT = NB * 32 * 4;
    for (int t = bid; t < nT; t += nb) {
        const int b = t / 128, q = t % 128, s0 = (q / 4) * 128, n0 = (q % 4) * 64;
        LA_dft la{ct, s0}; LB_z lb{(const bf16_t*)(ws + WS_ZB) + (size_t)b * SEQ * 512, n0}; EP_ob ep{(bf16_t*)(ws + WS_OB), b * SEQ + s0, 512 + n0};
        ngemm_tile<false, true>(As, Bs, Bs, 8192, la, lb, lb, ep);
    }
}

constexpr int P5_WA = 0, P5_WB = 131072 + 4096, P5_LG = P5_WB + 16384;
DI void p4_ln1_router(const Params& p, __attribute__((address_space(3))) unsigned char* lds, int gw, int NGW, int wave, int lane) {
    typedef __attribute__((address_space(3))) unsigned char* lptr;
    unsigned char* ws = p.ws;
    const float* Aout = (const float*)(ws + WS_AOUT); const float* st0 = (const float*)(ws + WS_STATS0); bf16_t* H1 = (bf16_t*)(ws + WS_XN);
    const float* WR = (const float*)(ws + WS_WR); unsigned* cnt = (unsigned*)(ws + WS_CTL) + CW_CNT; int* info = (int*)(ws + WS_TOKINFO); int* list = (int*)(ws + WS_LIST);
    __attribute__((address_space(3))) float* lg = (__attribute__((address_space(3))) float*)(lds + P5_LG) + wave * (8 * 36);
    __syncthreads();
#pragma unroll
    for (int i = 0; i < 18; ++i) { const int pc = wave * 18 + i, e = pc >> 2, part = pc & 3;
        const lptr dst = (e < 4) ? (lds + P5_WB + e * 4096 + part * 1024) : (lds + P5_WA + (e - 4) * 4096 + part * 1024);
        __builtin_amdgcn_global_load_lds((const unsigned*)(WR + (size_t)e * 1024 + part * 256 + lane * 4), (__attribute__((address_space(3))) unsigned*)dst, 16, 0, 0); }
    const f32x4* g0p = (const f32x4*)p.in[I_LN0G] + lane; const f32x4* b0p = (const f32x4*)p.in[I_LN0B] + lane;
    const f32x4* g1p = (const f32x4*)p.in[I_LN1G] + lane; const f32x4* b1p = (const f32x4*)p.in[I_LN1B] + lane;
    for (int grp = gw; grp < NTOK / 8; grp += NGW) {
        f32x4 hv[8][4];
        f32x4 cx[4], ca[4];
        { const int row = grp * 8; const f32x4* xr = (const f32x4*)(p.in[I_X] + (size_t)row * DM) + lane; const f32x4* ar = (const f32x4*)(Aout + (size_t)row * DM) + lane;
#pragma unroll
          for (int j = 0; j < 4; ++j) { cx[j] = xr[64 * j]; ca[j] = ar[64 * j]; } }
#pragma unroll
        for (int r = 0; r < 8; ++r) {
            const int row = grp * 8 + r;
            f32x4 nx[4], na[4];
            if (r < 7) { const f32x4* xr = (const f32x4*)(p.in[I_X] + (size_t)(row + 1) * DM) + lane; const f32x4* ar = (const f32x4*)(Aout + (size_t)(row + 1) * DM) + lane;
#pragma unroll
                for (int j = 0; j < 4; ++j) { nx[j] = xr[64 * j]; na[j] = ar[64 * j]; } }
            const float mu0 = st0[2 * row], rs0 = st0[2 * row + 1];
            float s = 0.f;
#pragma unroll
            for (int j = 0; j < 4; ++j) { const f32x4 h0 = (cx[j] - mu0) * rs0 * g0p[64 * j] + b0p[64 * j]; hv[r][j] = h0 * ALPHA + ca[j]; s += (hv[r][j].x + hv[r][j].y) + (hv[r][j].z + hv[r][j].w); }
            const float mean = wave_sum2(s) * (1.f / DM); float s2 = 0.f;
#pragma unroll
            for (int j = 0; j < 4; ++j) { hv[r][j] = hv[r][j] - mean; s2 += (hv[r][j].x * hv[r][j].x + hv[r][j].y * hv[r][j].y) + (hv[r][j].z * hv[r][j].z + hv[r][j].w * hv[r][j].w); }
            const float rstd = 1.f / sqrtf(wave_sum2(s2) * (1.f / DM) + LN_EPS);
            u32x2* o8 = (u32x2*)(H1 + (size_t)row * DM) + lane;
#pragma unroll
            for (int j = 0; j < 4; ++j) { hv[r][j] = hv[r][j] * rstd * g1p[64 * j] + b1p[64 * j]; u32x2 w; w.x = pk2(hv[r][j].x, hv[r][j].y); w.y = pk2(hv[r][j].z, hv[r][j].w); o8[64 * j] = w; }
            if (r < 7) {
#pragma unroll
                for (int j = 0; j < 4; ++j) { cx[j] = nx[j]; ca[j] = na[j]; } }
        }
        if (grp == gw) { asm volatile("s_waitcnt vmcnt(0)" ::: "memory"); __syncthreads(); }
        const bool b3 = (lane >> 3) & 1;
#pragma unroll 4
        for (int e = 0; e < 36; ++e) {
            const lptr wb = (e < 4) ? (lds + P5_WB + e * 4096) : (lds + P5_WA + (e - 4) * 4096);
            const __attribute__((address_space(3))) f32x4* wr = (const __attribute__((address_space(3))) f32x4*)wb + lane;
            const f32x4 w0 = wr[0], w1 = wr[64], w2 = wr[128], w3 = wr[192];
            float part[8];
#pragma unroll
            for (int r = 0; r < 8; ++r) { const f32x4 t = hv[r][0] * w0 + hv[r][1] * w1 + hv[r][2] * w2 + hv[r][3] * w3; part[r] = (t.x + t.y) + (t.z + t.w); }
            float q[4], q2[2];
#pragma unroll
            for (int r = 0; r < 4; ++r) { auto sw = __builtin_amdgcn_permlane32_swap(__float_as_uint(part[r]), __float_as_uint(part[r + 4]), false, false); q[r] = __uint_as_float(sw[0]) + __uint_as_float(sw[1]); }
#pragma unroll
            for (int r = 0; r < 2; ++r) { auto sw = __builtin_amdgcn_permlane16_swap(__float_as_uint(q[r]), __float_as_uint(q[r + 2]), false, false); q2[r] = __uint_as_float(sw[0]) + __uint_as_float(sw[1]); }
            const float snd = b3 ? q2[0] : q2[1], kp = b3 ? q2[1] : q2[0];
            float q3 = kp + dppf<0x128>(snd);
            q3 += dppf<0xB1>(q3); q3 += dppf<0x4E>(q3); q3 += dppf<0x141>(q3);
            if ((lane & 7) == 0) lg[(lane >> 3) * 36 + e] = q3;
        }
        asm volatile("s_waitcnt lgkmcnt(0)" ::: "memory");
        if (lane < 8) {
            const int row = grp * 8 + lane; const __attribute__((address_space(3))) float* L = lg + lane * 36;
            float gl[4]; int gs = 0; float gm;
#pragma unroll
            for (int j = 0; j < 4; ++j) gl[j] = L[j] + p.in[I_BG][j];
            gm = gl[0];
#pragma unroll
            for (int j = 1; j < 4; ++j) if (gl[j] > gm) { gm = gl[j]; gs = j; }
            float den = 0.f;
#pragma unroll
            for (int j = 0; j < 4; ++j) den += expf(gl[j] - gm);
            const float gate = 1.0f / den;
            float v0 = -1e30f, v1 = -1e30f; int i0 = 0, i1 = 0;
#pragma unroll
            for (int j = 0; j < 8; ++j) { const float v = L[4 + gs * 8 + j] + p.in[I_BRT][gs * 8 + j];
                if (v > v0) { v1 = v0; i1 = i0; v0 = v; i0 = j; } else if (v > v1) { v1 = v; i1 = j; } }
            const float ex = expf(v1 - v0); const float w0 = gate / (1.f + ex), w1 = gate * ex / (1.f + ex);
            const int e0 = gs * 8 + i0, e1 = gs * 8 + i1;
            const unsigned p0 = atomicAdd(cnt + e0, 1u), p1 = atomicAdd(cnt + e1, 1u);
            list[e0 * NTOK + p0] = row; list[e1 * NTOK + p1] = row;
            int* ii = info + (size_t)row * 8; ii[0] = e0; ii[1] = (int)p0; ii[2] = __float_as_int(w0); ii[3] = e1; ii[4] = (int)p1; ii[5] = __float_as_int(w1);
        }
        asm volatile("s_waitcnt lgkmcnt(0)" ::: "memory");
    }
    __syncthreads();
}

struct LA_gather { const bf16_t* H; const int* tok; DI float operator()(int r, int k) const { return bf2f(H[(size_t)tok[r] * 1024 + k]); } };
struct EP_hid { bf16_t* HID; int slot0, nvalid, n0; DI void operator()(int r, int n, float v1, float v3) const { if (r < nvalid) { const float s = v1 / (1.0f + expf(-v1)); HID[(size_t)(slot0 + r) * 256 + n0 + n] = (bf16_t)f2bf(s * v3); } } };
struct EP_y { bf16_t* Y; int slot0, nvalid, n0; DI void operator()(int r, int n, float v, float) const { if (r < nvalid) Y[(size_t)(slot0 + r) * 1024 + n0 + n] = (bf16_t)f2bf(v); } };
DI void nmoe_phase(const Params& p, int which, float* ldsf, int bid, int nb) {
    float* As = ldsf; float* Bs = ldsf + 32 * 132; float* Bs2 = Bs + 32 * 68; int* s_tok = (int*)(Bs2 + 32 * 68); int* s_cnt = s_tok + 128; int* s_tpre = s_cnt + 32; int* s_base = s_tpre + 33;
    unsigned char* ws = p.ws; const unsigned* cnt = (const unsigned*)(ws + WS_CTL) + CW_CNT; const int* list = (const int*)(ws + WS_LIST);
    const int tid = threadIdx.x;
    if (tid == 0) { int tp = 0, bs = 0; for (int e = 0; e < 32; ++e) { const int c = (int)cnt[e]; s_cnt[e] = c; s_tpre[e] = tp; s_base[e] = bs; tp += (c + 127) >> 7; bs += (c + 255) & ~255; } s_tpre[32] = tp; s_base[32] = bs; }
    __syncthreads();
    const int NT = which == 0 ? 4 : 16, total = s_tpre[32] * NT;
    for (int u = bid; u < total; u += nb) {
        const int T = u / NT, nt = u % NT; int e = 0; while (s_tpre[e + 1] <= T) ++e;
        const int mt = T - s_tpre[e], nvalid = min(128, s_cnt[e] - mt * 128), slot0 = s_base[e] + mt * 128;
        if (which == 0) {
            __syncthreads();
            if (tid < 128) s_tok[tid] = (tid < nvalid) ? list[e * NTOK + mt * 128 + tid] : 0;
            __syncthreads();
            const int j0 = nt * 64;
            const int r1 = e * 512 + (j0 >> 7) * 256 + (j0 & 127);
            LA_gather la{(const bf16_t*)(ws + WS_XN), s_tok}; LB_bf lb{(const bf16_t*)(ws + WS_W13T) + (size_t)r1 * 1024, 1024}; LB_bf lb2{(const bf16_t*)(ws + WS_W13T) + (size_t)(r1 + 128) * 1024, 1024};
            EP_hid ep{(bf16_t*)(ws + WS_OB), slot0, nvalid, j0};
            ngemm_tile<true, false>(As, Bs, Bs2, 1024, la, lb, lb2, ep);
        } else {
            LA_bf la{(const bf16_t*)(ws + WS_OB) + (size_t)slot0 * 256, 256}; LB_bf lb{(const bf16_t*)(ws + WS_W2T) + (size_t)(e * 1024 + nt * 64) * 256, 256};
            EP_y ep{(bf16_t*)(ws + WS_Y), slot0, nvalid, nt * 64};
            ngemm_tile<false, false>(As, Bs, Bs, 256, la, lb, lb, ep);
        }
    }
}

DI void p7_final(const Params& p, int gw, int NGW, int lane) {
    unsigned char* ws = p.ws; const unsigned* cnt = (const unsigned*)(ws + WS_CTL) + CW_CNT; const int* info = (const int*)(ws + WS_TOKINFO);
    const bf16_t* H1 = (const bf16_t*)(ws + WS_XN); const bf16_t* Y = (const bf16_t*)(ws + WS_Y);
    int base;
    { const int c = lane < 32 ? (int)cnt[lane] : 0; const int r = (c + 255) & ~255; int inc = r;
#pragma unroll
      for (int o = 1; o < 32; o <<= 1) { const int t = __shfl_up(inc, o); if ((lane & 31) >= o) inc += t; }
      base = inc - r; }
    for (int row = gw; row < NTOK; row += NGW) {
        const int* ii = info + (size_t)row * 8;
        const int e0 = ii[0], p0 = ii[1], e1 = ii[3], p1 = ii[4]; const float w0 = __int_as_float(ii[2]), w1 = __int_as_float(ii[5]);
        const size_t s0 = (size_t)(__shfl(base, e0) + p0), s1 = (size_t)(__shfl(base, e1) + p1);
        const u32x2* h8 = (const u32x2*)(H1 + (size_t)row * DM) + lane; const u32x2* y0 = (const u32x2*)(Y + s0 * DM) + lane; const u32x2* y1 = (const u32x2*)(Y + s1 * DM) + lane;
        f32x4 v[4]; float s = 0.f;
#pragma unroll
        for (int j = 0; j < 4; ++j) { const u32x2 a = h8[64 * j], b = y0[64 * j], c = y1[64 * j];
            v[j].x = ALPHA * __uint_as_float(a.x << 16) + w0 * __uint_as_float(b.x << 16) + w1 * __uint_as_float(c.x << 16);
            v[j].y = ALPHA * __uint_as_float(a.x & 0xffff0000u) + w0 * __uint_as_float(b.x & 0xffff0000u) + w1 * __uint_as_float(c.x & 0xffff0000u);
            v[j].z = ALPHA * __uint_as_float(a.y << 16) + w0 * __uint_as_float(b.y << 16) + w1 * __uint_as_float(c.y << 16);
            v[j].w = ALPHA * __uint_as_float(a.y & 0xffff0000u) + w0 * __uint_as_float(b.y & 0xffff0000u) + w1 * __uint_as_float(c.y & 0xffff0000u);
            s += (v[j].x + v[j].y) + (v[j].z + v[j].w); }
        const float mean = wave_sum(s) * (1.f / DM); float s2 = 0.f;
#pragma unroll
        for (int j = 0; j < 4; ++j) { v[j] = v[j] - mean; s2 += (v[j].x * v[j].x + v[j].y * v[j].y) + (v[j].z * v[j].z + v[j].w * v[j].w); }
        const float rstd = 1.f / sqrtf(wave_sum(s2) * (1.f / DM) + LN_EPS);
        f32x4* o = (f32x4*)(p.out + (size_t)row * DM) + lane;
#pragma unroll
        for (int j = 0; j < 4; ++j) { const f32x4 g = ((const f32x4*)p.in[I_LN2G])[lane + 64 * j], bb = ((const f32x4*)p.in[I_LN2B])[lane + 64 * j]; o[64 * j] = v[j] * rstd * g + bb; }
    }
}


#define LAS __attribute__((address_space(3)))
#define XB_TMO      128
#define XB_XCNT(j)  (256  + 64 * (j))
#define XB_XSUB(j)  (1280 + 64 * (j))
#define XB_XGEN(j)  (2304 + 64 * (j))
#define XB_TOP      3328
#define XB_TOPGEN   3392
#define XCD_BAR_WORDS 3456
#define XB_SPIN_CAP (1u << 18)

__device__ __forceinline__ unsigned xb_ld(unsigned* p)              { return __hip_atomic_load(p, __ATOMIC_RELAXED, __HIP_MEMORY_SCOPE_AGENT); }
__device__ __forceinline__ unsigned xb_add(unsigned* p, unsigned v) { return __hip_atomic_fetch_add(p, v, __ATOMIC_RELAXED, __HIP_MEMORY_SCOPE_AGENT); }
__device__ __forceinline__ unsigned xb_xcc_id() { return (unsigned)__builtin_amdgcn_s_getreg((3 << 11) | 20) & 0xFu; }
#define XB_SPIN(cond, bar) do { unsigned _sp = 0; while (cond) { __builtin_amdgcn_s_sleep(1); \
    if ((++_sp & 255u) == 0u) { if (xb_ld(&(bar)[XB_TMO])) break; if (_sp > XB_SPIN_CAP) { atomicAdd(&(bar)[XB_TMO], 1u); break; } } } } while (0)

struct XcdBarrier {
    unsigned* bar; unsigned x;
    volatile LAS unsigned* st;
};

__device__ __forceinline__ XcdBarrier xcd_barrier_post(unsigned* bar, volatile LAS unsigned* st) {
    XcdBarrier b; b.bar = bar; b.x = xb_xcc_id(); b.st = st;
    if (threadIdx.x == 0) (void)xb_add(&bar[XB_XCNT(b.x)], 1u);
    return b;
}
__device__ __forceinline__ void xcd_barrier_complete(unsigned* bar, unsigned x, unsigned& nloc, unsigned& nx) {
    const unsigned G = gridDim.x * gridDim.y * gridDim.z;
    unsigned sum, cnt, mine, sp = 0u;
    for (;;) {
        sum = 0u; cnt = 0u; mine = 0u;
#pragma unroll
        for (unsigned j = 0; j < 16; ++j) { const unsigned c = xb_ld(&bar[XB_XCNT(j)]); sum += c; cnt += (c > 0u) ? 1u : 0u; mine = (j == x) ? c : mine; }
        if (sum == G) break;
        __builtin_amdgcn_s_sleep(1);
        if ((++sp & 255u) == 0u) { if (xb_ld(&bar[XB_TMO])) break; if (sp > XB_SPIN_CAP) { atomicAdd(&bar[XB_TMO], 1u); break; } }
    }
    nloc = mine > 0u ? mine : 1u; nx = cnt > 0u ? cnt : 1u;
}

__device__ __forceinline__ void xcd_barrier(const XcdBarrier& b) {
    asm volatile("s_waitcnt vmcnt(0)" ::: "memory");
    __syncthreads();
    if (threadIdx.x == 0) {
        unsigned* bar = b.bar;
        __builtin_amdgcn_s_waitcnt(0);
        unsigned nloc = b.st[0], nx = b.st[1];
        if (nloc == 0u) { xcd_barrier_complete(bar, b.x, nloc, nx); b.st[0] = nloc; b.st[1] = nx; }
        const unsigned old = xb_add(&bar[XB_XSUB(b.x)], 1u);
        const unsigned gen = old / nloc;
        if (old + 1u == (gen + 1u) * nloc) {
            __builtin_amdgcn_fence(__ATOMIC_RELEASE, "agent");
            asm volatile("s_waitcnt vmcnt(0)" ::: "memory");
            const unsigned og = xb_add(&bar[XB_TOP], 1u);
            const unsigned tg = og / nx;
            if (og + 1u == (tg + 1u) * nx) xb_add(&bar[XB_TOPGEN], 1u);
            else XB_SPIN(xb_ld(&bar[XB_TOPGEN]) == tg, bar);
            __builtin_amdgcn_fence(__ATOMIC_ACQUIRE, "agent");
            xb_add(&bar[XB_XGEN(b.x)], 1u);
            asm volatile("s_waitcnt vmcnt(0)" ::: "memory");
        } else {
            XB_SPIN(xb_ld(&bar[XB_XGEN(b.x)]) == gen, bar);
            __builtin_amdgcn_fence(__ATOMIC_ACQUIRE, "agent");
            asm volatile("s_waitcnt vmcnt(0)" ::: "memory");
        }
    }
    __syncthreads();
}


namespace fft {
using att::bf16x8; using att::s16x4; using att::f32x16; using att::vtr; using att::cvtpk;
constexpr int XP = 1088, XOFF = 0, FOFF = 64 * XP;
template <int STAGE>
DI void fft_unit(ALAS unsigned char* lds, const Params& p, int unit, int wid, int lane) {
    constexpr int M = STAGE == 1 ? 128 : 64, MT = M / 32, CH = M * 16;
    unsigned char* ws = p.ws;
    const int tid = threadIdx.x, r32 = lane & 31, hi = lane >> 5;
    const int b = unit >> 6, u6 = unit & 63;
    __syncthreads();
    for (int idx = tid; idx < M * 128; idx += 512) {
        const int k = idx & 127, row = idx >> 7, part = k >> 6, kk = k & 63, rr = row & 63;
        const float ang = (float)((kk * rr) & 63) * (1.0f / 32.0f); const float c = cospif(ang), sn = sinpif(ang);
        float v;
        if (STAGE == 1) v = (row < 64) ? (part == 0 ? c : -sn) : (part == 0 ? -sn : -c);
        else v = part == 0 ? c : sn;
        *(ALAS bf16_t*)(lds + FOFF + (k >> 3) * CH + row * 16 + (k & 7) * 2) = (bf16_t)f2bf(v);
    }
    const bf16_t* src = STAGE == 1 ? (const bf16_t*)(ws + WS_ZB) + ((size_t)b * SEQ + u6) * 512 : (const bf16_t*)(ws + WS_ZS1) + ((size_t)(b * 64 + u6) * 64) * 512;
    const size_t rstride = STAGE == 1 ? (size_t)64 * 512 : (size_t)512;
#pragma unroll
    for (int i = 0; i < 8; ++i) { const int row = wid + 8 * i;
        __builtin_amdgcn_global_load_lds((const unsigned*)(src + row * rstride + lane * 8), (ALAS unsigned*)(lds + XOFF + row * XP), 16, 0, 0); }
    asm volatile("s_waitcnt vmcnt(0)" ::: "memory");
    __syncthreads();
    f32x16 acc[MT];
#pragma unroll
    for (int mt = 0; mt < MT; ++mt)
#pragma unroll
        for (int r = 0; r < 16; ++r) acc[mt][r] = 0.f;
    const ALAS unsigned char* xb = lds + XOFF + (8 * hi + ((lane & 15) >> 2)) * XP + (32 * wid + 16 * ((lane >> 4) & 1) + 4 * (lane & 3)) * 2;
    const ALAS unsigned char* fb = lds + FOFF + hi * CH + r32 * 16;
#pragma unroll
    for (int ks = 0; ks < 8; ++ks) {
        const ALAS unsigned char* bp = xb + (16 * (ks & 3)) * XP + (ks >> 2) * 512;
        const s16x4 lo = vtr(bp), hh = vtr(bp + 4 * XP);
        const bf16x8 bfr = __builtin_shufflevector(lo, hh, 0, 1, 2, 3, 4, 5, 6, 7);
#pragma unroll
        for (int mt = 0; mt < MT; ++mt) { const bf16x8 afr = *(const ALAS bf16x8*)(fb + (2 * ks) * CH + mt * 512); acc[mt] = ATT_MFMA(afr, bfr, acc[mt]); }
    }
    __syncthreads();
    const int col = 32 * wid + r32;
    if (STAGE == 1) {
#pragma unroll
        for (int mt = 0; mt < 2; ++mt)
#pragma unroll
            for (int r = 0; r < 16; ++r) { const int s1p = 32 * mt + (r & 3) + 8 * (r >> 2) + 4 * hi;
                const float x = (float)((s1p * u6) & 4095) * (1.0f / 4096.0f); const float ct = __builtin_amdgcn_cosf(x), st = __builtin_amdgcn_sinf(x);
                const float yr = acc[mt][r], yi = acc[mt + 2][r];
                *(ALAS bf16_t*)(lds + XOFF + s1p * 1024 + col * 2) = (bf16_t)f2bf(yr * ct + yi * st);
                *(ALAS bf16_t*)(lds + XOFF + s1p * 1024 + 512 + col * 2) = (bf16_t)f2bf(yi * ct - yr * st); }
        __syncthreads();
        bf16_t* dst = (bf16_t*)(ws + WS_ZS1);
#pragma unroll
        for (int i = 0; i < 8; ++i) { const int row = i * 8 + (tid >> 6), ch = tid & 63;
            const u32x4 v = *(const ALAS u32x4*)(lds + XOFF + row * 1024 + ch * 16);
            *(u32x4*)(dst + ((size_t)(b * 64 + row) * 64 + u6) * 512 + ch * 8) = v; }
    } else {
#pragma unroll
        for (int mt = 0; mt < 2; ++mt)
#pragma unroll
            for (int r = 0; r < 16; ++r) { const int s2p = 32 * mt + (r & 3) + 8 * (r >> 2) + 4 * hi;
                *(ALAS bf16_t*)(lds + XOFF + s2p * 512 + col * 2) = (bf16_t)f2bf(acc[mt][r]); }
        __syncthreads();
        bf16_t* dst = (bf16_t*)(ws + WS_OB);
#pragma unroll
        for (int i = 0; i < 4; ++i) { const int row = i * 16 + (tid >> 5), ch = tid & 31;
            const u32x4 v = *(const ALAS u32x4*)(lds + XOFF + row * 512 + ch * 16);
            *(u32x4*)(dst + ((size_t)b * SEQ + u6 + 64 * row) * 1024 + 512 + ch * 8) = v; }
    }
    __syncthreads();
}
}

constexpr int LDS_BYTES = 163840;
constexpr int LDSCTL_OFF = 131072, MISC_OFF = LDSCTL_OFF + 320;
constexpr int CW_BAR = 4096;
struct Args { Params p; int ph_lo, ph_hi; };
__global__ void __launch_bounds__(512, 2) mk_fwd(Args a) {
    extern __shared__ __attribute__((aligned(16))) unsigned char smem[];
    LAS unsigned char* lds = (LAS unsigned char*)smem;
    const int tid = threadIdx.x, lane = tid & 63, wave = __builtin_amdgcn_readfirstlane(tid >> 6);
    const int G = gridDim.x, bx = blockIdx.x, vcu = (G % 8 == 0) ? (bx % 8) * (G / 8) + bx / 8 : bx;
    const int lo = a.ph_lo, hi = a.ph_hi;
    unsigned char* ws = a.p.ws;
    volatile LAS unsigned* MISC = (volatile LAS unsigned*)(lds + MISC_OFF);
    for (int u = tid; u < (LDS_BYTES - LDSCTL_OFF) / 4; u += 512) ((LAS unsigned*)(lds + LDSCTL_OFF))[u] = 0u;
    __syncthreads();
    XcdBarrier bar = xcd_barrier_post((unsigned*)(ws + WS_CTL) + CW_BAR, MISC + 8);
#ifndef PHMASK
#define PHMASK 0xffff
#endif
#define IN(k) (((PHMASK >> (k)) & 1) && lo <= (k) && (k) < hi)
#define SEAM(k) do { if (IN(k) && IN((k) + 1)) xcd_barrier(bar); } while (0)
#ifndef REPMASK
#define REPMASK 0
#endif
    int one_ = 1; asm volatile("" : "+s"(one_));
#define REP(k) _Pragma("unroll 1") for (int rep_ = 0; rep_ < (((REPMASK >> (k)) & 1) ? one_ + 1 : 1); ++rep_)
    int kDM = DM, kDE = DEXP; asm volatile("" : "+s"(kDM), "+s"(kDE));
    if (IN(0)) REP(0) { p0_prologue(a.p, (float*)smem, vcu * 8 + wave, G * 8, wave, lane); }
    SEAM(0);
    if (IN(1)) REP(1) {
        { pg8::Gemm g{(const bf16_t*)(ws + WS_XN), (const bf16_t*)(ws + WS_WINT), NTOK, NIN, kDM}; pg8::StaticOrder S; S.init(NTOK, NIN, G, bx);
          pg8::EpiInproj E{ws}; pg8::gemm_phase<pg8::EpiInproj, pg8::StaticOrder, true, true>(lds, g, S, E); }
        { pg8::Gemm g{(const bf16_t*)(ws + WS_MEMB), (const bf16_t*)(ws + WS_WMT), NB * MEMLEN, 512, kDM}; pg8::StaticOrder S; S.init(NB * MEMLEN, 512, G, bx);
          pg8::EpiBf16Plain E{(bf16_t*)(ws + WS_MKV), 512}; pg8::gemm_phase<pg8::EpiBf16Plain, pg8::StaticOrder, true, true>(lds, g, S, E); }
    }
    SEAM(1);
    if (IN(2)) REP(2) { kmax_phase(a.p, vcu * 8 + wave, G * 8, lane); for (int u = vcu; u < 256; u += G) fft::fft_unit<1>(lds, a.p, u, wave, lane); }
    SEAM(2);
    if (IN(3)) REP(3) {
        for (int u = vcu; u < 256; u += G) att::attn_unit<128, true>(lds, a.p, u, wave, lane);
        { int lane_b = lane; asm volatile("" : "+v"(lane_b)); for (int u = vcu; u < 256; u += G) att::attn_unit<64, false>(lds, a.p, u, wave, lane_b); }
        { int lane_c = lane; asm volatile("" : "+v"(lane_c)); for (int u = vcu; u < 256; u += G) fft::fft_unit<2>(lds, a.p, u, wave, lane_c); }
    }
    SEAM(3);
    if (IN(4)) REP(4) {
        pg8::Gemm g{(const bf16_t*)(ws + WS_OB), (const bf16_t*)(ws + WS_WOT), NTOK, DM, kDM}; pg8::StaticOrder S; S.init(NTOK, DM, G, bx);
        pg8::EpiF32Plain E{(float*)(ws + WS_AOUT), DM}; pg8::gemm_phase<pg8::EpiF32Plain, pg8::StaticOrder, true, true>(lds, g, S, E);
    }
    SEAM(4);
    if (IN(5)) { p4_ln1_router(a.p, lds, vcu * 8 + wave, G * 8, wave, lane); }
    SEAM(5);
    LAS int* mtab = (LAS int*)(lds + LDSCTL_OFF + 1024);
    if (IN(6) || IN(7)) {
        if (tid == 0) { const unsigned* cnt = (const unsigned*)(ws + WS_CTL) + CW_CNT; int tp = 0;
            for (int e = 0; e < 32; ++e) { const int c = (int)cnt[e]; mtab[e] = tp; mtab[33 + e] = c; tp += (c + 255) >> 8; } mtab[32] = tp; }
        __syncthreads();
    }
    if (IN(6)) REP(6) {
        pg8::Gemm g{(const bf16_t*)(ws + WS_XN), (const bf16_t*)(ws + WS_W13T), 0, 0, kDM}; pg8::MoeOrder S{mtab, (const int*)(ws + WS_LIST), G, bx, 1};
        pg8::EpiSwiglu E{(bf16_t*)(ws + WS_OB)}; pg8::gemm_phase<pg8::EpiSwiglu, pg8::MoeOrder, true, true, true>(lds, g, S, E);
    }
    SEAM(6);
    if (IN(7)) REP(7) {
        pg8::Gemm g{(const bf16_t*)(ws + WS_OB), (const bf16_t*)(ws + WS_W2T), 0, 0, kDE}; pg8::MoeOrder S{mtab, (const int*)(ws + WS_LIST), G, bx, 2};
        pg8::EpiDown E{(bf16_t*)(ws + WS_Y)}; pg8::gemm_phase<pg8::EpiDown, pg8::MoeOrder, true, true, false>(lds, g, S, E);
    }
    SEAM(7);
    if (IN(8)) REP(8) { p7_final(a.p, vcu * 8 + wave, G * 8, lane); }
#undef IN
#undef SEAM
}

#ifndef N_LAUNCH_SPLIT
#define N_LAUNCH_SPLIT 0
#endif
extern "C" void kernel_launch(void* const* d_in, const int* in_sizes, int n_in, void* d_out, int out_size, void* d_ws, size_t ws_size, hipStream_t stream) {
    Params p{};
    for (int i = 0; i < 25; ++i) p.in[i] = (const float*)d_in[i];
    p.out = (float*)d_out; p.ws = (unsigned char*)d_ws;
    static int grid = 0;
    if (!grid) {
        (void)hipFuncSetAttribute((const void*)mk_fwd, hipFuncAttributeMaxDynamicSharedMemorySize, LDS_BYTES);
        int dev = 0, cus = 0, per_cu = 0;
        (void)hipGetDevice(&dev); (void)hipDeviceGetAttribute(&cus, hipDeviceAttributeMultiprocessorCount, dev);
        (void)hipOccupancyMaxActiveBlocksPerMultiprocessor(&per_cu, (const void*)mk_fwd, 512, LDS_BYTES);
        if (per_cu < 1) per_cu = 1;
        grid = cus * 1;
        if (grid > 256) grid = 256;
        (void)hipGetLastError();
    }
    (void)hipMemsetAsync((char*)d_ws + WS_CTL, 0, CTL_BYTES, stream);
    Args a{}; a.p = p;
#if N_LAUNCH_SPLIT
    for (int k = 0; k < 9; ++k) { a.ph_lo = k; a.ph_hi = k + 1; hipLaunchKernelGGL(mk_fwd, dim3(grid), dim3(512), LDS_BYTES, stream, a); }
#else
    a.ph_lo = 0; a.ph_hi = 9;
    void* kargs[] = {&a};
    (void)hipLaunchCooperativeKernel((const void*)mk_fwd, dim3(grid), dim3(512), kargs, LDS_BYTES, stream);
#ifdef PROBE_PHASE
    a.ph_lo = PROBE_PHASE; a.ph_hi = PROBE_PHASE + 1;
    hipLaunchKernelGGL(mk_fwd, dim3(grid), dim3(512), LDS_BYTES, stream, a);
#endif
#endif
}
```

```cpp
#include <hip/hip_runtime.h>
#include <stdint.h>

#define DI __device__ __forceinline__
typedef unsigned short bf16_t;
typedef float f32x4 __attribute__((ext_vector_type(4)));
typedef unsigned u32x4 __attribute__((ext_vector_type(4)));
typedef unsigned u32x2 __attribute__((ext_vector_type(2)));

constexpr int NB = 4, SEQ = 4096, DM = 1024, NTOK = NB * SEQ;
constexpr int NEXP = 32, DEXP = 256, MEMLEN = 256;
constexpr int NIN = 2304;
constexpr float LOG2E = 1.4426950408889634f;
constexpr float C2 = 0.125f * LOG2E;
constexpr float ALPHA = 1.189207115002721f;
constexpr float LN_EPS = 1e-5f;
constexpr float LAM_INIT = 0.2f;

constexpr size_t MiB = 1u << 20;
constexpr size_t WS_CTL = 0, CTL_BYTES = 1 * MiB;
constexpr size_t WS_WINT = 1 * MiB;
constexpr size_t WS_WOT = 6 * MiB;
constexpr size_t WS_WMT = 8 * MiB;
constexpr size_t WS_MEMB = 9 * MiB;
constexpr size_t WS_WR = 11 * MiB;
constexpr size_t WS_COSTAB = 11 * MiB + 256 * 1024;
constexpr size_t WS_STATS0 = 11 * MiB + 512 * 1024;
constexpr size_t WS_MKV = 12 * MiB;
constexpr size_t WS_TOKINFO = 13 * MiB;
constexpr size_t WS_LIST = 14 * MiB;
constexpr size_t WS_W13T = 16 * MiB;
constexpr size_t WS_W2T = 48 * MiB;
constexpr size_t WS_XN = 64 * MiB;
constexpr size_t WS_OB = 96 * MiB;
constexpr size_t WS_QB = 128 * MiB, WS_KB = 144 * MiB, WS_VB = 160 * MiB, WS_MQB = 176 * MiB, WS_ZB = 184 * MiB;
constexpr size_t WS_AOUT = 128 * MiB;
constexpr size_t WS_Y = 128 * MiB;
constexpr int CW_CNT = 64;

struct Params {
    const float* in[25];
    float* out;
    unsigned char* ws;
};
enum { I_X = 0, I_MEM, I_LN0G, I_LN0B, I_RELB, I_WIN, I_WMKV, I_WF, I_LQ1, I_LK1, I_LQ2, I_LK2, I_SUBG, I_WOUT, I_LN1G, I_LN1B,
       I_WG, I_BG, I_WRT, I_BRT, I_W1, I_W3, I_W2, I_LN2G, I_LN2B };

DI float bf2f(bf16_t v) { return __uint_as_float(((unsigned)v) << 16); }
DI unsigned f2bf(float f) { unsigned u = __float_as_uint(f); return (u + 0x7fffu + ((u >> 16) & 1u)) >> 16; }
DI unsigned pk2(float lo, float hi) { return f2bf(lo) | (f2bf(hi) << 16); }
DI float wave_sum(float v) {
#pragma unroll
    for (int o = 1; o < 64; o <<= 1) v += __shfl_xor(v, o);
    return v;
}
template <int CTRL> DI float dppf(float v) { return __int_as_float(__builtin_amdgcn_update_dpp(0, __float_as_int(v), CTRL, 0xF, 0xF, true)); }
DI float wave_sum2(float v) {
    v += dppf<0xB1>(v); v += dppf<0x4E>(v); v += dppf<0x141>(v); v += dppf<0x140>(v);
    { auto s = __builtin_amdgcn_permlane16_swap(__float_as_uint(v), __float_as_uint(v), false, false); v = __uint_as_float(s[0]) + __uint_as_float(s[1]); }
    { auto s = __builtin_amdgcn_permlane32_swap(__float_as_uint(v), __float_as_uint(v), false, false); v = __uint_as_float(s[0]) + __uint_as_float(s[1]); }
    return v;
}
DI int t5_bucket(int rel) {
    const int n = rel < 0 ? -rel : rel;
    int b;
    if (n < 8) b = n; else if (n < 12) b = 8; else if (n < 16) b = 9; else if (n < 23) b = 10; else if (n < 32) b = 11;
    else if (n < 46) b = 12; else if (n < 64) b = 13; else if (n < 91) b = 14; else b = 15;
    return b + (rel > 0 ? 16 : 0);
}


namespace pg8 {
#define PG8_LAS __attribute__((address_space(3)))
typedef unsigned short bf16_t;
typedef short bf16x8 __attribute__((ext_vector_type(8)));
typedef float f32x4 __attribute__((ext_vector_type(4)));
typedef unsigned u32x4 __attribute__((ext_vector_type(4)));
constexpr int BM = 256, BK = 64, HALF = 128, HTB = HALF * BK * 2  , STAGE_BYTES = 8 * HTB, NXCD = 8, WGM = 8;

__host__ __device__ __forceinline__ int lds_byte(int r, int c) { const int st = (r >> 4) * 2 + (c >> 5), rr = r & 15, cc = c & 31, ob = rr * 64 + cc * 2; return st * 1024 + (ob ^ (((ob >> 9) & 1) << 5)); }
__host__ __device__ __forceinline__ void stage_rc(int b, int& R, int& C) { const int st = b / 1024, sb = b % 1024, swz = sb ^ (((sb >> 9) & 1) << 5); R = (st >> 1) * 16 + swz / 64; C = (st & 1) * 32 + (swz % 64) / 2; }
__host__ __device__ __forceinline__ int perm32(int rho) { const int n = rho >> 4, i = rho & 15; return 8 * (i >> 2) + 4 * n + (i & 3); }

struct Unit { int pm, pn; };
struct Gemm { const bf16_t* A; const bf16_t* Bt; int M, N, K; };

struct StaticOrder {
    int nM, nN, nwg, G, c;
    __host__ __device__ void init(int M, int N, int G_, int c_) { nM = M / BM; nN = N / BM; nwg = nM * nN; G = G_; c = c_; }
    __host__ __device__ bool next(int i, Unit& u) const {
        const long L = (long)i * G + c; if (L >= nwg) return false;
        int wgid = (int)L; { const int q = nwg / NXCD, r = nwg % NXCD, xcd = wgid % NXCD, off = wgid / NXCD; wgid = (xcd < r ? xcd * (q + 1) : r * (q + 1) + (xcd - r) * q) + off; }
        const int nig = WGM * nN, gid = wgid / nig, fm = gid * WGM, gsz = (nM - fm) < WGM ? (nM - fm) : WGM;
        u.pm = fm + ((wgid % nig) % gsz); u.pn = (wgid % nig) / gsz; return true;
    }
    __device__ __forceinline__ void a_ready(const Unit&) const {}
    __device__ __forceinline__ void done(const Unit&) const {}
};

__device__ __forceinline__ unsigned cvt_pk_bf16(float lo, float hi) { unsigned r; asm volatile("v_cvt_pk_bf16_f32 %0, %1, %2" : "=v"(r) : "v"(lo), "v"(hi)); return r; }
typedef float f32x2 __attribute__((ext_vector_type(2)));
__device__ __forceinline__ f32x2 gelu_pk(f32x2 v) {
    const f32x2 av = __builtin_elementwise_abs(v), d = av * 0.2316418882f + 1.0f;
    f32x2 t; t.x = __builtin_amdgcn_rcpf(d.x); t.y = __builtin_amdgcn_rcpf(d.y);
    f32x2 q = t * 0.5307027145f + (-0.7265760135f); q = q * t + 0.7107068705f; q = q * t + (-0.142248368f); q = q * t + 0.127414796f; q = q * t;
    const f32x2 s = (v * v) * (-0.72134752044f);
    f32x2 e; e.x = __builtin_amdgcn_exp2f(s.x); e.y = __builtin_amdgcn_exp2f(s.y);
    const f32x2 m = v * (q * e), r = v - m;
    f32x2 o; o.x = v.x < 0.f ? m.x : r.x; o.y = v.y < 0.f ? m.y : r.y; return o;
}

template <int ACT  > struct EpiBf16 {
    static constexpr bool PERM = true, AFTER_DRAIN = false; static_assert(ACT == 0 || ACT == 1, "EpiBf16: ACT is 0 (none) or 1 (gelu_pk)");
    bf16_t* O; int ldc; const float* bias; int split_cols; size_t split_stride; float scale0;
    __device__ __forceinline__ void operator()(const f32x4 (&acc)[2][2][4][2], const Unit& u, int wr, int wc, int fr, int fq) const {
        const int row0 = u.pm * BM + wr * 64 + fr; int colt = u.pn * BM; bf16_t* base = O;
        float sc = 1.f; if (split_cols) { const int t = colt / split_cols; base += (size_t)t * split_stride; colt -= t * split_cols; if (t == 0) sc = scale0; }
        const int col0 = colt + wc * 32 + 8 * fq, bcol0 = u.pn * BM + wc * 32 + 8 * fq;
        f32x4 bv[2][2];
#pragma unroll
        for (int bj = 0; bj < 2; ++bj)
#pragma unroll
            for (int n = 0; n < 2; ++n) bv[bj][n] = bias ? *(const f32x4*)(bias + bcol0 + bj * HALF + 4 * n) : (f32x4){0.f, 0.f, 0.f, 0.f};
#pragma unroll
        for (int ai = 0; ai < 2; ++ai)
#pragma unroll
            for (int m = 0; m < 4; ++m) { bf16_t* rowp = base + (size_t)(row0 + ai * HALF + m * 16) * ldc + col0;
#pragma unroll
                for (int bj = 0; bj < 2; ++bj) { f32x4 v0 = acc[ai][bj][m][0] + bv[bj][0], v1 = acc[ai][bj][m][1] + bv[bj][1];
                    if (ACT == 1) { f32x2 a = gelu_pk((f32x2){v0[0], v0[1]}), b = gelu_pk((f32x2){v0[2], v0[3]}), c = gelu_pk((f32x2){v1[0], v1[1]}), d = gelu_pk((f32x2){v1[2], v1[3]});
                        v0 = (f32x4){a.x, a.y, b.x, b.y}; v1 = (f32x4){c.x, c.y, d.x, d.y}; }
                    v0 = v0 * sc; v1 = v1 * sc; u32x4 w; w.x = cvt_pk_bf16(v0[0], v0[1]); w.y = cvt_pk_bf16(v0[2], v0[3]); w.z = cvt_pk_bf16(v1[0], v1[1]); w.w = cvt_pk_bf16(v1[2], v1[3]);
                    *(u32x4*)(rowp + bj * HALF) = w; } }
    }
};

struct PanelStats {
    unsigned* xbuf;
    unsigned* cnt;
    unsigned* tmo;
    int ntn; float eps;
    unsigned code;
    __device__ __forceinline__ bool run(const f32x4 (&v)[2][2][4][2], const Unit& u, int wr, int wc, int fr, int fq, PG8_LAS unsigned char* lds, int wid, int lane) const {
        typedef float f32x2v __attribute__((ext_vector_type(2)));
        PG8_LAS f32x2v* P = (PG8_LAS f32x2v*)lds;
        PG8_LAS f32x2v* S = (PG8_LAS f32x2v*)(lds + 8192);
        PG8_LAS unsigned* flag = (PG8_LAS unsigned*)(lds + 8192 + 2048);
#pragma unroll
        for (int ai = 0; ai < 2; ++ai)
#pragma unroll
            for (int m = 0; m < 4; ++m) {
                float s = 0.f;
#pragma unroll
                for (int bj = 0; bj < 2; ++bj)
#pragma unroll
                    for (int n = 0; n < 2; ++n) { const f32x4 x = v[ai][bj][m][n]; s += (x[0] + x[1]) + (x[2] + x[3]); }
                s += __shfl_xor(s, 16); s += __shfl_xor(s, 32);
                const float mw = s * (1.0f / 64.0f); float q = 0.f;
#pragma unroll
                for (int bj = 0; bj < 2; ++bj)
#pragma unroll
                    for (int n = 0; n < 2; ++n) { const f32x4 d = v[ai][bj][m][n] - mw; q += (d[0] * d[0] + d[1] * d[1]) + (d[2] * d[2] + d[3] * d[3]); }
                q += __shfl_xor(q, 16); q += __shfl_xor(q, 32);
                if (fq == 0) P[(ai * HALF + wr * 64 + m * 16 + fr) * 4 + wc] = (f32x2v){mw, q};
            }
        asm volatile("s_waitcnt lgkmcnt(0)" ::: "memory"); __builtin_amdgcn_s_barrier(); asm volatile("" ::: "memory");
#if defined(BROKEN_EXCHANGE_NO_WAIT)
#warning BROKEN CONTROL BUILD: the row-statistics exchange does not wait; results are wrong by design
        if (blockIdx.x >= 64) { const long long t0_ = clock64(); while (clock64() - t0_ < 60000) __builtin_amdgcn_s_sleep(8); }
#endif
        const int row = wid * 32 + (lane & 31);
        if (lane < 32) {
            const f32x2v a = P[row * 4 + 0], b = P[row * 4 + 1], c = P[row * 4 + 2], d = P[row * 4 + 3];
            const float mt = (a.x + b.x + c.x + d.x) * 0.25f;
            const float da = a.x - mt, db = b.x - mt, dc = c.x - mt, dd = d.x - mt;
            const float m2 = (a.y + b.y) + (c.y + d.y) + 64.0f * ((da * da + db * db) + (dc * dc + dd * dd));
            unsigned long long* slot = (unsigned long long*)xbuf + ((size_t)(u.pm * BM + row) * 4 + u.pn);
            __hip_atomic_store(slot, ((unsigned long long)__float_as_uint(m2) << 32) | __float_as_uint(mt), __ATOMIC_RELAXED, __HIP_MEMORY_SCOPE_AGENT);
        }
        asm volatile("s_waitcnt vmcnt(0)" ::: "memory");
        if (lane == 0) __hip_atomic_fetch_add(cnt + 64 * u.pm, 1u, __ATOMIC_RELAXED, __HIP_MEMORY_SCOPE_AGENT);
        if (wid == 0) {
            bool dead = false; const unsigned long long t0 = __builtin_amdgcn_s_memrealtime(); const unsigned want = 8u * (unsigned)ntn;
            for (;;) {
#if defined(BROKEN_EXCHANGE_NO_WAIT)
                break;
#endif
                if ((unsigned)__builtin_amdgcn_readfirstlane(__hip_atomic_load(cnt + 64 * u.pm, __ATOMIC_RELAXED, __HIP_MEMORY_SCOPE_AGENT)) >= want) break;
                if (__builtin_amdgcn_s_memrealtime() - t0 > 2000000ull) {
                    if (lane == 0) { unsigned expect = 0u; __hip_atomic_compare_exchange_strong(tmo + 1, &expect, code | (unsigned)(u.pm & 0xff), __ATOMIC_RELAXED, __ATOMIC_RELAXED, __HIP_MEMORY_SCOPE_AGENT);
                                     __hip_atomic_store(tmo, 1u, __ATOMIC_RELAXED, __HIP_MEMORY_SCOPE_AGENT); }
                    dead = true; break; }
                __builtin_amdgcn_s_sleep(2);
            }
            __builtin_amdgcn_fence(__ATOMIC_ACQUIRE, "agent");
            if (lane == 0) flag[0] = dead ? 1u : 0u;
        }
        asm volatile("s_waitcnt vmcnt(0) lgkmcnt(0)" ::: "memory"); __builtin_amdgcn_s_barrier(); asm volatile("" ::: "memory");
        const bool bad = flag[0] != 0u;
        if (lane < 32) {
            const unsigned long long* slot = (const unsigned long long*)xbuf + (size_t)(u.pm * BM + row) * 4; float mt[4], m2[4]; float ms = 0.f;
#pragma unroll
            for (int t = 0; t < 4; ++t) { if (t < ntn) { const unsigned long long w = __hip_atomic_load(slot + t, __ATOMIC_RELAXED, __HIP_MEMORY_SCOPE_AGENT); mt[t] = __uint_as_float((unsigned)w); m2[t] = __uint_as_float((unsigned)(w >> 32)); } else { mt[t] = 0.f; m2[t] = 0.f; } ms += mt[t]; }
            const float mean = ms / (float)ntn; float q = 0.f;
#pragma unroll
            for (int t = 0; t < 4; ++t) if (t < ntn) { const float dm = mt[t] - mean; q += m2[t] + 256.0f * dm * dm; }
            S[row] = (f32x2v){mean, 1.0f / sqrtf(q / (256.0f * (float)ntn) + eps)};
        }
        asm volatile("s_waitcnt lgkmcnt(0)" ::: "memory"); __builtin_amdgcn_s_barrier(); asm volatile("" ::: "memory");
        return bad;
    }
};
struct EpiLnRes {
    static constexpr bool PERM = false, AFTER_DRAIN = true;
    const float* base; float* out; int ldc; const float* bias; PanelStats st; unsigned poison;
    __device__ __forceinline__ void fused(f32x4 (&acc)[2][2][4][2], const Unit& u, int wr, int wc, int fr, int fq, PG8_LAS unsigned char* lds, int wid, int lane) const {
        typedef float f32x2v __attribute__((ext_vector_type(2)));
        const PG8_LAS f32x2v* S = (const PG8_LAS f32x2v*)(lds + 8192);
        const int col0 = u.pn * BM + wc * 32 + 4 * fq;
#pragma unroll
        for (int bj = 0; bj < 2; ++bj)
#pragma unroll
            for (int n = 0; n < 2; ++n) { const f32x4 bv = bias ? *(const f32x4*)(bias + col0 + bj * HALF + n * 16) : (f32x4){0.f, 0.f, 0.f, 0.f};
#pragma unroll
                for (int ai = 0; ai < 2; ++ai)
#pragma unroll
                    for (int m = 0; m < 4; ++m) acc[ai][bj][m][n] += bv; }
        f32x4 pre[4][2][2];
#pragma unroll
        for (int m = 0; m < 4; ++m) { const size_t off = (size_t)(u.pm * BM + wr * 64 + m * 16 + fr) * ldc + col0;
#pragma unroll
            for (int bj = 0; bj < 2; ++bj)
#pragma unroll
                for (int n = 0; n < 2; ++n) pre[m][bj][n] = *(const f32x4*)(base + off + bj * HALF + n * 16); }
        const bool bad = st.run(acc, u, wr, wc, fr, fq, lds, wid, lane) || poison != 0u;
        const float qnan = __builtin_nanf("");
#pragma unroll
        for (int ai = 0; ai < 2; ++ai)
#pragma unroll
            for (int m = 0; m < 4; ++m) { const int r = ai * HALF + wr * 64 + m * 16 + fr; const f32x2v sr = S[r]; const size_t off = (size_t)(u.pm * BM + r) * ldc + col0;
#pragma unroll
                for (int bj = 0; bj < 2; ++bj)
#pragma unroll
                    for (int n = 0; n < 2; ++n) { const f32x4 bs = ai == 0 ? pre[m][bj][n] : *(const f32x4*)(base + off + bj * HALF + n * 16); f32x4 o = bs + (acc[ai][bj][m][n] - sr.x) * sr.y;
                        if (bad) o = (f32x4){qnan, qnan, qnan, qnan}; *(f32x4*)(out + off + bj * HALF + n * 16) = o; }
                if (m & 1) asm volatile("" ::: "memory"); }
    }
};
struct EpiLnResLn {
    static constexpr bool PERM = false, AFTER_DRAIN = true;
    const float* base; float* out; bf16_t* xn; int ldc; const float* bias; PanelStats st1, st2; unsigned poison;
    __device__ __forceinline__ void fused(f32x4 (&acc)[2][2][4][2], const Unit& u, int wr, int wc, int fr, int fq, PG8_LAS unsigned char* lds, int wid, int lane) const {
        typedef float f32x2v __attribute__((ext_vector_type(2))); typedef unsigned u32x2v __attribute__((ext_vector_type(2)));
        const PG8_LAS f32x2v* S = (const PG8_LAS f32x2v*)(lds + 8192);
        const int col0 = u.pn * BM + wc * 32 + 4 * fq;
#pragma unroll
        for (int bj = 0; bj < 2; ++bj)
#pragma unroll
            for (int n = 0; n < 2; ++n) { const f32x4 bv = bias ? *(const f32x4*)(bias + col0 + bj * HALF + n * 16) : (f32x4){0.f, 0.f, 0.f, 0.f};
#pragma unroll
                for (int ai = 0; ai < 2; ++ai)
#pragma unroll
                    for (int m = 0; m < 4; ++m) acc[ai][bj][m][n] += bv; }
        bool bad = st1.run(acc, u, wr, wc, fr, fq, lds, wid, lane) || poison != 0u;
        const float qnan = __builtin_nanf("");
#pragma unroll
        for (int ai = 0; ai < 2; ++ai)
#pragma unroll
            for (int m = 0; m < 4; ++m) { const int r = ai * HALF + wr * 64 + m * 16 + fr; const f32x2v sr = S[r]; const size_t off = (size_t)(u.pm * BM + r) * ldc + col0;
#pragma unroll
                for (int bj = 0; bj < 2; ++bj)
#pragma unroll
                    for (int n = 0; n < 2; ++n) { const f32x4 bs = *(const f32x4*)(base + off + bj * HALF + n * 16); acc[ai][bj][m][n] = bs + (acc[ai][bj][m][n] - sr.x) * sr.y; }
                asm volatile("" : "+v"(acc[ai][0][m][0]), "+v"(acc[ai][0][m][1]), "+v"(acc[ai][1][m][0]), "+v"(acc[ai][1][m][1]));
                if (m & 1) asm volatile("" ::: "memory"); }
        const bool bad1 = bad;
        bad = st2.run(acc, u, wr, wc, fr, fq, lds, wid, lane) || bad;
#pragma unroll
        for (int ai = 0; ai < 2; ++ai)
#pragma unroll
            for (int m = 0; m < 4; ++m) { const int r = ai * HALF + wr * 64 + m * 16 + fr; const f32x2v sr = S[r]; const size_t off = (size_t)(u.pm * BM + r) * ldc + col0;
#pragma unroll
                for (int bj = 0; bj < 2; ++bj)
#pragma unroll
                    for (int n = 0; n < 2; ++n) { const f32x4 x1 = acc[ai][bj][m][n]; *(f32x4*)(out + off + bj * HALF + n * 16) = bad1 ? (f32x4){qnan, qnan, qnan, qnan} : x1;
                        const f32x4 o = (x1 - sr.x) * sr.y; u32x2v w; w.x = cvt_pk_bf16(o[0], o[1]); w.y = cvt_pk_bf16(o[2], o[3]);
                        if (bad) { w.x = 0x7fc07fc0u; w.y = 0x7fc07fc0u; } *(u32x2v*)(xn + off + bj * HALF + n * 16) = w; }
                asm volatile("" ::: "memory"); }
    }
};

template <class Epi, class Sched, bool ALIGN_EPI = false, bool SP2 = false, bool GATHER = false>
__device__ __forceinline__ void gemm_phase(PG8_LAS unsigned char* lds, const Gemm g, const Sched& S, const Epi& E) {
    const int tid = threadIdx.x, wid = __builtin_amdgcn_readfirstlane(tid >> 6), lane = tid & 63, wr = wid >> 2, wc = wid & 3, fr = lane & 15, fq = lane >> 4;
    const int K = g.K, nt = K / BK;
    static_assert(!GATHER || SP2, "GATHER is wired into the SP2 loop only");
    unsigned voffA[2], voffB[2]; int gR_[2], gC_[2];
#pragma unroll
    for (int i = 0; i < 2; ++i) { int R, C; stage_rc(tid * 16 + i * 8192, R, C); const int Rb = Epi::PERM ? ((R & ~31) + perm32(R & 31)) : R; gR_[i] = R; gC_[i] = C;
        voffA[i] = (unsigned)(R * K + C) * 2u; voffB[i] = (unsigned)(Rb * K + C) * 2u; }
    unsigned gvo[2][2] = {{0u, 0u}, {0u, 0u}}, gvn[2][2] = {{0u, 0u}, {0u, 0u}};
#define PG8_GOFF(dst, unit) do { _Pragma("unroll") for (int h_ = 0; h_ < 2; ++h_) _Pragma("unroll") for (int i_ = 0; i_ < 2; ++i_) \
        dst[h_][i_] = ((unsigned)S.a_row(unit, h_ * HALF + gR_[i_]) * (unsigned)K + (unsigned)gC_[i_]) * 2u; \
        asm volatile("" : "+v"(dst[0][0]), "+v"(dst[0][1]), "+v"(dst[1][0]), "+v"(dst[1][1])); } while (0)
    const size_t kstep = (size_t)(BK * 2);
    const size_t hstep = (size_t)HALF * K * 2;
    const size_t tstep = 2 * hstep;
    const unsigned ldsw = (unsigned)wid * 1024u;
    const int aoff = lds_byte(wr * 64 + fr, fq * 8), boff = lds_byte(wc * 32 + fr, fq * 8);
#define PG8_SA(b, h) (((b) * 2 + (h)) * HTB)
#define PG8_SB(b, h) ((4 + (b) * 2 + (h)) * HTB)
#define PG8_STAGE(bufoff, gbase, voff) do { _Pragma("unroll") for (int _i = 0; _i < 2; ++_i) \
        __builtin_amdgcn_global_load_lds((const unsigned*)((const char*)(gbase) + (voff)[_i]), (PG8_LAS unsigned*)(lds + (bufoff) + ldsw + _i * 8192), 16, 0, 0); } while (0)
#define PG8_STAGE_AH(bufoff, gbase, h, usen) do { _Pragma("unroll") for (int _i = 0; _i < 2; ++_i) { \
        const unsigned vo_ = GATHER ? ((usen) ? gvn[h][_i] : gvo[h][_i]) : voffA[_i]; \
        __builtin_amdgcn_global_load_lds((const unsigned*)((const char*)(gbase) + (GATHER ? (size_t)0 : (size_t)(h) * hstep) + vo_), (PG8_LAS unsigned*)(lds + (bufoff) + ldsw + _i * 8192), 16, 0, 0); } } while (0)
#define PG8_LDA(dst, b, h) do { _Pragma("unroll") for (int m = 0; m < 4; ++m) _Pragma("unroll") for (int k = 0; k < 2; ++k) dst[m][k] = *(const PG8_LAS bf16x8*)(lds + PG8_SA(b, h) + aoff + m * 2048 + k * 1024); } while (0)
#define PG8_LDB(dst, b, h) do { _Pragma("unroll") for (int n = 0; n < 2; ++n) _Pragma("unroll") for (int k = 0; k < 2; ++k) dst[n][k] = *(const PG8_LAS bf16x8*)(lds + PG8_SB(b, h) + boff + n * 2048 + k * 1024); } while (0)
#define PG8_MMA(ai, bj, At, Bt) do { __builtin_amdgcn_s_setprio(1); _Pragma("unroll") for (int m = 0; m < 4; ++m) _Pragma("unroll") for (int n = 0; n < 2; ++n) _Pragma("unroll") for (int k = 0; k < 2; ++k) \
        acc[ai][bj][m][n] = __builtin_amdgcn_mfma_f32_16x16x32_bf16(Bt[n][k], At[m][k], acc[ai][bj][m][n], 0, 0, 0); __builtin_amdgcn_s_setprio(0); } while (0)
#define PG8_WAIT_V(n) asm volatile("s_waitcnt vmcnt(" #n ")" ::: "memory")
#define PG8_WAIT_L(n) asm volatile("s_waitcnt lgkmcnt(" #n ")" ::: "memory")
#define PG8_BAR __builtin_amdgcn_s_barrier()
#define PG8_SCHED __builtin_amdgcn_sched_barrier(0)
    Unit cur, nxt; int ui = 0;
    if (!S.next(0, cur)) return;
    f32x4 acc[2][2][4][2];
#pragma unroll
    for (int a = 0; a < 2; ++a)
#pragma unroll
        for (int b = 0; b < 2; ++b)
#pragma unroll
            for (int m = 0; m < 4; ++m)
#pragma unroll
                for (int n = 0; n < 2; ++n) acc[a][b][m][n] = (f32x4){0.f, 0.f, 0.f, 0.f};
    bf16x8 At[4][2], B0[2][2], B1[2][2];
    const char* cA = (const char*)g.A + (GATHER ? (size_t)0 : (size_t)cur.pm * tstep); const char* cB = (const char*)g.Bt + (size_t)cur.pn * tstep;
    S.a_ready(cur);
    if constexpr (GATHER) { PG8_GOFF(gvo, cur); }
    if constexpr (SP2) {
        PG8_STAGE(PG8_SB(0, 0), cB, voffB); PG8_STAGE(PG8_SB(0, 1), cB + hstep, voffB); PG8_STAGE_AH(PG8_SA(0, 0), cA, 0, false); PG8_STAGE_AH(PG8_SA(0, 1), cA, 1, false);
        if (wr == 1) PG8_BAR;
        PG8_WAIT_V(2); PG8_BAR;
        PG8_STAGE(PG8_SB(1, 0), cB + kstep, voffB); PG8_STAGE_AH(PG8_SA(1, 0), cA + kstep, 0, false); PG8_STAGE(PG8_SB(1, 1), cB + hstep + kstep, voffB);
        PG8_WAIT_V(6); PG8_BAR;
    } else {
        PG8_STAGE(PG8_SB(0, 0), cB, voffB); PG8_STAGE(PG8_SA(0, 0), cA, voffA); PG8_STAGE(PG8_SB(0, 1), cB + hstep, voffB); PG8_STAGE(PG8_SA(0, 1), cA + hstep, voffA);
        if (wr == 1) PG8_BAR;
        PG8_WAIT_V(4); PG8_BAR;
        PG8_STAGE(PG8_SB(1, 0), cB + kstep, voffB); PG8_STAGE(PG8_SA(1, 0), cA + kstep, voffA); PG8_STAGE(PG8_SB(1, 1), cB + hstep + kstep, voffB);
        PG8_WAIT_V(6); PG8_BAR;
    }
    for (;;) {
        const bool has_next = S.next(ui + 1, nxt);
        const char* nA = has_next ? (const char*)g.A + (GATHER ? (size_t)0 : (size_t)nxt.pm * tstep) : cA; const char* nB = has_next ? (const char*)g.Bt + (size_t)nxt.pn * tstep : cB;
        if constexpr (GATHER) { if (has_next) { PG8_GOFF(gvn, nxt); } else { gvn[0][0] = gvo[0][0]; gvn[0][1] = gvo[0][1]; gvn[1][0] = gvo[1][0]; gvn[1][1] = gvo[1][1]; } }
        for (int t = 0; t < nt; t += 2) {
            const bool last = (t == nt - 2);
            const char* a1 = cA + (size_t)(t + 1) * kstep;
            const char* a2 = last ? nA : cA + (size_t)(t + 2) * kstep; const char* b2 = last ? nB : cB + (size_t)(t + 2) * kstep;
            const char* a3 = a2 + kstep; const char* b3 = b2 + kstep;
            if (last && has_next) S.a_ready(nxt);
            if constexpr (SP2) {
            PG8_LDB(B0, 0, 0); PG8_LDB(B1, 0, 1); PG8_SCHED; PG8_LDA(At, 0, 0); PG8_STAGE_AH(PG8_SA(1, 1), a1, 1, false);
            PG8_WAIT_V(8); PG8_WAIT_L(0); PG8_BAR; PG8_MMA(0, 0, At, B0); PG8_MMA(0, 1, At, B1); PG8_BAR; PG8_SCHED;
            PG8_LDA(At, 0, 1); PG8_STAGE(PG8_SB(0, 0), b2, voffB); PG8_STAGE(PG8_SB(0, 1), b2 + hstep, voffB); PG8_STAGE_AH(PG8_SA(0, 0), a2, 0, last);
            PG8_WAIT_V(8); PG8_WAIT_L(0); PG8_BAR; PG8_MMA(1, 0, At, B0); PG8_MMA(1, 1, At, B1); PG8_BAR; PG8_SCHED;
            PG8_LDB(B0, 1, 0); PG8_LDB(B1, 1, 1); PG8_SCHED; PG8_LDA(At, 1, 0); PG8_STAGE_AH(PG8_SA(0, 1), a2, 1, last);
            PG8_WAIT_V(8); PG8_WAIT_L(0); PG8_BAR; PG8_MMA(0, 0, At, B0); PG8_MMA(0, 1, At, B1); PG8_BAR; PG8_SCHED;
            PG8_LDA(At, 1, 1); PG8_STAGE(PG8_SB(1, 0), b3, voffB); PG8_STAGE(PG8_SB(1, 1), b3 + hstep, voffB); PG8_STAGE_AH(PG8_SA(1, 0), a3, 0, last);
            PG8_WAIT_V(8); PG8_WAIT_L(0); PG8_BAR; PG8_MMA(1, 0, At, B0); PG8_MMA(1, 1, At, B1); PG8_BAR; PG8_SCHED;
            } else {
            PG8_LDB(B0, 0, 0); PG8_SCHED; PG8_LDA(At, 0, 0); PG8_STAGE(PG8_SA(1, 1), a1 + hstep, voffA);
            PG8_WAIT_L(8); PG8_BAR; PG8_WAIT_L(0); PG8_MMA(0, 0, At, B0); PG8_BAR; PG8_SCHED;
            PG8_LDB(B1, 0, 1); PG8_STAGE(PG8_SB(0, 0), b2, voffB);
            PG8_BAR; PG8_WAIT_L(0); PG8_MMA(0, 1, At, B1); PG8_BAR;
            PG8_LDA(At, 0, 1); PG8_STAGE(PG8_SA(0, 0), a2, voffA);
            PG8_BAR; PG8_WAIT_L(0); PG8_MMA(1, 0, At, B0); PG8_BAR; PG8_SCHED;
            PG8_STAGE(PG8_SB(0, 1), b2 + hstep, voffB);
            PG8_WAIT_V(6); PG8_BAR; PG8_MMA(1, 1, At, B1); PG8_BAR;
            PG8_LDB(B0, 1, 0); PG8_SCHED; PG8_LDA(At, 1, 0); PG8_STAGE(PG8_SA(0, 1), a2 + hstep, voffA);
            PG8_WAIT_L(8); PG8_BAR; PG8_WAIT_L(0); PG8_MMA(0, 0, At, B0); PG8_BAR; PG8_SCHED;
            PG8_LDB(B1, 1, 1); PG8_STAGE(PG8_SB(1, 0), b3, voffB);
            PG8_BAR; PG8_WAIT_L(0); PG8_MMA(0, 1, At, B1); PG8_BAR;
            PG8_LDA(At, 1, 1); PG8_STAGE(PG8_SA(1, 0), a3, voffA);
            PG8_BAR; PG8_WAIT_L(0); PG8_MMA(1, 0, At, B0); PG8_BAR; PG8_SCHED;
            PG8_STAGE(PG8_SB(1, 1), b3 + hstep, voffB);
            PG8_WAIT_V(6); PG8_BAR; PG8_MMA(1, 1, At, B1); PG8_BAR;
            }
        }
        if constexpr (ALIGN_EPI) { if (wr == 0) PG8_BAR; }
        if constexpr (!Epi::AFTER_DRAIN) { E(acc, cur, wr, wc, fr, fq); S.done(cur); }
        if (!has_next) break;
#pragma unroll
        for (int a = 0; a < 2; ++a)
#pragma unroll
            for (int b = 0; b < 2; ++b)
#pragma unroll
                for (int m = 0; m < 4; ++m)
#pragma unroll
                    for (int n = 0; n < 2; ++n) acc[a][b][m][n] = (f32x4){0.f, 0.f, 0.f, 0.f};
        cur = nxt; cA = nA; cB = nB; ++ui;
        if constexpr (GATHER) { gvo[0][0] = gvn[0][0]; gvo[0][1] = gvn[0][1]; gvo[1][0] = gvn[1][0]; gvo[1][1] = gvn[1][1]; }
        if constexpr (ALIGN_EPI) { if (wr == 1) PG8_BAR; }
    }
    PG8_WAIT_V(0);
    if constexpr (!ALIGN_EPI) { if (wr == 0) PG8_BAR; }
    PG8_BAR;
    if constexpr (Epi::AFTER_DRAIN) { E.fused(acc, cur, wr, wc, fr, fq, lds, wid, lane); S.done(cur); }
#undef PG8_SA
#undef PG8_SB
#undef PG8_STAGE
#undef PG8_STAGE_AH
#undef PG8_GOFF
#undef PG8_LDA
#undef PG8_LDB
#undef PG8_MMA
#undef PG8_WAIT_V
#undef PG8_WAIT_L
#undef PG8_BAR
#undef PG8_SCHED
}
}

DI void transpose_item(const float* W, int ldw, bf16_t* WT, int ldt, float scale, float* scr, int k0, int n0, int lane) {
#pragma unroll 8
    for (int i = 0; i < 32; ++i) { const int kk = 2 * i + (lane >> 5); scr[kk * 33 + (lane & 31)] = W[(size_t)(k0 + kk) * ldw + n0 + (lane & 31)] * scale; }
    asm volatile("s_waitcnt lgkmcnt(0)" ::: "memory");
    const int c = lane & 7;
#pragma unroll
    for (int j = 0; j < 4; ++j) { const int n = (lane >> 3) + 8 * j; const float* s = scr + (8 * c) * 33 + n;
        u32x4 o; o.x = pk2(s[0 * 33], s[1 * 33]); o.y = pk2(s[2 * 33], s[3 * 33]); o.z = pk2(s[4 * 33], s[5 * 33]); o.w = pk2(s[6 * 33], s[7 * 33]);
        *(u32x4*)(WT + (size_t)n * ldt + k0 + 8 * c) = o; }
    asm volatile("s_waitcnt lgkmcnt(0)" ::: "memory");
}

DI void p0_prologue(const Params& p, float* lds, int gw, int NGW, int wave, int lane) {
    unsigned char* ws = p.ws;
    bf16_t* WinT = (bf16_t*)(ws + WS_WINT); bf16_t* WoT = (bf16_t*)(ws + WS_WOT); bf16_t* WmT = (bf16_t*)(ws + WS_WMT);
    bf16_t* W13T = (bf16_t*)(ws + WS_W13T); bf16_t* W2T = (bf16_t*)(ws + WS_W2T);
    float* scr = lds + wave * (64 * 33);
    const float* w_in = p.in[I_WIN];
    constexpr int S0 = 256, S1 = 512, S2 = 768, S3 = 896, S4 = 1408, S5 = 1664, S6 = S5 + 4096, S7 = S6 + 4096, S8 = S7 + 4096;
    for (int it = gw; it < S8; it += NGW) {
        if (it < S3) {
            int seg, r;
            if (it < S0) { seg = 0; r = it; } else if (it < S1) { seg = 1; r = it - S0; } else if (it < S2) { seg = 2; r = it - S1; } else { seg = 3; r = it - S2; }
            const int ncb = (seg == 3) ? 8 : 16;
            const int kb = r / ncb, nb = r % ncb;
            const int coff = (seg == 3) ? 1792 : seg * 512, roff = (seg == 3) ? 1536 : seg * 512;
            const float sc = (seg == 0 || seg == 3) ? C2 : 1.0f;
            transpose_item(w_in + coff, 2048, WinT + (size_t)(roff + nb * 32) * 1024, 1024, sc, scr, kb * 64, nb * 32, lane);
        } else if (it < S4) { const int r = it - S3, kb = r / 32, nb = r % 32;
            transpose_item(p.in[I_WOUT], 1024, WoT + (size_t)(nb * 32) * 1024, 1024, 1.f, scr, kb * 64, nb * 32, lane);
        } else if (it < S5) { const int r = it - S4, kb = r / 16, nb = r % 16;
            transpose_item(p.in[I_WMKV], 512, WmT + (size_t)(nb * 32) * 1024, 1024, 1.f, scr, kb * 64, nb * 32, lane);
        } else if (it < S7) { const bool is3 = it >= S6; const int r = it - (is3 ? S6 : S5), e = r / 128, q = r % 128, kb = q / 8, nb = q % 8, n0 = nb * 32;
            const float* W = (is3 ? p.in[I_W3] : p.in[I_W1]) + (size_t)e * 1024 * 256;
            const int drow = e * 512 + (n0 >> 7) * 256 + (is3 ? 128 : 0) + (n0 & 127);
            transpose_item(W, 256, W13T + (size_t)drow * 1024, 1024, 1.f, scr, kb * 64, n0, lane);
        } else { const int r = it - S7, e = r / 128, q = r % 128, kb = q / 32, nb = q % 32;
            const float* W = p.in[I_W2] + (size_t)e * 256 * 1024;
            transpose_item(W, 1024, W2T + (size_t)(e * 1024 + nb * 32) * 256, 256, 1.f, scr, kb * 64, nb * 32, lane);
        }
    }
    {
        bf16_t* XN = (bf16_t*)(ws + WS_XN); float* st = (float*)(ws + WS_STATS0);
        const f32x4* g4 = (const f32x4*)p.in[I_LN0G] + lane; const f32x4* b4 = (const f32x4*)p.in[I_LN0B] + lane;
        for (int m = gw; m < NTOK; m += NGW) {
            const f32x4* xr = (const f32x4*)(p.in[I_X] + (size_t)m * DM) + lane;
            f32x4 v[4]; float s = 0.f;
#pragma unroll
            for (int j = 0; j < 4; ++j) { v[j] = xr[64 * j]; s += (v[j].x + v[j].y) + (v[j].z + v[j].w); }
            const float mean = wave_sum(s) * (1.f / DM); float s2 = 0.f;
#pragma unroll
            for (int j = 0; j < 4; ++j) { v[j] = v[j] - mean; s2 += (v[j].x * v[j].x + v[j].y * v[j].y) + (v[j].z * v[j].z + v[j].w * v[j].w); }
            const float rstd = 1.f / sqrtf(wave_sum(s2) * (1.f / DM) + LN_EPS);
            if (lane == 0) { st[2 * m] = mean; st[2 * m + 1] = rstd; }
            u32x2* o8 = (u32x2*)(XN + (size_t)m * DM) + lane;
#pragma unroll
            for (int j = 0; j < 4; ++j) { const f32x4 g = g4[64 * j], b = b4[64 * j]; const f32x4 y = v[j] * rstd * g + b; u32x2 w; w.x = pk2(y.x, y.y); w.y = pk2(y.z, y.w); o8[64 * j] = w; }
        }
    }
    {
        bf16_t* MB = (bf16_t*)(ws + WS_MEMB);
        for (int m = gw; m < NB * MEMLEN; m += NGW) {
            const f32x4* xr = (const f32x4*)(p.in[I_MEM] + (size_t)m * DM) + lane; u32x2* o8 = (u32x2*)(MB + (size_t)m * DM) + lane;
#pragma unroll
            for (int j = 0; j < 4; ++j) { const f32x4 y = xr[64 * j]; u32x2 w; w.x = pk2(y.x, y.y); w.y = pk2(y.z, y.w); o8[64 * j] = w; }
        }
    }
    {
        const float* wf = p.in[I_WF];
        for (int it = gw; it < 1024 * 4; it += NGW) {
            const int k = it >> 2, g = it & 3;
            const float wv = w_in[(size_t)k * 2048 + 1536 + g * 64 + lane];
            float ta = 0.f, tb = 0.f;
            for (int c = 0; c < 64; ++c) { const float wc = __shfl(wv, c); const float ang = (float)((c * lane) & 63) * (1.0f / 32.0f); ta += wc * cospif(ang); tb += wc * sinpif(ang); }
            float orr = 0.f, oi = 0.f;
            for (int c = 0; c < 64; ++c) { const float w = wf[(size_t)(g * 64 + c) * 64 + lane]; orr += __shfl(ta, c) * w; oi += __shfl(tb, c) * w; }
            WinT[(size_t)(1792 + g * 64 + lane) * 1024 + k] = (bf16_t)f2bf(orr * (1.0f / 512.0f));
            WinT[(size_t)(2048 + g * 64 + lane) * 1024 + k] = (bf16_t)f2bf(oi * (1.0f / 512.0f));
        }
    }
    {
        float* WR = (float*)(ws + WS_WR); float* ct = (float*)(ws + WS_COSTAB);
        const int gt = gw * 64 + lane, NGT = NGW * 64;
        for (int i = gt; i < 36 * 1024; i += NGT) { const int e = i >> 10, k = i & 1023; WR[i] = e < 4 ? p.in[I_WG][k * 4 + e] : p.in[I_WRT][k * 32 + (e - 4)]; }
        for (int i = gt; i < 4096; i += NGT) ct[i] = cospif((float)i * (1.0f / 2048.0f));
    }
}

constexpr size_t WS_ZS1 = 200 * MiB;
constexpr size_t WS_O1 = 216 * MiB;
constexpr int CW_KMAX = 128;
constexpr int CW_QMAX = 192;
constexpr int CW_KMAXM = 160;

namespace pg8 {
struct EpiInproj {
    static constexpr bool PERM = true, AFTER_DRAIN = false;
    unsigned char* ws;
    __device__ __forceinline__ void operator()(const f32x4 (&acc)[2][2][4][2], const Unit& u, int wr, int wc, int fr, int fq) const {
        const int pn = u.pn; bf16_t* base; int ldc, coff;
        if (pn < 6) { base = (bf16_t*)(ws + WS_QB + (size_t)(pn >> 1) * (16 * MiB)); ldc = 512; coff = (pn & 1) * 256; }
        else if (pn == 6) { base = (bf16_t*)(ws + WS_MQB); ldc = 256; coff = 0; }
        else { base = (bf16_t*)(ws + WS_ZB); ldc = 512; coff = (pn - 7) * 256; }
        const int row0 = u.pm * BM + wr * 64 + fr, col0 = coff + wc * 32 + 8 * fq;
#pragma unroll
        for (int ai = 0; ai < 2; ++ai)
#pragma unroll
            for (int m = 0; m < 4; ++m) { bf16_t* rowp = base + (size_t)(row0 + ai * HALF + m * 16) * ldc + col0;
#pragma unroll
                for (int bj = 0; bj < 2; ++bj) { const f32x4 v0 = acc[ai][bj][m][0], v1 = acc[ai][bj][m][1];
                    u32x4 w; w.x = cvt_pk_bf16(v0[0], v0[1]); w.y = cvt_pk_bf16(v0[2], v0[3]); w.z = cvt_pk_bf16(v1[0], v1[1]); w.w = cvt_pk_bf16(v1[2], v1[3]);
                    *(u32x4*)(rowp + bj * HALF) = w; } }
    }
};
struct EpiBf16Plain {
    static constexpr bool PERM = true, AFTER_DRAIN = false;
    bf16_t* O; int ldc;
    __device__ __forceinline__ void operator()(const f32x4 (&acc)[2][2][4][2], const Unit& u, int wr, int wc, int fr, int fq) const {
        const int row0 = u.pm * BM + wr * 64 + fr, col0 = u.pn * BM + wc * 32 + 8 * fq;
#pragma unroll
        for (int ai = 0; ai < 2; ++ai)
#pragma unroll
            for (int m = 0; m < 4; ++m) { bf16_t* rowp = O + (size_t)(row0 + ai * HALF + m * 16) * ldc + col0;
#pragma unroll
                for (int bj = 0; bj < 2; ++bj) { const f32x4 v0 = acc[ai][bj][m][0], v1 = acc[ai][bj][m][1];
                    u32x4 w; w.x = cvt_pk_bf16(v0[0], v0[1]); w.y = cvt_pk_bf16(v0[2], v0[3]); w.z = cvt_pk_bf16(v1[0], v1[1]); w.w = cvt_pk_bf16(v1[2], v1[3]);
                    *(u32x4*)(rowp + bj * HALF) = w; } }
    }
};
struct EpiF32Plain {
    static constexpr bool PERM = false, AFTER_DRAIN = false;
    float* C; int ldc;
    __device__ __forceinline__ void operator()(const f32x4 (&acc)[2][2][4][2], const Unit& u, int wr, int wc, int fr, int fq) const {
        const int row0 = u.pm * BM + wr * 64 + fr, col0 = u.pn * BM + wc * 32 + 4 * fq;
#pragma unroll
        for (int ai = 0; ai < 2; ++ai)
#pragma unroll
            for (int m = 0; m < 4; ++m) { float* rowp = C + (size_t)(row0 + ai * HALF + m * 16) * ldc + col0;
#pragma unroll
                for (int bj = 0; bj < 2; ++bj)
#pragma unroll
                    for (int n = 0; n < 2; ++n) *(f32x4*)(rowp + bj * HALF + n * 16) = acc[ai][bj][m][n]; }
    }
};
struct MoeOrder {
    const PG8_LAS int* tab; const int* list; int G, c, sh;
    __device__ __forceinline__ bool next(int i, Unit& u) const {
        const int L = i * G + c, total = tab[32] << sh; if (L >= total) return false;
        const int T = L >> sh, nt = L & ((1 << sh) - 1); int e = 0; while (tab[e + 1] <= T) ++e;
        u.pm = T; u.pn = (e << sh) + nt; return true; }
    __device__ __forceinline__ int a_row(const Unit& u, int r) const { const int e = u.pn >> sh; const int pos = (u.pm - tab[e]) * 256 + r; return pos < tab[33 + e] ? list[e * NTOK + pos] : 0; }
    __device__ __forceinline__ void a_ready(const Unit&) const {}
    __device__ __forceinline__ void done(const Unit&) const {}
};
struct EpiSwiglu {
    static constexpr bool PERM = true, AFTER_DRAIN = false;
    bf16_t* HID;
    __device__ __forceinline__ void operator()(const f32x4 (&acc)[2][2][4][2], const Unit& u, int wr, int wc, int fr, int fq) const {
        const int row0 = u.pm * BM + wr * 64 + fr, col0 = (u.pn & 1) * 128 + wc * 32 + 8 * fq;
#pragma unroll
        for (int ai = 0; ai < 2; ++ai)
#pragma unroll
            for (int m = 0; m < 4; ++m) { bf16_t* rowp = HID + (size_t)(row0 + ai * HALF + m * 16) * 256 + col0; float h[8];
#pragma unroll
                for (int n = 0; n < 2; ++n)
#pragma unroll
                    for (int j = 0; j < 4; ++j) { const float gte = acc[ai][0][m][n][j], up = acc[ai][1][m][n][j];
                        h[n * 4 + j] = gte * __builtin_amdgcn_rcpf(1.0f + __builtin_amdgcn_exp2f(-gte * 1.4426950408889634f)) * up; }
                u32x4 w; w.x = cvt_pk_bf16(h[0], h[1]); w.y = cvt_pk_bf16(h[2], h[3]); w.z = cvt_pk_bf16(h[4], h[5]); w.w = cvt_pk_bf16(h[6], h[7]);
                *(u32x4*)rowp = w; }
    }
};
struct EpiDown {
    static constexpr bool PERM = true, AFTER_DRAIN = false;
    bf16_t* Y;
    __device__ __forceinline__ void operator()(const f32x4 (&acc)[2][2][4][2], const Unit& u, int wr, int wc, int fr, int fq) const {
        const int row0 = u.pm * BM + wr * 64 + fr, col0 = (u.pn & 3) * BM + wc * 32 + 8 * fq;
#pragma unroll
        for (int ai = 0; ai < 2; ++ai)
#pragma unroll
            for (int m = 0; m < 4; ++m) { bf16_t* rowp = Y + (size_t)(row0 + ai * HALF + m * 16) * 1024 + col0;
#pragma unroll
                for (int bj = 0; bj < 2; ++bj) { const f32x4 v0 = acc[ai][bj][m][0], v1 = acc[ai][bj][m][1];
                    u32x4 w; w.x = cvt_pk_bf16(v0[0], v0[1]); w.y = cvt_pk_bf16(v0[2], v0[3]); w.z = cvt_pk_bf16(v1[0], v1[1]); w.w = cvt_pk_bf16(v1[2], v1[3]);
                    *(u32x4*)(rowp + bj * HALF) = w; } }
    }
};
}

DI void kmax_phase(const Params& p, int gw, int NGW, int lane) {
    unsigned char* ws = p.ws; unsigned* ctl = (unsigned*)(ws + WS_CTL);
    const bf16_t* Kb = (const bf16_t*)(ws + WS_KB); const bf16_t* Qb = (const bf16_t*)(ws + WS_QB); const bf16_t* MKV = (const bf16_t*)(ws + WS_MKV);
    for (int grp = gw; grp < NTOK / 8; grp += NGW) {
        float mx = 0.f;
#pragma unroll
        for (int r = 0; r < 8; ++r) { const u32x4 v = *(const u32x4*)(Kb + (size_t)(grp * 8 + r) * 512 + lane * 8); float s = 0.f;
#pragma unroll
            for (int j = 0; j < 4; ++j) { const float a = __uint_as_float(v[j] << 16), b = __uint_as_float(v[j] & 0xffff0000u); s += a * a + b * b; }
            s += __shfl_xor(s, 1); s += __shfl_xor(s, 2); s += __shfl_xor(s, 4); mx = fmaxf(mx, s); }
        if ((lane & 7) == 0) atomicMax(ctl + CW_KMAX + ((grp * 8) / SEQ) * 8 + (lane >> 3), __float_as_uint(mx));
        float mq = 0.f;
#pragma unroll
        for (int r = 0; r < 8; ++r) { const u32x4 v = *(const u32x4*)(Qb + (size_t)(grp * 8 + r) * 512 + lane * 8); float s = 0.f;
#pragma unroll
            for (int j = 0; j < 4; ++j) { const float a = __uint_as_float(v[j] << 16), b = __uint_as_float(v[j] & 0xffff0000u); s += a * a + b * b; }
            s += __shfl_xor(s, 1); s += __shfl_xor(s, 2); s += __shfl_xor(s, 4); mq = fmaxf(mq, s); }
        if ((lane & 7) == 0) atomicMax(ctl + CW_QMAX + ((grp * 8) / SEQ) * 8 + (lane >> 3), __float_as_uint(mq));
    }
    for (int grp = gw; grp < NB * MEMLEN / 8; grp += NGW) {
        float mx = 0.f;
#pragma unroll
        for (int r = 0; r < 8; ++r) { const u32x4 v = *(const u32x4*)(MKV + (size_t)(grp * 8 + r) * 512 + (lane & 31) * 8); float s = 0.f;
#pragma unroll
            for (int j = 0; j < 4; ++j) { const float a = __uint_as_float(v[j] << 16), b = __uint_as_float(v[j] & 0xffff0000u); s += a * a + b * b; }
            s += __shfl_xor(s, 1); s += __shfl_xor(s, 2); s += __shfl_xor(s, 4); mx = fmaxf(mx, s); }
        if (lane < 32 && (lane & 7) == 0) atomicMax(ctl + CW_KMAXM + ((grp * 8) / MEMLEN) * 4 + (lane >> 3), __float_as_uint(mx));
    }
}

namespace att {
#define ALAS __attribute__((address_space(3)))
typedef short bf16x8 __attribute__((ext_vector_type(8)));
typedef short s16x4 __attribute__((ext_vector_type(4)));
typedef short v4i16_t __attribute__((ext_vector_type(4)));
typedef float f32x16 __attribute__((ext_vector_type(16)));
typedef float f32x2_t __attribute__((ext_vector_type(2)));
typedef __bf16 bf16x2_t __attribute__((ext_vector_type(2)));
constexpr int KOFF = 0, VOFF = 16384, TOFF = 49152, ATT_LDS = TOFF + 1024;
DI unsigned cvtpk(float lo, float hi) { f32x2_t v = {lo, hi}; bf16x2_t b = __builtin_convertvector(v, bf16x2_t); return __builtin_bit_cast(unsigned, b); }
DI s16x4 vtr(const ALAS unsigned char* q) { return __builtin_bit_cast(s16x4, __builtin_amdgcn_ds_read_tr16_b64_v4i16((ALAS v4i16_t*)q)); }
#define ATT_MFMA(a, b, c) __builtin_amdgcn_mfma_f32_32x32x16_bf16((a), (b), (c), 0, 0, 0)

template <int NDT, bool BAND>
DI void tile(const ALAS unsigned char* kb, const ALAS unsigned char* vb, const bf16x8 (&qr)[4], const f32x16& cinit, f32x16 (&o)[NDT], float& lsum,
             const ALAS float* tbl, int relbase, float mrow) {
    f32x16 p0, p1;
#pragma unroll
    for (int d0 = 0; d0 < 4; ++d0) {
        const bf16x8 b0 = *(const ALAS bf16x8*)(kb + d0 * 2048), b1 = *(const ALAS bf16x8*)(kb + d0 * 2048 + 512);
        if (d0 == 0) { if (BAND) { const f32x16 z = {0.f,0.f,0.f,0.f,0.f,0.f,0.f,0.f,0.f,0.f,0.f,0.f,0.f,0.f,0.f,0.f}; p0 = ATT_MFMA(b0, qr[0], z); p1 = ATT_MFMA(b1, qr[0], z); }
                       else { p0 = ATT_MFMA(b0, qr[0], cinit); p1 = ATT_MFMA(b1, qr[0], cinit); } }
        else { p0 = ATT_MFMA(b0, qr[d0], p0); p1 = ATT_MFMA(b1, qr[d0], p1); }
    }
    if (BAND) {
#pragma unroll
        for (int r = 0; r < 16; ++r) {
            const int rel0 = relbase + (r & 3) + 8 * (r >> 2);
            const int i0 = min(max(rel0 + 128, 0), 255), i1 = min(max(rel0 + 160, 0), 255);
            p0[r] += tbl[i0] - mrow; p1[r] += tbl[i1] - mrow;
        }
    }
    float s = 0.f;
#pragma unroll
    for (int r = 0; r < 16; ++r) { p0[r] = __builtin_amdgcn_exp2f(p0[r]); p1[r] = __builtin_amdgcn_exp2f(p1[r]); s += p0[r] + p1[r]; }
    lsum += s;
    u32x4 w0, w1, w2, w3;
    w0.x = cvtpk(p0[0], p0[1]); w0.y = cvtpk(p0[2], p0[3]); w0.z = cvtpk(p0[4], p0[5]); w0.w = cvtpk(p0[6], p0[7]);
    w1.x = cvtpk(p0[8], p0[9]); w1.y = cvtpk(p0[10], p0[11]); w1.z = cvtpk(p0[12], p0[13]); w1.w = cvtpk(p0[14], p0[15]);
    w2.x = cvtpk(p1[0], p1[1]); w2.y = cvtpk(p1[2], p1[3]); w2.z = cvtpk(p1[4], p1[5]); w2.w = cvtpk(p1[6], p1[7]);
    w3.x = cvtpk(p1[8], p1[9]); w3.y = cvtpk(p1[10], p1[11]); w3.z = cvtpk(p1[12], p1[13]); w3.w = cvtpk(p1[14], p1[15]);
    const bf16x8 pb0 = __builtin_bit_cast(bf16x8, w0), pb1 = __builtin_bit_cast(bf16x8, w1), pb2 = __builtin_bit_cast(bf16x8, w2), pb3 = __builtin_bit_cast(bf16x8, w3);
#pragma unroll
    for (int dt = 0; dt < NDT; ++dt) {
        __builtin_amdgcn_sched_barrier(0);
#pragma unroll
        for (int ks = 0; ks < 4; ++ks) {
            const s16x4 lo = vtr(vb + (dt * 4 + ks) * 1024), hh = vtr(vb + (dt * 4 + ks) * 1024 + 512);
            const bf16x8 a = __builtin_shufflevector(lo, hh, 0, 1, 2, 3, 4, 5, 6, 7);
            o[dt] = ATT_MFMA(a, ks == 0 ? pb0 : ks == 1 ? pb1 : ks == 2 ? pb2 : pb3, o[dt]);
        }
    }
}

template <int DV, bool DIFF>
DI void attn_unit(ALAS unsigned char* lds, const Params& p, int unit, int wid, int lane) {
    unsigned char* ws = p.ws; const unsigned* ctl = (const unsigned*)(ws + WS_CTL);
    const int tid = threadIdx.x, r32 = lane & 31, hi = lane >> 5;
    constexpr int NDT = DV / 32, VBYTES = DV * 128, NCOMP = DIFF ? 2 : 1, NT = DIFF ? 64 : 4;
    int b, h, qb, qpitch, ocol; size_t kbase; const bf16_t *Qg, *Kg, *Vg;
    if (DIFF) { b = unit >> 6; h = (unit >> 4) & 3; qb = unit & 15; Qg = (const bf16_t*)(ws + WS_QB) + h * 128; qpitch = 512; Kg = (const bf16_t*)(ws + WS_KB) + h * 128;
        Vg = (const bf16_t*)(ws + WS_VB) + h * 128; kbase = (size_t)b * SEQ; ocol = h * 128; }
    else { const int qblk = unit >> 2; h = unit & 3; b = qblk >> 4; qb = qblk & 15; Qg = (const bf16_t*)(ws + WS_MQB) + h * 64; qpitch = 256; Kg = (const bf16_t*)(ws + WS_MKV) + h * 64;
        Vg = (const bf16_t*)(ws + WS_MKV) + 256 + h * 64; kbase = (size_t)b * MEMLEN; ocol = 768 + h * 64; }
    const int row0 = b * SEQ + qb * 256, qa = qb * 256 + wid * 32;
    const ALAS float* tbl = (const ALAS float*)(lds + TOFF);
    float bmax = 0.f, cL = 0.f, cR = 0.f, lam = 0.f;
    __syncthreads();
    if (DIFF) {
        const float* rb = p.in[I_RELB];
        if (tid < 256) ((ALAS float*)(lds + TOFF))[tid] = rb[t5_bucket(tid - 128) * 4 + h] * LOG2E;
        float bm = -1e30f;
        for (int i = 0; i < 32; ++i) bm = fmaxf(bm, rb[i * 4 + h]);
        bmax = bm * LOG2E; cL = rb[15 * 4 + h] * LOG2E; cR = rb[31 * 4 + h] * LOG2E;
        float s1 = 0.f, s2 = 0.f;
        for (int i = 0; i < 64; ++i) { s1 += p.in[I_LQ1][i] * p.in[I_LK1][i]; s2 += p.in[I_LQ2][i] * p.in[I_LK2][i]; }
        lam = expf(s1) - expf(s2) + LAM_INIT;
        __syncthreads();
    }
    const int tL = DIFF ? (qa >= 154 ? (qa - 154) / 64 + 1 : 0) : NT;
    const int tR = DIFF ? (qa + 185) / 64 : NT;
    const int vlane = (4 * hi + ((lane & 15) >> 2)) * 64 + ((lane >> 4) & 1) * 32 + (lane & 3) * 8;
#pragma unroll 1
    for (int c = 0; c < NCOMP; ++c) {
        const bf16_t* Qp = Qg + (size_t)(row0 + wid * 32 + r32) * qpitch + c * 64 + hi * 8;
        bf16x8 qr[4]; float qq = 0.f;
#pragma unroll
        for (int d0 = 0; d0 < 4; ++d0) { qr[d0] = *(const bf16x8*)(Qp + d0 * 16);
#pragma unroll
            for (int j = 0; j < 8; ++j) { const float f = __uint_as_float(((unsigned)(unsigned short)qr[d0][j]) << 16); qq += f * f; } }
        qq += __shfl_xor(qq, 32);
        const float kmx = sqrtf(__uint_as_float(DIFF ? ctl[CW_KMAX + b * 8 + h * 2 + c] : ctl[CW_KMAXM + b * 4 + h]));
        const float mrow = sqrtf(qq) * kmx * 1.0001f + bmax;
        f32x16 cinit;
#pragma unroll
        for (int r = 0; r < 16; ++r) cinit[r] = cL - mrow;
        f32x16 o[NDT];
#pragma unroll
        for (int dt = 0; dt < NDT; ++dt)
#pragma unroll
            for (int r = 0; r < 16; ++r) o[dt][r] = 0.f;
        float lsum = 0.f;
        const bf16_t* ksrc = Kg + (kbase + lane) * 512 + c * 64 + wid * 8;
#define ATT_DMA(t, buf) do { \
        __builtin_amdgcn_global_load_lds((const unsigned*)(ksrc + (size_t)(t) * 64 * 512), (ALAS unsigned*)(lds + KOFF + (buf) * 8192 + wid * 1024), 16, 0, 0); \
        _Pragma("unroll") for (int i_ = 0; i_ < DV / 64; ++i_) { const int pid_ = wid + 8 * i_; \
            __builtin_amdgcn_global_load_lds((const unsigned*)(Vg + (kbase + (size_t)(t) * 64 + 16 * (pid_ & 3) + (lane >> 2)) * 512 + 32 * (pid_ >> 2) + 8 * (lane & 3)), \
                                             (ALAS unsigned*)(lds + VOFF + (buf) * VBYTES + pid_ * 1024), 16, 0, 0); } } while (0)
        ATT_DMA(0, 0);
        asm volatile("s_waitcnt vmcnt(0)" ::: "memory");
        __syncthreads();
#pragma unroll 1
        for (int t = 0; t < NT; ++t) {
            const int buf = t & 1;
            if (t + 1 < NT) ATT_DMA(t + 1, buf ^ 1);
            if (DIFF && t == tR) {
                float dlt = cR - cL; asm volatile("" : "+v"(dlt));
#pragma unroll
                for (int r = 0; r < 16; ++r) cinit[r] += dlt;
            }
            const ALAS unsigned char* kb = lds + KOFF + buf * 8192 + hi * 1024 + r32 * 16;
            const ALAS unsigned char* vb = lds + VOFF + buf * VBYTES + vlane;
            if (DIFF && t >= tL && t < tR) tile<NDT, true>(kb, vb, qr, cinit, o, lsum, tbl, t * 64 + 4 * hi - qa - r32, mrow);
            else tile<NDT, false>(kb, vb, qr, cinit, o, lsum, tbl, 0, 0.f);
            asm volatile("s_waitcnt vmcnt(0)" ::: "memory");
            __syncthreads();
        }
#undef ATT_DMA
        lsum += __shfl_xor(lsum, 32);
        const float inv = 1.0f / lsum;
        int lane2 = lane; asm volatile("" : "+v"(lane2));
        const int r32b = lane2 & 31, hib = lane2 >> 5;
        float* o1p = (float*)(ws + WS_O1) + ((size_t)(unit * 8 + wid) * 64 + lane2) * 64;
        if (DIFF && c == 0) {
#pragma unroll
            for (int dt = 0; dt < NDT; ++dt)
#pragma unroll
                for (int r = 0; r < 16; ++r) o1p[dt * 16 + r] = o[dt][r] * inv;
        } else {
            bf16_t* Ob = (bf16_t*)(ws + WS_OB) + (size_t)(row0 + wid * 32 + r32b) * 1024 + ocol + 4 * hib;
            if (DIFF) {
                float ss = 0.f;
#pragma unroll
                for (int dt = 0; dt < NDT; ++dt)
#pragma unroll
                    for (int r = 0; r < 16; ++r) { const float v = o1p[dt * 16 + r] - lam * (o[dt][r] * inv); o[dt][r] = v; ss += v * v; }
                ss += __shfl_xor(ss, 32);
                const float rn = (1.0f - LAM_INIT) / sqrtf(ss * (1.0f / 128.0f) + LN_EPS);
#pragma unroll
                for (int dt = 0; dt < NDT; ++dt)
#pragma unroll
                    for (int g4 = 0; g4 < 4; ++g4) { const int d0 = 32 * dt + 8 * g4; const f32x4 sg = *(const f32x4*)(p.in[I_SUBG] + d0 + 4 * hib);
                        u32x2 w; w.x = cvtpk(o[dt][4 * g4] * rn * sg.x, o[dt][4 * g4 + 1] * rn * sg.y); w.y = cvtpk(o[dt][4 * g4 + 2] * rn * sg.z, o[dt][4 * g4 + 3] * rn * sg.w);
                        *(u32x2*)(Ob + d0) = w; }
            } else {
#pragma unroll
                for (int dt = 0; dt < NDT; ++dt)
#pragma unroll
                    for (int g4 = 0; g4 < 4; ++g4) { const int d0 = 32 * dt + 8 * g4;
                        u32x2 w; w.x = cvtpk(o[dt][4 * g4] * inv, o[dt][4 * g4 + 1] * inv); w.y = cvtpk(o[dt][4 * g4 + 2] * inv, o[dt][4 * g4 + 3] * inv);
                        *(u32x2*)(Ob + d0) = w; }
            }
        }
    }
}

constexpr int PK = 0, PVV = 24576, PT = 73728;
#define SBAR() __builtin_amdgcn_sched_barrier(0)
DI void glds16_asm(const void* gsrc, unsigned lds_dst) { unsigned keep;
    asm volatile("s_mov_b32 %0, m0\n\ts_mov_b32 m0, %2\n\ts_nop 0\n\tglobal_load_lds_dwordx4 %1, off\n\ts_mov_b32 m0, %0" : "=&s"(keep) : "v"(gsrc), "s"(lds_dst) : "memory"); }
#define PWAITBAR(N) asm volatile("s_waitcnt vmcnt(" #N ") lgkmcnt(0)\n\ts_barrier" ::: "memory")
template <bool FIRST>
DI void pstep(const bf16x8 (&qr)[4], f32x16 (&o)[4], f32x16& C0, f32x16& C1, const f32x16& P0, const f32x16& P1, float& l,
              const ALAS unsigned char* kq, const ALAS unsigned char* vq, bool band, int relbase, float cref, const ALAS float* tbl) {
    const f32x16 z = {0.f,0.f,0.f,0.f,0.f,0.f,0.f,0.f,0.f,0.f,0.f,0.f,0.f,0.f,0.f,0.f};
#define KRD(i) (*(const ALAS bf16x8*)(kq + ((i) >> 1) * 2048 + ((i) & 1) * 512))
#define VLO(f) vtr(vq + ((((f) & 3) * 4 + ((f) >> 2)) * 1024))
#define VHI(f) vtr(vq + ((((f) & 3) * 4 + ((f) >> 2)) * 1024 + 512))
#define VCAT(lo, hi) __builtin_shufflevector(lo, hi, 0, 1, 2, 3, 4, 5, 6, 7)
    u32x4 pw0, pw1, pw2, pw3; float sacc = 0.f;
    bf16x8 k0 = KRD(0), k1 = KRD(1), k2 = KRD(2), k3, k4, k5, k6, k7;
    s16x4 vl0, vh0, vl1, vh1, vl2, vh2, vl3, vh3, vl4, vh4, vl5, vh5, vl6, vh6, vl7, vh7, vl8, vh8, vl9, vh9, vl10, vh10, vl11, vh11, vl12, vh12, vl13, vh13, vl14, vh14, vl15, vh15;
    SBAR();
    k3 = KRD(3); C0 = ATT_MFMA(k0, qr[0], z); if (!FIRST) { sacc += (P0[0] + P0[1]) + (P0[2] + P0[3]); pw0.x = cvtpk(P0[0], P0[1]); pw0.y = cvtpk(P0[2], P0[3]); asm volatile("" : "+v"(sacc), "+v"(pw0.x), "+v"(pw0.y)); } SBAR();
    k4 = KRD(4); C1 = ATT_MFMA(k1, qr[0], z); if (!FIRST) { sacc += (P0[4] + P0[5]) + (P0[6] + P0[7]); pw0.z = cvtpk(P0[4], P0[5]); pw0.w = cvtpk(P0[6], P0[7]); asm volatile("" : "+v"(sacc), "+v"(pw0.z), "+v"(pw0.w)); } SBAR();
    k5 = KRD(5); C0 = ATT_MFMA(k2, qr[1], C0); if (!FIRST) { sacc += (P0[8] + P0[9]) + (P0[10] + P0[11]); pw1.x = cvtpk(P0[8], P0[9]); pw1.y = cvtpk(P0[10], P0[11]); asm volatile("" : "+v"(sacc), "+v"(pw1.x), "+v"(pw1.y)); } SBAR();
    k6 = KRD(6); C1 = ATT_MFMA(k3, qr[1], C1); if (!FIRST) { sacc += (P0[12] + P0[13]) + (P0[14] + P0[15]); pw1.z = cvtpk(P0[12], P0[13]); pw1.w = cvtpk(P0[14], P0[15]); asm volatile("" : "+v"(sacc), "+v"(pw1.z), "+v"(pw1.w)); } SBAR();
    k7 = KRD(7); if (!FIRST) { vl0 = VLO(0); vh0 = VHI(0); } C0 = ATT_MFMA(k4, qr[2], C0); if (!FIRST) { sacc += (P1[0] + P1[1]) + (P1[2] + P1[3]); pw2.x = cvtpk(P1[0], P1[1]); pw2.y = cvtpk(P1[2], P1[3]); asm volatile("" : "+v"(sacc), "+v"(pw2.x), "+v"(pw2.y)); } SBAR();
    if (!FIRST) { vl1 = VLO(1); vh1 = VHI(1); } C1 = ATT_MFMA(k5, qr[2], C1); if (!FIRST) { sacc += (P1[4] + P1[5]) + (P1[6] + P1[7]); pw2.z = cvtpk(P1[4], P1[5]); pw2.w = cvtpk(P1[6], P1[7]); asm volatile("" : "+v"(sacc), "+v"(pw2.z), "+v"(pw2.w)); } SBAR();
    if (!FIRST) { vl2 = VLO(2); vh2 = VHI(2); } C0 = ATT_MFMA(k6, qr[3], C0); if (!FIRST) { sacc += (P1[8] + P1[9]) + (P1[10] + P1[11]); pw3.x = cvtpk(P1[8], P1[9]); pw3.y = cvtpk(P1[10], P1[11]); asm volatile("" : "+v"(sacc), "+v"(pw3.x), "+v"(pw3.y)); } SBAR();
    if (!FIRST) { vl3 = VLO(3); vh3 = VHI(3); } C1 = ATT_MFMA(k7, qr[3], C1); if (!FIRST) { sacc += (P1[12] + P1[13]) + (P1[14] + P1[15]); pw3.z = cvtpk(P1[12], P1[13]); pw3.w = cvtpk(P1[14], P1[15]); asm volatile("" : "+v"(sacc), "+v"(pw3.z), "+v"(pw3.w)); } SBAR();
    l += sacc;
    if (band) {
        const ALAS float* tb_ = tbl + (relbase + 192);
#pragma unroll
        for (int r = 0; r < 16; ++r) { C0[r] += tb_[(r & 3) + 8 * (r >> 2)] - cref; C1[r] += tb_[32 + (r & 3) + 8 * (r >> 2)] - cref; }
    }
    SBAR();
    if (FIRST) {
#pragma unroll
        for (int r = 0; r < 16; ++r) { C0[r] = __builtin_amdgcn_exp2f(C0[r]); C1[r] = __builtin_amdgcn_exp2f(C1[r]); }
    } else {
        const bf16x8 pb0 = __builtin_bit_cast(bf16x8, pw0), pb1 = __builtin_bit_cast(bf16x8, pw1), pb2 = __builtin_bit_cast(bf16x8, pw2), pb3 = __builtin_bit_cast(bf16x8, pw3);
        vl4 = VLO(4); vh4 = VHI(4); o[0] = ATT_MFMA(VCAT(vl0, vh0), pb0, o[0]); C0[0] = __builtin_amdgcn_exp2f(C0[0]); C0[1] = __builtin_amdgcn_exp2f(C0[1]); asm volatile("" : "+v"(C0)); SBAR();
        vl5 = VLO(5); vh5 = VHI(5); o[1] = ATT_MFMA(VCAT(vl1, vh1), pb0, o[1]); C0[2] = __builtin_amdgcn_exp2f(C0[2]); C0[3] = __builtin_amdgcn_exp2f(C0[3]); asm volatile("" : "+v"(C0)); SBAR();
        vl6 = VLO(6); vh6 = VHI(6); o[2] = ATT_MFMA(VCAT(vl2, vh2), pb0, o[2]); C0[4] = __builtin_amdgcn_exp2f(C0[4]); C0[5] = __builtin_amdgcn_exp2f(C0[5]); asm volatile("" : "+v"(C0)); SBAR();
        vl7 = VLO(7); vh7 = VHI(7); o[3] = ATT_MFMA(VCAT(vl3, vh3), pb0, o[3]); C0[6] = __builtin_amdgcn_exp2f(C0[6]); C0[7] = __builtin_amdgcn_exp2f(C0[7]); asm volatile("" : "+v"(C0)); SBAR();
        vl8 = VLO(8); vh8 = VHI(8); o[0] = ATT_MFMA(VCAT(vl4, vh4), pb1, o[0]); C0[8] = __builtin_amdgcn_exp2f(C0[8]); C0[9] = __builtin_amdgcn_exp2f(C0[9]); asm volatile("" : "+v"(C0)); SBAR();
        vl9 = VLO(9); vh9 = VHI(9); o[1] = ATT_MFMA(VCAT(vl5, vh5), pb1, o[1]); C0[10] = __builtin_amdgcn_exp2f(C0[10]); C0[11] = __builtin_amdgcn_exp2f(C0[11]); asm volatile("" : "+v"(C0)); SBAR();
        vl10 = VLO(10); vh10 = VHI(10); o[2] = ATT_MFMA(VCAT(vl6, vh6), pb1, o[2]); C0[12] = __builtin_amdgcn_exp2f(C0[12]); C0[13] = __builtin_amdgcn_exp2f(C0[13]); asm volatile("" : "+v"(C0)); SBAR();
        vl11 = VLO(11); vh11 = VHI(11); o[3] = ATT_MFMA(VCAT(vl7, vh7), pb1, o[3]); C0[14] = __builtin_amdgcn_exp2f(C0[14]); C0[15] = __builtin_amdgcn_exp2f(C0[15]); asm volatile("" : "+v"(C0)); SBAR();
        vl12 = VLO(12); vh12 = VHI(12); o[0] = ATT_MFMA(VCAT(vl8, vh8), pb2, o[0]); C1[0] = __builtin_amdgcn_exp2f(C1[0]); C1[1] = __builtin_amdgcn_exp2f(C1[1]); asm volatile("" : "+v"(C1)); SBAR();
        vl13 = VLO(13); vh13 = VHI(13); o[1] = ATT_MFMA(VCAT(vl9, vh9), pb2, o[1]); C1[2] = __builtin_amdgcn_exp2f(C1[2]); C1[3] = __builtin_amdgcn_exp2f(C1[3]); asm volatile("" : "+v"(C1)); SBAR();
        vl14 = VLO(14); vh14 = VHI(14); o[2] = ATT_MFMA(VCAT(vl10, vh10), pb2, o[2]); C1[4] = __builtin_amdgcn_exp2f(C1[4]); C1[5] = __builtin_amdgcn_exp2f(C1[5]); asm volatile("" : "+v"(C1)); SBAR();
        vl15 = VLO(15); vh15 = VHI(15); o[3] = ATT_MFMA(VCAT(vl11, vh11), pb2, o[3]); C1[6] = __builtin_amdgcn_exp2f(C1[6]); C1[7] = __builtin_amdgcn_exp2f(C1[7]); asm volatile("" : "+v"(C1)); SBAR();
        o[0] = ATT_MFMA(VCAT(vl12, vh12), pb3, o[0]); C1[8] = __builtin_amdgcn_exp2f(C1[8]); C1[9] = __builtin_amdgcn_exp2f(C1[9]); asm volatile("" : "+v"(C1)); SBAR();
        o[1] = ATT_MFMA(VCAT(vl13, vh13), pb3, o[1]); C1[10] = __builtin_amdgcn_exp2f(C1[10]); C1[11] = __builtin_amdgcn_exp2f(C1[11]); asm volatile("" : "+v"(C1)); SBAR();
        o[2] = ATT_MFMA(VCAT(vl14, vh14), pb3, o[2]); C1[12] = __builtin_amdgcn_exp2f(C1[12]); C1[13] = __builtin_amdgcn_exp2f(C1[13]); asm volatile("" : "+v"(C1)); SBAR();
        o[3] = ATT_MFMA(VCAT(vl15, vh15), pb3, o[3]); C1[14] = __builtin_amdgcn_exp2f(C1[14]); C1[15] = __builtin_amdgcn_exp2f(C1[15]); asm volatile("" : "+v"(C1)); SBAR();
    }
#undef KRD
#undef VLO
#undef VHI
#undef VCAT
}
DI void pdrain(f32x16 (&o)[4], const f32x16& P0, const f32x16& P1, float& l, const ALAS unsigned char* vq) {
#define VLO(f) vtr(vq + ((((f) & 3) * 4 + ((f) >> 2)) * 1024))
#define VHI(f) vtr(vq + ((((f) & 3) * 4 + ((f) >> 2)) * 1024 + 512))
#define VCAT(lo, hi) __builtin_shufflevector(lo, hi, 0, 1, 2, 3, 4, 5, 6, 7)
    float sacc = 0.f;
#pragma unroll
    for (int r = 0; r < 16; ++r) sacc += P0[r] + P1[r];
    l += sacc;
    u32x4 pw0, pw1, pw2, pw3;
    pw0.x = cvtpk(P0[0], P0[1]); pw0.y = cvtpk(P0[2], P0[3]); pw0.z = cvtpk(P0[4], P0[5]); pw0.w = cvtpk(P0[6], P0[7]);
    pw1.x = cvtpk(P0[8], P0[9]); pw1.y = cvtpk(P0[10], P0[11]); pw1.z = cvtpk(P0[12], P0[13]); pw1.w = cvtpk(P0[14], P0[15]);
    pw2.x = cvtpk(P1[0], P1[1]); pw2.y = cvtpk(P1[2], P1[3]); pw2.z = cvtpk(P1[4], P1[5]); pw2.w = cvtpk(P1[6], P1[7]);
    pw3.x = cvtpk(P1[8], P1[9]); pw3.y = cvtpk(P1[10], P1[11]); pw3.z = cvtpk(P1[12], P1[13]); pw3.w = cvtpk(P1[14], P1[15]);
    const bf16x8 pb0 = __builtin_bit_cast(bf16x8, pw0), pb1 = __builtin_bit_cast(bf16x8, pw1), pb2 = __builtin_bit_cast(bf16x8, pw2), pb3 = __builtin_bit_cast(bf16x8, pw3);
    { const s16x4 lo_ = VLO(0), hi_ = VHI(0); o[0] = ATT_MFMA(VCAT(lo_, hi_), pb0, o[0]); }
    { const s16x4 lo_ = VLO(1), hi_ = VHI(1); o[1] = ATT_MFMA(VCAT(lo_, hi_), pb0, o[1]); }
    { const s16x4 lo_ = VLO(2), hi_ = VHI(2); o[2] = ATT_MFMA(VCAT(lo_, hi_), pb0, o[2]); }
    { const s16x4 lo_ = VLO(3), hi_ = VHI(3); o[3] = ATT_MFMA(VCAT(lo_, hi_), pb0, o[3]); }
    { const s16x4 lo_ = VLO(4), hi_ = VHI(4); o[0] = ATT_MFMA(VCAT(lo_, hi_), pb1, o[0]); }
    { const s16x4 lo_ = VLO(5), hi_ = VHI(5); o[1] = ATT_MFMA(VCAT(lo_, hi_), pb1, o[1]); }
    { const s16x4 lo_ = VLO(6), hi_ = VHI(6); o[2] = ATT_MFMA(VCAT(lo_, hi_), pb1, o[2]); }
    { const s16x4 lo_ = VLO(7), hi_ = VHI(7); o[3] = ATT_MFMA(VCAT(lo_, hi_), pb1, o[3]); }
    { const s16x4 lo_ = VLO(8), hi_ = VHI(8); o[0] = ATT_MFMA(VCAT(lo_, hi_), pb2, o[0]); }
    { const s16x4 lo_ = VLO(9), hi_ = VHI(9); o[1] = ATT_MFMA(VCAT(lo_, hi_), pb2, o[1]); }
    { const s16x4 lo_ = VLO(10), hi_ = VHI(10); o[2] = ATT_MFMA(VCAT(lo_, hi_), pb2, o[2]); }
    { const s16x4 lo_ = VLO(11), hi_ = VHI(11); o[3] = ATT_MFMA(VCAT(lo_, hi_), pb2, o[3]); }
    { const s16x4 lo_ = VLO(12), hi_ = VHI(12); o[0] = ATT_MFMA(VCAT(lo_, hi_), pb3, o[0]); }
    { const s16x4 lo_ = VLO(13), hi_ = VHI(13); o[1] = ATT_MFMA(VCAT(lo_, hi_), pb3, o[1]); }
    { const s16x4 lo_ = VLO(14), hi_ = VHI(14); o[2] = ATT_MFMA(VCAT(lo_, hi_), pb3, o[2]); }
    { const s16x4 lo_ = VLO(15), hi_ = VHI(15); o[3] = ATT_MFMA(VCAT(lo_, hi_), pb3, o[3]); }
#undef VLO
#undef VHI
#undef VCAT
}

DI void attn_pipe(ALAS unsigned char* lds, const Params& p, int unit, int wid, int lane) {
    unsigned char* ws = p.ws;
    const int tid = threadIdx.x, r32 = lane & 31, hi = lane >> 5;
    constexpr int NT = 64;
    const int b = unit >> 6, h = (unit >> 4) & 3, qb = unit & 15;
    const bf16_t* Qg = (const bf16_t*)(ws + WS_QB) + h * 128; const bf16_t* Kg = (const bf16_t*)(ws + WS_KB) + h * 128; const bf16_t* Vg = (const bf16_t*)(ws + WS_VB) + h * 128;
    const size_t kbase = (size_t)b * SEQ; const int ocol = h * 128;
    const int row0 = b * SEQ + qb * 256, qa = qb * 256 + wid * 32;
    const ALAS float* tbl = (const ALAS float*)(lds + PT);
    float cL, cR, lam;
    __syncthreads();
    {
        const float* rb = p.in[I_RELB];
        if (tid < 384) ((ALAS float*)(lds + PT))[tid] = rb[t5_bucket(tid - 192) * 4 + h] * LOG2E;
        cL = rb[15 * 4 + h] * LOG2E; cR = rb[31 * 4 + h] * LOG2E;
        float s1 = 0.f, s2 = 0.f;
        for (int i = 0; i < 64; ++i) { s1 += p.in[I_LQ1][i] * p.in[I_LK1][i]; s2 += p.in[I_LQ2][i] * p.in[I_LK2][i]; }
        lam = expf(s1) - expf(s2) + LAM_INIT;
        __syncthreads();
    }
    const int tL = qa >= 154 ? (qa - 154) / 64 + 1 : 0;
    const int tR = (qa + 185) / 64;
    const int vlane = (4 * hi + ((lane & 15) >> 2)) * 64 + ((lane >> 4) & 1) * 32 + (lane & 3) * 8;
    const int relb0 = 4 * hi - qa - r32;
#pragma unroll 1
    for (int c = 0; c < 2; ++c) {
        const bf16_t* Qp = Qg + (size_t)(row0 + wid * 32 + r32) * 512 + c * 64 + hi * 8;
        bf16x8 qr[4];
#pragma unroll
        for (int d0 = 0; d0 < 4; ++d0) qr[d0] = *(const bf16x8*)(Qp + d0 * 16);
        f32x16 o[4];
#pragma unroll
        for (int dt = 0; dt < 4; ++dt)
#pragma unroll
            for (int r = 0; r < 16; ++r) o[dt][r] = 0.f;
        float l = 0.f, cref = cL;
        f32x16 pA0, pA1, pB0, pB1;
        const bf16_t* ksrc = Kg + (kbase + lane) * 512 + c * 64 + wid * 8;
        const bf16_t* vsrc = Vg + (kbase + 16 * (wid & 3) + (lane >> 2)) * 512 + 32 * (wid >> 2) + 8 * (lane & 3);
        int ks_cur = 0, ks_nxt = 8192, ks_fre = 16384, vs_prv = 32768, vs_cur = 0, vs_fre = 16384;
#define PGLDS(src, dst) glds16_asm((src), (unsigned)__builtin_amdgcn_readfirstlane((int)(unsigned)(unsigned long)(dst)))
#define DMAK(t, off) PGLDS(ksrc + (size_t)(t) * (64 * 512), lds + PK + (off) + wid * 1024)
#define DMAV(t, off) do { PGLDS(vsrc + (size_t)(t) * (64 * 512), lds + PVV + (off) + wid * 1024); PGLDS(vsrc + 64 + (size_t)(t) * (64 * 512), lds + PVV + (off) + (wid + 8) * 1024); } while (0)
#define PROT() do { const int k_ = ks_cur; ks_cur = ks_nxt; ks_nxt = ks_fre; ks_fre = k_; const int v_ = vs_prv; vs_prv = vs_cur; vs_cur = vs_fre; vs_fre = v_; } while (0)
        DMAK(0, 0); DMAK(1, 8192); DMAV(0, 0);
        PWAITBAR(0);
        DMAK(2, 16384); DMAV(1, 16384);
        pstep<true>(qr, o, pA0, pA1, pA0, pA1, l, lds + PK + hi * 1024 + r32 * 16, lds + PVV + vlane, tL == 0, relb0, cref, tbl);
        PWAITBAR(3);
        PROT();
#define PSTEPX(C0, C1, P0, P1, tt) do { \
        DMAK(min((tt) + 2, NT - 1), ks_fre); DMAV(min((tt) + 1, NT - 1), vs_fre); \
        pstep<false>(qr, o, C0, C1, P0, P1, l, lds + PK + ks_cur + hi * 1024 + r32 * 16, lds + PVV + vs_prv + vlane, (tt) >= tL && (tt) < tR, relb0 + (tt) * 64, cref, tbl); \
        if ((tt) == tR) { float f_ = __builtin_amdgcn_exp2f(cL - cR); asm volatile("" : "+v"(f_)); l *= f_; cref = cR; \
            _Pragma("unroll") for (int dt_ = 0; dt_ < 4; ++dt_) _Pragma("unroll") for (int r_ = 0; r_ < 16; ++r_) o[dt_][r_] *= f_; } \
        PWAITBAR(3); PROT(); } while (0)
#pragma unroll 1
        for (int t = 1; t < NT; t += 2) {
            PSTEPX(pB0, pB1, pA0, pA1, t);
            if (t + 1 < NT) PSTEPX(pA0, pA1, pB0, pB1, t + 1);
        }
        pdrain(o, pB0, pB1, l, lds + PVV + vs_prv + vlane);
        PWAITBAR(0);
#undef PSTEPX
#undef PROT
#undef DMAV
#undef DMAK
#undef PGLDS
        l += __shfl_xor(l, 32);
        const float inv = 1.0f / l;
        int lane2 = lane; asm volatile("" : "+v"(lane2));
        const int r32b = lane2 & 31, hib = lane2 >> 5;
        float* o1p = (float*)(ws + WS_O1) + ((size_t)(unit * 8 + wid) * 64 + lane2) * 64;
        if (c == 0) {
#pragma unroll
            for (int dt = 0; dt < 4; ++dt)
#pragma unroll
                for (int r = 0; r < 16; ++r) o1p[dt * 16 + r] = o[dt][r] * inv;
        } else {
            bf16_t* Ob = (bf16_t*)(ws + WS_OB) + (size_t)(row0 + wid * 32 + r32b) * 1024 + ocol + 4 * hib;
            float ss = 0.f;
#pragma unroll
            for (int dt = 0; dt < 4; ++dt)
#pragma unroll
                for (int r = 0; r < 16; ++r) { const float v = o1p[dt * 16 + r] - lam * (o[dt][r] * inv); o[dt][r] = v; ss += v * v; }
            ss += __shfl_xor(ss, 32);
            const float rn = (1.0f - LAM_INIT) / sqrtf(ss * (1.0f / 128.0f) + LN_EPS);
#pragma unroll
            for (int dt = 0; dt < 4; ++dt)
#pragma unroll
                for (int g4 = 0; g4 < 4; ++g4) { const int d0 = 32 * dt + 8 * g4; const f32x4 sg = *(const f32x4*)(p.in[I_SUBG] + d0 + 4 * hib);
                    u32x2 w; w.x = cvtpk(o[dt][4 * g4] * rn * sg.x, o[dt][4 * g4 + 1] * rn * sg.y); w.y = cvtpk(o[dt][4 * g4 + 2] * rn * sg.z, o[dt][4 * g4 + 3] * rn * sg.w);
                    *(u32x2*)(Ob + d0) = w; }
        }
    }
}
}

template <bool DUAL, bool BKN, class LA, class LB, class EP>
DI void ngemm_tile(float* As, float* Bs, float* Bs2, int K, const LA& la, const LB& lb, const LB& lb2, const EP& ep) {
    const int tid = threadIdx.x, ty = tid >> 4, tx = tid & 15;
    float acc[4][4], acc2[4][4];
#pragma unroll
    for (int i = 0; i < 4; ++i)
#pragma unroll
        for (int j = 0; j < 4; ++j) { acc[i][j] = 0.f; acc2[i][j] = 0.f; }
    for (int kc = 0; kc < K; kc += 32) {
        __syncthreads();
#pragma unroll
        for (int j = 0; j < 8; ++j) { const int i = tid + 512 * j, k = i & 31, r = i >> 5; As[k * 132 + r] = la(r, kc + k); }
#pragma unroll
        for (int j = 0; j < 4; ++j) { const int i = tid + 512 * j; int k, n; if (BKN) { n = i & 63; k = i >> 6; } else { k = i & 31; n = i >> 5; }
            Bs[k * 68 + n] = lb(kc + k, n); if (DUAL) Bs2[k * 68 + n] = lb2(kc + k, n); }
        __syncthreads();
#pragma unroll 8
        for (int k = 0; k < 32; ++k) {
            const f32x4 a = *(const f32x4*)&As[k * 132 + ty * 4]; const f32x4 b = *(const f32x4*)&Bs[k * 68 + tx * 4];
#pragma unroll
            for (int i = 0; i < 4; ++i)
#pragma unroll
                for (int j = 0; j < 4; ++j) acc[i][j] += a[i] * b[j];
            if (DUAL) { const f32x4 b2 = *(const f32x4*)&Bs2[k * 68 + tx * 4];
#pragma unroll
                for (int i = 0; i < 4; ++i)
#pragma unroll
                    for (int j = 0; j < 4; ++j) acc2[i][j] += a[i] * b2[j]; }
        }
    }
#pragma unroll
    for (int i = 0; i < 4; ++i)
#pragma unroll
        for (int j = 0; j < 4; ++j) ep(ty * 4 + i, tx * 4 + j, acc[i][j], acc2[i][j]);
}

struct LA_bf { const bf16_t* A; int lda; DI float operator()(int r, int k) const { return bf2f(A[(size_t)r * lda + k]); } };
struct LB_bf { const bf16_t* B; int ldb; DI float operator()(int k, int n) const { return bf2f(B[(size_t)n * ldb + k]); } };
struct EP_inproj { unsigned char* ws; int m0, n0;
    DI void operator()(int r, int n, float v, float) const { const int row = m0 + r, c = n0 + n; bf16_t* dst;
        if (c < 512) dst = (bf16_t*)(ws + WS_QB) + (size_t)row * 512 + c; else if (c < 1024) dst = (bf16_t*)(ws + WS_KB) + (size_t)row * 512 + (c - 512);
        else if (c < 1536) dst = (bf16_t*)(ws + WS_VB) + (size_t)row * 512 + (c - 1024); else if (c < 1792) dst = (bf16_t*)(ws + WS_MQB) + (size_t)row * 256 + (c - 1536);
        else dst = (bf16_t*)(ws + WS_ZB) + (size_t)row * 512 + (c - 1792);
        *dst = (bf16_t)f2bf(v); } };
struct EP_bf { bf16_t* C; int ldc; int m0, n0; DI void operator()(int r, int n, float v, float) const { C[(size_t)(m0 + r) * ldc + n0 + n] = (bf16_t)f2bf(v); } };
struct EP_f32 { float* C; int ldc; int m0, n0; DI void operator()(int r, int n, float v, float) const { C[(size_t)(m0 + r) * ldc + n0 + n] = v; } };

struct LA_dft { const float* ct; int s0; DI float operator()(int r, int k) const { const int sp = s0 + r, s = k & 4095; const int idx = (s * sp) & 4095;
    return (k < 4096) ? ct[idx] : -ct[(idx - 1024) & 4095]; } };
struct LB_z { const bf16_t* Z; int n0; DI float operator()(int k, int n) const { return bf2f(Z[(size_t)(k & 4095) * 512 + (k >> 12) * 256 + n0 + n]); } };
struct EP_ob { bf16_t* O; int row0, col0; DI void operator()(int r, int n, float v, float) const { O[(size_t)(row0 + r) * 1024 + col0 + n] = (bf16_t)f2bf(v); } };
DI void nfourier_phase(const Params& p, float* As, float* Bs, int bid, int nb) {
    unsigned char* ws = p.ws; const float* ct = (const float*)(ws + WS_COSTAB);
    const int nT = NB * 32 * 4;
    for (int t = bid; t < nT; t += nb) {
        const int b = t / 128, q = t % 128, s0 = (q / 4) * 128, n0 = (q % 4) * 64;
        LA_dft la{ct, s0}; LB_z lb{(const bf16_t*)(ws + WS_ZB) + (size_t)b * SEQ * 512, n0}; EP_ob ep{(bf16_t*)(ws + WS_OB), b * SEQ + s0, 512 + n0};
        ngemm_tile<false, true>(As, Bs, Bs, 8192, la, lb, lb, ep);
    }
}

constexpr int P5_WA = 0, P5_WB = 131072 + 4096, P5_LG = P5_WB + 16384;
DI void p4_ln1_router(const Params& p, __attribute__((address_space(3))) unsigned char* lds, int gw, int NGW, int wave, int lane) {
    typedef __attribute__((address_space(3))) unsigned char* lptr;
    unsigned char* ws = p.ws;
    const float* Aout = (const float*)(ws + WS_AOUT); const float* st0 = (const float*)(ws + WS_STATS0); bf16_t* H1 = (bf16_t*)(ws + WS_XN);
    const float* WR = (const float*)(ws + WS_WR); unsigned* cnt = (unsigned*)(ws + WS_CTL) + CW_CNT; int* info = (int*)(ws + WS_TOKINFO); int* list = (int*)(ws + WS_LIST);
    __attribute__((address_space(3))) float* lg = (__attribute__((address_space(3))) float*)(lds + P5_LG) + wave * (8 * 36);
    __syncthreads();
#pragma unroll
    for (int i = 0; i < 18; ++i) { const int pc = wave * 18 + i, e = pc >> 2, part = pc & 3;
        const lptr dst = (e < 4) ? (lds + P5_WB + e * 4096 + part * 1024) : (lds + P5_WA + (e - 4) * 4096 + part * 1024);
        __builtin_amdgcn_global_load_lds((const unsigned*)(WR + (size_t)e * 1024 + part * 256 + lane * 4), (__attribute__((address_space(3))) unsigned*)dst, 16, 0, 0); }
    const f32x4* g0p = (const f32x4*)p.in[I_LN0G] + lane; const f32x4* b0p = (const f32x4*)p.in[I_LN0B] + lane;
    const f32x4* g1p = (const f32x4*)p.in[I_LN1G] + lane; const f32x4* b1p = (const f32x4*)p.in[I_LN1B] + lane;
    for (int grp = gw; grp < NTOK / 8; grp += NGW) {
        f32x4 hv[8][4];
        f32x4 cx[4], ca[4];
        { const int row = grp * 8; const f32x4* xr = (const f32x4*)(p.in[I_X] + (size_t)row * DM) + lane; const f32x4* ar = (const f32x4*)(Aout + (size_t)row * DM) + lane;
#pragma unroll
          for (int j = 0; j < 4; ++j) { cx[j] = xr[64 * j]; ca[j] = ar[64 * j]; } }
#pragma unroll
        for (int r = 0; r < 8; ++r) {
            const int row = grp * 8 + r;
            f32x4 nx[4], na[4];
            if (r < 7) { const f32x4* xr = (const f32x4*)(p.in[I_X] + (size_t)(row + 1) * DM) + lane; const f32x4* ar = (const f32x4*)(Aout + (size_t)(row + 1) * DM) + lane;
#pragma unroll
                for (int j = 0; j < 4; ++j) { nx[j] = xr[64 * j]; na[j] = ar[64 * j]; } }
            const float mu0 = st0[2 * row], rs0 = st0[2 * row + 1];
            float s = 0.f;
#pragma unroll
            for (int j = 0; j < 4; ++j) { const f32x4 h0 = (cx[j] - mu0) * rs0 * g0p[64 * j] + b0p[64 * j]; hv[r][j] = h0 * ALPHA + ca[j]; s += (hv[r][j].x + hv[r][j].y) + (hv[r][j].z + hv[r][j].w); }
            const float mean = wave_sum2(s) * (1.f / DM); float s2 = 0.f;
#pragma unroll
            for (int j = 0; j < 4; ++j) { hv[r][j] = hv[r][j] - mean; s2 += (hv[r][j].x * hv[r][j].x + hv[r][j].y * hv[r][j].y) + (hv[r][j].z * hv[r][j].z + hv[r][j].w * hv[r][j].w); }
            const float rstd = 1.f / sqrtf(wave_sum2(s2) * (1.f / DM) + LN_EPS);
            u32x2* o8 = (u32x2*)(H1 + (size_t)row * DM) + lane;
#pragma unroll
            for (int j = 0; j < 4; ++j) { hv[r][j] = hv[r][j] * rstd * g1p[64 * j] + b1p[64 * j]; u32x2 w; w.x = pk2(hv[r][j].x, hv[r][j].y); w.y = pk2(hv[r][j].z, hv[r][j].w); o8[64 * j] = w; }
            if (r < 7) {
#pragma unroll
                for (int j = 0; j < 4; ++j) { cx[j] = nx[j]; ca[j] = na[j]; } }
        }
        if (grp == gw) { asm volatile("s_waitcnt vmcnt(0)" ::: "memory"); __syncthreads(); }
        const bool b3 = (lane >> 3) & 1;
#pragma unroll 4
        for (int e = 0; e < 36; ++e) {
            const lptr wb = (e < 4) ? (lds + P5_WB + e * 4096) : (lds + P5_WA + (e - 4) * 4096);
            const __attribute__((address_space(3))) f32x4* wr = (const __attribute__((address_space(3))) f32x4*)wb + lane;
            const f32x4 w0 = wr[0], w1 = wr[64], w2 = wr[128], w3 = wr[192];
            float part[8];
#pragma unroll
            for (int r = 0; r < 8; ++r) { const f32x4 t = hv[r][0] * w0 + hv[r][1] * w1 + hv[r][2] * w2 + hv[r][3] * w3; part[r] = (t.x + t.y) + (t.z + t.w); }
            float q[4], q2[2];
#pragma unroll
            for (int r = 0; r < 4; ++r) { auto sw = __builtin_amdgcn_permlane32_swap(__float_as_uint(part[r]), __float_as_uint(part[r + 4]), false, false); q[r] = __uint_as_float(sw[0]) + __uint_as_float(sw[1]); }
#pragma unroll
            for (int r = 0; r < 2; ++r) { auto sw = __builtin_amdgcn_permlane16_swap(__float_as_uint(q[r]), __float_as_uint(q[r + 2]), false, false); q2[r] = __uint_as_float(sw[0]) + __uint_as_float(sw[1]); }
            const float snd = b3 ? q2[0] : q2[1], kp = b3 ? q2[1] : q2[0];
            float q3 = kp + dppf<0x128>(snd);
            q3 += dppf<0xB1>(q3); q3 += dppf<0x4E>(q3); q3 += dppf<0x141>(q3);
            if ((lane & 7) == 0) lg[(lane >> 3) * 36 + e] = q3;
        }
        asm volatile("s_waitcnt lgkmcnt(0)" ::: "memory");
        if (lane < 8) {
            const int row = grp * 8 + lane; const __attribute__((address_space(3))) float* L = lg + lane * 36;
            float gl[4]; int gs = 0; float gm;
#pragma unroll
            for (int j = 0; j < 4; ++j) gl[j] = L[j] + p.in[I_BG][j];
            gm = gl[0];
#pragma unroll
            for (int j = 1; j < 4; ++j) if (gl[j] > gm) { gm = gl[j]; gs = j; }
            float den = 0.f;
#pragma unroll
            for (int j = 0; j < 4; ++j) den += expf(gl[j] - gm);
            const float gate = 1.0f / den;
            float v0 = -1e30f, v1 = -1e30f; int i0 = 0, i1 = 0;
#pragma unroll
            for (int j = 0; j < 8; ++j) { const float v = L[4 + gs * 8 + j] + p.in[I_BRT][gs * 8 + j];
                if (v > v0) { v1 = v0; i1 = i0; v0 = v; i0 = j; } else if (v > v1) { v1 = v; i1 = j; } }
            const float ex = expf(v1 - v0); const float w0 = gate / (1.f + ex), w1 = gate * ex / (1.f + ex);
            const int e0 = gs * 8 + i0, e1 = gs * 8 + i1;
            const unsigned p0 = atomicAdd(cnt + e0, 1u), p1 = atomicAdd(cnt + e1, 1u);
            list[e0 * NTOK + p0] = row; list[e1 * NTOK + p1] = row;
            int* ii = info + (size_t)row * 8; ii[0] = e0; ii[1] = (int)p0; ii[2] = __float_as_int(w0); ii[3] = e1; ii[4] = (int)p1; ii[5] = __float_as_int(w1);
        }
        asm volatile("s_waitcnt lgkmcnt(0)" ::: "memory");
    }
    __syncthreads();
}

struct LA_gather { const bf16_t* H; const int* tok; DI float operator()(int r, int k) const { return bf2f(H[(size_t)tok[r] * 1024 + k]); } };
struct EP_hid { bf16_t* HID; int slot0, nvalid, n0; DI void operator()(int r, int n, float v1, float v3) const { if (r < nvalid) { const float s = v1 / (1.0f + expf(-v1)); HID[(size_t)(slot0 + r) * 256 + n0 + n] = (bf16_t)f2bf(s * v3); } } };
struct EP_y { bf16_t* Y; int slot0, nvalid, n0; DI void operator()(int r, int n, float v, float) const { if (r < nvalid) Y[(size_t)(slot0 + r) * 1024 + n0 + n] = (bf16_t)f2bf(v); } };
DI void nmoe_phase(const Params& p, int which, float* ldsf, int bid, int nb) {
    float* As = ldsf; float* Bs = ldsf + 32 * 132; float* Bs2 = Bs + 32 * 68; int* s_tok = (int*)(Bs2 + 32 * 68); int* s_cnt = s_tok + 128; int* s_tpre = s_cnt + 32; int* s_base = s_tpre + 33;
    unsigned char* ws = p.ws; const unsigned* cnt = (const unsigned*)(ws + WS_CTL) + CW_CNT; const int* list = (const int*)(ws + WS_LIST);
    const int tid = threadIdx.x;
    if (tid == 0) { int tp = 0, bs = 0; for (int e = 0; e < 32; ++e) { const int c = (int)cnt[e]; s_cnt[e] = c; s_tpre[e] = tp; s_base[e] = bs; tp += (c + 127) >> 7; bs += (c + 255) & ~255; } s_tpre[32] = tp; s_base[32] = bs; }
    __syncthreads();
    const int NT = which == 0 ? 4 : 16, total = s_tpre[32] * NT;
    for (int u = bid; u < total; u += nb) {
        const int T = u / NT, nt = u % NT; int e = 0; while (s_tpre[e + 1] <= T) ++e;
        const int mt = T - s_tpre[e], nvalid = min(128, s_cnt[e] - mt * 128), slot0 = s_base[e] + mt * 128;
        if (which == 0) {
            __syncthreads();
            if (tid < 128) s_tok[tid] = (tid < nvalid) ? list[e * NTOK + mt * 128 + tid] : 0;
            __syncthreads();
            const int j0 = nt * 64;
            const int r1 = e * 512 + (j0 >> 7) * 256 + (j0 & 127);
            LA_gather la{(const bf16_t*)(ws + WS_XN), s_tok}; LB_bf lb{(const bf16_t*)(ws + WS_W13T) + (size_t)r1 * 1024, 1024}; LB_bf lb2{(const bf16_t*)(ws + WS_W13T) + (size_t)(r1 + 128) * 1024, 1024};
            EP_hid ep{(bf16_t*)(ws + WS_OB), slot0, nvalid, j0};
            ngemm_tile<true, false>(As, Bs, Bs2, 1024, la, lb, lb2, ep);
        } else {
            LA_bf la{(const bf16_t*)(ws + WS_OB) + (size_t)slot0 * 256, 256}; LB_bf lb{(const bf16_t*)(ws + WS_W2T) + (size_t)(e * 1024 + nt * 64) * 256, 256};
            EP_y ep{(bf16_t*)(ws + WS_Y), slot0, nvalid, nt * 64};
            ngemm_tile<false, false>(As, Bs, Bs, 256, la, lb, lb, ep);
        }
    }
}

DI void p7_final(const Params& p, int gw, int NGW, int lane) {
    unsigned char* ws = p.ws; const unsigned* cnt = (const unsigned*)(ws + WS_CTL) + CW_CNT; const int* info = (const int*)(ws + WS_TOKINFO);
    const bf16_t* H1 = (const bf16_t*)(ws + WS_XN); const bf16_t* Y = (const bf16_t*)(ws + WS_Y);
    int base;
    { const int c = lane < 32 ? (int)cnt[lane] : 0; const int r = (c + 255) & ~255; int inc = r;
#pragma unroll
      for (int o = 1; o < 32; o <<= 1) { const int t = __shfl_up(inc, o); if ((lane & 31) >= o) inc += t; }
      base = inc - r; }
    for (int row = gw; row < NTOK; row += NGW) {
        const int* ii = info + (size_t)row * 8;
        const int e0 = ii[0], p0 = ii[1], e1 = ii[3], p1 = ii[4]; const float w0 = __int_as_float(ii[2]), w1 = __int_as_float(ii[5]);
        const size_t s0 = (size_t)(__shfl(base, e0) + p0), s1 = (size_t)(__shfl(base, e1) + p1);
        const u32x2* h8 = (const u32x2*)(H1 + (size_t)row * DM) + lane; const u32x2* y0 = (const u32x2*)(Y + s0 * DM) + lane; const u32x2* y1 = (const u32x2*)(Y + s1 * DM) + lane;
        f32x4 v[4]; float s = 0.f;
#pragma unroll
        for (int j = 0; j < 4; ++j) { const u32x2 a = h8[64 * j], b = y0[64 * j], c = y1[64 * j];
            v[j].x = ALPHA * __uint_as_float(a.x << 16) + w0 * __uint_as_float(b.x << 16) + w1 * __uint_as_float(c.x << 16);
            v[j].y = ALPHA * __uint_as_float(a.x & 0xffff0000u) + w0 * __uint_as_float(b.x & 0xffff0000u) + w1 * __uint_as_float(c.x & 0xffff0000u);
            v[j].z = ALPHA * __uint_as_float(a.y << 16) + w0 * __uint_as_float(b.y << 16) + w1 * __uint_as_float(c.y << 16);
            v[j].w = ALPHA * __uint_as_float(a.y & 0xffff0000u) + w0 * __uint_as_float(b.y & 0xffff0000u) + w1 * __uint_as_float(c.y & 0xffff0000u);
            s += (v[j].x + v[j].y) + (v[j].z + v[j].w); }
        const float mean = wave_sum(s) * (1.f / DM); float s2 = 0.f;
#pragma unroll
        for (int j = 0; j < 4; ++j) { v[j] = v[j] - mean; s2 += (v[j].x * v[j].x + v[j].y * v[j].y) + (v[j].z * v[j].z + v[j].w * v[j].w); }
        const float rstd = 1.f / sqrtf(wave_sum(s2) * (1.f / DM) + LN_EPS);
        f32x4* o = (f32x4*)(p.out + (size_t)row * DM) + lane;
#pragma unroll
        for (int j = 0; j < 4; ++j) { const f32x4 g = ((const f32x4*)p.in[I_LN2G])[lane + 64 * j], bb = ((const f32x4*)p.in[I_LN2B])[lane + 64 * j]; o[64 * j] = v[j] * rstd * g + bb; }
    }
}


#define LAS __attribute__((address_space(3)))
#define XB_TMO      128
#define XB_XCNT(j)  (256  + 64 * (j))
#define XB_XSUB(j)  (1280 + 64 * (j))
#define XB_XGEN(j)  (2304 + 64 * (j))
#define XB_TOP      3328
#define XB_TOPGEN   3392
#define XCD_BAR_WORDS 3456
#define XB_SPIN_CAP (1u << 18)

__device__ __forceinline__ unsigned xb_ld(unsigned* p)              { return __hip_atomic_load(p, __ATOMIC_RELAXED, __HIP_MEMORY_SCOPE_AGENT); }
__device__ __forceinline__ unsigned xb_add(unsigned* p, unsigned v) { return __hip_atomic_fetch_add(p, v, __ATOMIC_RELAXED, __HIP_MEMORY_SCOPE_AGENT); }
__device__ __forceinline__ unsigned xb_xcc_id() { return (unsigned)__builtin_amdgcn_s_getreg((3 << 11) | 20) & 0xFu; }
#define XB_SPIN(cond, bar) do { unsigned _sp = 0; while (cond) { __builtin_amdgcn_s_sleep(1); \
    if ((++_sp & 255u) == 0u) { if (xb_ld(&(bar)[XB_TMO])) break; if (_sp > XB_SPIN_CAP) { atomicAdd(&(bar)[XB_TMO], 1u); break; } } } } while (0)

struct XcdBarrier {
    unsigned* bar; unsigned x;
    volatile LAS unsigned* st;
};

__device__ __forceinline__ XcdBarrier xcd_barrier_post(unsigned* bar, volatile LAS unsigned* st) {
    XcdBarrier b; b.bar = bar; b.x = xb_xcc_id(); b.st = st;
    if (threadIdx.x == 0) (void)xb_add(&bar[XB_XCNT(b.x)], 1u);
    return b;
}
__device__ __forceinline__ void xcd_barrier_complete(unsigned* bar, unsigned x, unsigned& nloc, unsigned& nx) {
    const unsigned G = gridDim.x * gridDim.y * gridDim.z;
    unsigned sum, cnt, mine, sp = 0u;
    for (;;) {
        sum = 0u; cnt = 0u; mine = 0u;
#pragma unroll
        for (unsigned j = 0; j < 16; ++j) { const unsigned c = xb_ld(&bar[XB_XCNT(j)]); sum += c; cnt += (c > 0u) ? 1u : 0u; mine = (j == x) ? c : mine; }
        if (sum == G) break;
        __builtin_amdgcn_s_sleep(1);
        if ((++sp & 255u) == 0u) { if (xb_ld(&bar[XB_TMO])) break; if (sp > XB_SPIN_CAP) { atomicAdd(&bar[XB_TMO], 1u); break; } }
    }
    nloc = mine > 0u ? mine : 1u; nx = cnt > 0u ? cnt : 1u;
}

__device__ __forceinline__ void xcd_barrier(const XcdBarrier& b) {
    asm volatile("s_waitcnt vmcnt(0)" ::: "memory");
    __syncthreads();
    if (threadIdx.x == 0) {
        unsigned* bar = b.bar;
        __builtin_amdgcn_s_waitcnt(0);
        unsigned nloc = b.st[0], nx = b.st[1];
        if (nloc == 0u) { xcd_barrier_complete(bar, b.x, nloc, nx); b.st[0] = nloc; b.st[1] = nx; }
        const unsigned old = xb_add(&bar[XB_XSUB(b.x)], 1u);
        const unsigned gen = old / nloc;
        if (old + 1u == (gen + 1u) * nloc) {
            __builtin_amdgcn_fence(__ATOMIC_RELEASE, "agent");
            asm volatile("s_waitcnt vmcnt(0)" ::: "memory");
            const unsigned og = xb_add(&bar[XB_TOP], 1u);
            const unsigned tg = og / nx;
            if (og + 1u == (tg + 1u) * nx) xb_add(&bar[XB_TOPGEN], 1u);
            else XB_SPIN(xb_ld(&bar[XB_TOPGEN]) == tg, bar);
            __builtin_amdgcn_fence(__ATOMIC_ACQUIRE, "agent");
            xb_add(&bar[XB_XGEN(b.x)], 1u);
            asm volatile("s_waitcnt vmcnt(0)" ::: "memory");
        } else {
            XB_SPIN(xb_ld(&bar[XB_XGEN(b.x)]) == gen, bar);
            __builtin_amdgcn_fence(__ATOMIC_ACQUIRE, "agent");
            asm volatile("s_waitcnt vmcnt(0)" ::: "memory");
        }
    }
    __syncthreads();
}


namespace fft {
using att::bf16x8; using att::s16x4; using att::f32x16; using att::vtr; using att::cvtpk;
constexpr int XP = 1088, XOFF = 0, FOFF = 64 * XP;
template <int STAGE>
DI void fft_unit(ALAS unsigned char* lds, const Params& p, int unit, int wid, int lane) {
    constexpr int M = STAGE == 1 ? 128 : 64, MT = M / 32, CH = M * 16;
    unsigned char* ws = p.ws;
    const int tid = threadIdx.x, r32 = lane & 31, hi = lane >> 5;
    const int b = unit >> 6, u6 = unit & 63;
    __syncthreads();
    for (int idx = tid; idx < M * 128; idx += 512) {
        const int k = idx & 127, row = idx >> 7, part = k >> 6, kk = k & 63, rr = row & 63;
        const float ang = (float)((kk * rr) & 63) * (1.0f / 32.0f); const float c = cospif(ang), sn = sinpif(ang);
        float v;
        if (STAGE == 1) v = (row < 64) ? (part == 0 ? c : -sn) : (part == 0 ? -sn : -c);
        else v = part == 0 ? c : sn;
        *(ALAS bf16_t*)(lds + FOFF + (k >> 3) * CH + row * 16 + (k & 7) * 2) = (bf16_t)f2bf(v);
    }
    const bf16_t* src = STAGE == 1 ? (const bf16_t*)(ws + WS_ZB) + ((size_t)b * SEQ + u6) * 512 : (const bf16_t*)(ws + WS_ZS1) + ((size_t)(b * 64 + u6) * 64) * 512;
    const size_t rstride = STAGE == 1 ? (size_t)64 * 512 : (size_t)512;
#pragma unroll
    for (int i = 0; i < 8; ++i) { const int row = wid + 8 * i;
        __builtin_amdgcn_global_load_lds((const unsigned*)(src + row * rstride + lane * 8), (ALAS unsigned*)(lds + XOFF + row * XP), 16, 0, 0); }
    asm volatile("s_waitcnt vmcnt(0)" ::: "memory");
    __syncthreads();
    f32x16 acc[MT];
#pragma unroll
    for (int mt = 0; mt < MT; ++mt)
#pragma unroll
        for (int r = 0; r < 16; ++r) acc[mt][r] = 0.f;
    const ALAS unsigned char* xb = lds + XOFF + (8 * hi + ((lane & 15) >> 2)) * XP + (32 * wid + 16 * ((lane >> 4) & 1) + 4 * (lane & 3)) * 2;
    const ALAS unsigned char* fb = lds + FOFF + hi * CH + r32 * 16;
#pragma unroll
    for (int ks = 0; ks < 8; ++ks) {
        const ALAS unsigned char* bp = xb + (16 * (ks & 3)) * XP + (ks >> 2) * 512;
        const s16x4 lo = vtr(bp), hh = vtr(bp + 4 * XP);
        const bf16x8 bfr = __builtin_shufflevector(lo, hh, 0, 1, 2, 3, 4, 5, 6, 7);
#pragma unroll
        for (int mt = 0; mt < MT; ++mt) { const bf16x8 afr = *(const ALAS bf16x8*)(fb + (2 * ks) * CH + mt * 512); acc[mt] = ATT_MFMA(afr, bfr, acc[mt]); }
    }
    __syncthreads();
    const int col = 32 * wid + r32;
    if (STAGE == 1) {
#pragma unroll
        for (int mt = 0; mt < 2; ++mt)
#pragma unroll
            for (int r = 0; r < 16; ++r) { const int s1p = 32 * mt + (r & 3) + 8 * (r >> 2) + 4 * hi;
                const float x = (float)((s1p * u6) & 4095) * (1.0f / 4096.0f); const float ct = __builtin_amdgcn_cosf(x), st = __builtin_amdgcn_sinf(x);
                const float yr = acc[mt][r], yi = acc[mt + 2][r];
                *(ALAS bf16_t*)(lds + XOFF + s1p * 1024 + col * 2) = (bf16_t)f2bf(yr * ct + yi * st);
                *(ALAS bf16_t*)(lds + XOFF + s1p * 1024 + 512 + col * 2) = (bf16_t)f2bf(yi * ct - yr * st); }
        __syncthreads();
        bf16_t* dst = (bf16_t*)(ws + WS_ZS1);
#pragma unroll
        for (int i = 0; i < 8; ++i) { const int row = i * 8 + (tid >> 6), ch = tid & 63;
            const u32x4 v = *(const ALAS u32x4*)(lds + XOFF + row * 1024 + ch * 16);
            *(u32x4*)(dst + ((size_t)(b * 64 + row) * 64 + u6) * 512 + ch * 8) = v; }
    } else {
#pragma unroll
        for (int mt = 0; mt < 2; ++mt)
#pragma unroll
            for (int r = 0; r < 16; ++r) { const int s2p = 32 * mt + (r & 3) + 8 * (r >> 2) + 4 * hi;
                *(ALAS bf16_t*)(lds + XOFF + s2p * 512 + col * 2) = (bf16_t)f2bf(acc[mt][r]); }
        __syncthreads();
        bf16_t* dst = (bf16_t*)(ws + WS_OB);
#pragma unroll
        for (int i = 0; i < 4; ++i) { const int row = i * 16 + (tid >> 5), ch = tid & 31;
            const u32x4 v = *(const ALAS u32x4*)(lds + XOFF + row * 512 + ch * 16);
            *(u32x4*)(dst + ((size_t)b * SEQ + u6 + 64 * row) * 1024 + 512 + ch * 8) = v; }
    }
    __syncthreads();
}
}

constexpr int LDS_BYTES = 163840;
constexpr int LDSCTL_OFF = 131072, MISC_OFF = LDSCTL_OFF + 320;
constexpr int CW_BAR = 4096;
struct Args { Params p; int ph_lo, ph_hi; };
__global__ void __launch_bounds__(512, 2) mk_fwd(Args a) {
    extern __shared__ __attribute__((aligned(16))) unsigned char smem[];
    LAS unsigned char* lds = (LAS unsigned char*)smem;
    const int tid = threadIdx.x, lane = tid & 63, wave = __builtin_amdgcn_readfirstlane(tid >> 6);
    const int G = gridDim.x, bx = blockIdx.x, vcu = (G % 8 == 0) ? (bx % 8) * (G / 8) + bx / 8 : bx;
    const int lo = a.ph_lo, hi = a.ph_hi;
    unsigned char* ws = a.p.ws;
    volatile LAS unsigned* MISC = (volatile LAS unsigned*)(lds + MISC_OFF);
    for (int u = tid; u < (LDS_BYTES - LDSCTL_OFF) / 4; u += 512) ((LAS unsigned*)(lds + LDSCTL_OFF))[u] = 0u;
    __syncthreads();
    XcdBarrier bar = xcd_barrier_post((unsigned*)(ws + WS_CTL) + CW_BAR, MISC + 8);
#ifndef PHMASK
#define PHMASK 0xffff
#endif
#define IN(k) (((PHMASK >> (k)) & 1) && lo <= (k) && (k) < hi)
#define SEAM(k) do { if (IN(k) && IN((k) + 1)) xcd_barrier(bar); } while (0)
#ifndef REPMASK
#define REPMASK 0
#endif
    int one_ = 1; asm volatile("" : "+s"(one_));
#define REP(k) _Pragma("unroll 1") for (int rep_ = 0; rep_ < (((REPMASK >> (k)) & 1) ? one_ + 1 : 1); ++rep_)
    int kDM = DM, kDE = DEXP; asm volatile("" : "+s"(kDM), "+s"(kDE));
    if (IN(0)) REP(0) { p0_prologue(a.p, (float*)smem, vcu * 8 + wave, G * 8, wave, lane); }
    SEAM(0);
    if (IN(1)) REP(1) {
        { pg8::Gemm g{(const bf16_t*)(ws + WS_XN), (const bf16_t*)(ws + WS_WINT), NTOK, NIN, kDM}; pg8::StaticOrder S; S.init(NTOK, NIN, G, bx);
          pg8::EpiInproj E{ws}; pg8::gemm_phase<pg8::EpiInproj, pg8::StaticOrder, true, true>(lds, g, S, E); }
        { pg8::Gemm g{(const bf16_t*)(ws + WS_MEMB), (const bf16_t*)(ws + WS_WMT), NB * MEMLEN, 512, kDM}; pg8::StaticOrder S; S.init(NB * MEMLEN, 512, G, bx);
          pg8::EpiBf16Plain E{(bf16_t*)(ws + WS_MKV), 512}; pg8::gemm_phase<pg8::EpiBf16Plain, pg8::StaticOrder, true, true>(lds, g, S, E); }
    }
    SEAM(1);
    if (IN(2)) REP(2) { kmax_phase(a.p, vcu * 8 + wave, G * 8, lane); for (int u = vcu; u < 256; u += G) fft::fft_unit<1>(lds, a.p, u, wave, lane); }
    SEAM(2);
    if (IN(3)) REP(3) {
        for (int u = vcu; u < 256; u += G) {
            const unsigned* ctl = (const unsigned*)(ws + WS_CTL); const int bh2 = (u >> 4) * 2; const float* rb = a.p.in[I_RELB];
            float babs = 0.f; for (int i = 0; i < 32; ++i) babs = fmaxf(babs, fabsf(rb[i * 4 + ((u >> 4) & 3)]));
            const float cs = sqrtf(fmaxf(__uint_as_float(ctl[CW_QMAX + bh2]) * __uint_as_float(ctl[CW_KMAX + bh2]), __uint_as_float(ctl[CW_QMAX + bh2 + 1]) * __uint_as_float(ctl[CW_KMAX + bh2 + 1]))) + 2.f * babs * LOG2E;
            int lane_u = lane; asm volatile("" : "+v"(lane_u));
            if (cs < 100.f) att::attn_pipe(lds, a.p, u, wave, lane_u);
            else att::attn_unit<128, true>(lds, a.p, u, wave, lane_u);
        }
        { int lane_b = lane; asm volatile("" : "+v"(lane_b)); for (int u = vcu; u < 256; u += G) att::attn_unit<64, false>(lds, a.p, u, wave, lane_b); }
        { int lane_c = lane; asm volatile("" : "+v"(lane_c)); for (int u = vcu; u < 256; u += G) fft::fft_unit<2>(lds, a.p, u, wave, lane_c); }
    }
    SEAM(3);
    if (IN(4)) REP(4) {
        pg8::Gemm g{(const bf16_t*)(ws + WS_OB), (const bf16_t*)(ws + WS_WOT), NTOK, DM, kDM}; pg8::StaticOrder S; S.init(NTOK, DM, G, bx);
        pg8::EpiF32Plain E{(float*)(ws + WS_AOUT), DM}; pg8::gemm_phase<pg8::EpiF32Plain, pg8::StaticOrder, true, true>(lds, g, S, E);
    }
    SEAM(4);
    if (IN(5)) { p4_ln1_router(a.p, lds, vcu * 8 + wave, G * 8, wave, lane); }
    SEAM(5);
    LAS int* mtab = (LAS int*)(lds + LDSCTL_OFF + 1024);
    if (IN(6) || IN(7)) {
        if (tid == 0) { const unsigned* cnt = (const unsigned*)(ws + WS_CTL) + CW_CNT; int tp = 0;
            for (int e = 0; e < 32; ++e) { const int c = (int)cnt[e]; mtab[e] = tp; mtab[33 + e] = c; tp += (c + 255) >> 8; } mtab[32] = tp; }
        __syncthreads();
    }
    if (IN(6)) REP(6) {
        pg8::Gemm g{(const bf16_t*)(ws + WS_XN), (const bf16_t*)(ws + WS_W13T), 0, 0, kDM}; pg8::MoeOrder S{mtab, (const int*)(ws + WS_LIST), G, bx, 1};
        pg8::EpiSwiglu E{(bf16_t*)(ws + WS_OB)}; pg8::gemm_phase<pg8::EpiSwiglu, pg8::MoeOrder, true, true, true>(lds, g, S, E);
    }
    SEAM(6);
    if (IN(7)) REP(7) {
        pg8::Gemm g{(const bf16_t*)(ws + WS_OB), (const bf16_t*)(ws + WS_W2T), 0, 0, kDE}; pg8::MoeOrder S{mtab, (const int*)(ws + WS_LIST), G, bx, 2};
        pg8::EpiDown E{(bf16_t*)(ws + WS_Y)}; pg8::gemm_phase<pg8::EpiDown, pg8::MoeOrder, true, true, false>(lds, g, S, E);
    }
    SEAM(7);
    if (IN(8)) REP(8) { p7_final(a.p, vcu * 8 + wave, G * 8, lane); }
#undef IN
#undef SEAM
}

#ifndef N_LAUNCH_SPLIT
#define N_LAUNCH_SPLIT 0
#endif
extern "C" void kernel_launch(void* const* d_in, const int* in_sizes, int n_in, void* d_out, int out_size, void* d_ws, size_t ws_size, hipStream_t stream) {
    Params p{};
    for (int i = 0; i < 25; ++i) p.in[i] = (const float*)d_in[i];
    p.out = (float*)d_out; p.ws = (unsigned char*)d_ws;
    static int grid = 0;
    if (!grid) {
        (void)hipFuncSetAttribute((const void*)mk_fwd, hipFuncAttributeMaxDynamicSharedMemorySize, LDS_BYTES);
        int dev = 0, cus = 0, per_cu = 0;
        (void)hipGetDevice(&dev); (void)hipDeviceGetAttribute(&cus, hipDeviceAttributeMultiprocessorCount, dev);
        (void)hipOccupancyMaxActiveBlocksPerMultiprocessor(&per_cu, (const void*)mk_fwd, 512, LDS_BYTES);
        if (per_cu < 1) per_cu = 1;
        grid = cus * 1;
        if (grid > 256) grid = 256;
        (void)hipGetLastError();
    }
    (void)hipMemsetAsync((char*)d_ws + WS_CTL, 0, CTL_BYTES, stream);
    Args a{}; a.p = p;
#if N_LAUNCH_SPLIT
    for (int k = 0; k < 9; ++k) { a.ph_lo = k; a.ph_hi = k + 1; hipLaunchKernelGGL(mk_fwd, dim3(grid), dim3(512), LDS_BYTES, stream, a); }
#else
    a.ph_lo = 0; a.ph_hi = 9;
    void* kargs[] = {&a};
    (void)hipLaunchCooperativeKernel((const void*)mk_fwd, dim3(grid), dim3(512), kargs, LDS_BYTES, stream);
#ifdef PROBE_PHASE
    a.ph_lo = PROBE_PHASE; a.ph_hi = PROBE_PHASE + 1;
    hipLaunchKernelGGL(mk_fwd, dim3(grid), dim3(512), LDS_BYTES, stream, a);
#endif
#endif
}
```

```cpp
#include <hip/hip_runtime.h>
#include <stdint.h>

#define DI __device__ __forceinline__
typedef unsigned short bf16_t;
typedef float f32x4 __attribute__((ext_vector_type(4)));
typedef unsigned u32x4 __attribute__((ext_vector_type(4)));
typedef unsigned u32x2 __attribute__((ext_vector_type(2)));

constexpr int NB = 4, SEQ = 4096, DM = 1024, NTOK = NB * SEQ;
constexpr int NEXP = 32, DEXP = 256, MEMLEN = 256;
constexpr int NIN = 2304;
constexpr float LOG2E = 1.4426950408889634f;
constexpr float C2 = 0.125f * LOG2E;
constexpr float ALPHA = 1.189207115002721f;
constexpr float LN_EPS = 1e-5f;
constexpr float LAM_INIT = 0.2f;

constexpr size_t MiB = 1u << 20;
constexpr size_t WS_CTL = 0, CTL_BYTES = 1 * MiB;
constexpr size_t WS_WINT = 1 * MiB;
constexpr size_t WS_WOT = 6 * MiB;
constexpr size_t WS_WMT = 8 * MiB;
constexpr size_t WS_MEMB = 9 * MiB;
constexpr size_t WS_WR = 11 * MiB;
constexpr size_t WS_COSTAB = 11 * MiB + 256 * 1024;
constexpr size_t WS_STATS0 = 11 * MiB + 512 * 1024;
constexpr size_t WS_MKV = 12 * MiB;
constexpr size_t WS_TOKINFO = 13 * MiB;
constexpr size_t WS_LIST = 14 * MiB;
constexpr size_t WS_W13T = 16 * MiB;
constexpr size_t WS_W2T = 48 * MiB;
constexpr size_t WS_XN = 64 * MiB;
constexpr size_t WS_OB = 96 * MiB;
constexpr size_t WS_QB = 128 * MiB, WS_KB = 144 * MiB, WS_VB = 160 * MiB, WS_MQB = 176 * MiB, WS_ZB = 184 * MiB;
constexpr size_t WS_AOUT = 128 * MiB;
constexpr size_t WS_Y = 128 * MiB;
constexpr int CW_CNT = 8192, CNT_STRIDE = 64;

struct Params {
    const float* in[25];
    float* out;
    unsigned char* ws;
};
enum { I_X = 0, I_MEM, I_LN0G, I_LN0B, I_RELB, I_WIN, I_WMKV, I_WF, I_LQ1, I_LK1, I_LQ2, I_LK2, I_SUBG, I_WOUT, I_LN1G, I_LN1B,
       I_WG, I_BG, I_WRT, I_BRT, I_W1, I_W3, I_W2, I_LN2G, I_LN2B };

DI float bf2f(bf16_t v) { return __uint_as_float(((unsigned)v) << 16); }
DI unsigned f2bf(float f) { unsigned u = __float_as_uint(f); return (u + 0x7fffu + ((u >> 16) & 1u)) >> 16; }
DI unsigned pk2(float lo, float hi) { return f2bf(lo) | (f2bf(hi) << 16); }
DI float wave_sum(float v) {
#pragma unroll
    for (int o = 1; o < 64; o <<= 1) v += __shfl_xor(v, o);
    return v;
}
template <int CTRL> DI float dppf(float v) { return __int_as_float(__builtin_amdgcn_update_dpp(0, __float_as_int(v), CTRL, 0xF, 0xF, true)); }
DI float wave_sum2(float v) {
    v += dppf<0xB1>(v); v += dppf<0x4E>(v); v += dppf<0x141>(v); v += dppf<0x140>(v);
    { auto s = __builtin_amdgcn_permlane16_swap(__float_as_uint(v), __float_as_uint(v), false, false); v = __uint_as_float(s[0]) + __uint_as_float(s[1]); }
    { auto s = __builtin_amdgcn_permlane32_swap(__float_as_uint(v), __float_as_uint(v), false, false); v = __uint_as_float(s[0]) + __uint_as_float(s[1]); }
    return v;
}
DI int t5_bucket(int rel) {
    const int n = rel < 0 ? -rel : rel;
    int b;
    if (n < 8) b = n; else if (n < 12) b = 8; else if (n < 16) b = 9; else if (n < 23) b = 10; else if (n < 32) b = 11;
    else if (n < 46) b = 12; else if (n < 64) b = 13; else if (n < 91) b = 14; else b = 15;
    return b + (rel > 0 ? 16 : 0);
}


namespace pg8 {
#define PG8_LAS __attribute__((address_space(3)))
typedef unsigned short bf16_t;
typedef short bf16x8 __attribute__((ext_vector_type(8)));
typedef float f32x4 __attribute__((ext_vector_type(4)));
typedef unsigned u32x4 __attribute__((ext_vector_type(4)));
constexpr int BM = 256, BK = 64, HALF = 128, HTB = HALF * BK * 2  , STAGE_BYTES = 8 * HTB, NXCD = 8, WGM = 8;

__host__ __device__ __forceinline__ int lds_byte(int r, int c) { const int st = (r >> 4) * 2 + (c >> 5), rr = r & 15, cc = c & 31, ob = rr * 64 + cc * 2; return st * 1024 + (ob ^ (((ob >> 9) & 1) << 5)); }
__host__ __device__ __forceinline__ void stage_rc(int b, int& R, int& C) { const int st = b / 1024, sb = b % 1024, swz = sb ^ (((sb >> 9) & 1) << 5); R = (st >> 1) * 16 + swz / 64; C = (st & 1) * 32 + (swz % 64) / 2; }
__host__ __device__ __forceinline__ int perm32(int rho) { const int n = rho >> 4, i = rho & 15; return 8 * (i >> 2) + 4 * n + (i & 3); }

struct Unit { int pm, pn; };
struct Gemm { const bf16_t* A; const bf16_t* Bt; int M, N, K; };

struct StaticOrder {
    int nM, nN, nwg, G, c;
    __host__ __device__ void init(int M, int N, int G_, int c_) { nM = M / BM; nN = N / BM; nwg = nM * nN; G = G_; c = c_; }
    __host__ __device__ bool next(int i, Unit& u) const {
        const long L = (long)i * G + c; if (L >= nwg) return false;
        int wgid = (int)L; { const int q = nwg / NXCD, r = nwg % NXCD, xcd = wgid % NXCD, off = wgid / NXCD; wgid = (xcd < r ? xcd * (q + 1) : r * (q + 1) + (xcd - r) * q) + off; }
        const int nig = WGM * nN, gid = wgid / nig, fm = gid * WGM, gsz = (nM - fm) < WGM ? (nM - fm) : WGM;
        u.pm = fm + ((wgid % nig) % gsz); u.pn = (wgid % nig) / gsz; return true;
    }
    __device__ __forceinline__ void a_ready(const Unit&) const {}
    __device__ __forceinline__ void done(const Unit&) const {}
};

__device__ __forceinline__ unsigned cvt_pk_bf16(float lo, float hi) { unsigned r; asm volatile("v_cvt_pk_bf16_f32 %0, %1, %2" : "=v"(r) : "v"(lo), "v"(hi)); return r; }
typedef float f32x2 __attribute__((ext_vector_type(2)));
__device__ __forceinline__ f32x2 gelu_pk(f32x2 v) {
    const f32x2 av = __builtin_elementwise_abs(v), d = av * 0.2316418882f + 1.0f;
    f32x2 t; t.x = __builtin_amdgcn_rcpf(d.x); t.y = __builtin_amdgcn_rcpf(d.y);
    f32x2 q = t * 0.5307027145f + (-0.7265760135f); q = q * t + 0.7107068705f; q = q * t + (-0.142248368f); q = q * t + 0.127414796f; q = q * t;
    const f32x2 s = (v * v) * (-0.72134752044f);
    f32x2 e; e.x = __builtin_amdgcn_exp2f(s.x); e.y = __builtin_amdgcn_exp2f(s.y);
    const f32x2 m = v * (q * e), r = v - m;
    f32x2 o; o.x = v.x < 0.f ? m.x : r.x; o.y = v.y < 0.f ? m.y : r.y; return o;
}

template <int ACT  > struct EpiBf16 {
    static constexpr bool PERM = true, AFTER_DRAIN = false; static_assert(ACT == 0 || ACT == 1, "EpiBf16: ACT is 0 (none) or 1 (gelu_pk)");
    bf16_t* O; int ldc; const float* bias; int split_cols; size_t split_stride; float scale0;
    __device__ __forceinline__ void operator()(const f32x4 (&acc)[2][2][4][2], const Unit& u, int wr, int wc, int fr, int fq) const {
        const int row0 = u.pm * BM + wr * 64 + fr; int colt = u.pn * BM; bf16_t* base = O;
        float sc = 1.f; if (split_cols) { const int t = colt / split_cols; base += (size_t)t * split_stride; colt -= t * split_cols; if (t == 0) sc = scale0; }
        const int col0 = colt + wc * 32 + 8 * fq, bcol0 = u.pn * BM + wc * 32 + 8 * fq;
        f32x4 bv[2][2];
#pragma unroll
        for (int bj = 0; bj < 2; ++bj)
#pragma unroll
            for (int n = 0; n < 2; ++n) bv[bj][n] = bias ? *(const f32x4*)(bias + bcol0 + bj * HALF + 4 * n) : (f32x4){0.f, 0.f, 0.f, 0.f};
#pragma unroll
        for (int ai = 0; ai < 2; ++ai)
#pragma unroll
            for (int m = 0; m < 4; ++m) { bf16_t* rowp = base + (size_t)(row0 + ai * HALF + m * 16) * ldc + col0;
#pragma unroll
                for (int bj = 0; bj < 2; ++bj) { f32x4 v0 = acc[ai][bj][m][0] + bv[bj][0], v1 = acc[ai][bj][m][1] + bv[bj][1];
                    if (ACT == 1) { f32x2 a = gelu_pk((f32x2){v0[0], v0[1]}), b = gelu_pk((f32x2){v0[2], v0[3]}), c = gelu_pk((f32x2){v1[0], v1[1]}), d = gelu_pk((f32x2){v1[2], v1[3]});
                        v0 = (f32x4){a.x, a.y, b.x, b.y}; v1 = (f32x4){c.x, c.y, d.x, d.y}; }
                    v0 = v0 * sc; v1 = v1 * sc; u32x4 w; w.x = cvt_pk_bf16(v0[0], v0[1]); w.y = cvt_pk_bf16(v0[2], v0[3]); w.z = cvt_pk_bf16(v1[0], v1[1]); w.w = cvt_pk_bf16(v1[2], v1[3]);
                    *(u32x4*)(rowp + bj * HALF) = w; } }
    }
};

struct PanelStats {
    unsigned* xbuf;
    unsigned* cnt;
    unsigned* tmo;
    int ntn; float eps;
    unsigned code;
    __device__ __forceinline__ bool run(const f32x4 (&v)[2][2][4][2], const Unit& u, int wr, int wc, int fr, int fq, PG8_LAS unsigned char* lds, int wid, int lane) const {
        typedef float f32x2v __attribute__((ext_vector_type(2)));
        PG8_LAS f32x2v* P = (PG8_LAS f32x2v*)lds;
        PG8_LAS f32x2v* S = (PG8_LAS f32x2v*)(lds + 8192);
        PG8_LAS unsigned* flag = (PG8_LAS unsigned*)(lds + 8192 + 2048);
#pragma unroll
        for (int ai = 0; ai < 2; ++ai)
#pragma unroll
            for (int m = 0; m < 4; ++m) {
                float s = 0.f;
#pragma unroll
                for (int bj = 0; bj < 2; ++bj)
#pragma unroll
                    for (int n = 0; n < 2; ++n) { const f32x4 x = v[ai][bj][m][n]; s += (x[0] + x[1]) + (x[2] + x[3]); }
                s += __shfl_xor(s, 16); s += __shfl_xor(s, 32);
                const float mw = s * (1.0f / 64.0f); float q = 0.f;
#pragma unroll
                for (int bj = 0; bj < 2; ++bj)
#pragma unroll
                    for (int n = 0; n < 2; ++n) { const f32x4 d = v[ai][bj][m][n] - mw; q += (d[0] * d[0] + d[1] * d[1]) + (d[2] * d[2] + d[3] * d[3]); }
                q += __shfl_xor(q, 16); q += __shfl_xor(q, 32);
                if (fq == 0) P[(ai * HALF + wr * 64 + m * 16 + fr) * 4 + wc] = (f32x2v){mw, q};
            }
        asm volatile("s_waitcnt lgkmcnt(0)" ::: "memory"); __builtin_amdgcn_s_barrier(); asm volatile("" ::: "memory");
#if defined(BROKEN_EXCHANGE_NO_WAIT)
#warning BROKEN CONTROL BUILD: the row-statistics exchange does not wait; results are wrong by design
        if (blockIdx.x >= 64) { const long long t0_ = clock64(); while (clock64() - t0_ < 60000) __builtin_amdgcn_s_sleep(8); }
#endif
        const int row = wid * 32 + (lane & 31);
        if (lane < 32) {
            const f32x2v a = P[row * 4 + 0], b = P[row * 4 + 1], c = P[row * 4 + 2], d = P[row * 4 + 3];
            const float mt = (a.x + b.x + c.x + d.x) * 0.25f;
            const float da = a.x - mt, db = b.x - mt, dc = c.x - mt, dd = d.x - mt;
            const float m2 = (a.y + b.y) + (c.y + d.y) + 64.0f * ((da * da + db * db) + (dc * dc + dd * dd));
            unsigned long long* slot = (unsigned long long*)xbuf + ((size_t)(u.pm * BM + row) * 4 + u.pn);
            __hip_atomic_store(slot, ((unsigned long long)__float_as_uint(m2) << 32) | __float_as_uint(mt), __ATOMIC_RELAXED, __HIP_MEMORY_SCOPE_AGENT);
        }
        asm volatile("s_waitcnt vmcnt(0)" ::: "memory");
        if (lane == 0) __hip_atomic_fetch_add(cnt + 64 * u.pm, 1u, __ATOMIC_RELAXED, __HIP_MEMORY_SCOPE_AGENT);
        if (wid == 0) {
            bool dead = false; const unsigned long long t0 = __builtin_amdgcn_s_memrealtime(); const unsigned want = 8u * (unsigned)ntn;
            for (;;) {
#if defined(BROKEN_EXCHANGE_NO_WAIT)
                break;
#endif
                if ((unsigned)__builtin_amdgcn_readfirstlane(__hip_atomic_load(cnt + 64 * u.pm, __ATOMIC_RELAXED, __HIP_MEMORY_SCOPE_AGENT)) >= want) break;
                if (__builtin_amdgcn_s_memrealtime() - t0 > 2000000ull) {
                    if (lane == 0) { unsigned expect = 0u; __hip_atomic_compare_exchange_strong(tmo + 1, &expect, code | (unsigned)(u.pm & 0xff), __ATOMIC_RELAXED, __ATOMIC_RELAXED, __HIP_MEMORY_SCOPE_AGENT);
                                     __hip_atomic_store(tmo, 1u, __ATOMIC_RELAXED, __HIP_MEMORY_SCOPE_AGENT); }
                    dead = true; break; }
                __builtin_amdgcn_s_sleep(2);
            }
            __builtin_amdgcn_fence(__ATOMIC_ACQUIRE, "agent");
            if (lane == 0) flag[0] = dead ? 1u : 0u;
        }
        asm volatile("s_waitcnt vmcnt(0) lgkmcnt(0)" ::: "memory"); __builtin_amdgcn_s_barrier(); asm volatile("" ::: "memory");
        const bool bad = flag[0] != 0u;
        if (lane < 32) {
            const unsigned long long* slot = (const unsigned long long*)xbuf + (size_t)(u.pm * BM + row) * 4; float mt[4], m2[4]; float ms = 0.f;
#pragma unroll
            for (int t = 0; t < 4; ++t) { if (t < ntn) { const unsigned long long w = __hip_atomic_load(slot + t, __ATOMIC_RELAXED, __HIP_MEMORY_SCOPE_AGENT); mt[t] = __uint_as_float((unsigned)w); m2[t] = __uint_as_float((unsigned)(w >> 32)); } else { mt[t] = 0.f; m2[t] = 0.f; } ms += mt[t]; }
            const float mean = ms / (float)ntn; float q = 0.f;
#pragma unroll
            for (int t = 0; t < 4; ++t) if (t < ntn) { const float dm = mt[t] - mean; q += m2[t] + 256.0f * dm * dm; }
            S[row] = (f32x2v){mean, 1.0f / sqrtf(q / (256.0f * (float)ntn) + eps)};
        }
        asm volatile("s_waitcnt lgkmcnt(0)" ::: "memory"); __builtin_amdgcn_s_barrier(); asm volatile("" ::: "memory");
        return bad;
    }
};
struct EpiLnRes {
    static constexpr bool PERM = false, AFTER_DRAIN = true;
    const float* base; float* out; int ldc; const float* bias; PanelStats st; unsigned poison;
    __device__ __forceinline__ void fused(f32x4 (&acc)[2][2][4][2], const Unit& u, int wr, int wc, int fr, int fq, PG8_LAS unsigned char* lds, int wid, int lane) const {
        typedef float f32x2v __attribute__((ext_vector_type(2)));
        const PG8_LAS f32x2v* S = (const PG8_LAS f32x2v*)(lds + 8192);
        const int col0 = u.pn * BM + wc * 32 + 4 * fq;
#pragma unroll
        for (int bj = 0; bj < 2; ++bj)
#pragma unroll
            for (int n = 0; n < 2; ++n) { const f32x4 bv = bias ? *(const f32x4*)(bias + col0 + bj * HALF + n * 16) : (f32x4){0.f, 0.f, 0.f, 0.f};
#pragma unroll
                for (int ai = 0; ai < 2; ++ai)
#pragma unroll
                    for (int m = 0; m < 4; ++m) acc[ai][bj][m][n] += bv; }
        f32x4 pre[4][2][2];
#pragma unroll
        for (int m = 0; m < 4; ++m) { const size_t off = (size_t)(u.pm * BM + wr * 64 + m * 16 + fr) * ldc + col0;
#pragma unroll
            for (int bj = 0; bj < 2; ++bj)
#pragma unroll
                for (int n = 0; n < 2; ++n) pre[m][bj][n] = *(const f32x4*)(base + off + bj * HALF + n * 16); }
        const bool bad = st.run(acc, u, wr, wc, fr, fq, lds, wid, lane) || poison != 0u;
        const float qnan = __builtin_nanf("");
#pragma unroll
        for (int ai = 0; ai < 2; ++ai)
#pragma unroll
            for (int m = 0; m < 4; ++m) { const int r = ai * HALF + wr * 64 + m * 16 + fr; const f32x2v sr = S[r]; const size_t off = (size_t)(u.pm * BM + r) * ldc + col0;
#pragma unroll
                for (int bj = 0; bj < 2; ++bj)
#pragma unroll
                    for (int n = 0; n < 2; ++n) { const f32x4 bs = ai == 0 ? pre[m][bj][n] : *(const f32x4*)(base + off + bj * HALF + n * 16); f32x4 o = bs + (acc[ai][bj][m][n] - sr.x) * sr.y;
                        if (bad) o = (f32x4){qnan, qnan, qnan, qnan}; *(f32x4*)(out + off + bj * HALF + n * 16) = o; }
                if (m & 1) asm volatile("" ::: "memory"); }
    }
};
struct EpiLnResLn {
    static constexpr bool PERM = false, AFTER_DRAIN = true;
    const float* base; float* out; bf16_t* xn; int ldc; const float* bias; PanelStats st1, st2; unsigned poison;
    __device__ __forceinline__ void fused(f32x4 (&acc)[2][2][4][2], const Unit& u, int wr, int wc, int fr, int fq, PG8_LAS unsigned char* lds, int wid, int lane) const {
        typedef float f32x2v __attribute__((ext_vector_type(2))); typedef unsigned u32x2v __attribute__((ext_vector_type(2)));
        const PG8_LAS f32x2v* S = (const PG8_LAS f32x2v*)(lds + 8192);
        const int col0 = u.pn * BM + wc * 32 + 4 * fq;
#pragma unroll
        for (int bj = 0; bj < 2; ++bj)
#pragma unroll
            for (int n = 0; n < 2; ++n) { const f32x4 bv = bias ? *(const f32x4*)(bias + col0 + bj * HALF + n * 16) : (f32x4){0.f, 0.f, 0.f, 0.f};
#pragma unroll
                for (int ai = 0; ai < 2; ++ai)
#pragma unroll
                    for (int m = 0; m < 4; ++m) acc[ai][bj][m][n] += bv; }
        bool bad = st1.run(acc, u, wr, wc, fr, fq, lds, wid, lane) || poison != 0u;
        const float qnan = __builtin_nanf("");
#pragma unroll
        for (int ai = 0; ai < 2; ++ai)
#pragma unroll
            for (int m = 0; m < 4; ++m) { const int r = ai * HALF + wr * 64 + m * 16 + fr; const f32x2v sr = S[r]; const size_t off = (size_t)(u.pm * BM + r) * ldc + col0;
#pragma unroll
                for (int bj = 0; bj < 2; ++bj)
#pragma unroll
                    for (int n = 0; n < 2; ++n) { const f32x4 bs = *(const f32x4*)(base + off + bj * HALF + n * 16); acc[ai][bj][m][n] = bs + (acc[ai][bj][m][n] - sr.x) * sr.y; }
                asm volatile("" : "+v"(acc[ai][0][m][0]), "+v"(acc[ai][0][m][1]), "+v"(acc[ai][1][m][0]), "+v"(acc[ai][1][m][1]));
                if (m & 1) asm volatile("" ::: "memory"); }
        const bool bad1 = bad;
        bad = st2.run(acc, u, wr, wc, fr, fq, lds, wid, lane) || bad;
#pragma unroll
        for (int ai = 0; ai < 2; ++ai)
#pragma unroll
            for (int m = 0; m < 4; ++m) { const int r = ai * HALF + wr * 64 + m * 16 + fr; const f32x2v sr = S[r]; const size_t off = (size_t)(u.pm * BM + r) * ldc + col0;
#pragma unroll
                for (int bj = 0; bj < 2; ++bj)
#pragma unroll
                    for (int n = 0; n < 2; ++n) { const f32x4 x1 = acc[ai][bj][m][n]; *(f32x4*)(out + off + bj * HALF + n * 16) = bad1 ? (f32x4){qnan, qnan, qnan, qnan} : x1;
                        const f32x4 o = (x1 - sr.x) * sr.y; u32x2v w; w.x = cvt_pk_bf16(o[0], o[1]); w.y = cvt_pk_bf16(o[2], o[3]);
                        if (bad) { w.x = 0x7fc07fc0u; w.y = 0x7fc07fc0u; } *(u32x2v*)(xn + off + bj * HALF + n * 16) = w; }
                asm volatile("" ::: "memory"); }
    }
};

template <class Epi, class Sched, bool ALIGN_EPI = false, bool SP2 = false, bool GATHER = false>
__device__ __forceinline__ void gemm_phase(PG8_LAS unsigned char* lds, const Gemm g, const Sched& S, const Epi& E) {
    const int tid = threadIdx.x, wid = __builtin_amdgcn_readfirstlane(tid >> 6), lane = tid & 63, wr = wid >> 2, wc = wid & 3, fr = lane & 15, fq = lane >> 4;
    const int K = g.K, nt = K / BK;
    static_assert(!GATHER || SP2, "GATHER is wired into the SP2 loop only");
    unsigned voffA[2], voffB[2]; int gR_[2], gC_[2];
#pragma unroll
    for (int i = 0; i < 2; ++i) { int R, C; stage_rc(tid * 16 + i * 8192, R, C); const int Rb = Epi::PERM ? ((R & ~31) + perm32(R & 31)) : R; gR_[i] = R; gC_[i] = C;
        voffA[i] = (unsigned)(R * K + C) * 2u; voffB[i] = (unsigned)(Rb * K + C) * 2u; }
    unsigned gvo[2][2] = {{0u, 0u}, {0u, 0u}}, gvn[2][2] = {{0u, 0u}, {0u, 0u}};
#define PG8_GOFF(dst, unit) do { _Pragma("unroll") for (int h_ = 0; h_ < 2; ++h_) _Pragma("unroll") for (int i_ = 0; i_ < 2; ++i_) \
        dst[h_][i_] = ((unsigned)S.a_row(unit, h_ * HALF + gR_[i_]) * (unsigned)K + (unsigned)gC_[i_]) * 2u; \
        asm volatile("" : "+v"(dst[0][0]), "+v"(dst[0][1]), "+v"(dst[1][0]), "+v"(dst[1][1])); } while (0)
    const size_t kstep = (size_t)(BK * 2);
    const size_t hstep = (size_t)HALF * K * 2;
    const size_t tstep = 2 * hstep;
    const unsigned ldsw = (unsigned)wid * 1024u;
    const int aoff = lds_byte(wr * 64 + fr, fq * 8), boff = lds_byte(wc * 32 + fr, fq * 8);
#define PG8_SA(b, h) (((b) * 2 + (h)) * HTB)
#define PG8_SB(b, h) ((4 + (b) * 2 + (h)) * HTB)
#define PG8_STAGE(bufoff, gbase, voff) do { _Pragma("unroll") for (int _i = 0; _i < 2; ++_i) \
        __builtin_amdgcn_global_load_lds((const unsigned*)((const char*)(gbase) + (voff)[_i]), (PG8_LAS unsigned*)(lds + (bufoff) + ldsw + _i * 8192), 16, 0, 0); } while (0)
#define PG8_STAGE_AH(bufoff, gbase, h, usen) do { _Pragma("unroll") for (int _i = 0; _i < 2; ++_i) { \
        const unsigned vo_ = GATHER ? ((usen) ? gvn[h][_i] : gvo[h][_i]) : voffA[_i]; \
        __builtin_amdgcn_global_load_lds((const unsigned*)((const char*)(gbase) + (GATHER ? (size_t)0 : (size_t)(h) * hstep) + vo_), (PG8_LAS unsigned*)(lds + (bufoff) + ldsw + _i * 8192), 16, 0, 0); } } while (0)
#define PG8_LDA(dst, b, h) do { _Pragma("unroll") for (int m = 0; m < 4; ++m) _Pragma("unroll") for (int k = 0; k < 2; ++k) dst[m][k] = *(const PG8_LAS bf16x8*)(lds + PG8_SA(b, h) + aoff + m * 2048 + k * 1024); } while (0)
#define PG8_LDB(dst, b, h) do { _Pragma("unroll") for (int n = 0; n < 2; ++n) _Pragma("unroll") for (int k = 0; k < 2; ++k) dst[n][k] = *(const PG8_LAS bf16x8*)(lds + PG8_SB(b, h) + boff + n * 2048 + k * 1024); } while (0)
#define PG8_MMA(ai, bj, At, Bt) do { __builtin_amdgcn_s_setprio(1); _Pragma("unroll") for (int m = 0; m < 4; ++m) _Pragma("unroll") for (int n = 0; n < 2; ++n) _Pragma("unroll") for (int k = 0; k < 2; ++k) \
        acc[ai][bj][m][n] = __builtin_amdgcn_mfma_f32_16x16x32_bf16(Bt[n][k], At[m][k], acc[ai][bj][m][n], 0, 0, 0); __builtin_amdgcn_s_setprio(0); } while (0)
#define PG8_WAIT_V(n) asm volatile("s_waitcnt vmcnt(" #n ")" ::: "memory")
#define PG8_WAIT_L(n) asm volatile("s_waitcnt lgkmcnt(" #n ")" ::: "memory")
#define PG8_BAR __builtin_amdgcn_s_barrier()
#define PG8_SCHED __builtin_amdgcn_sched_barrier(0)
    Unit cur, nxt; int ui = 0;
    if (!S.next(0, cur)) return;
    f32x4 acc[2][2][4][2];
#pragma unroll
    for (int a = 0; a < 2; ++a)
#pragma unroll
        for (int b = 0; b < 2; ++b)
#pragma unroll
            for (int m = 0; m < 4; ++m)
#pragma unroll
                for (int n = 0; n < 2; ++n) acc[a][b][m][n] = (f32x4){0.f, 0.f, 0.f, 0.f};
    bf16x8 At[4][2], B0[2][2], B1[2][2];
    const char* cA = (const char*)g.A + (GATHER ? (size_t)0 : (size_t)cur.pm * tstep); const char* cB = (const char*)g.Bt + (size_t)cur.pn * tstep;
    S.a_ready(cur);
    if constexpr (GATHER) { PG8_GOFF(gvo, cur); }
    if constexpr (SP2) {
        PG8_STAGE(PG8_SB(0, 0), cB, voffB); PG8_STAGE(PG8_SB(0, 1), cB + hstep, voffB); PG8_STAGE_AH(PG8_SA(0, 0), cA, 0, false); PG8_STAGE_AH(PG8_SA(0, 1), cA, 1, false);
        if (wr == 1) PG8_BAR;
        PG8_WAIT_V(2); PG8_BAR;
        PG8_STAGE(PG8_SB(1, 0), cB + kstep, voffB); PG8_STAGE_AH(PG8_SA(1, 0), cA + kstep, 0, false); PG8_STAGE(PG8_SB(1, 1), cB + hstep + kstep, voffB);
        PG8_WAIT_V(6); PG8_BAR;
    } else {
        PG8_STAGE(PG8_SB(0, 0), cB, voffB); PG8_STAGE(PG8_SA(0, 0), cA, voffA); PG8_STAGE(PG8_SB(0, 1), cB + hstep, voffB); PG8_STAGE(PG8_SA(0, 1), cA + hstep, voffA);
        if (wr == 1) PG8_BAR;
        PG8_WAIT_V(4); PG8_BAR;
        PG8_STAGE(PG8_SB(1, 0), cB + kstep, voffB); PG8_STAGE(PG8_SA(1, 0), cA + kstep, voffA); PG8_STAGE(PG8_SB(1, 1), cB + hstep + kstep, voffB);
        PG8_WAIT_V(6); PG8_BAR;
    }
    for (;;) {
        const bool has_next = S.next(ui + 1, nxt);
        const char* nA = has_next ? (const char*)g.A + (GATHER ? (size_t)0 : (size_t)nxt.pm * tstep) : cA; const char* nB = has_next ? (const char*)g.Bt + (size_t)nxt.pn * tstep : cB;
        if constexpr (GATHER) { if (has_next) { PG8_GOFF(gvn, nxt); } else { gvn[0][0] = gvo[0][0]; gvn[0][1] = gvo[0][1]; gvn[1][0] = gvo[1][0]; gvn[1][1] = gvo[1][1]; } }
        for (int t = 0; t < nt; t += 2) {
            const bool last = (t == nt - 2);
            const char* a1 = cA + (size_t)(t + 1) * kstep;
            const char* a2 = last ? nA : cA + (size_t)(t + 2) * kstep; const char* b2 = last ? nB : cB + (size_t)(t + 2) * kstep;
            const char* a3 = a2 + kstep; const char* b3 = b2 + kstep;
            if (last && has_next) S.a_ready(nxt);
            if constexpr (SP2) {
            PG8_LDB(B0, 0, 0); PG8_LDB(B1, 0, 1); PG8_SCHED; PG8_LDA(At, 0, 0); PG8_STAGE_AH(PG8_SA(1, 1), a1, 1, false);
            PG8_WAIT_V(8); PG8_WAIT_L(0); PG8_BAR; PG8_MMA(0, 0, At, B0); PG8_MMA(0, 1, At, B1); PG8_BAR; PG8_SCHED;
            PG8_LDA(At, 0, 1); PG8_STAGE(PG8_SB(0, 0), b2, voffB); PG8_STAGE(PG8_SB(0, 1), b2 + hstep, voffB); PG8_STAGE_AH(PG8_SA(0, 0), a2, 0, last);
            PG8_WAIT_V(8); PG8_WAIT_L(0); PG8_BAR; PG8_MMA(1, 0, At, B0); PG8_MMA(1, 1, At, B1); PG8_BAR; PG8_SCHED;
            PG8_LDB(B0, 1, 0); PG8_LDB(B1, 1, 1); PG8_SCHED; PG8_LDA(At, 1, 0); PG8_STAGE_AH(PG8_SA(0, 1), a2, 1, last);
            PG8_WAIT_V(8); PG8_WAIT_L(0); PG8_BAR; PG8_MMA(0, 0, At, B0); PG8_MMA(0, 1, At, B1); PG8_BAR; PG8_SCHED;
            PG8_LDA(At, 1, 1); PG8_STAGE(PG8_SB(1, 0), b3, voffB); PG8_STAGE(PG8_SB(1, 1), b3 + hstep, voffB); PG8_STAGE_AH(PG8_SA(1, 0), a3, 0, last);
            PG8_WAIT_V(8); PG8_WAIT_L(0); PG8_BAR; PG8_MMA(1, 0, At, B0); PG8_MMA(1, 1, At, B1); PG8_BAR; PG8_SCHED;
            } else {
            PG8_LDB(B0, 0, 0); PG8_SCHED; PG8_LDA(At, 0, 0); PG8_STAGE(PG8_SA(1, 1), a1 + hstep, voffA);
            PG8_WAIT_L(8); PG8_BAR; PG8_WAIT_L(0); PG8_MMA(0, 0, At, B0); PG8_BAR; PG8_SCHED;
            PG8_LDB(B1, 0, 1); PG8_STAGE(PG8_SB(0, 0), b2, voffB);
            PG8_BAR; PG8_WAIT_L(0); PG8_MMA(0, 1, At, B1); PG8_BAR;
            PG8_LDA(At, 0, 1); PG8_STAGE(PG8_SA(0, 0), a2, voffA);
            PG8_BAR; PG8_WAIT_L(0); PG8_MMA(1, 0, At, B0); PG8_BAR; PG8_SCHED;
            PG8_STAGE(PG8_SB(0, 1), b2 + hstep, voffB);
            PG8_WAIT_V(6); PG8_BAR; PG8_MMA(1, 1, At, B1); PG8_BAR;
            PG8_LDB(B0, 1, 0); PG8_SCHED; PG8_LDA(At, 1, 0); PG8_STAGE(PG8_SA(0, 1), a2 + hstep, voffA);
            PG8_WAIT_L(8); PG8_BAR; PG8_WAIT_L(0); PG8_MMA(0, 0, At, B0); PG8_BAR; PG8_SCHED;
            PG8_LDB(B1, 1, 1); PG8_STAGE(PG8_SB(1, 0), b3, voffB);
            PG8_BAR; PG8_WAIT_L(0); PG8_MMA(0, 1, At, B1); PG8_BAR;
            PG8_LDA(At, 1, 1); PG8_STAGE(PG8_SA(1, 0), a3, voffA);
            PG8_BAR; PG8_WAIT_L(0); PG8_MMA(1, 0, At, B0); PG8_BAR; PG8_SCHED;
            PG8_STAGE(PG8_SB(1, 1), b3 + hstep, voffB);
            PG8_WAIT_V(6); PG8_BAR; PG8_MMA(1, 1, At, B1); PG8_BAR;
            }
        }
        if constexpr (ALIGN_EPI) { if (wr == 0) PG8_BAR; }
        if constexpr (!Epi::AFTER_DRAIN) { E(acc, cur, wr, wc, fr, fq); S.done(cur); }
        if (!has_next) break;
#pragma unroll
        for (int a = 0; a < 2; ++a)
#pragma unroll
            for (int b = 0; b < 2; ++b)
#pragma unroll
                for (int m = 0; m < 4; ++m)
#pragma unroll
                    for (int n = 0; n < 2; ++n) acc[a][b][m][n] = (f32x4){0.f, 0.f, 0.f, 0.f};
        cur = nxt; cA = nA; cB = nB; ++ui;
        if constexpr (GATHER) { gvo[0][0] = gvn[0][0]; gvo[0][1] = gvn[0][1]; gvo[1][0] = gvn[1][0]; gvo[1][1] = gvn[1][1]; }
        if constexpr (ALIGN_EPI) { if (wr == 1) PG8_BAR; }
    }
    PG8_WAIT_V(0);
    if constexpr (!ALIGN_EPI) { if (wr == 0) PG8_BAR; }
    PG8_BAR;
    if constexpr (Epi::AFTER_DRAIN) { E.fused(acc, cur, wr, wc, fr, fq, lds, wid, lane); S.done(cur); }
#undef PG8_SA
#undef PG8_SB
#undef PG8_STAGE
#undef PG8_STAGE_AH
#undef PG8_GOFF
#undef PG8_LDA
#undef PG8_LDB
#undef PG8_MMA
#undef PG8_WAIT_V
#undef PG8_WAIT_L
#undef PG8_BAR
#undef PG8_SCHED
}
}

DI void transpose_item(const float* W, int ldw, bf16_t* WT, int ldt, float scale, float* scr, int k0, int n0, int lane) {
#pragma unroll 8
    for (int i = 0; i < 32; ++i) { const int kk = 2 * i + (lane >> 5); scr[kk * 33 + (lane & 31)] = W[(size_t)(k0 + kk) * ldw + n0 + (lane & 31)] * scale; }
    asm volatile("s_waitcnt lgkmcnt(0)" ::: "memory");
    const int c = lane & 7;
#pragma unroll
    for (int j = 0; j < 4; ++j) { const int n = (lane >> 3) + 8 * j; const float* s = scr + (8 * c) * 33 + n;
        u32x4 o; o.x = pk2(s[0 * 33], s[1 * 33]); o.y = pk2(s[2 * 33], s[3 * 33]); o.z = pk2(s[4 * 33], s[5 * 33]); o.w = pk2(s[6 * 33], s[7 * 33]);
        *(u32x4*)(WT + (size_t)n * ldt + k0 + 8 * c) = o; }
    asm volatile("s_waitcnt lgkmcnt(0)" ::: "memory");
}

DI void p0_prologue(const Params& p, float* lds, int gw, int NGW, int wave, int lane) {
    unsigned char* ws = p.ws;
    bf16_t* WinT = (bf16_t*)(ws + WS_WINT); bf16_t* WoT = (bf16_t*)(ws + WS_WOT); bf16_t* WmT = (bf16_t*)(ws + WS_WMT);
    bf16_t* W13T = (bf16_t*)(ws + WS_W13T); bf16_t* W2T = (bf16_t*)(ws + WS_W2T);
    float* scr = lds + wave * (64 * 33);
    const float* w_in = p.in[I_WIN];
    constexpr int S0 = 256, S1 = 512, S2 = 768, S3 = 896, S4 = 1408, S5 = 1664, S6 = S5 + 4096, S7 = S6 + 4096, S8 = S7 + 4096;
    for (int it = gw; it < S8; it += NGW) {
        if (it < S3) {
            int seg, r;
            if (it < S0) { seg = 0; r = it; } else if (it < S1) { seg = 1; r = it - S0; } else if (it < S2) { seg = 2; r = it - S1; } else { seg = 3; r = it - S2; }
            const int ncb = (seg == 3) ? 8 : 16;
            const int kb = r / ncb, nb = r % ncb;
            const int coff = (seg == 3) ? 1792 : seg * 512, roff = (seg == 3) ? 1536 : seg * 512;
            const float sc = (seg == 0 || seg == 3) ? C2 : 1.0f;
            transpose_item(w_in + coff, 2048, WinT + (size_t)(roff + nb * 32) * 1024, 1024, sc, scr, kb * 64, nb * 32, lane);
        } else if (it < S4) { const int r = it - S3, kb = r / 32, nb = r % 32;
            transpose_item(p.in[I_WOUT], 1024, WoT + (size_t)(nb * 32) * 1024, 1024, 1.f, scr, kb * 64, nb * 32, lane);
        } else if (it < S5) { const int r = it - S4, kb = r / 16, nb = r % 16;
            transpose_item(p.in[I_WMKV], 512, WmT + (size_t)(nb * 32) * 1024, 1024, 1.f, scr, kb * 64, nb * 32, lane);
        } else if (it < S7) { const bool is3 = it >= S6; const int r = it - (is3 ? S6 : S5), e = r / 128, q = r % 128, kb = q / 8, nb = q % 8, n0 = nb * 32;
            const float* W = (is3 ? p.in[I_W3] : p.in[I_W1]) + (size_t)e * 1024 * 256;
            const int drow = e * 512 + (n0 >> 7) * 256 + (is3 ? 128 : 0) + (n0 & 127);
            transpose_item(W, 256, W13T + (size_t)drow * 1024, 1024, 1.f, scr, kb * 64, n0, lane);
        } else { const int r = it - S7, e = r / 128, q = r % 128, kb = q / 32, nb = q % 32;
            const float* W = p.in[I_W2] + (size_t)e * 256 * 1024;
            transpose_item(W, 1024, W2T + (size_t)(e * 1024 + nb * 32) * 256, 256, 1.f, scr, kb * 64, nb * 32, lane);
        }
    }
    {
        bf16_t* XN = (bf16_t*)(ws + WS_XN); float* st = (float*)(ws + WS_STATS0);
        const f32x4* g4 = (const f32x4*)p.in[I_LN0G] + lane; const f32x4* b4 = (const f32x4*)p.in[I_LN0B] + lane;
        for (int m = gw; m < NTOK; m += NGW) {
            const f32x4* xr = (const f32x4*)(p.in[I_X] + (size_t)m * DM) + lane;
            f32x4 v[4]; float s = 0.f;
#pragma unroll
            for (int j = 0; j < 4; ++j) { v[j] = xr[64 * j]; s += (v[j].x + v[j].y) + (v[j].z + v[j].w); }
            const float mean = wave_sum(s) * (1.f / DM); float s2 = 0.f;
#pragma unroll
            for (int j = 0; j < 4; ++j) { v[j] = v[j] - mean; s2 += (v[j].x * v[j].x + v[j].y * v[j].y) + (v[j].z * v[j].z + v[j].w * v[j].w); }
            const float rstd = 1.f / sqrtf(wave_sum(s2) * (1.f / DM) + LN_EPS);
            if (lane == 0) { st[2 * m] = mean; st[2 * m + 1] = rstd; }
            u32x2* o8 = (u32x2*)(XN + (size_t)m * DM) + lane;
#pragma unroll
            for (int j = 0; j < 4; ++j) { const f32x4 g = g4[64 * j], b = b4[64 * j]; const f32x4 y = v[j] * rstd * g + b; u32x2 w; w.x = pk2(y.x, y.y); w.y = pk2(y.z, y.w); o8[64 * j] = w; }
        }
    }
    {
        bf16_t* MB = (bf16_t*)(ws + WS_MEMB);
        for (int m = gw; m < NB * MEMLEN; m += NGW) {
            const f32x4* xr = (const f32x4*)(p.in[I_MEM] + (size_t)m * DM) + lane; u32x2* o8 = (u32x2*)(MB + (size_t)m * DM) + lane;
#pragma unroll
            for (int j = 0; j < 4; ++j) { const f32x4 y = xr[64 * j]; u32x2 w; w.x = pk2(y.x, y.y); w.y = pk2(y.z, y.w); o8[64 * j] = w; }
        }
    }
    {
        const float* wf = p.in[I_WF];
        for (int it = gw; it < 1024 * 4; it += NGW) {
            const int k = it >> 2, g = it & 3;
            const float wv = w_in[(size_t)k * 2048 + 1536 + g * 64 + lane];
            float ta = 0.f, tb = 0.f;
            for (int c = 0; c < 64; ++c) { const float wc = __shfl(wv, c); const float ang = (float)((c * lane) & 63) * (1.0f / 32.0f); ta += wc * cospif(ang); tb += wc * sinpif(ang); }
            float orr = 0.f, oi = 0.f;
            for (int c = 0; c < 64; ++c) { const float w = wf[(size_t)(g * 64 + c) * 64 + lane]; orr += __shfl(ta, c) * w; oi += __shfl(tb, c) * w; }
            WinT[(size_t)(1792 + g * 64 + lane) * 1024 + k] = (bf16_t)f2bf(orr * (1.0f / 512.0f));
            WinT[(size_t)(2048 + g * 64 + lane) * 1024 + k] = (bf16_t)f2bf(oi * (1.0f / 512.0f));
        }
    }
    {
        float* WR = (float*)(ws + WS_WR); float* ct = (float*)(ws + WS_COSTAB);
        const int gt = gw * 64 + lane, NGT = NGW * 64;
        for (int i = gt; i < 36 * 1024; i += NGT) { const int e = i >> 10, k = i & 1023; WR[i] = e < 4 ? p.in[I_WG][k * 4 + e] : p.in[I_WRT][k * 32 + (e - 4)]; }
        for (int i = gt; i < 4096; i += NGT) ct[i] = cospif((float)i * (1.0f / 2048.0f));
    }
}

constexpr size_t WS_ZS1 = 200 * MiB;
constexpr size_t WS_O1 = 216 * MiB;
constexpr int CW_KMAX = 128;
constexpr int CW_QMAX = 192;
constexpr int CW_KMAXM = 160;

namespace pg8 {
struct EpiInproj {
    static constexpr bool PERM = true, AFTER_DRAIN = false;
    unsigned char* ws;
    __device__ __forceinline__ void operator()(const f32x4 (&acc)[2][2][4][2], const Unit& u, int wr, int wc, int fr, int fq) const {
        const int pn = u.pn; bf16_t* base; int ldc, coff;
        if (pn < 6) { base = (bf16_t*)(ws + WS_QB + (size_t)(pn >> 1) * (16 * MiB)); ldc = 512; coff = (pn & 1) * 256; }
        else if (pn == 6) { base = (bf16_t*)(ws + WS_MQB); ldc = 256; coff = 0; }
        else { base = (bf16_t*)(ws + WS_ZB); ldc = 512; coff = (pn - 7) * 256; }
        const int row0 = u.pm * BM + wr * 64 + fr, col0 = coff + wc * 32 + 8 * fq;
#pragma unroll
        for (int ai = 0; ai < 2; ++ai)
#pragma unroll
            for (int m = 0; m < 4; ++m) { bf16_t* rowp = base + (size_t)(row0 + ai * HALF + m * 16) * ldc + col0;
#pragma unroll
                for (int bj = 0; bj < 2; ++bj) { const f32x4 v0 = acc[ai][bj][m][0], v1 = acc[ai][bj][m][1];
                    u32x4 w; w.x = cvt_pk_bf16(v0[0], v0[1]); w.y = cvt_pk_bf16(v0[2], v0[3]); w.z = cvt_pk_bf16(v1[0], v1[1]); w.w = cvt_pk_bf16(v1[2], v1[3]);
                    *(u32x4*)(rowp + bj * HALF) = w; } }
    }
};
struct EpiBf16Plain {
    static constexpr bool PERM = true, AFTER_DRAIN = false;
    bf16_t* O; int ldc;
    __device__ __forceinline__ void operator()(const f32x4 (&acc)[2][2][4][2], const Unit& u, int wr, int wc, int fr, int fq) const {
        const int row0 = u.pm * BM + wr * 64 + fr, col0 = u.pn * BM + wc * 32 + 8 * fq;
#pragma unroll
        for (int ai = 0; ai < 2; ++ai)
#pragma unroll
            for (int m = 0; m < 4; ++m) { bf16_t* rowp = O + (size_t)(row0 + ai * HALF + m * 16) * ldc + col0;
#pragma unroll
                for (int bj = 0; bj < 2; ++bj) { const f32x4 v0 = acc[ai][bj][m][0], v1 = acc[ai][bj][m][1];
                    u32x4 w; w.x = cvt_pk_bf16(v0[0], v0[1]); w.y = cvt_pk_bf16(v0[2], v0[3]); w.z = cvt_pk_bf16(v1[0], v1[1]); w.w = cvt_pk_bf16(v1[2], v1[3]);
                    *(u32x4*)(rowp + bj * HALF) = w; } }
    }
};
struct EpiF32Plain {
    static constexpr bool PERM = false, AFTER_DRAIN = false;
    float* C; int ldc;
    __device__ __forceinline__ void operator()(const f32x4 (&acc)[2][2][4][2], const Unit& u, int wr, int wc, int fr, int fq) const {
        const int row0 = u.pm * BM + wr * 64 + fr, col0 = u.pn * BM + wc * 32 + 4 * fq;
#pragma unroll
        for (int ai = 0; ai < 2; ++ai)
#pragma unroll
            for (int m = 0; m < 4; ++m) { float* rowp = C + (size_t)(row0 + ai * HALF + m * 16) * ldc + col0;
#pragma unroll
                for (int bj = 0; bj < 2; ++bj)
#pragma unroll
                    for (int n = 0; n < 2; ++n) *(f32x4*)(rowp + bj * HALF + n * 16) = acc[ai][bj][m][n]; }
    }
};
struct MoeOrder {
    const PG8_LAS int* tab; const int* list; int G, c, sh;
    __device__ __forceinline__ bool next(int i, Unit& u) const {
        const int L = i * G + c, total = tab[32] << sh; if (L >= total) return false;
        const int T = L >> sh, nt = L & ((1 << sh) - 1); int e = 0; while (tab[e + 1] <= T) ++e;
        u.pm = T; u.pn = (e << sh) + nt; return true; }
    __device__ __forceinline__ int a_row(const Unit& u, int r) const { const int e = u.pn >> sh; const int pos = (u.pm - tab[e]) * 256 + r; return pos < tab[33 + e] ? list[e * NTOK + pos] : 0; }
    __device__ __forceinline__ void a_ready(const Unit&) const {}
    __device__ __forceinline__ void done(const Unit&) const {}
};
struct EpiSwiglu {
    static constexpr bool PERM = true, AFTER_DRAIN = false;
    bf16_t* HID;
    __device__ __forceinline__ void operator()(const f32x4 (&acc)[2][2][4][2], const Unit& u, int wr, int wc, int fr, int fq) const {
        const int row0 = u.pm * BM + wr * 64 + fr, col0 = (u.pn & 1) * 128 + wc * 32 + 8 * fq;
#pragma unroll
        for (int ai = 0; ai < 2; ++ai)
#pragma unroll
            for (int m = 0; m < 4; ++m) { bf16_t* rowp = HID + (size_t)(row0 + ai * HALF + m * 16) * 256 + col0; float h[8];
#pragma unroll
                for (int n = 0; n < 2; ++n)
#pragma unroll
                    for (int j = 0; j < 4; ++j) { const float gte = acc[ai][0][m][n][j], up = acc[ai][1][m][n][j];
                        h[n * 4 + j] = gte * __builtin_amdgcn_rcpf(1.0f + __builtin_amdgcn_exp2f(-gte * 1.4426950408889634f)) * up; }
                u32x4 w; w.x = cvt_pk_bf16(h[0], h[1]); w.y = cvt_pk_bf16(h[2], h[3]); w.z = cvt_pk_bf16(h[4], h[5]); w.w = cvt_pk_bf16(h[6], h[7]);
                *(u32x4*)rowp = w; }
    }
};
struct EpiDown {
    static constexpr bool PERM = true, AFTER_DRAIN = false;
    bf16_t* Y;
    __device__ __forceinline__ void operator()(const f32x4 (&acc)[2][2][4][2], const Unit& u, int wr, int wc, int fr, int fq) const {
        const int row0 = u.pm * BM + wr * 64 + fr, col0 = (u.pn & 3) * BM + wc * 32 + 8 * fq;
#pragma unroll
        for (int ai = 0; ai < 2; ++ai)
#pragma unroll
            for (int m = 0; m < 4; ++m) { bf16_t* rowp = Y + (size_t)(row0 + ai * HALF + m * 16) * 1024 + col0;
#pragma unroll
                for (int bj = 0; bj < 2; ++bj) { const f32x4 v0 = acc[ai][bj][m][0], v1 = acc[ai][bj][m][1];
                    u32x4 w; w.x = cvt_pk_bf16(v0[0], v0[1]); w.y = cvt_pk_bf16(v0[2], v0[3]); w.z = cvt_pk_bf16(v1[0], v1[1]); w.w = cvt_pk_bf16(v1[2], v1[3]);
                    *(u32x4*)(rowp + bj * HALF) = w; } }
    }
};
}

DI void kmax_phase(const Params& p, int gw, int NGW, int lane) {
    unsigned char* ws = p.ws; unsigned* ctl = (unsigned*)(ws + WS_CTL);
    const bf16_t* Kb = (const bf16_t*)(ws + WS_KB); const bf16_t* Qb = (const bf16_t*)(ws + WS_QB); const bf16_t* MKV = (const bf16_t*)(ws + WS_MKV);
    for (int grp = gw; grp < NTOK / 8; grp += NGW) {
        float mx = 0.f;
#pragma unroll
        for (int r = 0; r < 8; ++r) { const u32x4 v = *(const u32x4*)(Kb + (size_t)(grp * 8 + r) * 512 + lane * 8); float s = 0.f;
#pragma unroll
            for (int j = 0; j < 4; ++j) { const float a = __uint_as_float(v[j] << 16), b = __uint_as_float(v[j] & 0xffff0000u); s += a * a + b * b; }
            s += __shfl_xor(s, 1); s += __shfl_xor(s, 2); s += __shfl_xor(s, 4); mx = fmaxf(mx, s); }
        if ((lane & 7) == 0) atomicMax(ctl + CW_KMAX + ((grp * 8) / SEQ) * 8 + (lane >> 3), __float_as_uint(mx));
        float mq = 0.f;
#pragma unroll
        for (int r = 0; r < 8; ++r) { const u32x4 v = *(const u32x4*)(Qb + (size_t)(grp * 8 + r) * 512 + lane * 8); float s = 0.f;
#pragma unroll
            for (int j = 0; j < 4; ++j) { const float a = __uint_as_float(v[j] << 16), b = __uint_as_float(v[j] & 0xffff0000u); s += a * a + b * b; }
            s += __shfl_xor(s, 1); s += __shfl_xor(s, 2); s += __shfl_xor(s, 4); mq = fmaxf(mq, s); }
        if ((lane & 7) == 0) atomicMax(ctl + CW_QMAX + ((grp * 8) / SEQ) * 8 + (lane >> 3), __float_as_uint(mq));
    }
    for (int grp = gw; grp < NB * MEMLEN / 8; grp += NGW) {
        float mx = 0.f;
#pragma unroll
        for (int r = 0; r < 8; ++r) { const u32x4 v = *(const u32x4*)(MKV + (size_t)(grp * 8 + r) * 512 + (lane & 31) * 8); float s = 0.f;
#pragma unroll
            for (int j = 0; j < 4; ++j) { const float a = __uint_as_float(v[j] << 16), b = __uint_as_float(v[j] & 0xffff0000u); s += a * a + b * b; }
            s += __shfl_xor(s, 1); s += __shfl_xor(s, 2); s += __shfl_xor(s, 4); mx = fmaxf(mx, s); }
        if (lane < 32 && (lane & 7) == 0) atomicMax(ctl + CW_KMAXM + ((grp * 8) / MEMLEN) * 4 + (lane >> 3), __float_as_uint(mx));
    }
}

namespace att {
#define ALAS __attribute__((address_space(3)))
typedef short bf16x8 __attribute__((ext_vector_type(8)));
typedef short s16x4 __attribute__((ext_vector_type(4)));
typedef short v4i16_t __attribute__((ext_vector_type(4)));
typedef float f32x16 __attribute__((ext_vector_type(16)));
typedef float f32x2_t __attribute__((ext_vector_type(2)));
typedef __bf16 bf16x2_t __attribute__((ext_vector_type(2)));
constexpr int KOFF = 0, VOFF = 16384, TOFF = 49152, ATT_LDS = TOFF + 1024;
DI unsigned cvtpk(float lo, float hi) { f32x2_t v = {lo, hi}; bf16x2_t b = __builtin_convertvector(v, bf16x2_t); return __builtin_bit_cast(unsigned, b); }
DI s16x4 vtr(const ALAS unsigned char* q) { return __builtin_bit_cast(s16x4, __builtin_amdgcn_ds_read_tr16_b64_v4i16((ALAS v4i16_t*)q)); }
#define ATT_MFMA(a, b, c) __builtin_amdgcn_mfma_f32_32x32x16_bf16((a), (b), (c), 0, 0, 0)

template <int NDT, bool BAND>
DI void tile(const ALAS unsigned char* kb, const ALAS unsigned char* vb, const bf16x8 (&qr)[4], const f32x16& cinit, f32x16 (&o)[NDT], float& lsum,
             const ALAS float* tbl, int relbase, float mrow) {
    f32x16 p0, p1;
#pragma unroll
    for (int d0 = 0; d0 < 4; ++d0) {
        const bf16x8 b0 = *(const ALAS bf16x8*)(kb + d0 * 2048), b1 = *(const ALAS bf16x8*)(kb + d0 * 2048 + 512);
        if (d0 == 0) { if (BAND) { const f32x16 z = {0.f,0.f,0.f,0.f,0.f,0.f,0.f,0.f,0.f,0.f,0.f,0.f,0.f,0.f,0.f,0.f}; p0 = ATT_MFMA(b0, qr[0], z); p1 = ATT_MFMA(b1, qr[0], z); }
                       else { p0 = ATT_MFMA(b0, qr[0], cinit); p1 = ATT_MFMA(b1, qr[0], cinit); } }
        else { p0 = ATT_MFMA(b0, qr[d0], p0); p1 = ATT_MFMA(b1, qr[d0], p1); }
    }
    if (BAND) {
#pragma unroll
        for (int r = 0; r < 16; ++r) {
            const int rel0 = relbase + (r & 3) + 8 * (r >> 2);
            const int i0 = min(max(rel0 + 128, 0), 255), i1 = min(max(rel0 + 160, 0), 255);
            p0[r] += tbl[i0] - mrow; p1[r] += tbl[i1] - mrow;
        }
    }
    float s = 0.f;
#pragma unroll
    for (int r = 0; r < 16; ++r) { p0[r] = __builtin_amdgcn_exp2f(p0[r]); p1[r] = __builtin_amdgcn_exp2f(p1[r]); s += p0[r] + p1[r]; }
    lsum += s;
    u32x4 w0, w1, w2, w3;
    w0.x = cvtpk(p0[0], p0[1]); w0.y = cvtpk(p0[2], p0[3]); w0.z = cvtpk(p0[4], p0[5]); w0.w = cvtpk(p0[6], p0[7]);
    w1.x = cvtpk(p0[8], p0[9]); w1.y = cvtpk(p0[10], p0[11]); w1.z = cvtpk(p0[12], p0[13]); w1.w = cvtpk(p0[14], p0[15]);
    w2.x = cvtpk(p1[0], p1[1]); w2.y = cvtpk(p1[2], p1[3]); w2.z = cvtpk(p1[4], p1[5]); w2.w = cvtpk(p1[6], p1[7]);
    w3.x = cvtpk(p1[8], p1[9]); w3.y = cvtpk(p1[10], p1[11]); w3.z = cvtpk(p1[12], p1[13]); w3.w = cvtpk(p1[14], p1[15]);
    const bf16x8 pb0 = __builtin_bit_cast(bf16x8, w0), pb1 = __builtin_bit_cast(bf16x8, w1), pb2 = __builtin_bit_cast(bf16x8, w2), pb3 = __builtin_bit_cast(bf16x8, w3);
#pragma unroll
    for (int dt = 0; dt < NDT; ++dt) {
        __builtin_amdgcn_sched_barrier(0);
#pragma unroll
        for (int ks = 0; ks < 4; ++ks) {
            const s16x4 lo = vtr(vb + (dt * 4 + ks) * 1024), hh = vtr(vb + (dt * 4 + ks) * 1024 + 512);
            const bf16x8 a = __builtin_shufflevector(lo, hh, 0, 1, 2, 3, 4, 5, 6, 7);
            o[dt] = ATT_MFMA(a, ks == 0 ? pb0 : ks == 1 ? pb1 : ks == 2 ? pb2 : pb3, o[dt]);
        }
    }
}

template <int DV, bool DIFF>
DI void attn_unit(ALAS unsigned char* lds, const Params& p, int unit, int wid, int lane) {
    unsigned char* ws = p.ws; const unsigned* ctl = (const unsigned*)(ws + WS_CTL);
    const int tid = threadIdx.x, r32 = lane & 31, hi = lane >> 5;
    constexpr int NDT = DV / 32, VBYTES = DV * 128, NCOMP = DIFF ? 2 : 1, NT = DIFF ? 64 : 4;
    int b, h, qb, qpitch, ocol; size_t kbase; const bf16_t *Qg, *Kg, *Vg;
    if (DIFF) { b = unit >> 6; h = (unit >> 4) & 3; qb = unit & 15; Qg = (const bf16_t*)(ws + WS_QB) + h * 128; qpitch = 512; Kg = (const bf16_t*)(ws + WS_KB) + h * 128;
        Vg = (const bf16_t*)(ws + WS_VB) + h * 128; kbase = (size_t)b * SEQ; ocol = h * 128; }
    else { const int qblk = unit >> 2; h = unit & 3; b = qblk >> 4; qb = qblk & 15; Qg = (const bf16_t*)(ws + WS_MQB) + h * 64; qpitch = 256; Kg = (const bf16_t*)(ws + WS_MKV) + h * 64;
        Vg = (const bf16_t*)(ws + WS_MKV) + 256 + h * 64; kbase = (size_t)b * MEMLEN; ocol = 768 + h * 64; }
    const int row0 = b * SEQ + qb * 256, qa = qb * 256 + wid * 32;
    const ALAS float* tbl = (const ALAS float*)(lds + TOFF);
    float bmax = 0.f, cL = 0.f, cR = 0.f, lam = 0.f;
    __syncthreads();
    if (DIFF) {
        const float* rb = p.in[I_RELB];
        if (tid < 256) ((ALAS float*)(lds + TOFF))[tid] = rb[t5_bucket(tid - 128) * 4 + h] * LOG2E;
        float bm = -1e30f;
        for (int i = 0; i < 32; ++i) bm = fmaxf(bm, rb[i * 4 + h]);
        bmax = bm * LOG2E; cL = rb[15 * 4 + h] * LOG2E; cR = rb[31 * 4 + h] * LOG2E;
        float s1 = 0.f, s2 = 0.f;
        for (int i = 0; i < 64; ++i) { s1 += p.in[I_LQ1][i] * p.in[I_LK1][i]; s2 += p.in[I_LQ2][i] * p.in[I_LK2][i]; }
        lam = expf(s1) - expf(s2) + LAM_INIT;
        __syncthreads();
    }
    const int tL = DIFF ? (qa >= 154 ? (qa - 154) / 64 + 1 : 0) : NT;
    const int tR = DIFF ? (qa + 185) / 64 : NT;
    const int vlane = (4 * hi + ((lane & 15) >> 2)) * 64 + ((lane >> 4) & 1) * 32 + (lane & 3) * 8;
#pragma unroll 1
    for (int c = 0; c < NCOMP; ++c) {
        const bf16_t* Qp = Qg + (size_t)(row0 + wid * 32 + r32) * qpitch + c * 64 + hi * 8;
        bf16x8 qr[4]; float qq = 0.f;
#pragma unroll
        for (int d0 = 0; d0 < 4; ++d0) { qr[d0] = *(const bf16x8*)(Qp + d0 * 16);
#pragma unroll
            for (int j = 0; j < 8; ++j) { const float f = __uint_as_float(((unsigned)(unsigned short)qr[d0][j]) << 16); qq += f * f; } }
        qq += __shfl_xor(qq, 32);
        const float kmx = sqrtf(__uint_as_float(DIFF ? ctl[CW_KMAX + b * 8 + h * 2 + c] : ctl[CW_KMAXM + b * 4 + h]));
        const float mrow = sqrtf(qq) * kmx * 1.0001f + bmax;
        f32x16 cinit;
#pragma unroll
        for (int r = 0; r < 16; ++r) cinit[r] = cL - mrow;
        f32x16 o[NDT];
#pragma unroll
        for (int dt = 0; dt < NDT; ++dt)
#pragma unroll
            for (int r = 0; r < 16; ++r) o[dt][r] = 0.f;
        float lsum = 0.f;
        const bf16_t* ksrc = Kg + (kbase + lane) * 512 + c * 64 + wid * 8;
#define ATT_DMA(t, buf) do { \
        __builtin_amdgcn_global_load_lds((const unsigned*)(ksrc + (size_t)(t) * 64 * 512), (ALAS unsigned*)(lds + KOFF + (buf) * 8192 + wid * 1024), 16, 0, 0); \
        _Pragma("unroll") for (int i_ = 0; i_ < DV / 64; ++i_) { const int pid_ = wid + 8 * i_; \
            __builtin_amdgcn_global_load_lds((const unsigned*)(Vg + (kbase + (size_t)(t) * 64 + 16 * (pid_ & 3) + (lane >> 2)) * 512 + 32 * (pid_ >> 2) + 8 * (lane & 3)), \
                                             (ALAS unsigned*)(lds + VOFF + (buf) * VBYTES + pid_ * 1024), 16, 0, 0); } } while (0)
        ATT_DMA(0, 0);
        asm volatile("s_waitcnt vmcnt(0)" ::: "memory");
        __syncthreads();
#pragma unroll 1
        for (int t = 0; t < NT; ++t) {
            const int buf = t & 1;
            if (t + 1 < NT) ATT_DMA(t + 1, buf ^ 1);
            if (DIFF && t == tR) {
                float dlt = cR - cL; asm volatile("" : "+v"(dlt));
#pragma unroll
                for (int r = 0; r < 16; ++r) cinit[r] += dlt;
            }
            const ALAS unsigned char* kb = lds + KOFF + buf * 8192 + hi * 1024 + r32 * 16;
            const ALAS unsigned char* vb = lds + VOFF + buf * VBYTES + vlane;
            if (DIFF && t >= tL && t < tR) tile<NDT, true>(kb, vb, qr, cinit, o, lsum, tbl, t * 64 + 4 * hi - qa - r32, mrow);
            else tile<NDT, false>(kb, vb, qr, cinit, o, lsum, tbl, 0, 0.f);
            asm volatile("s_waitcnt vmcnt(0)" ::: "memory");
            __syncthreads();
        }
#undef ATT_DMA
        lsum += __shfl_xor(lsum, 32);
        const float inv = 1.0f / lsum;
        int lane2 = lane; asm volatile("" : "+v"(lane2));
        const int r32b = lane2 & 31, hib = lane2 >> 5;
        float* o1p = (float*)(ws + WS_O1) + ((size_t)(unit * 8 + wid) * 64 + lane2) * 64;
        if (DIFF && c == 0) {
#pragma unroll
            for (int dt = 0; dt < NDT; ++dt)
#pragma unroll
                for (int r = 0; r < 16; ++r) o1p[dt * 16 + r] = o[dt][r] * inv;
        } else {
            bf16_t* Ob = (bf16_t*)(ws + WS_OB) + (size_t)(row0 + wid * 32 + r32b) * 1024 + ocol + 4 * hib;
            if (DIFF) {
                float ss = 0.f;
#pragma unroll
                for (int dt = 0; dt < NDT; ++dt)
#pragma unroll
                    for (int r = 0; r < 16; ++r) { const float v = o1p[dt * 16 + r] - lam * (o[dt][r] * inv); o[dt][r] = v; ss += v * v; }
                ss += __shfl_xor(ss, 32);
                const float rn = (1.0f - LAM_INIT) / sqrtf(ss * (1.0f / 128.0f) + LN_EPS);
#pragma unroll
                for (int dt = 0; dt < NDT; ++dt)
#pragma unroll
                    for (int g4 = 0; g4 < 4; ++g4) { const int d0 = 32 * dt + 8 * g4; const f32x4 sg = *(const f32x4*)(p.in[I_SUBG] + d0 + 4 * hib);
                        u32x2 w; w.x = cvtpk(o[dt][4 * g4] * rn * sg.x, o[dt][4 * g4 + 1] * rn * sg.y); w.y = cvtpk(o[dt][4 * g4 + 2] * rn * sg.z, o[dt][4 * g4 + 3] * rn * sg.w);
                        *(u32x2*)(Ob + d0) = w; }
            } else {
#pragma unroll
                for (int dt = 0; dt < NDT; ++dt)
#pragma unroll
                    for (int g4 = 0; g4 < 4; ++g4) { const int d0 = 32 * dt + 8 * g4;
                        u32x2 w; w.x = cvtpk(o[dt][4 * g4] * inv, o[dt][4 * g4 + 1] * inv); w.y = cvtpk(o[dt][4 * g4 + 2] * inv, o[dt][4 * g4 + 3] * inv);
                        *(u32x2*)(Ob + d0) = w; }
            }
        }
    }
}

constexpr int PK = 0, PVV = 24576, PT = 73728;
#define SBAR() __builtin_amdgcn_sched_barrier(0)
DI void glds16_asm(const void* gsrc, unsigned lds_dst) { unsigned keep;
    asm volatile("s_mov_b32 %0, m0\n\ts_mov_b32 m0, %2\n\ts_nop 0\n\tglobal_load_lds_dwordx4 %1, off\n\ts_mov_b32 m0, %0" : "=&s"(keep) : "v"(gsrc), "s"(lds_dst) : "memory"); }
#define PWAITBAR(N) asm volatile("s_waitcnt vmcnt(" #N ") lgkmcnt(0)\n\ts_barrier" ::: "memory")
template <bool FIRST>
DI void pstep(const bf16x8 (&qr)[4], f32x16 (&o)[4], f32x16& C0, f32x16& C1, const f32x16& P0, const f32x16& P1, float& l,
              const ALAS unsigned char* kq, const ALAS unsigned char* vq, bool band, int relbase, float cref, const ALAS float* tbl) {
    const f32x16 z = {0.f,0.f,0.f,0.f,0.f,0.f,0.f,0.f,0.f,0.f,0.f,0.f,0.f,0.f,0.f,0.f};
#define KRD(i) (*(const ALAS bf16x8*)(kq + ((i) >> 1) * 2048 + ((i) & 1) * 512))
#define VLO(f) vtr(vq + ((((f) & 3) * 4 + ((f) >> 2)) * 1024))
#define VHI(f) vtr(vq + ((((f) & 3) * 4 + ((f) >> 2)) * 1024 + 512))
#define VCAT(lo, hi) __builtin_shufflevector(lo, hi, 0, 1, 2, 3, 4, 5, 6, 7)
    u32x4 pw0, pw1, pw2, pw3; float sacc = 0.f;
    bf16x8 k0 = KRD(0), k1 = KRD(1), k2 = KRD(2), k3, k4, k5, k6, k7;
    s16x4 vl0, vh0, vl1, vh1, vl2, vh2, vl3, vh3, vl4, vh4, vl5, vh5, vl6, vh6, vl7, vh7, vl8, vh8, vl9, vh9, vl10, vh10, vl11, vh11, vl12, vh12, vl13, vh13, vl14, vh14, vl15, vh15;
    SBAR();
    k3 = KRD(3); C0 = ATT_MFMA(k0, qr[0], z); if (!FIRST) { sacc += (P0[0] + P0[1]) + (P0[2] + P0[3]); pw0.x = cvtpk(P0[0], P0[1]); pw0.y = cvtpk(P0[2], P0[3]); asm volatile("" : "+v"(sacc), "+v"(pw0.x), "+v"(pw0.y)); } SBAR();
    k4 = KRD(4); C1 = ATT_MFMA(k1, qr[0], z); if (!FIRST) { sacc += (P0[4] + P0[5]) + (P0[6] + P0[7]); pw0.z = cvtpk(P0[4], P0[5]); pw0.w = cvtpk(P0[6], P0[7]); asm volatile("" : "+v"(sacc), "+v"(pw0.z), "+v"(pw0.w)); } SBAR();
    k5 = KRD(5); C0 = ATT_MFMA(k2, qr[1], C0); if (!FIRST) { sacc += (P0[8] + P0[9]) + (P0[10] + P0[11]); pw1.x = cvtpk(P0[8], P0[9]); pw1.y = cvtpk(P0[10], P0[11]); asm volatile("" : "+v"(sacc), "+v"(pw1.x), "+v"(pw1.y)); } SBAR();
    k6 = KRD(6); C1 = ATT_MFMA(k3, qr[1], C1); if (!FIRST) { sacc += (P0[12] + P0[13]) + (P0[14] + P0[15]); pw1.z = cvtpk(P0[12], P0[13]); pw1.w = cvtpk(P0[14], P0[15]); asm volatile("" : "+v"(sacc), "+v"(pw1.z), "+v"(pw1.w)); } SBAR();
    k7 = KRD(7); if (!FIRST) { vl0 = VLO(0); vh0 = VHI(0); } C0 = ATT_MFMA(k4, qr[2], C0); if (!FIRST) { sacc += (P1[0] + P1[1]) + (P1[2] + P1[3]); pw2.x = cvtpk(P1[0], P1[1]); pw2.y = cvtpk(P1[2], P1[3]); asm volatile("" : "+v"(sacc), "+v"(pw2.x), "+v"(pw2.y)); } SBAR();
    if (!FIRST) { vl1 = VLO(1); vh1 = VHI(1); } C1 = ATT_MFMA(k5, qr[2], C1); if (!FIRST) { sacc += (P1[4] + P1[5]) + (P1[6] + P1[7]); pw2.z = cvtpk(P1[4], P1[5]); pw2.w = cvtpk(P1[6], P1[7]); asm volatile("" : "+v"(sacc), "+v"(pw2.z), "+v"(pw2.w)); } SBAR();
    if (!FIRST) { vl2 = VLO(2); vh2 = VHI(2); } C0 = ATT_MFMA(k6, qr[3], C0); if (!FIRST) { sacc += (P1[8] + P1[9]) + (P1[10] + P1[11]); pw3.x = cvtpk(P1[8], P1[9]); pw3.y = cvtpk(P1[10], P1[11]); asm volatile("" : "+v"(sacc), "+v"(pw3.x), "+v"(pw3.y)); } SBAR();
    if (!FIRST) { vl3 = VLO(3); vh3 = VHI(3); } C1 = ATT_MFMA(k7, qr[3], C1); if (!FIRST) { sacc += (P1[12] + P1[13]) + (P1[14] + P1[15]); pw3.z = cvtpk(P1[12], P1[13]); pw3.w = cvtpk(P1[14], P1[15]); asm volatile("" : "+v"(sacc), "+v"(pw3.z), "+v"(pw3.w)); } SBAR();
    l += sacc;
    if (band) {
        const ALAS float* tb_ = tbl + (relbase + 192);
#pragma unroll
        for (int r = 0; r < 16; ++r) { C0[r] += tb_[(r & 3) + 8 * (r >> 2)] - cref; C1[r] += tb_[32 + (r & 3) + 8 * (r >> 2)] - cref; }
    }
    SBAR();
    if (FIRST) {
#pragma unroll
        for (int r = 0; r < 16; ++r) { C0[r] = __builtin_amdgcn_exp2f(C0[r]); C1[r] = __builtin_amdgcn_exp2f(C1[r]); }
    } else {
        const bf16x8 pb0 = __builtin_bit_cast(bf16x8, pw0), pb1 = __builtin_bit_cast(bf16x8, pw1), pb2 = __builtin_bit_cast(bf16x8, pw2), pb3 = __builtin_bit_cast(bf16x8, pw3);
        vl4 = VLO(4); vh4 = VHI(4); o[0] = ATT_MFMA(VCAT(vl0, vh0), pb0, o[0]); C0[0] = __builtin_amdgcn_exp2f(C0[0]); C0[1] = __builtin_amdgcn_exp2f(C0[1]); asm volatile("" : "+v"(C0)); SBAR();
        vl5 = VLO(5); vh5 = VHI(5); o[1] = ATT_MFMA(VCAT(vl1, vh1), pb0, o[1]); C0[2] = __builtin_amdgcn_exp2f(C0[2]); C0[3] = __builtin_amdgcn_exp2f(C0[3]); asm volatile("" : "+v"(C0)); SBAR();
        vl6 = VLO(6); vh6 = VHI(6); o[2] = ATT_MFMA(VCAT(vl2, vh2), pb0, o[2]); C0[4] = __builtin_amdgcn_exp2f(C0[4]); C0[5] = __builtin_amdgcn_exp2f(C0[5]); asm volatile("" : "+v"(C0)); SBAR();
        vl7 = VLO(7); vh7 = VHI(7); o[3] = ATT_MFMA(VCAT(vl3, vh3), pb0, o[3]); C0[6] = __builtin_amdgcn_exp2f(C0[6]); C0[7] = __builtin_amdgcn_exp2f(C0[7]); asm volatile("" : "+v"(C0)); SBAR();
        vl8 = VLO(8); vh8 = VHI(8); o[0] = ATT_MFMA(VCAT(vl4, vh4), pb1, o[0]); C0[8] = __builtin_amdgcn_exp2f(C0[8]); C0[9] = __builtin_amdgcn_exp2f(C0[9]); asm volatile("" : "+v"(C0)); SBAR();
        vl9 = VLO(9); vh9 = VHI(9); o[1] = ATT_MFMA(VCAT(vl5, vh5), pb1, o[1]); C0[10] = __builtin_amdgcn_exp2f(C0[10]); C0[11] = __builtin_amdgcn_exp2f(C0[11]); asm volatile("" : "+v"(C0)); SBAR();
        vl10 = VLO(10); vh10 = VHI(10); o[2] = ATT_MFMA(VCAT(vl6, vh6), pb1, o[2]); C0[12] = __builtin_amdgcn_exp2f(C0[12]); C0[13] = __builtin_amdgcn_exp2f(C0[13]); asm volatile("" : "+v"(C0)); SBAR();
        vl11 = VLO(11); vh11 = VHI(11); o[3] = ATT_MFMA(VCAT(vl7, vh7), pb1, o[3]); C0[14] = __builtin_amdgcn_exp2f(C0[14]); C0[15] = __builtin_amdgcn_exp2f(C0[15]); asm volatile("" : "+v"(C0)); SBAR();
        vl12 = VLO(12); vh12 = VHI(12); o[0] = ATT_MFMA(VCAT(vl8, vh8), pb2, o[0]); C1[0] = __builtin_amdgcn_exp2f(C1[0]); C1[1] = __builtin_amdgcn_exp2f(C1[1]); asm volatile("" : "+v"(C1)); SBAR();
        vl13 = VLO(13); vh13 = VHI(13); o[1] = ATT_MFMA(VCAT(vl9, vh9), pb2, o[1]); C1[2] = __builtin_amdgcn_exp2f(C1[2]); C1[3] = __builtin_amdgcn_exp2f(C1[3]); asm volatile("" : "+v"(C1)); SBAR();
        vl14 = VLO(14); vh14 = VHI(14); o[2] = ATT_MFMA(VCAT(vl10, vh10), pb2, o[2]); C1[4] = __builtin_amdgcn_exp2f(C1[4]); C1[5] = __builtin_amdgcn_exp2f(C1[5]); asm volatile("" : "+v"(C1)); SBAR();
        vl15 = VLO(15); vh15 = VHI(15); o[3] = ATT_MFMA(VCAT(vl11, vh11), pb2, o[3]); C1[6] = __builtin_amdgcn_exp2f(C1[6]); C1[7] = __builtin_amdgcn_exp2f(C1[7]); asm volatile("" : "+v"(C1)); SBAR();
        o[0] = ATT_MFMA(VCAT(vl12, vh12), pb3, o[0]); C1[8] = __builtin_amdgcn_exp2f(C1[8]); C1[9] = __builtin_amdgcn_exp2f(C1[9]); asm volatile("" : "+v"(C1)); SBAR();
        o[1] = ATT_MFMA(VCAT(vl13, vh13), pb3, o[1]); C1[10] = __builtin_amdgcn_exp2f(C1[10]); C1[11] = __builtin_amdgcn_exp2f(C1[11]); asm volatile("" : "+v"(C1)); SBAR();
        o[2] = ATT_MFMA(VCAT(vl14, vh14), pb3, o[2]); C1[12] = __builtin_amdgcn_exp2f(C1[12]); C1[13] = __builtin_amdgcn_exp2f(C1[13]); asm volatile("" : "+v"(C1)); SBAR();
        o[3] = ATT_MFMA(VCAT(vl15, vh15), pb3, o[3]); C1[14] = __builtin_amdgcn_exp2f(C1[14]); C1[15] = __builtin_amdgcn_exp2f(C1[15]); asm volatile("" : "+v"(C1)); SBAR();
    }
#undef KRD
#undef VLO
#undef VHI
#undef VCAT
}
DI void pdrain(f32x16 (&o)[4], const f32x16& P0, const f32x16& P1, float& l, const ALAS unsigned char* vq) {
#define VLO(f) vtr(vq + ((((f) & 3) * 4 + ((f) >> 2)) * 1024))
#define VHI(f) vtr(vq + ((((f) & 3) * 4 + ((f) >> 2)) * 1024 + 512))
#define VCAT(lo, hi) __builtin_shufflevector(lo, hi, 0, 1, 2, 3, 4, 5, 6, 7)
    float sacc = 0.f;
#pragma unroll
    for (int r = 0; r < 16; ++r) sacc += P0[r] + P1[r];
    l += sacc;
    u32x4 pw0, pw1, pw2, pw3;
    pw0.x = cvtpk(P0[0], P0[1]); pw0.y = cvtpk(P0[2], P0[3]); pw0.z = cvtpk(P0[4], P0[5]); pw0.w = cvtpk(P0[6], P0[7]);
    pw1.x = cvtpk(P0[8], P0[9]); pw1.y = cvtpk(P0[10], P0[11]); pw1.z = cvtpk(P0[12], P0[13]); pw1.w = cvtpk(P0[14], P0[15]);
    pw2.x = cvtpk(P1[0], P1[1]); pw2.y = cvtpk(P1[2], P1[3]); pw2.z = cvtpk(P1[4], P1[5]); pw2.w = cvtpk(P1[6], P1[7]);
    pw3.x = cvtpk(P1[8], P1[9]); pw3.y = cvtpk(P1[10], P1[11]); pw3.z = cvtpk(P1[12], P1[13]); pw3.w = cvtpk(P1[14], P1[15]);
    const bf16x8 pb0 = __builtin_bit_cast(bf16x8, pw0), pb1 = __builtin_bit_cast(bf16x8, pw1), pb2 = __builtin_bit_cast(bf16x8, pw2), pb3 = __builtin_bit_cast(bf16x8, pw3);
    { const s16x4 lo_ = VLO(0), hi_ = VHI(0); o[0] = ATT_MFMA(VCAT(lo_, hi_), pb0, o[0]); }
    { const s16x4 lo_ = VLO(1), hi_ = VHI(1); o[1] = ATT_MFMA(VCAT(lo_, hi_), pb0, o[1]); }
    { const s16x4 lo_ = VLO(2), hi_ = VHI(2); o[2] = ATT_MFMA(VCAT(lo_, hi_), pb0, o[2]); }
    { const s16x4 lo_ = VLO(3), hi_ = VHI(3); o[3] = ATT_MFMA(VCAT(lo_, hi_), pb0, o[3]); }
    { const s16x4 lo_ = VLO(4), hi_ = VHI(4); o[0] = ATT_MFMA(VCAT(lo_, hi_), pb1, o[0]); }
    { const s16x4 lo_ = VLO(5), hi_ = VHI(5); o[1] = ATT_MFMA(VCAT(lo_, hi_), pb1, o[1]); }
    { const s16x4 lo_ = VLO(6), hi_ = VHI(6); o[2] = ATT_MFMA(VCAT(lo_, hi_), pb1, o[2]); }
    { const s16x4 lo_ = VLO(7), hi_ = VHI(7); o[3] = ATT_MFMA(VCAT(lo_, hi_), pb1, o[3]); }
    { const s16x4 lo_ = VLO(8), hi_ = VHI(8); o[0] = ATT_MFMA(VCAT(lo_, hi_), pb2, o[0]); }
    { const s16x4 lo_ = VLO(9), hi_ = VHI(9); o[1] = ATT_MFMA(VCAT(lo_, hi_), pb2, o[1]); }
    { const s16x4 lo_ = VLO(10), hi_ = VHI(10); o[2] = ATT_MFMA(VCAT(lo_, hi_), pb2, o[2]); }
    { const s16x4 lo_ = VLO(11), hi_ = VHI(11); o[3] = ATT_MFMA(VCAT(lo_, hi_), pb2, o[3]); }
    { const s16x4 lo_ = VLO(12), hi_ = VHI(12); o[0] = ATT_MFMA(VCAT(lo_, hi_), pb3, o[0]); }
    { const s16x4 lo_ = VLO(13), hi_ = VHI(13); o[1] = ATT_MFMA(VCAT(lo_, hi_), pb3, o[1]); }
    { const s16x4 lo_ = VLO(14), hi_ = VHI(14); o[2] = ATT_MFMA(VCAT(lo_, hi_), pb3, o[2]); }
    { const s16x4 lo_ = VLO(15), hi_ = VHI(15); o[3] = ATT_MFMA(VCAT(lo_, hi_), pb3, o[3]); }
#undef VLO
#undef VHI
#undef VCAT
}

DI void attn_pipe(ALAS unsigned char* lds, const Params& p, int unit, int wid, int lane) {
    unsigned char* ws = p.ws;
    const int tid = threadIdx.x, r32 = lane & 31, hi = lane >> 5;
    constexpr int NT = 64;
    const int b = unit >> 6, h = (unit >> 4) & 3, qb = unit & 15;
    const bf16_t* Qg = (const bf16_t*)(ws + WS_QB) + h * 128; const bf16_t* Kg = (const bf16_t*)(ws + WS_KB) + h * 128; const bf16_t* Vg = (const bf16_t*)(ws + WS_VB) + h * 128;
    const size_t kbase = (size_t)b * SEQ; const int ocol = h * 128;
    const int row0 = b * SEQ + qb * 256, qa = qb * 256 + wid * 32;
    const ALAS float* tbl = (const ALAS float*)(lds + PT);
    float cL, cR, lam;
    __syncthreads();
    {
        const float* rb = p.in[I_RELB];
        if (tid < 384) ((ALAS float*)(lds + PT))[tid] = rb[t5_bucket(tid - 192) * 4 + h] * LOG2E;
        cL = rb[15 * 4 + h] * LOG2E; cR = rb[31 * 4 + h] * LOG2E;
        float s1 = 0.f, s2 = 0.f;
        for (int i = 0; i < 64; ++i) { s1 += p.in[I_LQ1][i] * p.in[I_LK1][i]; s2 += p.in[I_LQ2][i] * p.in[I_LK2][i]; }
        lam = expf(s1) - expf(s2) + LAM_INIT;
        __syncthreads();
    }
    const int tL = qa >= 154 ? (qa - 154) / 64 + 1 : 0;
    const int tR = (qa + 185) / 64;
    const int vlane = (4 * hi + ((lane & 15) >> 2)) * 64 + ((lane >> 4) & 1) * 32 + (lane & 3) * 8;
    const int relb0 = 4 * hi - qa - r32;
#pragma unroll 1
    for (int c = 0; c < 2; ++c) {
        const bf16_t* Qp = Qg + (size_t)(row0 + wid * 32 + r32) * 512 + c * 64 + hi * 8;
        bf16x8 qr[4];
#pragma unroll
        for (int d0 = 0; d0 < 4; ++d0) qr[d0] = *(const bf16x8*)(Qp + d0 * 16);
        f32x16 o[4];
#pragma unroll
        for (int dt = 0; dt < 4; ++dt)
#pragma unroll
            for (int r = 0; r < 16; ++r) o[dt][r] = 0.f;
        float l = 0.f, cref = cL;
        f32x16 pA0, pA1, pB0, pB1;
        const bf16_t* ksrc = Kg + (kbase + lane) * 512 + c * 64 + wid * 8;
        const bf16_t* vsrc = Vg + (kbase + 16 * (wid & 3) + (lane >> 2)) * 512 + 32 * (wid >> 2) + 8 * (lane & 3);
        int ks_cur = 0, ks_nxt = 8192, ks_fre = 16384, vs_prv = 32768, vs_cur = 0, vs_fre = 16384;
#define PGLDS(src, dst) glds16_asm((src), (unsigned)__builtin_amdgcn_readfirstlane((int)(unsigned)(unsigned long)(dst)))
#define DMAK(t, off) PGLDS(ksrc + (size_t)(t) * (64 * 512), lds + PK + (off) + wid * 1024)
#define DMAV(t, off) do { PGLDS(vsrc + (size_t)(t) * (64 * 512), lds + PVV + (off) + wid * 1024); PGLDS(vsrc + 64 + (size_t)(t) * (64 * 512), lds + PVV + (off) + (wid + 8) * 1024); } while (0)
#define PROT() do { const int k_ = ks_cur; ks_cur = ks_nxt; ks_nxt = ks_fre; ks_fre = k_; const int v_ = vs_prv; vs_prv = vs_cur; vs_cur = vs_fre; vs_fre = v_; } while (0)
        DMAK(0, 0); DMAK(1, 8192); DMAV(0, 0);
        PWAITBAR(0);
        DMAK(2, 16384); DMAV(1, 16384);
        pstep<true>(qr, o, pA0, pA1, pA0, pA1, l, lds + PK + hi * 1024 + r32 * 16, lds + PVV + vlane, tL == 0, relb0, cref, tbl);
        PWAITBAR(3);
        PROT();
#define PSTEPX(C0, C1, P0, P1, tt) do { \
        DMAK(min((tt) + 2, NT - 1), ks_fre); DMAV(min((tt) + 1, NT - 1), vs_fre); \
        pstep<false>(qr, o, C0, C1, P0, P1, l, lds + PK + ks_cur + hi * 1024 + r32 * 16, lds + PVV + vs_prv + vlane, (tt) >= tL && (tt) < tR, relb0 + (tt) * 64, cref, tbl); \
        if ((tt) == tR) { float f_ = __builtin_amdgcn_exp2f(cL - cR); asm volatile("" : "+v"(f_)); l *= f_; cref = cR; \
            _Pragma("unroll") for (int dt_ = 0; dt_ < 4; ++dt_) _Pragma("unroll") for (int r_ = 0; r_ < 16; ++r_) o[dt_][r_] *= f_; } \
        PWAITBAR(3); PROT(); } while (0)
#pragma unroll 1
        for (int t = 1; t < NT; t += 2) {
            PSTEPX(pB0, pB1, pA0, pA1, t);
            if (t + 1 < NT) PSTEPX(pA0, pA1, pB0, pB1, t + 1);
        }
        pdrain(o, pB0, pB1, l, lds + PVV + vs_prv + vlane);
        PWAITBAR(0);
#undef PSTEPX
#undef PROT
#undef DMAV
#undef DMAK
#undef PGLDS
        l += __shfl_xor(l, 32);
        const float inv = 1.0f / l;
        int lane2 = lane; asm volatile("" : "+v"(lane2));
        const int r32b = lane2 & 31, hib = lane2 >> 5;
        float* o1p = (float*)(ws + WS_O1) + ((size_t)(unit * 8 + wid) * 64 + lane2) * 64;
        if (c == 0) {
#pragma unroll
            for (int dt = 0; dt < 4; ++dt)
#pragma unroll
                for (int r = 0; r < 16; ++r) o1p[dt * 16 + r] = o[dt][r] * inv;
        } else {
            bf16_t* Ob = (bf16_t*)(ws + WS_OB) + (size_t)(row0 + wid * 32 + r32b) * 1024 + ocol + 4 * hib;
            float ss = 0.f;
#pragma unroll
            for (int dt = 0; dt < 4; ++dt)
#pragma unroll
                for (int r = 0; r < 16; ++r) { const float v = o1p[dt * 16 + r] - lam * (o[dt][r] * inv); o[dt][r] = v; ss += v * v; }
            ss += __shfl_xor(ss, 32);
            const float rn = (1.0f - LAM_INIT) / sqrtf(ss * (1.0f / 128.0f) + LN_EPS);
#pragma unroll
            for (int dt = 0; dt < 4; ++dt)
#pragma unroll
                for (int g4 = 0; g4 < 4; ++g4) { const int d0 = 32 * dt + 8 * g4; const f32x4 sg = *(const f32x4*)(p.in[I_SUBG] + d0 + 4 * hib);
                    u32x2 w; w.x = cvtpk(o[dt][4 * g4] * rn * sg.x, o[dt][4 * g4 + 1] * rn * sg.y); w.y = cvtpk(o[dt][4 * g4 + 2] * rn * sg.z, o[dt][4 * g4 + 3] * rn * sg.w);
                    *(u32x2*)(Ob + d0) = w; }
        }
    }
}
}

template <bool DUAL, bool BKN, class LA, class LB, class EP>
DI void ngemm_tile(float* As, float* Bs, float* Bs2, int K, const LA& la, const LB& lb, const LB& lb2, const EP& ep) {
    const int tid = threadIdx.x, ty = tid >> 4, tx = tid & 15;
    float acc[4][4], acc2[4][4];
#pragma unroll
    for (int i = 0; i < 4; ++i)
#pragma unroll
        for (int j = 0; j < 4; ++j) { acc[i][j] = 0.f; acc2[i][j] = 0.f; }
    for (int kc = 0; kc < K; kc += 32) {
        __syncthreads();
#pragma unroll
        for (int j = 0; j < 8; ++j) { const int i = tid + 512 * j, k = i & 31, r = i >> 5; As[k * 132 + r] = la(r, kc + k); }
#pragma unroll
        for (int j = 0; j < 4; ++j) { const int i = tid + 512 * j; int k, n; if (BKN) { n = i & 63; k = i >> 6; } else { k = i & 31; n = i >> 5; }
            Bs[k * 68 + n] = lb(kc + k, n); if (DUAL) Bs2[k * 68 + n] = lb2(kc + k, n); }
        __syncthreads();
#pragma unroll 8
        for (int k = 0; k < 32; ++k) {
            const f32x4 a = *(const f32x4*)&As[k * 132 + ty * 4]; const f32x4 b = *(const f32x4*)&Bs[k * 68 + tx * 4];
#pragma unroll
            for (int i = 0; i < 4; ++i)
#pragma unroll
                for (int j = 0; j < 4; ++j) acc[i][j] += a[i] * b[j];
            if (DUAL) { const f32x4 b2 = *(const f32x4*)&Bs2[k * 68 + tx * 4];
#pragma unroll
                for (int i = 0; i < 4; ++i)
#pragma unroll
                    for (int j = 0; j < 4; ++j) acc2[i][j] += a[i] * b2[j]; }
        }
    }
#pragma unroll
    for (int i = 0; i < 4; ++i)
#pragma unroll
        for (int j = 0; j < 4; ++j) ep(ty * 4 + i, tx * 4 + j, acc[i][j], acc2[i][j]);
}

struct LA_bf { const bf16_t* A; int lda; DI float operator()(int r, int k) const { return bf2f(A[(size_t)r * lda + k]); } };
struct LB_bf { const bf16_t* B; int ldb; DI float operator()(int k, int n) const { return bf2f(B[(size_t)n * ldb + k]); } };
struct EP_inproj { unsigned char* ws; int m0, n0;
    DI void operator()(int r, int n, float v, float) const { const int row = m0 + r, c = n0 + n; bf16_t* dst;
        if (c < 512) dst = (bf16_t*)(ws + WS_QB) + (size_t)row * 512 + c; else if (c < 1024) dst = (bf16_t*)(ws + WS_KB) + (size_t)row * 512 + (c - 512);
        else if (c < 1536) dst = (bf16_t*)(ws + WS_VB) + (size_t)row * 512 + (c - 1024); else if (c < 1792) dst = (bf16_t*)(ws + WS_MQB) + (size_t)row * 256 + (c - 1536);
        else dst = (bf16_t*)(ws + WS_ZB) + (size_t)row * 512 + (c - 1792);
        *dst = (bf16_t)f2bf(v); } };
struct EP_bf { bf16_t* C; int ldc; int m0, n0; DI void operator()(int r, int n, float v, float) const { C[(size_t)(m0 + r) * ldc + n0 + n] = (bf16_t)f2bf(v); } };
struct EP_f32 { float* C; int ldc; int m0, n0; DI void operator()(int r, int n, float v, float) const { C[(size_t)(m0 + r) * ldc + n0 + n] = v; } };

struct LA_dft { const float* ct; int s0; DI float operator()(int r, int k) const { const int sp = s0 + r, s = k & 4095; const int idx = (s * sp) & 4095;
    return (k < 4096) ? ct[idx] : -ct[(idx - 1024) & 4095]; } };
struct LB_z { const bf16_t* Z; int n0; DI float operator()(int k, int n) const { return bf2f(Z[(size_t)(k & 4095) * 512 + (k >> 12) * 256 + n0 + n]); } };
struct EP_ob { bf16_t* O; int row0, col0; DI void operator()(int r, int n, float v, float) const { O[(size_t)(row0 + r) * 1024 + col0 + n] = (bf16_t)f2bf(v); } };
DI void nfourier_phase(const Params& p, float* As, float* Bs, int bid, int nb) {
    unsigned char* ws = p.ws; const float* ct = (const float*)(ws + WS_COSTAB);
    const int nT = NB * 32 * 4;
    for (int t = bid; t < nT; t += nb) {
        const int b = t / 128, q = t % 128, s0 = (q / 4) * 128, n0 = (q % 4) * 64;
        LA_dft la{ct, s0}; LB_z lb{(const bf16_t*)(ws + WS_ZB) + (size_t)b * SEQ * 512, n0}; EP_ob ep{(bf16_t*)(ws + WS_OB), b * SEQ + s0, 512 + n0};
        ngemm_tile<false, true>(As, Bs, Bs, 8192, la, lb, lb, ep);
    }
}

constexpr int P5_WA = 0, P5_WB = 131072 + 4096, P5_LG = P5_WB + 16384;
DI void p4_ln1_router(const Params& p, __attribute__((address_space(3))) unsigned char* lds, int gw, int NGW, int wave, int lane) {
    typedef __attribute__((address_space(3))) unsigned char* lptr;
    unsigned char* ws = p.ws;
    const float* Aout = (const float*)(ws + WS_AOUT); const float* st0 = (const float*)(ws + WS_STATS0); bf16_t* H1 = (bf16_t*)(ws + WS_XN);
    const float* WR = (const float*)(ws + WS_WR); unsigned* cnt = (unsigned*)(ws + WS_CTL) + CW_CNT; int* info = (int*)(ws + WS_TOKINFO); int* list = (int*)(ws + WS_LIST);
    __attribute__((address_space(3))) float* lg = (__attribute__((address_space(3))) float*)(lds + P5_LG) + wave * (8 * 36);
    __syncthreads();
#pragma unroll
    for (int i = 0; i < 18; ++i) { const int pc = wave * 18 + i, e = pc >> 2, part = pc & 3;
        const lptr dst = (e < 4) ? (lds + P5_WB + e * 4096 + part * 1024) : (lds + P5_WA + (e - 4) * 4096 + part * 1024);
        att::glds16_asm(WR + (size_t)e * 1024 + part * 256 + lane * 4, (unsigned)__builtin_amdgcn_readfirstlane((int)(unsigned)(unsigned long)dst)); }
    const f32x4* __restrict__ g0p = (const f32x4*)p.in[I_LN0G] + lane; const f32x4* __restrict__ b0p = (const f32x4*)p.in[I_LN0B] + lane;
    const f32x4* __restrict__ g1p = (const f32x4*)p.in[I_LN1G] + lane; const f32x4* __restrict__ b1p = (const f32x4*)p.in[I_LN1B] + lane;
    for (int grp = gw; grp < NTOK / 8; grp += NGW) {
        f32x4 hv[8][4];
        f32x4 cx[4], ca[4];
        { const int row = grp * 8; const f32x4* __restrict__ xr = (const f32x4*)(p.in[I_X] + (size_t)row * DM) + lane; const f32x4* __restrict__ ar = (const f32x4*)(Aout + (size_t)row * DM) + lane;
#pragma unroll
          for (int j = 0; j < 4; ++j) { cx[j] = xr[64 * j]; ca[j] = ar[64 * j]; } }
#pragma unroll
        for (int r = 0; r < 8; ++r) {
            const int row = grp * 8 + r;
            f32x4 nx[4], na[4], pg[4], pb[4], qg[4], qb[4];
#pragma unroll
            for (int j = 0; j < 4; ++j) { pg[j] = g0p[64 * j]; pb[j] = b0p[64 * j]; }
#pragma unroll
            for (int j = 0; j < 4; ++j) { qg[j] = g1p[64 * j]; qb[j] = b1p[64 * j]; }
            if (r < 7) { const f32x4* __restrict__ xr = (const f32x4*)(p.in[I_X] + (size_t)(row + 1) * DM) + lane; const f32x4* __restrict__ ar = (const f32x4*)(Aout + (size_t)(row + 1) * DM) + lane;
#pragma unroll
                for (int j = 0; j < 4; ++j) { nx[j] = xr[64 * j]; na[j] = ar[64 * j]; } }
            const float mu0 = st0[2 * row], rs0 = st0[2 * row + 1];
            float s = 0.f;
#pragma unroll
            for (int j = 0; j < 4; ++j) { const f32x4 h0 = (cx[j] - mu0) * rs0 * pg[j] + pb[j]; hv[r][j] = h0 * ALPHA + ca[j]; s += (hv[r][j].x + hv[r][j].y) + (hv[r][j].z + hv[r][j].w); }
            const float mean = wave_sum2(s) * (1.f / DM); float s2 = 0.f;
#pragma unroll
            for (int j = 0; j < 4; ++j) { hv[r][j] = hv[r][j] - mean; s2 += (hv[r][j].x * hv[r][j].x + hv[r][j].y * hv[r][j].y) + (hv[r][j].z * hv[r][j].z + hv[r][j].w * hv[r][j].w); }
            const float rstd = 1.f / sqrtf(wave_sum2(s2) * (1.f / DM) + LN_EPS);
            u32x2 wv[4];
#pragma unroll
            for (int j = 0; j < 4; ++j) { hv[r][j] = hv[r][j] * rstd * qg[j] + qb[j]; wv[j].x = pk2(hv[r][j].x, hv[r][j].y); wv[j].y = pk2(hv[r][j].z, hv[r][j].w); }
            u32x2* __restrict__ o8 = (u32x2*)(H1 + (size_t)row * DM) + lane;
#pragma unroll
            for (int j = 0; j < 4; ++j) o8[64 * j] = wv[j];
            if (r < 7) {
#pragma unroll
                for (int j = 0; j < 4; ++j) { cx[j] = nx[j]; ca[j] = na[j]; } }
        }
        if (grp == gw) { asm volatile("s_waitcnt vmcnt(0)" ::: "memory"); __syncthreads(); }
        const bool b3 = (lane >> 3) & 1;
#pragma unroll 4
        for (int e = 0; e < 36; ++e) {
            const lptr wb = (e < 4) ? (lds + P5_WB + e * 4096) : (lds + P5_WA + (e - 4) * 4096);
            const __attribute__((address_space(3))) f32x4* wr = (const __attribute__((address_space(3))) f32x4*)wb + lane;
            const f32x4 w0 = wr[0], w1 = wr[64], w2 = wr[128], w3 = wr[192];
            float part[8];
#pragma unroll
            for (int r = 0; r < 8; ++r) { const f32x4 t = hv[r][0] * w0 + hv[r][1] * w1 + hv[r][2] * w2 + hv[r][3] * w3; part[r] = (t.x + t.y) + (t.z + t.w); }
            float q[4], q2[2];
#pragma unroll
            for (int r = 0; r < 4; ++r) { auto sw = __builtin_amdgcn_permlane32_swap(__float_as_uint(part[r]), __float_as_uint(part[r + 4]), false, false); q[r] = __uint_as_float(sw[0]) + __uint_as_float(sw[1]); }
#pragma unroll
            for (int r = 0; r < 2; ++r) { auto sw = __builtin_amdgcn_permlane16_swap(__float_as_uint(q[r]), __float_as_uint(q[r + 2]), false, false); q2[r] = __uint_as_float(sw[0]) + __uint_as_float(sw[1]); }
            const float snd = b3 ? q2[0] : q2[1], kp = b3 ? q2[1] : q2[0];
            float q3 = kp + dppf<0x128>(snd);
            q3 += dppf<0xB1>(q3); q3 += dppf<0x4E>(q3); q3 += dppf<0x141>(q3);
            if ((lane & 7) == 0) lg[(lane >> 3) * 36 + e] = q3;
        }
        asm volatile("s_waitcnt lgkmcnt(0)" ::: "memory");
        __attribute__((address_space(3))) unsigned* lcnt = (__attribute__((address_space(3))) unsigned*)(lds + P5_LG + 8 * 8 * 36 * 4);
        if (threadIdx.x < 32) lcnt[threadIdx.x] = 0u;
        __syncthreads();
        int e0 = 0, e1 = 0; unsigned r0 = 0, r1 = 0; float w0 = 0.f, w1 = 0.f;
        if (lane < 8) {
            const __attribute__((address_space(3))) float* L = lg + lane * 36;
            float gl[4]; int gs = 0; float gm;
#pragma unroll
            for (int j = 0; j < 4; ++j) gl[j] = L[j] + p.in[I_BG][j];
            gm = gl[0];
#pragma unroll
            for (int j = 1; j < 4; ++j) if (gl[j] > gm) { gm = gl[j]; gs = j; }
            float den = 0.f;
#pragma unroll
            for (int j = 0; j < 4; ++j) den += expf(gl[j] - gm);
            const float gate = 1.0f / den;
            float v0 = -1e30f, v1 = -1e30f; int i0 = 0, i1 = 0;
#pragma unroll
            for (int j = 0; j < 8; ++j) { const float v = L[4 + gs * 8 + j] + p.in[I_BRT][gs * 8 + j];
                if (v > v0) { v1 = v0; i1 = i0; v0 = v; i0 = j; } else if (v > v1) { v1 = v; i1 = j; } }
            const float ex = expf(v1 - v0); w0 = gate / (1.f + ex); w1 = gate * ex / (1.f + ex);
            e0 = gs * 8 + i0; e1 = gs * 8 + i1;
            r0 = __hip_atomic_fetch_add(lcnt + e0, 1u, __ATOMIC_RELAXED, __HIP_MEMORY_SCOPE_WORKGROUP); r1 = __hip_atomic_fetch_add(lcnt + e1, 1u, __ATOMIC_RELAXED, __HIP_MEMORY_SCOPE_WORKGROUP);
        }
        __syncthreads();
        if (threadIdx.x < 32) { const unsigned c = lcnt[threadIdx.x]; lcnt[32 + threadIdx.x] = c ? atomicAdd(cnt + threadIdx.x * CNT_STRIDE, c) : 0u; }
        __syncthreads();
        if (lane < 8) {
            const int row = grp * 8 + lane;
            const unsigned p0 = lcnt[32 + e0] + r0, p1 = lcnt[32 + e1] + r1;
            list[e0 * NTOK + p0] = row; list[e1 * NTOK + p1] = row;
            int* ii = info + (size_t)row * 8; ii[0] = e0; ii[1] = (int)p0; ii[2] = __float_as_int(w0); ii[3] = e1; ii[4] = (int)p1; ii[5] = __float_as_int(w1);
        }
        asm volatile("s_waitcnt lgkmcnt(0)" ::: "memory");
    }
    __syncthreads();
}

struct LA_gather { const bf16_t* H; const int* tok; DI float operator()(int r, int k) const { return bf2f(H[(size_t)tok[r] * 1024 + k]); } };
struct EP_hid { bf16_t* HID; int slot0, nvalid, n0; DI void operator()(int r, int n, float v1, float v3) const { if (r < nvalid) { const float s = v1 / (1.0f + expf(-v1)); HID[(size_t)(slot0 + r) * 256 + n0 + n] = (bf16_t)f2bf(s * v3); } } };
struct EP_y { bf16_t* Y; int slot0, nvalid, n0; DI void operator()(int r, int n, float v, float) const { if (r < nvalid) Y[(size_t)(slot0 + r) * 1024 + n0 + n] = (bf16_t)f2bf(v); } };
DI void nmoe_phase(const Params& p, int which, float* ldsf, int bid, int nb) {
    float* As = ldsf; float* Bs = ldsf + 32 * 132; float* Bs2 = Bs + 32 * 68; int* s_tok = (int*)(Bs2 + 32 * 68); int* s_cnt = s_tok + 128; int* s_tpre = s_cnt + 32; int* s_base = s_tpre + 33;
    unsigned char* ws = p.ws; const unsigned* cnt = (const unsigned*)(ws + WS_CTL) + CW_CNT; const int* list = (const int*)(ws + WS_LIST);
    const int tid = threadIdx.x;
    if (tid == 0) { int tp = 0, bs = 0; for (int e = 0; e < 32; ++e) { const int c = (int)cnt[e * CNT_STRIDE]; s_cnt[e] = c; s_tpre[e] = tp; s_base[e] = bs; tp += (c + 127) >> 7; bs += (c + 255) & ~255; } s_tpre[32] = tp; s_base[32] = bs; }
    __syncthreads();
    const int NT = which == 0 ? 4 : 16, total = s_tpre[32] * NT;
    for (int u = bid; u < total; u += nb) {
        const int T = u / NT, nt = u % NT; int e = 0; while (s_tpre[e + 1] <= T) ++e;
        const int mt = T - s_tpre[e], nvalid = min(128, s_cnt[e] - mt * 128), slot0 = s_base[e] + mt * 128;
        if (which == 0) {
            __syncthreads();
            if (tid < 128) s_tok[tid] = (tid < nvalid) ? list[e * NTOK + mt * 128 + tid] : 0;
            __syncthreads();
            const int j0 = nt * 64;
            const int r1 = e * 512 + (j0 >> 7) * 256 + (j0 & 127);
            LA_gather la{(const bf16_t*)(ws + WS_XN), s_tok}; LB_bf lb{(const bf16_t*)(ws + WS_W13T) + (size_t)r1 * 1024, 1024}; LB_bf lb2{(const bf16_t*)(ws + WS_W13T) + (size_t)(r1 + 128) * 1024, 1024};
            EP_hid ep{(bf16_t*)(ws + WS_OB), slot0, nvalid, j0};
            ngemm_tile<true, false>(As, Bs, Bs2, 1024, la, lb, lb2, ep);
        } else {
            LA_bf la{(const bf16_t*)(ws + WS_OB) + (size_t)slot0 * 256, 256}; LB_bf lb{(const bf16_t*)(ws + WS_W2T) + (size_t)(e * 1024 + nt * 64) * 256, 256};
            EP_y ep{(bf16_t*)(ws + WS_Y), slot0, nvalid, nt * 64};
            ngemm_tile<false, false>(As, Bs, Bs, 256, la, lb, lb, ep);
        }
    }
}

DI void p7_final(const Params& p, int gw, int NGW, int lane) {
    unsigned char* ws = p.ws; const unsigned* cnt = (const unsigned*)(ws + WS_CTL) + CW_CNT; const int* info = (const int*)(ws + WS_TOKINFO);
    const bf16_t* H1 = (const bf16_t*)(ws + WS_XN); const bf16_t* Y = (const bf16_t*)(ws + WS_Y);
    int base;
    { const int c = lane < 32 ? (int)cnt[lane * CNT_STRIDE] : 0; const int r = (c + 255) & ~255; int inc = r;
#pragma unroll
      for (int o = 1; o < 32; o <<= 1) { const int t = __shfl_up(inc, o); if ((lane & 31) >= o) inc += t; }
      base = inc - r; }
    for (int row = gw; row < NTOK; row += NGW) {
        const int* ii = info + (size_t)row * 8;
        const int e0 = ii[0], p0 = ii[1], e1 = ii[3], p1 = ii[4]; const float w0 = __int_as_float(ii[2]), w1 = __int_as_float(ii[5]);
        const size_t s0 = (size_t)(__shfl(base, e0) + p0), s1 = (size_t)(__shfl(base, e1) + p1);
        const u32x2* h8 = (const u32x2*)(H1 + (size_t)row * DM) + lane; const u32x2* y0 = (const u32x2*)(Y + s0 * DM) + lane; const u32x2* y1 = (const u32x2*)(Y + s1 * DM) + lane;
        f32x4 v[4]; float s = 0.f;
#pragma unroll
        for (int j = 0; j < 4; ++j) { const u32x2 a = h8[64 * j], b = y0[64 * j], c = y1[64 * j];
            v[j].x = ALPHA * __uint_as_float(a.x << 16) + w0 * __uint_as_float(b.x << 16) + w1 * __uint_as_float(c.x << 16);
            v[j].y = ALPHA * __uint_as_float(a.x & 0xffff0000u) + w0 * __uint_as_float(b.x & 0xffff0000u) + w1 * __uint_as_float(c.x & 0xffff0000u);
            v[j].z = ALPHA * __uint_as_float(a.y << 16) + w0 * __uint_as_float(b.y << 16) + w1 * __uint_as_float(c.y << 16);
            v[j].w = ALPHA * __uint_as_float(a.y & 0xffff0000u) + w0 * __uint_as_float(b.y & 0xffff0000u) + w1 * __uint_as_float(c.y & 0xffff0000u);
            s += (v[j].x + v[j].y) + (v[j].z + v[j].w); }
        const float mean = wave_sum(s) * (1.f / DM); float s2 = 0.f;
#pragma unroll
        for (int j = 0; j < 4; ++j) { v[j] = v[j] - mean; s2 += (v[j].x * v[j].x + v[j].y * v[j].y) + (v[j].z * v[j].z + v[j].w * v[j].w); }
        const float rstd = 1.f / sqrtf(wave_sum(s2) * (1.f / DM) + LN_EPS);
        f32x4* o = (f32x4*)(p.out + (size_t)row * DM) + lane;
#pragma unroll
        for (int j = 0; j < 4; ++j) { const f32x4 g = ((const f32x4*)p.in[I_LN2G])[lane + 64 * j], bb = ((const f32x4*)p.in[I_LN2B])[lane + 64 * j]; o[64 * j] = v[j] * rstd * g + bb; }
    }
}


#define LAS __attribute__((address_space(3)))
#define XB_TMO      128
#define XB_XCNT(j)  (256  + 64 * (j))
#define XB_XSUB(j)  (1280 + 64 * (j))
#define XB_XGEN(j)  (2304 + 64 * (j))
#define XB_TOP      3328
#define XB_TOPGEN   3392
#define XCD_BAR_WORDS 3456
#define XB_SPIN_CAP (1u << 18)

__device__ __forceinline__ unsigned xb_ld(unsigned* p)              { return __hip_atomic_load(p, __ATOMIC_RELAXED, __HIP_MEMORY_SCOPE_AGENT); }
__device__ __forceinline__ unsigned xb_add(unsigned* p, unsigned v) { return __hip_atomic_fetch_add(p, v, __ATOMIC_RELAXED, __HIP_MEMORY_SCOPE_AGENT); }
__device__ __forceinline__ unsigned xb_xcc_id() { return (unsigned)__builtin_amdgcn_s_getreg((3 << 11) | 20) & 0xFu; }
#define XB_SPIN(cond, bar) do { unsigned _sp = 0; while (cond) { __builtin_amdgcn_s_sleep(1); \
    if ((++_sp & 255u) == 0u) { if (xb_ld(&(bar)[XB_TMO])) break; if (_sp > XB_SPIN_CAP) { atomicAdd(&(bar)[XB_TMO], 1u); break; } } } } while (0)

struct XcdBarrier {
    unsigned* bar; unsigned x;
    volatile LAS unsigned* st;
};

__device__ __forceinline__ XcdBarrier xcd_barrier_post(unsigned* bar, volatile LAS unsigned* st) {
    XcdBarrier b; b.bar = bar; b.x = xb_xcc_id(); b.st = st;
    if (threadIdx.x == 0) (void)xb_add(&bar[XB_XCNT(b.x)], 1u);
    return b;
}
__device__ __forceinline__ void xcd_barrier_complete(unsigned* bar, unsigned x, unsigned& nloc, unsigned& nx) {
    const unsigned G = gridDim.x * gridDim.y * gridDim.z;
    unsigned sum, cnt, mine, sp = 0u;
    for (;;) {
        sum = 0u; cnt = 0u; mine = 0u;
#pragma unroll
        for (unsigned j = 0; j < 16; ++j) { const unsigned c = xb_ld(&bar[XB_XCNT(j)]); sum += c; cnt += (c > 0u) ? 1u : 0u; mine = (j == x) ? c : mine; }
        if (sum == G) break;
        __builtin_amdgcn_s_sleep(1);
        if ((++sp & 255u) == 0u) { if (xb_ld(&bar[XB_TMO])) break; if (sp > XB_SPIN_CAP) { atomicAdd(&bar[XB_TMO], 1u); break; } }
    }
    nloc = mine > 0u ? mine : 1u; nx = cnt > 0u ? cnt : 1u;
}

__device__ __forceinline__ void xcd_barrier(const XcdBarrier& b) {
    asm volatile("s_waitcnt vmcnt(0)" ::: "memory");
    __syncthreads();
    if (threadIdx.x == 0) {
        unsigned* bar = b.bar;
        __builtin_amdgcn_s_waitcnt(0);
        unsigned nloc = b.st[0], nx = b.st[1];
        if (nloc == 0u) { xcd_barrier_complete(bar, b.x, nloc, nx); b.st[0] = nloc; b.st[1] = nx; }
        const unsigned old = xb_add(&bar[XB_XSUB(b.x)], 1u);
        const unsigned gen = old / nloc;
        if (old + 1u == (gen + 1u) * nloc) {
            __builtin_amdgcn_fence(__ATOMIC_RELEASE, "agent");
            asm volatile("s_waitcnt vmcnt(0)" ::: "memory");
            const unsigned og = xb_add(&bar[XB_TOP], 1u);
            const unsigned tg = og / nx;
            if (og + 1u == (tg + 1u) * nx) xb_add(&bar[XB_TOPGEN], 1u);
            else XB_SPIN(xb_ld(&bar[XB_TOPGEN]) == tg, bar);
            __builtin_amdgcn_fence(__ATOMIC_ACQUIRE, "agent");
            xb_add(&bar[XB_XGEN(b.x)], 1u);
            asm volatile("s_waitcnt vmcnt(0)" ::: "memory");
        } else {
            XB_SPIN(xb_ld(&bar[XB_XGEN(b.x)]) == gen, bar);
            __builtin_amdgcn_fence(__ATOMIC_ACQUIRE, "agent");
            asm volatile("s_waitcnt vmcnt(0)" ::: "memory");
        }
    }
    __syncthreads();
}


namespace fft {
using att::bf16x8; using att::s16x4; using att::f32x16; using att::vtr; using att::cvtpk;
constexpr int XP = 1088, XOFF = 0, FOFF = 64 * XP;
template <int STAGE>
DI void fft_unit(ALAS unsigned char* lds, const Params& p, int unit, int wid, int lane) {
    constexpr int M = STAGE == 1 ? 128 : 64, MT = M / 32, CH = M * 16;
    unsigned char* ws = p.ws;
    const int tid = threadIdx.x, r32 = lane & 31, hi = lane >> 5;
    const int b = unit >> 6, u6 = unit & 63;
    __syncthreads();
    for (int idx = tid; idx < M * 128; idx += 512) {
        const int k = idx & 127, row = idx >> 7, part = k >> 6, kk = k & 63, rr = row & 63;
        const float ang = (float)((kk * rr) & 63) * (1.0f / 32.0f); const float c = cospif(ang), sn = sinpif(ang);
        float v;
        if (STAGE == 1) v = (row < 64) ? (part == 0 ? c : -sn) : (part == 0 ? -sn : -c);
        else v = part == 0 ? c : sn;
        *(ALAS bf16_t*)(lds + FOFF + (k >> 3) * CH + row * 16 + (k & 7) * 2) = (bf16_t)f2bf(v);
    }
    const bf16_t* src = STAGE == 1 ? (const bf16_t*)(ws + WS_ZB) + ((size_t)b * SEQ + u6) * 512 : (const bf16_t*)(ws + WS_ZS1) + ((size_t)(b * 64 + u6) * 64) * 512;
    const size_t rstride = STAGE == 1 ? (size_t)64 * 512 : (size_t)512;
#pragma unroll
    for (int i = 0; i < 8; ++i) { const int row = wid + 8 * i;
        __builtin_amdgcn_global_load_lds((const unsigned*)(src + row * rstride + lane * 8), (ALAS unsigned*)(lds + XOFF + row * XP), 16, 0, 0); }
    asm volatile("s_waitcnt vmcnt(0)" ::: "memory");
    __syncthreads();
    f32x16 acc[MT];
#pragma unroll
    for (int mt = 0; mt < MT; ++mt)
#pragma unroll
        for (int r = 0; r < 16; ++r) acc[mt][r] = 0.f;
    const ALAS unsigned char* xb = lds + XOFF + (8 * hi + ((lane & 15) >> 2)) * XP + (32 * wid + 16 * ((lane >> 4) & 1) + 4 * (lane & 3)) * 2;
    const ALAS unsigned char* fb = lds + FOFF + hi * CH + r32 * 16;
#pragma unroll
    for (int ks = 0; ks < 8; ++ks) {
        const ALAS unsigned char* bp = xb + (16 * (ks & 3)) * XP + (ks >> 2) * 512;
        const s16x4 lo = vtr(bp), hh = vtr(bp + 4 * XP);
        const bf16x8 bfr = __builtin_shufflevector(lo, hh, 0, 1, 2, 3, 4, 5, 6, 7);
#pragma unroll
        for (int mt = 0; mt < MT; ++mt) { const bf16x8 afr = *(const ALAS bf16x8*)(fb + (2 * ks) * CH + mt * 512); acc[mt] = ATT_MFMA(afr, bfr, acc[mt]); }
    }
    __syncthreads();
    const int col = 32 * wid + r32;
    if (STAGE == 1) {
#pragma unroll
        for (int mt = 0; mt < 2; ++mt)
#pragma unroll
            for (int r = 0; r < 16; ++r) { const int s1p = 32 * mt + (r & 3) + 8 * (r >> 2) + 4 * hi;
                const float x = (float)((s1p * u6) & 4095) * (1.0f / 4096.0f); const float ct = __builtin_amdgcn_cosf(x), st = __builtin_amdgcn_sinf(x);
                const float yr = acc[mt][r], yi = acc[mt + 2][r];
                *(ALAS bf16_t*)(lds + XOFF + s1p * 1024 + col * 2) = (bf16_t)f2bf(yr * ct + yi * st);
                *(ALAS bf16_t*)(lds + XOFF + s1p * 1024 + 512 + col * 2) = (bf16_t)f2bf(yi * ct - yr * st); }
        __syncthreads();
        bf16_t* dst = (bf16_t*)(ws + WS_ZS1);
#pragma unroll
        for (int i = 0; i < 8; ++i) { const int row = i * 8 + (tid >> 6), ch = tid & 63;
            const u32x4 v = *(const ALAS u32x4*)(lds + XOFF + row * 1024 + ch * 16);
            *(u32x4*)(dst + ((size_t)(b * 64 + row) * 64 + u6) * 512 + ch * 8) = v; }
    } else {
#pragma unroll
        for (int mt = 0; mt < 2; ++mt)
#pragma unroll
            for (int r = 0; r < 16; ++r) { const int s2p = 32 * mt + (r & 3) + 8 * (r >> 2) + 4 * hi;
                *(ALAS bf16_t*)(lds + XOFF + s2p * 512 + col * 2) = (bf16_t)f2bf(acc[mt][r]); }
        __syncthreads();
        bf16_t* dst = (bf16_t*)(ws + WS_OB);
#pragma unroll
        for (int i = 0; i < 4; ++i) { const int row = i * 16 + (tid >> 5), ch = tid & 31;
            const u32x4 v = *(const ALAS u32x4*)(lds + XOFF + row * 512 + ch * 16);
            *(u32x4*)(dst + ((size_t)b * SEQ + u6 + 64 * row) * 1024 + 512 + ch * 8) = v; }
    }
    __syncthreads();
}
}

constexpr int LDS_BYTES = 163840;
constexpr int LDSCTL_OFF = 131072, MISC_OFF = LDSCTL_OFF + 320;
constexpr int CW_BAR = 4096;
struct Args { Params p; int ph_lo, ph_hi; };
__global__ void __launch_bounds__(512, 2) mk_fwd(Args a) {
    extern __shared__ __attribute__((aligned(16))) unsigned char smem[];
    LAS unsigned char* lds = (LAS unsigned char*)smem;
    const int tid = threadIdx.x, lane = tid & 63, wave = __builtin_amdgcn_readfirstlane(tid >> 6);
    const int G = gridDim.x, bx = blockIdx.x, vcu = (G % 8 == 0) ? (bx % 8) * (G / 8) + bx / 8 : bx;
    const int lo = a.ph_lo, hi = a.ph_hi;
    unsigned char* ws = a.p.ws;
    volatile LAS unsigned* MISC = (volatile LAS unsigned*)(lds + MISC_OFF);
    for (int u = tid; u < (LDS_BYTES - LDSCTL_OFF) / 4; u += 512) ((LAS unsigned*)(lds + LDSCTL_OFF))[u] = 0u;
    __syncthreads();
    XcdBarrier bar = xcd_barrier_post((unsigned*)(ws + WS_CTL) + CW_BAR, MISC + 8);
#ifndef PHMASK
#define PHMASK 0xffff
#endif
#define IN(k) (((PHMASK >> (k)) & 1) && lo <= (k) && (k) < hi)
#define SEAM(k) do { if (IN(k) && IN((k) + 1)) xcd_barrier(bar); } while (0)
#ifndef REPMASK
#define REPMASK 0
#endif
    int one_ = 1; asm volatile("" : "+s"(one_));
#define REP(k) _Pragma("unroll 1") for (int rep_ = 0; rep_ < (((REPMASK >> (k)) & 1) ? one_ + 1 : 1); ++rep_)
    int kDM = DM, kDE = DEXP; asm volatile("" : "+s"(kDM), "+s"(kDE));
    if (IN(0)) REP(0) { p0_prologue(a.p, (float*)smem, vcu * 8 + wave, G * 8, wave, lane); }
    SEAM(0);
    if (IN(1)) REP(1) {
        { pg8::Gemm g{(const bf16_t*)(ws + WS_XN), (const bf16_t*)(ws + WS_WINT), NTOK, NIN, kDM}; pg8::StaticOrder S; S.init(NTOK, NIN, G, bx);
          pg8::EpiInproj E{ws}; pg8::gemm_phase<pg8::EpiInproj, pg8::StaticOrder, true, true>(lds, g, S, E); }
        { pg8::Gemm g{(const bf16_t*)(ws + WS_MEMB), (const bf16_t*)(ws + WS_WMT), NB * MEMLEN, 512, kDM}; pg8::StaticOrder S; S.init(NB * MEMLEN, 512, G, bx);
          pg8::EpiBf16Plain E{(bf16_t*)(ws + WS_MKV), 512}; pg8::gemm_phase<pg8::EpiBf16Plain, pg8::StaticOrder, true, true>(lds, g, S, E); }
    }
    SEAM(1);
    if (IN(2)) REP(2) { kmax_phase(a.p, vcu * 8 + wave, G * 8, lane); for (int u = vcu; u < 256; u += G) fft::fft_unit<1>(lds, a.p, u, wave, lane); }
    SEAM(2);
    if (IN(3)) REP(3) {
        for (int u = vcu; u < 256; u += G) {
            const unsigned* ctl = (const unsigned*)(ws + WS_CTL); const int bh2 = (u >> 4) * 2; const float* rb = a.p.in[I_RELB];
            float babs = 0.f; for (int i = 0; i < 32; ++i) babs = fmaxf(babs, fabsf(rb[i * 4 + ((u >> 4) & 3)]));
            const float cs = sqrtf(fmaxf(__uint_as_float(ctl[CW_QMAX + bh2]) * __uint_as_float(ctl[CW_KMAX + bh2]), __uint_as_float(ctl[CW_QMAX + bh2 + 1]) * __uint_as_float(ctl[CW_KMAX + bh2 + 1]))) + 2.f * babs * LOG2E;
            int lane_u = lane; asm volatile("" : "+v"(lane_u));
            if (cs < 100.f) att::attn_pipe(lds, a.p, u, wave, lane_u);
            else att::attn_unit<128, true>(lds, a.p, u, wave, lane_u);
        }
        { int lane_b = lane; asm volatile("" : "+v"(lane_b)); for (int u = vcu; u < 256; u += G) att::attn_unit<64, false>(lds, a.p, u, wave, lane_b); }
        { int lane_c = lane; asm volatile("" : "+v"(lane_c)); for (int u = vcu; u < 256; u += G) fft::fft_unit<2>(lds, a.p, u, wave, lane_c); }
    }
    SEAM(3);
    if (IN(4)) REP(4) {
        pg8::Gemm g{(const bf16_t*)(ws + WS_OB), (const bf16_t*)(ws + WS_WOT), NTOK, DM, kDM}; pg8::StaticOrder S; S.init(NTOK, DM, G, bx);
        pg8::EpiF32Plain E{(float*)(ws + WS_AOUT), DM}; pg8::gemm_phase<pg8::EpiF32Plain, pg8::StaticOrder, true, true>(lds, g, S, E);
    }
    SEAM(4);
    if (IN(5)) { p4_ln1_router(a.p, lds, vcu * 8 + wave, G * 8, wave, lane); }
    SEAM(5);
    LAS int* mtab = (LAS int*)(lds + LDSCTL_OFF + 1024);
    if (IN(6) || IN(7)) {
        if (tid == 0) { const unsigned* cnt = (const unsigned*)(ws + WS_CTL) + CW_CNT; int tp = 0;
            for (int e = 0; e < 32; ++e) { const int c = (int)cnt[e * CNT_STRIDE]; mtab[e] = tp; mtab[33 + e] = c; tp += (c + 255) >> 8; } mtab[32] = tp; }
        __syncthreads();
    }
    if (IN(6)) REP(6) {
        pg8::Gemm g{(const bf16_t*)(ws + WS_XN), (const bf16_t*)(ws + WS_W13T), 0, 0, kDM}; pg8::MoeOrder S{mtab, (const int*)(ws + WS_LIST), G, bx, 1};
        pg8::EpiSwiglu E{(bf16_t*)(ws + WS_OB)}; pg8::gemm_phase<pg8::EpiSwiglu, pg8::MoeOrder, true, true, true>(lds, g, S, E);
    }
    SEAM(6);
    if (IN(7)) REP(7) {
        pg8::Gemm g{(const bf16_t*)(ws + WS_OB), (const bf16_t*)(ws + WS_W2T), 0, 0, kDE}; pg8::MoeOrder S{mtab, (const int*)(ws + WS_LIST), G, bx, 2};
        pg8::EpiDown E{(bf16_t*)(ws + WS_Y)}; pg8::gemm_phase<pg8::EpiDown, pg8::MoeOrder, true, true, false>(lds, g, S, E);
    }
    SEAM(7);
    if (IN(8)) REP(8) { p7_final(a.p, vcu * 8 + wave, G * 8, lane); }
#undef IN
#undef SEAM
}

#ifndef N_LAUNCH_SPLIT
#define N_LAUNCH_SPLIT 0
#endif
extern "C" void kernel_launch(void* const* d_in, const int* in_sizes, int n_in, void* d_out, int out_size, void* d_ws, size_t ws_size, hipStream_t stream) {
    Params p{};
    for (int i = 0; i < 25; ++i) p.in[i] = (const float*)d_in[i];
    p.out = (float*)d_out; p.ws = (unsigned char*)d_ws;
    static int grid = 0;
    if (!grid) {
        (void)hipFuncSetAttribute((const void*)mk_fwd, hipFuncAttributeMaxDynamicSharedMemorySize, LDS_BYTES);
        int dev = 0, cus = 0, per_cu = 0;
        (void)hipGetDevice(&dev); (void)hipDeviceGetAttribute(&cus, hipDeviceAttributeMultiprocessorCount, dev);
        (void)hipOccupancyMaxActiveBlocksPerMultiprocessor(&per_cu, (const void*)mk_fwd, 512, LDS_BYTES);
        if (per_cu < 1) per_cu = 1;
        grid = cus * 1;
        if (grid > 256) grid = 256;
        (void)hipGetLastError();
    }
    (void)hipMemsetAsync((char*)d_ws + WS_CTL, 0, CTL_BYTES, stream);
    Args a{}; a.p = p;
#if N_LAUNCH_SPLIT
    for (int k = 0; k < 9; ++k) { a.ph_lo = k; a.ph_hi = k + 1; hipLaunchKernelGGL(mk_fwd, dim3(grid), dim3(512), LDS_BYTES, stream, a); }
#else
    a.ph_lo = 0; a.ph_hi = 9;
    void* kargs[] = {&a};
    (void)hipLaunchCooperativeKernel((const void*)mk_fwd, dim3(grid), dim3(512), kargs, LDS_BYTES, stream);
#ifdef PROBE_PHASE
    a.ph_lo = PROBE_PHASE; a.ph_hi = PROBE_PHASE + 1;
    hipLaunchKernelGGL(mk_fwd, dim3(grid), dim3(512), LDS_BYTES, stream, a);
#endif
#endif
}
```

```cpp
#include <hip/hip_runtime.h>
#include <stdint.h>

#define DI __device__ __forceinline__
typedef unsigned short bf16_t;
typedef float f32x4 __attribute__((ext_vector_type(4)));
typedef unsigned u32x4 __attribute__((ext_vector_type(4)));
typedef unsigned u32x2 __attribute__((ext_vector_type(2)));

constexpr int NB = 4, SEQ = 4096, DM = 1024, NTOK = NB * SEQ;
constexpr int NEXP = 32, DEXP = 256, MEMLEN = 256;
constexpr int NIN = 2048;
constexpr float LOG2E = 1.4426950408889634f;
constexpr float C2 = 0.125f * LOG2E;
constexpr float ALPHA = 1.189207115002721f;
constexpr float LN_EPS = 1e-5f;
constexpr float LAM_INIT = 0.2f;

constexpr size_t MiB = 1u << 20;
constexpr size_t WS_CTL = 0, CTL_BYTES = 1 * MiB;
constexpr size_t WS_WINT = 1 * MiB;
constexpr size_t WS_WOT = 6 * MiB;
constexpr size_t WS_WMT = 8 * MiB;
constexpr size_t WS_MEMB = 9 * MiB;
constexpr size_t WS_WR = 11 * MiB;
constexpr size_t WS_COSTAB = 11 * MiB + 256 * 1024;
constexpr size_t WS_F1L = 11 * MiB + 288 * 1024;
constexpr size_t WS_F2L = 11 * MiB + 320 * 1024;
constexpr size_t WS_GT = 11 * MiB + 352 * 1024;
constexpr size_t WS_STATS0 = 11 * MiB + 512 * 1024;
constexpr size_t WS_MKV = 12 * MiB;
constexpr size_t WS_TOKINFO = 13 * MiB;
constexpr size_t WS_LIST = 14 * MiB;
constexpr size_t WS_W13T = 16 * MiB;
constexpr size_t WS_W2T = 48 * MiB;
constexpr size_t WS_XN = 64 * MiB;
constexpr size_t WS_OB = 96 * MiB;
constexpr size_t WS_QB = 128 * MiB, WS_KB = 144 * MiB, WS_VB = 160 * MiB, WS_MQB = 176 * MiB, WS_ZB = 184 * MiB;
constexpr size_t WS_AOUT = 128 * MiB;
constexpr size_t WS_Y = 128 * MiB;
constexpr int CW_CNT = 8192, CNT_STRIDE = 64;

struct Params {
    const float* in[25];
    float* out;
    unsigned char* ws;
};
enum { I_X = 0, I_MEM, I_LN0G, I_LN0B, I_RELB, I_WIN, I_WMKV, I_WF, I_LQ1, I_LK1, I_LQ2, I_LK2, I_SUBG, I_WOUT, I_LN1G, I_LN1B,
       I_WG, I_BG, I_WRT, I_BRT, I_W1, I_W3, I_W2, I_LN2G, I_LN2B };

DI float bf2f(bf16_t v) { return __uint_as_float(((unsigned)v) << 16); }
DI unsigned f2bf(float f) { unsigned u = __float_as_uint(f); return (u + 0x7fffu + ((u >> 16) & 1u)) >> 16; }
DI unsigned pk2(float lo, float hi) { return f2bf(lo) | (f2bf(hi) << 16); }
DI float wave_sum(float v) {
#pragma unroll
    for (int o = 1; o < 64; o <<= 1) v += __shfl_xor(v, o);
    return v;
}
template <int CTRL> DI float dppf(float v) { return __int_as_float(__builtin_amdgcn_update_dpp(0, __float_as_int(v), CTRL, 0xF, 0xF, true)); }
DI float wave_sum2(float v) {
    v += dppf<0xB1>(v); v += dppf<0x4E>(v); v += dppf<0x141>(v); v += dppf<0x140>(v);
    { auto s = __builtin_amdgcn_permlane16_swap(__float_as_uint(v), __float_as_uint(v), false, false); v = __uint_as_float(s[0]) + __uint_as_float(s[1]); }
    { auto s = __builtin_amdgcn_permlane32_swap(__float_as_uint(v), __float_as_uint(v), false, false); v = __uint_as_float(s[0]) + __uint_as_float(s[1]); }
    return v;
}
DI int t5_bucket(int rel) {
    const int n = rel < 0 ? -rel : rel;
    int b;
    if (n < 8) b = n; else if (n < 12) b = 8; else if (n < 16) b = 9; else if (n < 23) b = 10; else if (n < 32) b = 11;
    else if (n < 46) b = 12; else if (n < 64) b = 13; else if (n < 91) b = 14; else b = 15;
    return b + (rel > 0 ? 16 : 0);
}


namespace pg8 {
#define PG8_LAS __attribute__((address_space(3)))
typedef unsigned short bf16_t;
typedef short bf16x8 __attribute__((ext_vector_type(8)));
typedef float f32x4 __attribute__((ext_vector_type(4)));
typedef unsigned u32x4 __attribute__((ext_vector_type(4)));
constexpr int BM = 256, BK = 64, HALF = 128, HTB = HALF * BK * 2  , STAGE_BYTES = 8 * HTB, NXCD = 8, WGM = 8;

__host__ __device__ __forceinline__ int lds_byte(int r, int c) { const int st = (r >> 4) * 2 + (c >> 5), rr = r & 15, cc = c & 31, ob = rr * 64 + cc * 2; return st * 1024 + (ob ^ (((ob >> 9) & 1) << 5)); }
__host__ __device__ __forceinline__ void stage_rc(int b, int& R, int& C) { const int st = b / 1024, sb = b % 1024, swz = sb ^ (((sb >> 9) & 1) << 5); R = (st >> 1) * 16 + swz / 64; C = (st & 1) * 32 + (swz % 64) / 2; }
__host__ __device__ __forceinline__ int perm32(int rho) { const int n = rho >> 4, i = rho & 15; return 8 * (i >> 2) + 4 * n + (i & 3); }

struct Unit { int pm, pn; };
struct Gemm { const bf16_t* A; const bf16_t* Bt; int M, N, K; };

struct StaticOrder {
    int nM, nN, nwg, G, c;
    __host__ __device__ void init(int M, int N, int G_, int c_) { nM = M / BM; nN = N / BM; nwg = nM * nN; G = G_; c = c_; }
    __host__ __device__ bool next(int i, Unit& u) const {
        const long L = (long)i * G + c; if (L >= nwg) return false;
        int wgid = (int)L; { const int q = nwg / NXCD, r = nwg % NXCD, xcd = wgid % NXCD, off = wgid / NXCD; wgid = (xcd < r ? xcd * (q + 1) : r * (q + 1) + (xcd - r) * q) + off; }
        const int nig = WGM * nN, gid = wgid / nig, fm = gid * WGM, gsz = (nM - fm) < WGM ? (nM - fm) : WGM;
        u.pm = fm + ((wgid % nig) % gsz); u.pn = (wgid % nig) / gsz; return true;
    }
    __device__ __forceinline__ void a_ready(const Unit&) const {}
    __device__ __forceinline__ void done(const Unit&) const {}
};

__device__ __forceinline__ unsigned cvt_pk_bf16(float lo, float hi) { unsigned r; asm volatile("v_cvt_pk_bf16_f32 %0, %1, %2" : "=v"(r) : "v"(lo), "v"(hi)); return r; }
typedef float f32x2 __attribute__((ext_vector_type(2)));
__device__ __forceinline__ f32x2 gelu_pk(f32x2 v) {
    const f32x2 av = __builtin_elementwise_abs(v), d = av * 0.2316418882f + 1.0f;
    f32x2 t; t.x = __builtin_amdgcn_rcpf(d.x); t.y = __builtin_amdgcn_rcpf(d.y);
    f32x2 q = t * 0.5307027145f + (-0.7265760135f); q = q * t + 0.7107068705f; q = q * t + (-0.142248368f); q = q * t + 0.127414796f; q = q * t;
    const f32x2 s = (v * v) * (-0.72134752044f);
    f32x2 e; e.x = __builtin_amdgcn_exp2f(s.x); e.y = __builtin_amdgcn_exp2f(s.y);
    const f32x2 m = v * (q * e), r = v - m;
    f32x2 o; o.x = v.x < 0.f ? m.x : r.x; o.y = v.y < 0.f ? m.y : r.y; return o;
}

template <int ACT  > struct EpiBf16 {
    static constexpr bool PERM = true, AFTER_DRAIN = false; static_assert(ACT == 0 || ACT == 1, "EpiBf16: ACT is 0 (none) or 1 (gelu_pk)");
    bf16_t* O; int ldc; const float* bias; int split_cols; size_t split_stride; float scale0;
    __device__ __forceinline__ void operator()(const f32x4 (&acc)[2][2][4][2], const Unit& u, int wr, int wc, int fr, int fq) const {
        const int row0 = u.pm * BM + wr * 64 + fr; int colt = u.pn * BM; bf16_t* base = O;
        float sc = 1.f; if (split_cols) { const int t = colt / split_cols; base += (size_t)t * split_stride; colt -= t * split_cols; if (t == 0) sc = scale0; }
        const int col0 = colt + wc * 32 + 8 * fq, bcol0 = u.pn * BM + wc * 32 + 8 * fq;
        f32x4 bv[2][2];
#pragma unroll
        for (int bj = 0; bj < 2; ++bj)
#pragma unroll
            for (int n = 0; n < 2; ++n) bv[bj][n] = bias ? *(const f32x4*)(bias + bcol0 + bj * HALF + 4 * n) : (f32x4){0.f, 0.f, 0.f, 0.f};
#pragma unroll
        for (int ai = 0; ai < 2; ++ai)
#pragma unroll
            for (int m = 0; m < 4; ++m) { bf16_t* rowp = base + (size_t)(row0 + ai * HALF + m * 16) * ldc + col0;
#pragma unroll
                for (int bj = 0; bj < 2; ++bj) { f32x4 v0 = acc[ai][bj][m][0] + bv[bj][0], v1 = acc[ai][bj][m][1] + bv[bj][1];
                    if (ACT == 1) { f32x2 a = gelu_pk((f32x2){v0[0], v0[1]}), b = gelu_pk((f32x2){v0[2], v0[3]}), c = gelu_pk((f32x2){v1[0], v1[1]}), d = gelu_pk((f32x2){v1[2], v1[3]});
                        v0 = (f32x4){a.x, a.y, b.x, b.y}; v1 = (f32x4){c.x, c.y, d.x, d.y}; }
                    v0 = v0 * sc; v1 = v1 * sc; u32x4 w; w.x = cvt_pk_bf16(v0[0], v0[1]); w.y = cvt_pk_bf16(v0[2], v0[3]); w.z = cvt_pk_bf16(v1[0], v1[1]); w.w = cvt_pk_bf16(v1[2], v1[3]);
                    *(u32x4*)(rowp + bj * HALF) = w; } }
    }
};

struct PanelStats {
    unsigned* xbuf;
    unsigned* cnt;
    unsigned* tmo;
    int ntn; float eps;
    unsigned code;
    __device__ __forceinline__ bool run(const f32x4 (&v)[2][2][4][2], const Unit& u, int wr, int wc, int fr, int fq, PG8_LAS unsigned char* lds, int wid, int lane) const {
        typedef float f32x2v __attribute__((ext_vector_type(2)));
        PG8_LAS f32x2v* P = (PG8_LAS f32x2v*)lds;
        PG8_LAS f32x2v* S = (PG8_LAS f32x2v*)(lds + 8192);
        PG8_LAS unsigned* flag = (PG8_LAS unsigned*)(lds + 8192 + 2048);
#pragma unroll
        for (int ai = 0; ai < 2; ++ai)
#pragma unroll
            for (int m = 0; m < 4; ++m) {
                float s = 0.f;
#pragma unroll
                for (int bj = 0; bj < 2; ++bj)
#pragma unroll
                    for (int n = 0; n < 2; ++n) { const f32x4 x = v[ai][bj][m][n]; s += (x[0] + x[1]) + (x[2] + x[3]); }
                s += __shfl_xor(s, 16); s += __shfl_xor(s, 32);
                const float mw = s * (1.0f / 64.0f); float q = 0.f;
#pragma unroll
                for (int bj = 0; bj < 2; ++bj)
#pragma unroll
                    for (int n = 0; n < 2; ++n) { const f32x4 d = v[ai][bj][m][n] - mw; q += (d[0] * d[0] + d[1] * d[1]) + (d[2] * d[2] + d[3] * d[3]); }
                q += __shfl_xor(q, 16); q += __shfl_xor(q, 32);
                if (fq == 0) P[(ai * HALF + wr * 64 + m * 16 + fr) * 4 + wc] = (f32x2v){mw, q};
            }
        asm volatile("s_waitcnt lgkmcnt(0)" ::: "memory"); __builtin_amdgcn_s_barrier(); asm volatile("" ::: "memory");
#if defined(BROKEN_EXCHANGE_NO_WAIT)
#warning BROKEN CONTROL BUILD: the row-statistics exchange does not wait; results are wrong by design
        if (blockIdx.x >= 64) { const long long t0_ = clock64(); while (clock64() - t0_ < 60000) __builtin_amdgcn_s_sleep(8); }
#endif
        const int row = wid * 32 + (lane & 31);
        if (lane < 32) {
            const f32x2v a = P[row * 4 + 0], b = P[row * 4 + 1], c = P[row * 4 + 2], d = P[row * 4 + 3];
            const float mt = (a.x + b.x + c.x + d.x) * 0.25f;
            const float da = a.x - mt, db = b.x - mt, dc = c.x - mt, dd = d.x - mt;
            const float m2 = (a.y + b.y) + (c.y + d.y) + 64.0f * ((da * da + db * db) + (dc * dc + dd * dd));
            unsigned long long* slot = (unsigned long long*)xbuf + ((size_t)(u.pm * BM + row) * 4 + u.pn);
            __hip_atomic_store(slot, ((unsigned long long)__float_as_uint(m2) << 32) | __float_as_uint(mt), __ATOMIC_RELAXED, __HIP_MEMORY_SCOPE_AGENT);
        }
        asm volatile("s_waitcnt vmcnt(0)" ::: "memory");
        if (lane == 0) __hip_atomic_fetch_add(cnt + 64 * u.pm, 1u, __ATOMIC_RELAXED, __HIP_MEMORY_SCOPE_AGENT);
        if (wid == 0) {
            bool dead = false; const unsigned long long t0 = __builtin_amdgcn_s_memrealtime(); const unsigned want = 8u * (unsigned)ntn;
            for (;;) {
#if defined(BROKEN_EXCHANGE_NO_WAIT)
                break;
#endif
                if ((unsigned)__builtin_amdgcn_readfirstlane(__hip_atomic_load(cnt + 64 * u.pm, __ATOMIC_RELAXED, __HIP_MEMORY_SCOPE_AGENT)) >= want) break;
                if (__builtin_amdgcn_s_memrealtime() - t0 > 2000000ull) {
                    if (lane == 0) { unsigned expect = 0u; __hip_atomic_compare_exchange_strong(tmo + 1, &expect, code | (unsigned)(u.pm & 0xff), __ATOMIC_RELAXED, __ATOMIC_RELAXED, __HIP_MEMORY_SCOPE_AGENT);
                                     __hip_atomic_store(tmo, 1u, __ATOMIC_RELAXED, __HIP_MEMORY_SCOPE_AGENT); }
                    dead = true; break; }
                __builtin_amdgcn_s_sleep(2);
            }
            __builtin_amdgcn_fence(__ATOMIC_ACQUIRE, "agent");
            if (lane == 0) flag[0] = dead ? 1u : 0u;
        }
        asm volatile("s_waitcnt vmcnt(0) lgkmcnt(0)" ::: "memory"); __builtin_amdgcn_s_barrier(); asm volatile("" ::: "memory");
        const bool bad = flag[0] != 0u;
        if (lane < 32) {
            const unsigned long long* slot = (const unsigned long long*)xbuf + (size_t)(u.pm * BM + row) * 4; float mt[4], m2[4]; float ms = 0.f;
#pragma unroll
            for (int t = 0; t < 4; ++t) { if (t < ntn) { const unsigned long long w = __hip_atomic_load(slot + t, __ATOMIC_RELAXED, __HIP_MEMORY_SCOPE_AGENT); mt[t] = __uint_as_float((unsigned)w); m2[t] = __uint_as_float((unsigned)(w >> 32)); } else { mt[t] = 0.f; m2[t] = 0.f; } ms += mt[t]; }
            const float mean = ms / (float)ntn; float q = 0.f;
#pragma unroll
            for (int t = 0; t < 4; ++t) if (t < ntn) { const float dm = mt[t] - mean; q += m2[t] + 256.0f * dm * dm; }
            S[row] = (f32x2v){mean, 1.0f / sqrtf(q / (256.0f * (float)ntn) + eps)};
        }
        asm volatile("s_waitcnt lgkmcnt(0)" ::: "memory"); __builtin_amdgcn_s_barrier(); asm volatile("" ::: "memory");
        return bad;
    }
};
struct EpiLnRes {
    static constexpr bool PERM = false, AFTER_DRAIN = true;
    const float* base; float* out; int ldc; const float* bias; PanelStats st; unsigned poison;
    __device__ __forceinline__ void fused(f32x4 (&acc)[2][2][4][2], const Unit& u, int wr, int wc, int fr, int fq, PG8_LAS unsigned char* lds, int wid, int lane) const {
        typedef float f32x2v __attribute__((ext_vector_type(2)));
        const PG8_LAS f32x2v* S = (const PG8_LAS f32x2v*)(lds + 8192);
        const int col0 = u.pn * BM + wc * 32 + 4 * fq;
#pragma unroll
        for (int bj = 0; bj < 2; ++bj)
#pragma unroll
            for (int n = 0; n < 2; ++n) { const f32x4 bv = bias ? *(const f32x4*)(bias + col0 + bj * HALF + n * 16) : (f32x4){0.f, 0.f, 0.f, 0.f};
#pragma unroll
                for (int ai = 0; ai < 2; ++ai)
#pragma unroll
                    for (int m = 0; m < 4; ++m) acc[ai][bj][m][n] += bv; }
        f32x4 pre[4][2][2];
#pragma unroll
        for (int m = 0; m < 4; ++m) { const size_t off = (size_t)(u.pm * BM + wr * 64 + m * 16 + fr) * ldc + col0;
#pragma unroll
            for (int bj = 0; bj < 2; ++bj)
#pragma unroll
                for (int n = 0; n < 2; ++n) pre[m][bj][n] = *(const f32x4*)(base + off + bj * HALF + n * 16); }
        const bool bad = st.run(acc, u, wr, wc, fr, fq, lds, wid, lane) || poison != 0u;
        const float qnan = __builtin_nanf("");
#pragma unroll
        for (int ai = 0; ai < 2; ++ai)
#pragma unroll
            for (int m = 0; m < 4; ++m) { const int r = ai * HALF + wr * 64 + m * 16 + fr; const f32x2v sr = S[r]; const size_t off = (size_t)(u.pm * BM + r) * ldc + col0;
#pragma unroll
                for (int bj = 0; bj < 2; ++bj)
#pragma unroll
                    for (int n = 0; n < 2; ++n) { const f32x4 bs = ai == 0 ? pre[m][bj][n] : *(const f32x4*)(base + off + bj * HALF + n * 16); f32x4 o = bs + (acc[ai][bj][m][n] - sr.x) * sr.y;
                        if (bad) o = (f32x4){qnan, qnan, qnan, qnan}; *(f32x4*)(out + off + bj * HALF + n * 16) = o; }
                if (m & 1) asm volatile("" ::: "memory"); }
    }
};
struct EpiLnResLn {
    static constexpr bool PERM = false, AFTER_DRAIN = true;
    const float* base; float* out; bf16_t* xn; int ldc; const float* bias; PanelStats st1, st2; unsigned poison;
    __device__ __forceinline__ void fused(f32x4 (&acc)[2][2][4][2], const Unit& u, int wr, int wc, int fr, int fq, PG8_LAS unsigned char* lds, int wid, int lane) const {
        typedef float f32x2v __attribute__((ext_vector_type(2))); typedef unsigned u32x2v __attribute__((ext_vector_type(2)));
        const PG8_LAS f32x2v* S = (const PG8_LAS f32x2v*)(lds + 8192);
        const int col0 = u.pn * BM + wc * 32 + 4 * fq;
#pragma unroll
        for (int bj = 0; bj < 2; ++bj)
#pragma unroll
            for (int n = 0; n < 2; ++n) { const f32x4 bv = bias ? *(const f32x4*)(bias + col0 + bj * HALF + n * 16) : (f32x4){0.f, 0.f, 0.f, 0.f};
#pragma unroll
                for (int ai = 0; ai < 2; ++ai)
#pragma unroll
                    for (int m = 0; m < 4; ++m) acc[ai][bj][m][n] += bv; }
        bool bad = st1.run(acc, u, wr, wc, fr, fq, lds, wid, lane) || poison != 0u;
        const float qnan = __builtin_nanf("");
#pragma unroll
        for (int ai = 0; ai < 2; ++ai)
#pragma unroll
            for (int m = 0; m < 4; ++m) { const int r = ai * HALF + wr * 64 + m * 16 + fr; const f32x2v sr = S[r]; const size_t off = (size_t)(u.pm * BM + r) * ldc + col0;
#pragma unroll
                for (int bj = 0; bj < 2; ++bj)
#pragma unroll
                    for (int n = 0; n < 2; ++n) { const f32x4 bs = *(const f32x4*)(base + off + bj * HALF + n * 16); acc[ai][bj][m][n] = bs + (acc[ai][bj][m][n] - sr.x) * sr.y; }
                asm volatile("" : "+v"(acc[ai][0][m][0]), "+v"(acc[ai][0][m][1]), "+v"(acc[ai][1][m][0]), "+v"(acc[ai][1][m][1]));
                if (m & 1) asm volatile("" ::: "memory"); }
        const bool bad1 = bad;
        bad = st2.run(acc, u, wr, wc, fr, fq, lds, wid, lane) || bad;
#pragma unroll
        for (int ai = 0; ai < 2; ++ai)
#pragma unroll
            for (int m = 0; m < 4; ++m) { const int r = ai * HALF + wr * 64 + m * 16 + fr; const f32x2v sr = S[r]; const size_t off = (size_t)(u.pm * BM + r) * ldc + col0;
#pragma unroll
                for (int bj = 0; bj < 2; ++bj)
#pragma unroll
                    for (int n = 0; n < 2; ++n) { const f32x4 x1 = acc[ai][bj][m][n]; *(f32x4*)(out + off + bj * HALF + n * 16) = bad1 ? (f32x4){qnan, qnan, qnan, qnan} : x1;
                        const f32x4 o = (x1 - sr.x) * sr.y; u32x2v w; w.x = cvt_pk_bf16(o[0], o[1]); w.y = cvt_pk_bf16(o[2], o[3]);
                        if (bad) { w.x = 0x7fc07fc0u; w.y = 0x7fc07fc0u; } *(u32x2v*)(xn + off + bj * HALF + n * 16) = w; }
                asm volatile("" ::: "memory"); }
    }
};

template <class Epi, class Sched, bool ALIGN_EPI = false, bool SP2 = false, bool GATHER = false>
__device__ __forceinline__ void gemm_phase(PG8_LAS unsigned char* lds, const Gemm g, const Sched& S, const Epi& E) {
    const int tid = threadIdx.x, wid = __builtin_amdgcn_readfirstlane(tid >> 6), lane = tid & 63, wr = wid >> 2, wc = wid & 3, fr = lane & 15, fq = lane >> 4;
    const int K = g.K, nt = K / BK;
    static_assert(!GATHER || SP2, "GATHER is wired into the SP2 loop only");
    unsigned voffA[2], voffB[2]; int gR_[2], gC_[2];
#pragma unroll
    for (int i = 0; i < 2; ++i) { int R, C; stage_rc(tid * 16 + i * 8192, R, C); const int Rb = Epi::PERM ? ((R & ~31) + perm32(R & 31)) : R; gR_[i] = R; gC_[i] = C;
        voffA[i] = (unsigned)(R * K + C) * 2u; voffB[i] = (unsigned)(Rb * K + C) * 2u; }
    unsigned gvo[2][2] = {{0u, 0u}, {0u, 0u}}, gvn[2][2] = {{0u, 0u}, {0u, 0u}};
#define PG8_GOFF(dst, unit) do { _Pragma("unroll") for (int h_ = 0; h_ < 2; ++h_) _Pragma("unroll") for (int i_ = 0; i_ < 2; ++i_) \
        dst[h_][i_] = ((unsigned)S.a_row(unit, h_ * HALF + gR_[i_]) * (unsigned)K + (unsigned)gC_[i_]) * 2u; \
        asm volatile("" : "+v"(dst[0][0]), "+v"(dst[0][1]), "+v"(dst[1][0]), "+v"(dst[1][1])); } while (0)
    const size_t kstep = (size_t)(BK * 2);
    const size_t hstep = (size_t)HALF * K * 2;
    const size_t tstep = 2 * hstep;
    const unsigned ldsw = (unsigned)wid * 1024u;
    const int aoff = lds_byte(wr * 64 + fr, fq * 8), boff = lds_byte(wc * 32 + fr, fq * 8);
#define PG8_SA(b, h) (((b) * 2 + (h)) * HTB)
#define PG8_SB(b, h) ((4 + (b) * 2 + (h)) * HTB)
#define PG8_STAGE(bufoff, gbase, voff) do { _Pragma("unroll") for (int _i = 0; _i < 2; ++_i) \
        __builtin_amdgcn_global_load_lds((const unsigned*)((const char*)(gbase) + (voff)[_i]), (PG8_LAS unsigned*)(lds + (bufoff) + ldsw + _i * 8192), 16, 0, 0); } while (0)
#define PG8_STAGE_AH(bufoff, gbase, h, usen) do { _Pragma("unroll") for (int _i = 0; _i < 2; ++_i) { \
        const unsigned vo_ = GATHER ? ((usen) ? gvn[h][_i] : gvo[h][_i]) : voffA[_i]; \
        __builtin_amdgcn_global_load_lds((const unsigned*)((const char*)(gbase) + (GATHER ? (size_t)0 : (size_t)(h) * hstep) + vo_), (PG8_LAS unsigned*)(lds + (bufoff) + ldsw + _i * 8192), 16, 0, 0); } } while (0)
#define PG8_LDA(dst, b, h) do { _Pragma("unroll") for (int m = 0; m < 4; ++m) _Pragma("unroll") for (int k = 0; k < 2; ++k) dst[m][k] = *(const PG8_LAS bf16x8*)(lds + PG8_SA(b, h) + aoff + m * 2048 + k * 1024); } while (0)
#define PG8_LDB(dst, b, h) do { _Pragma("unroll") for (int n = 0; n < 2; ++n) _Pragma("unroll") for (int k = 0; k < 2; ++k) dst[n][k] = *(const PG8_LAS bf16x8*)(lds + PG8_SB(b, h) + boff + n * 2048 + k * 1024); } while (0)
#define PG8_MMA(ai, bj, At, Bt) do { __builtin_amdgcn_s_setprio(1); _Pragma("unroll") for (int m = 0; m < 4; ++m) _Pragma("unroll") for (int n = 0; n < 2; ++n) _Pragma("unroll") for (int k = 0; k < 2; ++k) \
        acc[ai][bj][m][n] = __builtin_amdgcn_mfma_f32_16x16x32_bf16(Bt[n][k], At[m][k], acc[ai][bj][m][n], 0, 0, 0); __builtin_amdgcn_s_setprio(0); } while (0)
#define PG8_WAIT_V(n) asm volatile("s_waitcnt vmcnt(" #n ")" ::: "memory")
#define PG8_WAIT_L(n) asm volatile("s_waitcnt lgkmcnt(" #n ")" ::: "memory")
#define PG8_BAR __builtin_amdgcn_s_barrier()
#define PG8_SCHED __builtin_amdgcn_sched_barrier(0)
    Unit cur, nxt; int ui = 0;
    if (!S.next(0, cur)) return;
    f32x4 acc[2][2][4][2];
#pragma unroll
    for (int a = 0; a < 2; ++a)
#pragma unroll
        for (int b = 0; b < 2; ++b)
#pragma unroll
            for (int m = 0; m < 4; ++m)
#pragma unroll
                for (int n = 0; n < 2; ++n) acc[a][b][m][n] = (f32x4){0.f, 0.f, 0.f, 0.f};
    bf16x8 At[4][2], B0[2][2], B1[2][2];
    const char* cA = (const char*)g.A + (GATHER ? (size_t)0 : (size_t)cur.pm * tstep); const char* cB = (const char*)g.Bt + (size_t)cur.pn * tstep;
    S.a_ready(cur);
    if constexpr (GATHER) { PG8_GOFF(gvo, cur); }
    if constexpr (SP2) {
        PG8_STAGE(PG8_SB(0, 0), cB, voffB); PG8_STAGE(PG8_SB(0, 1), cB + hstep, voffB); PG8_STAGE_AH(PG8_SA(0, 0), cA, 0, false); PG8_STAGE_AH(PG8_SA(0, 1), cA, 1, false);
        if (wr == 1) PG8_BAR;
        PG8_WAIT_V(2); PG8_BAR;
        PG8_STAGE(PG8_SB(1, 0), cB + kstep, voffB); PG8_STAGE_AH(PG8_SA(1, 0), cA + kstep, 0, false); PG8_STAGE(PG8_SB(1, 1), cB + hstep + kstep, voffB);
        PG8_WAIT_V(6); PG8_BAR;
    } else {
        PG8_STAGE(PG8_SB(0, 0), cB, voffB); PG8_STAGE(PG8_SA(0, 0), cA, voffA); PG8_STAGE(PG8_SB(0, 1), cB + hstep, voffB); PG8_STAGE(PG8_SA(0, 1), cA + hstep, voffA);
        if (wr == 1) PG8_BAR;
        PG8_WAIT_V(4); PG8_BAR;
        PG8_STAGE(PG8_SB(1, 0), cB + kstep, voffB); PG8_STAGE(PG8_SA(1, 0), cA + kstep, voffA); PG8_STAGE(PG8_SB(1, 1), cB + hstep + kstep, voffB);
        PG8_WAIT_V(6); PG8_BAR;
    }
    for (;;) {
        const bool has_next = S.next(ui + 1, nxt);
        const char* nA = has_next ? (const char*)g.A + (GATHER ? (size_t)0 : (size_t)nxt.pm * tstep) : cA; const char* nB = has_next ? (const char*)g.Bt + (size_t)nxt.pn * tstep : cB;
        if constexpr (GATHER) { if (has_next) { PG8_GOFF(gvn, nxt); } else { gvn[0][0] = gvo[0][0]; gvn[0][1] = gvo[0][1]; gvn[1][0] = gvo[1][0]; gvn[1][1] = gvo[1][1]; } }
        for (int t = 0; t < nt; t += 2) {
            const bool last = (t == nt - 2);
            const char* a1 = cA + (size_t)(t + 1) * kstep;
            const char* a2 = last ? nA : cA + (size_t)(t + 2) * kstep; const char* b2 = last ? nB : cB + (size_t)(t + 2) * kstep;
            const char* a3 = a2 + kstep; const char* b3 = b2 + kstep;
            if (last && has_next) S.a_ready(nxt);
            if constexpr (SP2) {
            PG8_LDB(B0, 0, 0); PG8_LDB(B1, 0, 1); PG8_SCHED; PG8_LDA(At, 0, 0); PG8_STAGE_AH(PG8_SA(1, 1), a1, 1, false);
            PG8_WAIT_V(8); PG8_WAIT_L(0); PG8_BAR; PG8_MMA(0, 0, At, B0); PG8_MMA(0, 1, At, B1); PG8_BAR; PG8_SCHED;
            PG8_LDA(At, 0, 1); PG8_STAGE(PG8_SB(0, 0), b2, voffB); PG8_STAGE(PG8_SB(0, 1), b2 + hstep, voffB); PG8_STAGE_AH(PG8_SA(0, 0), a2, 0, last);
            PG8_WAIT_V(8); PG8_WAIT_L(0); PG8_BAR; PG8_MMA(1, 0, At, B0); PG8_MMA(1, 1, At, B1); PG8_BAR; PG8_SCHED;
            PG8_LDB(B0, 1, 0); PG8_LDB(B1, 1, 1); PG8_SCHED; PG8_LDA(At, 1, 0); PG8_STAGE_AH(PG8_SA(0, 1), a2, 1, last);
            PG8_WAIT_V(8); PG8_WAIT_L(0); PG8_BAR; PG8_MMA(0, 0, At, B0); PG8_MMA(0, 1, At, B1); PG8_BAR; PG8_SCHED;
            PG8_LDA(At, 1, 1); PG8_STAGE(PG8_SB(1, 0), b3, voffB); PG8_STAGE(PG8_SB(1, 1), b3 + hstep, voffB); PG8_STAGE_AH(PG8_SA(1, 0), a3, 0, last);
            PG8_WAIT_V(8); PG8_WAIT_L(0); PG8_BAR; PG8_MMA(1, 0, At, B0); PG8_MMA(1, 1, At, B1); PG8_BAR; PG8_SCHED;
            } else {
            PG8_LDB(B0, 0, 0); PG8_SCHED; PG8_LDA(At, 0, 0); PG8_STAGE(PG8_SA(1, 1), a1 + hstep, voffA);
            PG8_WAIT_L(8); PG8_BAR; PG8_WAIT_L(0); PG8_MMA(0, 0, At, B0); PG8_BAR; PG8_SCHED;
            PG8_LDB(B1, 0, 1); PG8_STAGE(PG8_SB(0, 0), b2, voffB);
            PG8_BAR; PG8_WAIT_L(0); PG8_MMA(0, 1, At, B1); PG8_BAR;
            PG8_LDA(At, 0, 1); PG8_STAGE(PG8_SA(0, 0), a2, voffA);
            PG8_BAR; PG8_WAIT_L(0); PG8_MMA(1, 0, At, B0); PG8_BAR; PG8_SCHED;
            PG8_STAGE(PG8_SB(0, 1), b2 + hstep, voffB);
            PG8_WAIT_V(6); PG8_BAR; PG8_MMA(1, 1, At, B1); PG8_BAR;
            PG8_LDB(B0, 1, 0); PG8_SCHED; PG8_LDA(At, 1, 0); PG8_STAGE(PG8_SA(0, 1), a2 + hstep, voffA);
            PG8_WAIT_L(8); PG8_BAR; PG8_WAIT_L(0); PG8_MMA(0, 0, At, B0); PG8_BAR; PG8_SCHED;
            PG8_LDB(B1, 1, 1); PG8_STAGE(PG8_SB(1, 0), b3, voffB);
            PG8_BAR; PG8_WAIT_L(0); PG8_MMA(0, 1, At, B1); PG8_BAR;
            PG8_LDA(At, 1, 1); PG8_STAGE(PG8_SA(1, 0), a3, voffA);
            PG8_BAR; PG8_WAIT_L(0); PG8_MMA(1, 0, At, B0); PG8_BAR; PG8_SCHED;
            PG8_STAGE(PG8_SB(1, 1), b3 + hstep, voffB);
            PG8_WAIT_V(6); PG8_BAR; PG8_MMA(1, 1, At, B1); PG8_BAR;
            }
        }
        if constexpr (ALIGN_EPI) { if (wr == 0) PG8_BAR; }
        if constexpr (!Epi::AFTER_DRAIN) { E(acc, cur, wr, wc, fr, fq); S.done(cur); }
        if (!has_next) break;
#pragma unroll
        for (int a = 0; a < 2; ++a)
#pragma unroll
            for (int b = 0; b < 2; ++b)
#pragma unroll
                for (int m = 0; m < 4; ++m)
#pragma unroll
                    for (int n = 0; n < 2; ++n) acc[a][b][m][n] = (f32x4){0.f, 0.f, 0.f, 0.f};
        cur = nxt; cA = nA; cB = nB; ++ui;
        if constexpr (GATHER) { gvo[0][0] = gvn[0][0]; gvo[0][1] = gvn[0][1]; gvo[1][0] = gvn[1][0]; gvo[1][1] = gvn[1][1]; }
        if constexpr (ALIGN_EPI) { if (wr == 1) PG8_BAR; }
    }
    PG8_WAIT_V(0);
    if constexpr (!ALIGN_EPI) { if (wr == 0) PG8_BAR; }
    PG8_BAR;
    if constexpr (Epi::AFTER_DRAIN) { E.fused(acc, cur, wr, wc, fr, fq, lds, wid, lane); S.done(cur); }
#undef PG8_SA
#undef PG8_SB
#undef PG8_STAGE
#undef PG8_STAGE_AH
#undef PG8_GOFF
#undef PG8_LDA
#undef PG8_LDB
#undef PG8_MMA
#undef PG8_WAIT_V
#undef PG8_WAIT_L
#undef PG8_BAR
#undef PG8_SCHED
}
}

DI void transpose_item(const float* W, int ldw, bf16_t* WT, int ldt, float scale, float* scr, int k0, int n0, int lane) {
#pragma unroll 8
    for (int i = 0; i < 32; ++i) { const int kk = 2 * i + (lane >> 5); scr[kk * 33 + (lane & 31)] = W[(size_t)(k0 + kk) * ldw + n0 + (lane & 31)] * scale; }
    asm volatile("s_waitcnt lgkmcnt(0)" ::: "memory");
    const int c = lane & 7;
#pragma unroll
    for (int j = 0; j < 4; ++j) { const int n = (lane >> 3) + 8 * j; const float* s = scr + (8 * c) * 33 + n;
        u32x4 o; o.x = pk2(s[0 * 33], s[1 * 33]); o.y = pk2(s[2 * 33], s[3 * 33]); o.z = pk2(s[4 * 33], s[5 * 33]); o.w = pk2(s[6 * 33], s[7 * 33]);
        *(u32x4*)(WT + (size_t)n * ldt + k0 + 8 * c) = o; }
    asm volatile("s_waitcnt lgkmcnt(0)" ::: "memory");
}

DI void p0_prologue(const Params& p, float* lds, int gw, int NGW, int wave, int lane) {
    unsigned char* ws = p.ws;
    bf16_t* WinT = (bf16_t*)(ws + WS_WINT); bf16_t* WoT = (bf16_t*)(ws + WS_WOT); bf16_t* WmT = (bf16_t*)(ws + WS_WMT);
    bf16_t* W13T = (bf16_t*)(ws + WS_W13T); bf16_t* W2T = (bf16_t*)(ws + WS_W2T);
    float* scr = lds + wave * (64 * 33);
    const float* w_in = p.in[I_WIN];
    constexpr int S2 = 768, S3 = 1024, S4 = S3 + 512, S5 = S4 + 256, S6 = S5 + 4096, S7 = S6 + 4096, S8 = S7 + 4096;
    for (int it = gw; it < S8; it += NGW) {
        if (it < S3) {
            int coff, roff, ncb, r;
            if (it < S2) { r = it; coff = 0; roff = 0; ncb = 48; } else if (it < S2 + 128) { r = it - S2; coff = 1792; roff = 1536; ncb = 8; } else { r = it - S2 - 128; coff = 1536; roff = 1792; ncb = 8; }
            const int kb = r / ncb, nb = r % ncb;
            const float sc = (coff == 1792 || (coff == 0 && nb < 16)) ? C2 : 1.0f;
            transpose_item(w_in + coff, 2048, WinT + (size_t)(roff + nb * 32) * 1024, 1024, sc, scr, kb * 64, nb * 32, lane);
        } else if (it < S4) { const int r = it - S3, kb = r / 32, nb = r % 32;
            transpose_item(p.in[I_WOUT], 1024, WoT + (size_t)(nb * 32) * 1024, 1024, 1.f, scr, kb * 64, nb * 32, lane);
        } else if (it < S5) { const int r = it - S4, kb = r / 16, nb = r % 16;
            transpose_item(p.in[I_WMKV], 512, WmT + (size_t)(nb * 32) * 1024, 1024, 1.f, scr, kb * 64, nb * 32, lane);
        } else if (it < S7) { const bool is3 = it >= S6; const int r = it - (is3 ? S6 : S5), e = r / 128, q = r % 128, kb = q / 8, nb = q % 8, n0 = nb * 32;
            const float* W = (is3 ? p.in[I_W3] : p.in[I_W1]) + (size_t)e * 1024 * 256;
            const int drow = e * 512 + (n0 >> 7) * 256 + (is3 ? 128 : 0) + (n0 & 127);
            transpose_item(W, 256, W13T + (size_t)drow * 1024, 1024, 1.f, scr, kb * 64, n0, lane);
        } else { const int r = it - S7, e = r / 128, q = r % 128, kb = q / 32, nb = q % 32;
            const float* W = p.in[I_W2] + (size_t)e * 256 * 1024;
            transpose_item(W, 1024, W2T + (size_t)(e * 1024 + nb * 32) * 256, 256, 1.f, scr, kb * 64, nb * 32, lane);
        }
    }
    {
        bf16_t* XN = (bf16_t*)(ws + WS_XN); float* st = (float*)(ws + WS_STATS0);
        const f32x4* g4 = (const f32x4*)p.in[I_LN0G] + lane; const f32x4* b4 = (const f32x4*)p.in[I_LN0B] + lane;
        for (int m = gw; m < NTOK; m += NGW) {
            const f32x4* xr = (const f32x4*)(p.in[I_X] + (size_t)m * DM) + lane;
            f32x4 v[4]; float s = 0.f;
#pragma unroll
            for (int j = 0; j < 4; ++j) { v[j] = xr[64 * j]; s += (v[j].x + v[j].y) + (v[j].z + v[j].w); }
            const float mean = wave_sum(s) * (1.f / DM); float s2 = 0.f;
#pragma unroll
            for (int j = 0; j < 4; ++j) { v[j] = v[j] - mean; s2 += (v[j].x * v[j].x + v[j].y * v[j].y) + (v[j].z * v[j].z + v[j].w * v[j].w); }
            const float rstd = 1.f / sqrtf(wave_sum(s2) * (1.f / DM) + LN_EPS);
            if (lane == 0) { st[2 * m] = mean; st[2 * m + 1] = rstd; }
            u32x2* o8 = (u32x2*)(XN + (size_t)m * DM) + lane;
#pragma unroll
            for (int j = 0; j < 4; ++j) { const f32x4 g = g4[64 * j], b = b4[64 * j]; const f32x4 y = v[j] * rstd * g + b; u32x2 w; w.x = pk2(y.x, y.y); w.y = pk2(y.z, y.w); o8[64 * j] = w; }
        }
    }
    {
        bf16_t* MB = (bf16_t*)(ws + WS_MEMB);
        for (int m = gw; m < NB * MEMLEN; m += NGW) {
            const f32x4* xr = (const f32x4*)(p.in[I_MEM] + (size_t)m * DM) + lane; u32x2* o8 = (u32x2*)(MB + (size_t)m * DM) + lane;
#pragma unroll
            for (int j = 0; j < 4; ++j) { const f32x4 y = xr[64 * j]; u32x2 w; w.x = pk2(y.x, y.y); w.y = pk2(y.z, y.w); o8[64 * j] = w; }
        }
    }
    {
        const float* wf = p.in[I_WF]; bf16_t* GT = (bf16_t*)(ws + WS_GT); bf16_t* F1L = (bf16_t*)(ws + WS_F1L); bf16_t* F2L = (bf16_t*)(ws + WS_F2L);
        for (int it = gw; it < 4 * 2 * 64; it += NGW) {
            const int g = it >> 7, part = (it >> 6) & 1, c = it & 63; float acc = 0.f;
            for (int c2 = 0; c2 < 64; ++c2) { const float ang = (float)((c * c2) & 63) * (1.0f / 32.0f); acc += (part ? sinpif(ang) : cospif(ang)) * wf[(size_t)(g * 64 + c2) * 64 + lane]; }
            GT[(size_t)(g * 128 + part * 64 + lane) * 64 + c] = (bf16_t)f2bf(acc * (1.0f / 512.0f));
        }
        const int gt = gw * 64 + lane, NGT = NGW * 64;
        for (int idx = gt; idx < 128 * 128; idx += NGT) {
            const int k = idx & 127, row = idx >> 7, part = k >> 6; const float ang = (float)(((k & 63) * (row & 63)) & 63) * (1.0f / 32.0f); const float c = cospif(ang), sn = sinpif(ang);
            F1L[(k >> 3) * 1024 + row * 8 + (k & 7)] = (bf16_t)f2bf((row < 64) ? (part == 0 ? c : -sn) : (part == 0 ? -sn : -c));
            if (row < 64) F2L[(k >> 3) * 512 + row * 8 + (k & 7)] = (bf16_t)f2bf(part == 0 ? c : sn);
        }
    }
    {
        float* WR = (float*)(ws + WS_WR); float* ct = (float*)(ws + WS_COSTAB);
        const int gt = gw * 64 + lane, NGT = NGW * 64;
        for (int i = gt; i < 36 * 1024; i += NGT) { const int e = i >> 10, k = i & 1023; WR[i] = e < 4 ? p.in[I_WG][k * 4 + e] : p.in[I_WRT][k * 32 + (e - 4)]; }
        for (int i = gt; i < 4096; i += NGT) ct[i] = cospif((float)i * (1.0f / 2048.0f));
    }
}

constexpr size_t WS_ZS1 = 200 * MiB;
constexpr size_t WS_O1 = 216 * MiB;
constexpr int CW_KMAX = 128;
constexpr int CW_QMAX = 192;
constexpr int CW_KMAXM = 160;

namespace pg8 {
struct EpiInproj {
    static constexpr bool PERM = true, AFTER_DRAIN = false;
    unsigned char* ws;
    __device__ __forceinline__ void operator()(const f32x4 (&acc)[2][2][4][2], const Unit& u, int wr, int wc, int fr, int fq) const {
        const int pn = u.pn; bf16_t* base; int ldc, coff;
        if (pn < 6) { base = (bf16_t*)(ws + WS_QB + (size_t)(pn >> 1) * (16 * MiB)); ldc = 512; coff = (pn & 1) * 256; }
        else if (pn == 6) { base = (bf16_t*)(ws + WS_MQB); ldc = 256; coff = 0; }
        else { base = (bf16_t*)(ws + WS_ZB); ldc = 256; coff = 0; }
        const int row0 = u.pm * BM + wr * 64 + fr, col0 = coff + wc * 32 + 8 * fq;
#pragma unroll
        for (int ai = 0; ai < 2; ++ai)
#pragma unroll
            for (int m = 0; m < 4; ++m) { bf16_t* rowp = base + (size_t)(row0 + ai * HALF + m * 16) * ldc + col0;
#pragma unroll
                for (int bj = 0; bj < 2; ++bj) { const f32x4 v0 = acc[ai][bj][m][0], v1 = acc[ai][bj][m][1];
                    u32x4 w; w.x = cvt_pk_bf16(v0[0], v0[1]); w.y = cvt_pk_bf16(v0[2], v0[3]); w.z = cvt_pk_bf16(v1[0], v1[1]); w.w = cvt_pk_bf16(v1[2], v1[3]);
                    *(u32x4*)(rowp + bj * HALF) = w; } }
    }
};
struct EpiBf16Plain {
    static constexpr bool PERM = true, AFTER_DRAIN = false;
    bf16_t* O; int ldc;
    __device__ __forceinline__ void operator()(const f32x4 (&acc)[2][2][4][2], const Unit& u, int wr, int wc, int fr, int fq) const {
        const int row0 = u.pm * BM + wr * 64 + fr, col0 = u.pn * BM + wc * 32 + 8 * fq;
#pragma unroll
        for (int ai = 0; ai < 2; ++ai)
#pragma unroll
            for (int m = 0; m < 4; ++m) { bf16_t* rowp = O + (size_t)(row0 + ai * HALF + m * 16) * ldc + col0;
#pragma unroll
                for (int bj = 0; bj < 2; ++bj) { const f32x4 v0 = acc[ai][bj][m][0], v1 = acc[ai][bj][m][1];
                    u32x4 w; w.x = cvt_pk_bf16(v0[0], v0[1]); w.y = cvt_pk_bf16(v0[2], v0[3]); w.z = cvt_pk_bf16(v1[0], v1[1]); w.w = cvt_pk_bf16(v1[2], v1[3]);
                    *(u32x4*)(rowp + bj * HALF) = w; } }
    }
};
struct EpiF32Plain {
    static constexpr bool PERM = false, AFTER_DRAIN = false;
    float* C; int ldc;
    __device__ __forceinline__ void operator()(const f32x4 (&acc)[2][2][4][2], const Unit& u, int wr, int wc, int fr, int fq) const {
        const int row0 = u.pm * BM + wr * 64 + fr, col0 = u.pn * BM + wc * 32 + 4 * fq;
#pragma unroll
        for (int ai = 0; ai < 2; ++ai)
#pragma unroll
            for (int m = 0; m < 4; ++m) { float* rowp = C + (size_t)(row0 + ai * HALF + m * 16) * ldc + col0;
#pragma unroll
                for (int bj = 0; bj < 2; ++bj)
#pragma unroll
                    for (int n = 0; n < 2; ++n) *(f32x4*)(rowp + bj * HALF + n * 16) = acc[ai][bj][m][n]; }
    }
};
struct MoeOrder {
    const PG8_LAS int* tab; const int* list; int G, c, sh;
    __device__ __forceinline__ bool next(int i, Unit& u) const {
        const int L = i * G + c, total = tab[32] << sh; if (L >= total) return false;
        const int T = L >> sh, nt = L & ((1 << sh) - 1); int e = 0; while (tab[e + 1] <= T) ++e;
        u.pm = T; u.pn = (e << sh) + nt; return true; }
    __device__ __forceinline__ int a_row(const Unit& u, int r) const { const int e = u.pn >> sh; const int pos = (u.pm - tab[e]) * 256 + r; return pos < tab[33 + e] ? list[e * NTOK + pos] : 0; }
    __device__ __forceinline__ void a_ready(const Unit&) const {}
    __device__ __forceinline__ void done(const Unit&) const {}
};
struct EpiSwiglu {
    static constexpr bool PERM = true, AFTER_DRAIN = false;
    bf16_t* HID;
    __device__ __forceinline__ void operator()(const f32x4 (&acc)[2][2][4][2], const Unit& u, int wr, int wc, int fr, int fq) const {
        const int row0 = u.pm * BM + wr * 64 + fr, col0 = (u.pn & 1) * 128 + wc * 32 + 8 * fq;
#pragma unroll
        for (int ai = 0; ai < 2; ++ai)
#pragma unroll
            for (int m = 0; m < 4; ++m) { bf16_t* rowp = HID + (size_t)(row0 + ai * HALF + m * 16) * 256 + col0; float h[8];
#pragma unroll
                for (int n = 0; n < 2; ++n)
#pragma unroll
                    for (int j = 0; j < 4; ++j) { const float gte = acc[ai][0][m][n][j], up = acc[ai][1][m][n][j];
                        h[n * 4 + j] = gte * __builtin_amdgcn_rcpf(1.0f + __builtin_amdgcn_exp2f(-gte * 1.4426950408889634f)) * up; }
                u32x4 w; w.x = cvt_pk_bf16(h[0], h[1]); w.y = cvt_pk_bf16(h[2], h[3]); w.z = cvt_pk_bf16(h[4], h[5]); w.w = cvt_pk_bf16(h[6], h[7]);
                *(u32x4*)rowp = w; }
    }
};
struct EpiDown {
    static constexpr bool PERM = true, AFTER_DRAIN = false;
    bf16_t* Y;
    __device__ __forceinline__ void operator()(const f32x4 (&acc)[2][2][4][2], const Unit& u, int wr, int wc, int fr, int fq) const {
        const int row0 = u.pm * BM + wr * 64 + fr, col0 = (u.pn & 3) * BM + wc * 32 + 8 * fq;
#pragma unroll
        for (int ai = 0; ai < 2; ++ai)
#pragma unroll
            for (int m = 0; m < 4; ++m) { bf16_t* rowp = Y + (size_t)(row0 + ai * HALF + m * 16) * 1024 + col0;
#pragma unroll
                for (int bj = 0; bj < 2; ++bj) { const f32x4 v0 = acc[ai][bj][m][0], v1 = acc[ai][bj][m][1];
                    u32x4 w; w.x = cvt_pk_bf16(v0[0], v0[1]); w.y = cvt_pk_bf16(v0[2], v0[3]); w.z = cvt_pk_bf16(v1[0], v1[1]); w.w = cvt_pk_bf16(v1[2], v1[3]);
                    *(u32x4*)(rowp + bj * HALF) = w; } }
    }
};
}

DI void kmax_phase(const Params& p, int gw, int NGW, int lane) {
    unsigned char* ws = p.ws; unsigned* ctl = (unsigned*)(ws + WS_CTL);
    const bf16_t* Kb = (const bf16_t*)(ws + WS_KB); const bf16_t* Qb = (const bf16_t*)(ws + WS_QB); const bf16_t* MKV = (const bf16_t*)(ws + WS_MKV);
    for (int grp = gw; grp < NTOK / 8; grp += NGW) {
        float mx = 0.f;
#pragma unroll
        for (int r = 0; r < 8; ++r) { const u32x4 v = *(const u32x4*)(Kb + (size_t)(grp * 8 + r) * 512 + lane * 8); float s = 0.f;
#pragma unroll
            for (int j = 0; j < 4; ++j) { const float a = __uint_as_float(v[j] << 16), b = __uint_as_float(v[j] & 0xffff0000u); s += a * a + b * b; }
            s += __shfl_xor(s, 1); s += __shfl_xor(s, 2); s += __shfl_xor(s, 4); mx = fmaxf(mx, s); }
        if ((lane & 7) == 0) atomicMax(ctl + CW_KMAX + ((grp * 8) / SEQ) * 8 + (lane >> 3), __float_as_uint(mx));
        float mq = 0.f;
#pragma unroll
        for (int r = 0; r < 8; ++r) { const u32x4 v = *(const u32x4*)(Qb + (size_t)(grp * 8 + r) * 512 + lane * 8); float s = 0.f;
#pragma unroll
            for (int j = 0; j < 4; ++j) { const float a = __uint_as_float(v[j] << 16), b = __uint_as_float(v[j] & 0xffff0000u); s += a * a + b * b; }
            s += __shfl_xor(s, 1); s += __shfl_xor(s, 2); s += __shfl_xor(s, 4); mq = fmaxf(mq, s); }
        if ((lane & 7) == 0) atomicMax(ctl + CW_QMAX + ((grp * 8) / SEQ) * 8 + (lane >> 3), __float_as_uint(mq));
    }
}

namespace att {
#define ALAS __attribute__((address_space(3)))
typedef short bf16x8 __attribute__((ext_vector_type(8)));
typedef short s16x4 __attribute__((ext_vector_type(4)));
typedef short v4i16_t __attribute__((ext_vector_type(4)));
typedef float f32x16 __attribute__((ext_vector_type(16)));
typedef float f32x2_t __attribute__((ext_vector_type(2)));
typedef __bf16 bf16x2_t __attribute__((ext_vector_type(2)));
constexpr int KOFF = 0, VOFF = 16384, TOFF = 49152, ATT_LDS = TOFF + 1024;
DI unsigned cvtpk(float lo, float hi) { f32x2_t v = {lo, hi}; bf16x2_t b = __builtin_convertvector(v, bf16x2_t); return __builtin_bit_cast(unsigned, b); }
DI s16x4 vtr(const ALAS unsigned char* q) { return __builtin_bit_cast(s16x4, __builtin_amdgcn_ds_read_tr16_b64_v4i16((ALAS v4i16_t*)q)); }
#define ATT_MFMA(a, b, c) __builtin_amdgcn_mfma_f32_32x32x16_bf16((a), (b), (c), 0, 0, 0)

template <int NDT, bool BAND>
DI void tile(const ALAS unsigned char* kb, const ALAS unsigned char* vb, const bf16x8 (&qr)[4], const f32x16& cinit, f32x16 (&o)[NDT], float& lsum,
             const ALAS float* tbl, int relbase, float mrow) {
    f32x16 p0, p1;
#pragma unroll
    for (int d0 = 0; d0 < 4; ++d0) {
        const bf16x8 b0 = *(const ALAS bf16x8*)(kb + d0 * 2048), b1 = *(const ALAS bf16x8*)(kb + d0 * 2048 + 512);
        if (d0 == 0) { if (BAND) { const f32x16 z = {0.f,0.f,0.f,0.f,0.f,0.f,0.f,0.f,0.f,0.f,0.f,0.f,0.f,0.f,0.f,0.f}; p0 = ATT_MFMA(b0, qr[0], z); p1 = ATT_MFMA(b1, qr[0], z); }
                       else { p0 = ATT_MFMA(b0, qr[0], cinit); p1 = ATT_MFMA(b1, qr[0], cinit); } }
        else { p0 = ATT_MFMA(b0, qr[d0], p0); p1 = ATT_MFMA(b1, qr[d0], p1); }
    }
    if (BAND) {
#pragma unroll
        for (int r = 0; r < 16; ++r) {
            const int rel0 = relbase + (r & 3) + 8 * (r >> 2);
            const int i0 = min(max(rel0 + 128, 0), 255), i1 = min(max(rel0 + 160, 0), 255);
            p0[r] += tbl[i0] - mrow; p1[r] += tbl[i1] - mrow;
        }
    }
    float s = 0.f;
#pragma unroll
    for (int r = 0; r < 16; ++r) { p0[r] = __builtin_amdgcn_exp2f(p0[r]); p1[r] = __builtin_amdgcn_exp2f(p1[r]); s += p0[r] + p1[r]; }
    lsum += s;
    u32x4 w0, w1, w2, w3;
    w0.x = cvtpk(p0[0], p0[1]); w0.y = cvtpk(p0[2], p0[3]); w0.z = cvtpk(p0[4], p0[5]); w0.w = cvtpk(p0[6], p0[7]);
    w1.x = cvtpk(p0[8], p0[9]); w1.y = cvtpk(p0[10], p0[11]); w1.z = cvtpk(p0[12], p0[13]); w1.w = cvtpk(p0[14], p0[15]);
    w2.x = cvtpk(p1[0], p1[1]); w2.y = cvtpk(p1[2], p1[3]); w2.z = cvtpk(p1[4], p1[5]); w2.w = cvtpk(p1[6], p1[7]);
    w3.x = cvtpk(p1[8], p1[9]); w3.y = cvtpk(p1[10], p1[11]); w3.z = cvtpk(p1[12], p1[13]); w3.w = cvtpk(p1[14], p1[15]);
    const bf16x8 pb0 = __builtin_bit_cast(bf16x8, w0), pb1 = __builtin_bit_cast(bf16x8, w1), pb2 = __builtin_bit_cast(bf16x8, w2), pb3 = __builtin_bit_cast(bf16x8, w3);
#pragma unroll
    for (int dt = 0; dt < NDT; ++dt) {
        __builtin_amdgcn_sched_barrier(0);
#pragma unroll
        for (int ks = 0; ks < 4; ++ks) {
            const s16x4 lo = vtr(vb + (dt * 4 + ks) * 1024), hh = vtr(vb + (dt * 4 + ks) * 1024 + 512);
            const bf16x8 a = __builtin_shufflevector(lo, hh, 0, 1, 2, 3, 4, 5, 6, 7);
            o[dt] = ATT_MFMA(a, ks == 0 ? pb0 : ks == 1 ? pb1 : ks == 2 ? pb2 : pb3, o[dt]);
        }
    }
}

template <int DV, bool DIFF>
DI void attn_unit(ALAS unsigned char* lds, const Params& p, int unit, int wid, int lane) {
    unsigned char* ws = p.ws; const unsigned* ctl = (const unsigned*)(ws + WS_CTL);
    const int tid = threadIdx.x, r32 = lane & 31, hi = lane >> 5;
    constexpr int NDT = DV / 32, VBYTES = DV * 128, NCOMP = DIFF ? 2 : 1, NT = DIFF ? 64 : 4;
    int b, h, qb, qpitch, ocol; size_t kbase; const bf16_t *Qg, *Kg, *Vg;
    if (DIFF) { b = unit >> 6; h = (unit >> 4) & 3; qb = unit & 15; Qg = (const bf16_t*)(ws + WS_QB) + h * 128; qpitch = 512; Kg = (const bf16_t*)(ws + WS_KB) + h * 128;
        Vg = (const bf16_t*)(ws + WS_VB) + h * 128; kbase = (size_t)b * SEQ; ocol = h * 128; }
    else { const int qblk = unit >> 2; h = unit & 3; b = qblk >> 4; qb = qblk & 15; Qg = (const bf16_t*)(ws + WS_MQB) + h * 64; qpitch = 256; Kg = (const bf16_t*)(ws + WS_MKV) + h * 64;
        Vg = (const bf16_t*)(ws + WS_MKV) + 256 + h * 64; kbase = (size_t)b * MEMLEN; ocol = 768 + h * 64; }
    const int row0 = b * SEQ + qb * 256, qa = qb * 256 + wid * 32;
    const ALAS float* tbl = (const ALAS float*)(lds + TOFF);
    float bmax = 0.f, cL = 0.f, cR = 0.f, lam = 0.f;
    __syncthreads();
    if (DIFF) {
        const float* rb = p.in[I_RELB];
        if (tid < 256) ((ALAS float*)(lds + TOFF))[tid] = rb[t5_bucket(tid - 128) * 4 + h] * LOG2E;
        float bm = -1e30f;
        for (int i = 0; i < 32; ++i) bm = fmaxf(bm, rb[i * 4 + h]);
        bmax = bm * LOG2E; cL = rb[15 * 4 + h] * LOG2E; cR = rb[31 * 4 + h] * LOG2E;
        float s1 = 0.f, s2 = 0.f;
        for (int i = 0; i < 64; ++i) { s1 += p.in[I_LQ1][i] * p.in[I_LK1][i]; s2 += p.in[I_LQ2][i] * p.in[I_LK2][i]; }
        lam = expf(s1) - expf(s2) + LAM_INIT;
        __syncthreads();
    }
    const int tL = DIFF ? (qa >= 154 ? (qa - 154) / 64 + 1 : 0) : NT;
    const int tR = DIFF ? (qa + 185) / 64 : NT;
    const int vlane = (4 * hi + ((lane & 15) >> 2)) * 64 + ((lane >> 4) & 1) * 32 + (lane & 3) * 8;
#pragma unroll 1
    for (int c = 0; c < NCOMP; ++c) {
        const bf16_t* Qp = Qg + (size_t)(row0 + wid * 32 + r32) * qpitch + c * 64 + hi * 8;
        bf16x8 qr[4]; float qq = 0.f;
#pragma unroll
        for (int d0 = 0; d0 < 4; ++d0) { qr[d0] = *(const bf16x8*)(Qp + d0 * 16);
#pragma unroll
            for (int j = 0; j < 8; ++j) { const float f = __uint_as_float(((unsigned)(unsigned short)qr[d0][j]) << 16); qq += f * f; } }
        qq += __shfl_xor(qq, 32);
        const float kmx = sqrtf(__uint_as_float(DIFF ? ctl[CW_KMAX + b * 8 + h * 2 + c] : ctl[CW_KMAXM + b * 4 + h]));
        const float mrow = sqrtf(qq) * kmx * 1.0001f + bmax;
        f32x16 cinit;
#pragma unroll
        for (int r = 0; r < 16; ++r) cinit[r] = cL - mrow;
        f32x16 o[NDT];
#pragma unroll
        for (int dt = 0; dt < NDT; ++dt)
#pragma unroll
            for (int r = 0; r < 16; ++r) o[dt][r] = 0.f;
        float lsum = 0.f;
        const bf16_t* ksrc = Kg + (kbase + lane) * 512 + c * 64 + wid * 8;
#define ATT_DMA(t, buf) do { \
        __builtin_amdgcn_global_load_lds((const unsigned*)(ksrc + (size_t)(t) * 64 * 512), (ALAS unsigned*)(lds + KOFF + (buf) * 8192 + wid * 1024), 16, 0, 0); \
        _Pragma("unroll") for (int i_ = 0; i_ < DV / 64; ++i_) { const int pid_ = wid + 8 * i_; \
            __builtin_amdgcn_global_load_lds((const unsigned*)(Vg + (kbase + (size_t)(t) * 64 + 16 * (pid_ & 3) + (lane >> 2)) * 512 + 32 * (pid_ >> 2) + 8 * (lane & 3)), \
                                             (ALAS unsigned*)(lds + VOFF + (buf) * VBYTES + pid_ * 1024), 16, 0, 0); } } while (0)
        ATT_DMA(0, 0);
        asm volatile("s_waitcnt vmcnt(0)" ::: "memory");
        __syncthreads();
#pragma unroll 1
        for (int t = 0; t < NT; ++t) {
            const int buf = t & 1;
            if (t + 1 < NT) ATT_DMA(t + 1, buf ^ 1);
            if (DIFF && t == tR) {
                float dlt = cR - cL; asm volatile("" : "+v"(dlt));
#pragma unroll
                for (int r = 0; r < 16; ++r) cinit[r] += dlt;
            }
            const ALAS unsigned char* kb = lds + KOFF + buf * 8192 + hi * 1024 + r32 * 16;
            const ALAS unsigned char* vb = lds + VOFF + buf * VBYTES + vlane;
            if (DIFF && t >= tL && t < tR) tile<NDT, true>(kb, vb, qr, cinit, o, lsum, tbl, t * 64 + 4 * hi - qa - r32, mrow);
            else tile<NDT, false>(kb, vb, qr, cinit, o, lsum, tbl, 0, 0.f);
            asm volatile("s_waitcnt vmcnt(0)" ::: "memory");
            __syncthreads();
        }
#undef ATT_DMA
        lsum += __shfl_xor(lsum, 32);
        const float inv = 1.0f / lsum;
        int lane2 = lane; asm volatile("" : "+v"(lane2));
        const int r32b = lane2 & 31, hib = lane2 >> 5;
        float* o1p = (float*)(ws + WS_O1) + ((size_t)(unit * 8 + wid) * 64 + lane2) * 64;
        if (DIFF && c == 0) {
#pragma unroll
            for (int dt = 0; dt < NDT; ++dt)
#pragma unroll
                for (int r = 0; r < 16; ++r) o1p[dt * 16 + r] = o[dt][r] * inv;
        } else {
            bf16_t* Ob = (bf16_t*)(ws + WS_OB) + (size_t)(row0 + wid * 32 + r32b) * 1024 + ocol + 4 * hib;
            if (DIFF) {
                float ss = 0.f;
#pragma unroll
                for (int dt = 0; dt < NDT; ++dt)
#pragma unroll
                    for (int r = 0; r < 16; ++r) { const float v = o1p[dt * 16 + r] - lam * (o[dt][r] * inv); o[dt][r] = v; ss += v * v; }
                ss += __shfl_xor(ss, 32);
                const float rn = (1.0f - LAM_INIT) / sqrtf(ss * (1.0f / 128.0f) + LN_EPS);
#pragma unroll
                for (int dt = 0; dt < NDT; ++dt)
#pragma unroll
                    for (int g4 = 0; g4 < 4; ++g4) { const int d0 = 32 * dt + 8 * g4; const f32x4 sg = *(const f32x4*)(p.in[I_SUBG] + d0 + 4 * hib);
                        u32x2 w; w.x = cvtpk(o[dt][4 * g4] * rn * sg.x, o[dt][4 * g4 + 1] * rn * sg.y); w.y = cvtpk(o[dt][4 * g4 + 2] * rn * sg.z, o[dt][4 * g4 + 3] * rn * sg.w);
                        *(u32x2*)(Ob + d0) = w; }
            } else {
#pragma unroll
                for (int dt = 0; dt < NDT; ++dt)
#pragma unroll
                    for (int g4 = 0; g4 < 4; ++g4) { const int d0 = 32 * dt + 8 * g4;
                        u32x2 w; w.x = cvtpk(o[dt][4 * g4] * inv, o[dt][4 * g4 + 1] * inv); w.y = cvtpk(o[dt][4 * g4 + 2] * inv, o[dt][4 * g4 + 3] * inv);
                        *(u32x2*)(Ob + d0) = w; }
            }
        }
    }
}

constexpr int PK = 0, PVV = 24576, PT = 73728;
#define SBAR() __builtin_amdgcn_sched_barrier(0)
DI void glds16_asm(const void* gsrc, unsigned lds_dst) { unsigned keep;
    asm volatile("s_mov_b32 %0, m0\n\ts_mov_b32 m0, %2\n\ts_nop 0\n\tglobal_load_lds_dwordx4 %1, off\n\ts_mov_b32 m0, %0" : "=&s"(keep) : "v"(gsrc), "s"(lds_dst) : "memory"); }
#define PWAITBAR(N) asm volatile("s_waitcnt vmcnt(" #N ") lgkmcnt(0)\n\ts_barrier" ::: "memory")
template <bool FIRST>
DI void pstep(const bf16x8 (&qr)[4], f32x16 (&o)[4], f32x16& C0, f32x16& C1, const f32x16& P0, const f32x16& P1, float& l,
              const ALAS unsigned char* kq, const ALAS unsigned char* vq, bool band, int relbase, float cref, const ALAS float* tbl) {
    const f32x16 z = {0.f,0.f,0.f,0.f,0.f,0.f,0.f,0.f,0.f,0.f,0.f,0.f,0.f,0.f,0.f,0.f};
#define KRD(i) (*(const ALAS bf16x8*)(kq + ((i) >> 1) * 2048 + ((i) & 1) * 512))
#define VLO(f) vtr(vq + ((((f) & 3) * 4 + ((f) >> 2)) * 1024))
#define VHI(f) vtr(vq + ((((f) & 3) * 4 + ((f) >> 2)) * 1024 + 512))
#define VCAT(lo, hi) __builtin_shufflevector(lo, hi, 0, 1, 2, 3, 4, 5, 6, 7)
    u32x4 pw0, pw1, pw2, pw3; float sacc = 0.f;
    bf16x8 k0 = KRD(0), k1 = KRD(1), k2 = KRD(2), k3, k4, k5, k6, k7;
    s16x4 vl0, vh0, vl1, vh1, vl2, vh2, vl3, vh3, vl4, vh4, vl5, vh5, vl6, vh6, vl7, vh7, vl8, vh8, vl9, vh9, vl10, vh10, vl11, vh11, vl12, vh12, vl13, vh13, vl14, vh14, vl15, vh15;
    SBAR();
    k3 = KRD(3); C0 = ATT_MFMA(k0, qr[0], z); if (!FIRST) { sacc += (P0[0] + P0[1]) + (P0[2] + P0[3]); pw0.x = cvtpk(P0[0], P0[1]); pw0.y = cvtpk(P0[2], P0[3]); asm volatile("" : "+v"(sacc), "+v"(pw0.x), "+v"(pw0.y)); } SBAR();
    k4 = KRD(4); C1 = ATT_MFMA(k1, qr[0], z); if (!FIRST) { sacc += (P0[4] + P0[5]) + (P0[6] + P0[7]); pw0.z = cvtpk(P0[4], P0[5]); pw0.w = cvtpk(P0[6], P0[7]); asm volatile("" : "+v"(sacc), "+v"(pw0.z), "+v"(pw0.w)); } SBAR();
    k5 = KRD(5); C0 = ATT_MFMA(k2, qr[1], C0); if (!FIRST) { sacc += (P0[8] + P0[9]) + (P0[10] + P0[11]); pw1.x = cvtpk(P0[8], P0[9]); pw1.y = cvtpk(P0[10], P0[11]); asm volatile("" : "+v"(sacc), "+v"(pw1.x), "+v"(pw1.y)); } SBAR();
    k6 = KRD(6); C1 = ATT_MFMA(k3, qr[1], C1); if (!FIRST) { sacc += (P0[12] + P0[13]) + (P0[14] + P0[15]); pw1.z = cvtpk(P0[12], P0[13]); pw1.w = cvtpk(P0[14], P0[15]); asm volatile("" : "+v"(sacc), "+v"(pw1.z), "+v"(pw1.w)); } SBAR();
    k7 = KRD(7); if (!FIRST) { vl0 = VLO(0); vh0 = VHI(0); } C0 = ATT_MFMA(k4, qr[2], C0); if (!FIRST) { sacc += (P1[0] + P1[1]) + (P1[2] + P1[3]); pw2.x = cvtpk(P1[0], P1[1]); pw2.y = cvtpk(P1[2], P1[3]); asm volatile("" : "+v"(sacc), "+v"(pw2.x), "+v"(pw2.y)); } SBAR();
    if (!FIRST) { vl1 = VLO(1); vh1 = VHI(1); } C1 = ATT_MFMA(k5, qr[2], C1); if (!FIRST) { sacc += (P1[4] + P1[5]) + (P1[6] + P1[7]); pw2.z = cvtpk(P1[4], P1[5]); pw2.w = cvtpk(P1[6], P1[7]); asm volatile("" : "+v"(sacc), "+v"(pw2.z), "+v"(pw2.w)); } SBAR();
    if (!FIRST) { vl2 = VLO(2); vh2 = VHI(2); } C0 = ATT_MFMA(k6, qr[3], C0); if (!FIRST) { sacc += (P1[8] + P1[9]) + (P1[10] + P1[11]); pw3.x = cvtpk(P1[8], P1[9]); pw3.y = cvtpk(P1[10], P1[11]); asm volatile("" : "+v"(sacc), "+v"(pw3.x), "+v"(pw3.y)); } SBAR();
    if (!FIRST) { vl3 = VLO(3); vh3 = VHI(3); } C1 = ATT_MFMA(k7, qr[3], C1); if (!FIRST) { sacc += (P1[12] + P1[13]) + (P1[14] + P1[15]); pw3.z = cvtpk(P1[12], P1[13]); pw3.w = cvtpk(P1[14], P1[15]); asm volatile("" : "+v"(sacc), "+v"(pw3.z), "+v"(pw3.w)); } SBAR();
    l += sacc;
    if (band) {
        const ALAS float* tb_ = tbl + (relbase + 192);
#pragma unroll
        for (int r = 0; r < 16; ++r) { C0[r] += tb_[(r & 3) + 8 * (r >> 2)] - cref; C1[r] += tb_[32 + (r & 3) + 8 * (r >> 2)] - cref; }
    }
    SBAR();
    if (FIRST) {
#pragma unroll
        for (int r = 0; r < 16; ++r) { C0[r] = __builtin_amdgcn_exp2f(C0[r]); C1[r] = __builtin_amdgcn_exp2f(C1[r]); }
    } else {
        const bf16x8 pb0 = __builtin_bit_cast(bf16x8, pw0), pb1 = __builtin_bit_cast(bf16x8, pw1), pb2 = __builtin_bit_cast(bf16x8, pw2), pb3 = __builtin_bit_cast(bf16x8, pw3);
        vl4 = VLO(4); vh4 = VHI(4); o[0] = ATT_MFMA(VCAT(vl0, vh0), pb0, o[0]); C0[0] = __builtin_amdgcn_exp2f(C0[0]); C0[1] = __builtin_amdgcn_exp2f(C0[1]); asm volatile("" : "+v"(C0)); SBAR();
        vl5 = VLO(5); vh5 = VHI(5); o[1] = ATT_MFMA(VCAT(vl1, vh1), pb0, o[1]); C0[2] = __builtin_amdgcn_exp2f(C0[2]); C0[3] = __builtin_amdgcn_exp2f(C0[3]); asm volatile("" : "+v"(C0)); SBAR();
        vl6 = VLO(6); vh6 = VHI(6); o[2] = ATT_MFMA(VCAT(vl2, vh2), pb0, o[2]); C0[4] = __builtin_amdgcn_exp2f(C0[4]); C0[5] = __builtin_amdgcn_exp2f(C0[5]); asm volatile("" : "+v"(C0)); SBAR();
        vl7 = VLO(7); vh7 = VHI(7); o[3] = ATT_MFMA(VCAT(vl3, vh3), pb0, o[3]); C0[6] = __builtin_amdgcn_exp2f(C0[6]); C0[7] = __builtin_amdgcn_exp2f(C0[7]); asm volatile("" : "+v"(C0)); SBAR();
        vl8 = VLO(8); vh8 = VHI(8); o[0] = ATT_MFMA(VCAT(vl4, vh4), pb1, o[0]); C0[8] = __builtin_amdgcn_exp2f(C0[8]); C0[9] = __builtin_amdgcn_exp2f(C0[9]); asm volatile("" : "+v"(C0)); SBAR();
        vl9 = VLO(9); vh9 = VHI(9); o[1] = ATT_MFMA(VCAT(vl5, vh5), pb1, o[1]); C0[10] = __builtin_amdgcn_exp2f(C0[10]); C0[11] = __builtin_amdgcn_exp2f(C0[11]); asm volatile("" : "+v"(C0)); SBAR();
        vl10 = VLO(10); vh10 = VHI(10); o[2] = ATT_MFMA(VCAT(vl6, vh6), pb1, o[2]); C0[12] = __builtin_amdgcn_exp2f(C0[12]); C0[13] = __builtin_amdgcn_exp2f(C0[13]); asm volatile("" : "+v"(C0)); SBAR();
        vl11 = VLO(11); vh11 = VHI(11); o[3] = ATT_MFMA(VCAT(vl7, vh7), pb1, o[3]); C0[14] = __builtin_amdgcn_exp2f(C0[14]); C0[15] = __builtin_amdgcn_exp2f(C0[15]); asm volatile("" : "+v"(C0)); SBAR();
        vl12 = VLO(12); vh12 = VHI(12); o[0] = ATT_MFMA(VCAT(vl8, vh8), pb2, o[0]); C1[0] = __builtin_amdgcn_exp2f(C1[0]); C1[1] = __builtin_amdgcn_exp2f(C1[1]); asm volatile("" : "+v"(C1)); SBAR();
        vl13 = VLO(13); vh13 = VHI(13); o[1] = ATT_MFMA(VCAT(vl9, vh9), pb2, o[1]); C1[2] = __builtin_amdgcn_exp2f(C1[2]); C1[3] = __builtin_amdgcn_exp2f(C1[3]); asm volatile("" : "+v"(C1)); SBAR();
        vl14 = VLO(14); vh14 = VHI(14); o[2] = ATT_MFMA(VCAT(vl10, vh10), pb2, o[2]); C1[4] = __builtin_amdgcn_exp2f(C1[4]); C1[5] = __builtin_amdgcn_exp2f(C1[5]); asm volatile("" : "+v"(C1)); SBAR();
        vl15 = VLO(15); vh15 = VHI(15); o[3] = ATT_MFMA(VCAT(vl11, vh11), pb2, o[3]); C1[6] = __builtin_amdgcn_exp2f(C1[6]); C1[7] = __builtin_amdgcn_exp2f(C1[7]); asm volatile("" : "+v"(C1)); SBAR();
        o[0] = ATT_MFMA(VCAT(vl12, vh12), pb3, o[0]); C1[8] = __builtin_amdgcn_exp2f(C1[8]); C1[9] = __builtin_amdgcn_exp2f(C1[9]); asm volatile("" : "+v"(C1)); SBAR();
        o[1] = ATT_MFMA(VCAT(vl13, vh13), pb3, o[1]); C1[10] = __builtin_amdgcn_exp2f(C1[10]); C1[11] = __builtin_amdgcn_exp2f(C1[11]); asm volatile("" : "+v"(C1)); SBAR();
        o[2] = ATT_MFMA(VCAT(vl14, vh14), pb3, o[2]); C1[12] = __builtin_amdgcn_exp2f(C1[12]); C1[13] = __builtin_amdgcn_exp2f(C1[13]); asm volatile("" : "+v"(C1)); SBAR();
        o[3] = ATT_MFMA(VCAT(vl15, vh15), pb3, o[3]); C1[14] = __builtin_amdgcn_exp2f(C1[14]); C1[15] = __builtin_amdgcn_exp2f(C1[15]); asm volatile("" : "+v"(C1)); SBAR();
    }
#undef KRD
#undef VLO
#undef VHI
#undef VCAT
}
DI void pdrain(f32x16 (&o)[4], const f32x16& P0, const f32x16& P1, float& l, const ALAS unsigned char* vq) {
#define VLO(f) vtr(vq + ((((f) & 3) * 4 + ((f) >> 2)) * 1024))
#define VHI(f) vtr(vq + ((((f) & 3) * 4 + ((f) >> 2)) * 1024 + 512))
#define VCAT(lo, hi) __builtin_shufflevector(lo, hi, 0, 1, 2, 3, 4, 5, 6, 7)
    float sacc = 0.f;
#pragma unroll
    for (int r = 0; r < 16; ++r) sacc += P0[r] + P1[r];
    l += sacc;
    u32x4 pw0, pw1, pw2, pw3;
    pw0.x = cvtpk(P0[0], P0[1]); pw0.y = cvtpk(P0[2], P0[3]); pw0.z = cvtpk(P0[4], P0[5]); pw0.w = cvtpk(P0[6], P0[7]);
    pw1.x = cvtpk(P0[8], P0[9]); pw1.y = cvtpk(P0[10], P0[11]); pw1.z = cvtpk(P0[12], P0[13]); pw1.w = cvtpk(P0[14], P0[15]);
    pw2.x = cvtpk(P1[0], P1[1]); pw2.y = cvtpk(P1[2], P1[3]); pw2.z = cvtpk(P1[4], P1[5]); pw2.w = cvtpk(P1[6], P1[7]);
    pw3.x = cvtpk(P1[8], P1[9]); pw3.y = cvtpk(P1[10], P1[11]); pw3.z = cvtpk(P1[12], P1[13]); pw3.w = cvtpk(P1[14], P1[15]);
    const bf16x8 pb0 = __builtin_bit_cast(bf16x8, pw0), pb1 = __builtin_bit_cast(bf16x8, pw1), pb2 = __builtin_bit_cast(bf16x8, pw2), pb3 = __builtin_bit_cast(bf16x8, pw3);
    { const s16x4 lo_ = VLO(0), hi_ = VHI(0); o[0] = ATT_MFMA(VCAT(lo_, hi_), pb0, o[0]); }
    { const s16x4 lo_ = VLO(1), hi_ = VHI(1); o[1] = ATT_MFMA(VCAT(lo_, hi_), pb0, o[1]); }
    { const s16x4 lo_ = VLO(2), hi_ = VHI(2); o[2] = ATT_MFMA(VCAT(lo_, hi_), pb0, o[2]); }
    { const s16x4 lo_ = VLO(3), hi_ = VHI(3); o[3] = ATT_MFMA(VCAT(lo_, hi_), pb0, o[3]); }
    { const s16x4 lo_ = VLO(4), hi_ = VHI(4); o[0] = ATT_MFMA(VCAT(lo_, hi_), pb1, o[0]); }
    { const s16x4 lo_ = VLO(5), hi_ = VHI(5); o[1] = ATT_MFMA(VCAT(lo_, hi_), pb1, o[1]); }
    { const s16x4 lo_ = VLO(6), hi_ = VHI(6); o[2] = ATT_MFMA(VCAT(lo_, hi_), pb1, o[2]); }
    { const s16x4 lo_ = VLO(7), hi_ = VHI(7); o[3] = ATT_MFMA(VCAT(lo_, hi_), pb1, o[3]); }
    { const s16x4 lo_ = VLO(8), hi_ = VHI(8); o[0] = ATT_MFMA(VCAT(lo_, hi_), pb2, o[0]); }
    { const s16x4 lo_ = VLO(9), hi_ = VHI(9); o[1] = ATT_MFMA(VCAT(lo_, hi_), pb2, o[1]); }
    { const s16x4 lo_ = VLO(10), hi_ = VHI(10); o[2] = ATT_MFMA(VCAT(lo_, hi_), pb2, o[2]); }
    { const s16x4 lo_ = VLO(11), hi_ = VHI(11); o[3] = ATT_MFMA(VCAT(lo_, hi_), pb2, o[3]); }
    { const s16x4 lo_ = VLO(12), hi_ = VHI(12); o[0] = ATT_MFMA(VCAT(lo_, hi_), pb3, o[0]); }
    { const s16x4 lo_ = VLO(13), hi_ = VHI(13); o[1] = ATT_MFMA(VCAT(lo_, hi_), pb3, o[1]); }
    { const s16x4 lo_ = VLO(14), hi_ = VHI(14); o[2] = ATT_MFMA(VCAT(lo_, hi_), pb3, o[2]); }
    { const s16x4 lo_ = VLO(15), hi_ = VHI(15); o[3] = ATT_MFMA(VCAT(lo_, hi_), pb3, o[3]); }
#undef VLO
#undef VHI
#undef VCAT
}

DI void attn_pipe(ALAS unsigned char* lds, const Params& p, int unit, int wid, int lane) {
    unsigned char* ws = p.ws;
    const int tid = threadIdx.x, r32 = lane & 31, hi = lane >> 5;
    constexpr int NT = 64;
    const int b = unit >> 6, h = (unit >> 4) & 3, qb = unit & 15;
    const bf16_t* Qg = (const bf16_t*)(ws + WS_QB) + h * 128; const bf16_t* Kg = (const bf16_t*)(ws + WS_KB) + h * 128; const bf16_t* Vg = (const bf16_t*)(ws + WS_VB) + h * 128;
    const size_t kbase = (size_t)b * SEQ; const int ocol = h * 128;
    const int row0 = b * SEQ + qb * 256, qa = qb * 256 + wid * 32;
    const ALAS float* tbl = (const ALAS float*)(lds + PT);
    float cL, cR, lam;
    __syncthreads();
    {
        const float* rb = p.in[I_RELB];
        if (tid < 384) ((ALAS float*)(lds + PT))[tid] = rb[t5_bucket(tid - 192) * 4 + h] * LOG2E;
        cL = rb[15 * 4 + h] * LOG2E; cR = rb[31 * 4 + h] * LOG2E;
        float s1 = 0.f, s2 = 0.f;
        for (int i = 0; i < 64; ++i) { s1 += p.in[I_LQ1][i] * p.in[I_LK1][i]; s2 += p.in[I_LQ2][i] * p.in[I_LK2][i]; }
        lam = expf(s1) - expf(s2) + LAM_INIT;
        __syncthreads();
    }
    const int tL = qa >= 154 ? (qa - 154) / 64 + 1 : 0;
    const int tR = (qa + 185) / 64;
    const int vlane = (4 * hi + ((lane & 15) >> 2)) * 64 + ((lane >> 4) & 1) * 32 + (lane & 3) * 8;
    const int relb0 = 4 * hi - qa - r32;
#pragma unroll 1
    for (int c = 0; c < 2; ++c) {
        const bf16_t* Qp = Qg + (size_t)(row0 + wid * 32 + r32) * 512 + c * 64 + hi * 8;
        bf16x8 qr[4];
#pragma unroll
        for (int d0 = 0; d0 < 4; ++d0) qr[d0] = *(const bf16x8*)(Qp + d0 * 16);
        f32x16 o[4];
#pragma unroll
        for (int dt = 0; dt < 4; ++dt)
#pragma unroll
            for (int r = 0; r < 16; ++r) o[dt][r] = 0.f;
        float l = 0.f, cref = cL;
        f32x16 pA0, pA1, pB0, pB1;
        const bf16_t* ksrc = Kg + (kbase + lane) * 512 + c * 64 + wid * 8;
        const bf16_t* vsrc = Vg + (kbase + 16 * (wid & 3) + (lane >> 2)) * 512 + 32 * (wid >> 2) + 8 * (lane & 3);
        int ks_cur = 0, ks_nxt = 8192, ks_fre = 16384, vs_prv = 32768, vs_cur = 0, vs_fre = 16384;
#define PGLDS(src, dst) glds16_asm((src), (unsigned)__builtin_amdgcn_readfirstlane((int)(unsigned)(unsigned long)(dst)))
#define DMAK(t, off) PGLDS(ksrc + (size_t)(t) * (64 * 512), lds + PK + (off) + wid * 1024)
#define DMAV(t, off) do { PGLDS(vsrc + (size_t)(t) * (64 * 512), lds + PVV + (off) + wid * 1024); PGLDS(vsrc + 64 + (size_t)(t) * (64 * 512), lds + PVV + (off) + (wid + 8) * 1024); } while (0)
#define PROT() do { const int k_ = ks_cur; ks_cur = ks_nxt; ks_nxt = ks_fre; ks_fre = k_; const int v_ = vs_prv; vs_prv = vs_cur; vs_cur = vs_fre; vs_fre = v_; } while (0)
        DMAK(0, 0); DMAK(1, 8192); DMAV(0, 0);
        PWAITBAR(0);
        DMAK(2, 16384); DMAV(1, 16384);
        pstep<true>(qr, o, pA0, pA1, pA0, pA1, l, lds + PK + hi * 1024 + r32 * 16, lds + PVV + vlane, tL == 0, relb0, cref, tbl);
        PWAITBAR(3);
        PROT();
#define PSTEPX(C0, C1, P0, P1, tt) do { \
        DMAK(min((tt) + 2, NT - 1), ks_fre); DMAV(min((tt) + 1, NT - 1), vs_fre); \
        pstep<false>(qr, o, C0, C1, P0, P1, l, lds + PK + ks_cur + hi * 1024 + r32 * 16, lds + PVV + vs_prv + vlane, (tt) >= tL && (tt) < tR, relb0 + (tt) * 64, cref, tbl); \
        if ((tt) == tR) { float f_ = __builtin_amdgcn_exp2f(cL - cR); asm volatile("" : "+v"(f_)); l *= f_; cref = cR; \
            _Pragma("unroll") for (int dt_ = 0; dt_ < 4; ++dt_) _Pragma("unroll") for (int r_ = 0; r_ < 16; ++r_) o[dt_][r_] *= f_; } \
        PWAITBAR(3); PROT(); } while (0)
#pragma unroll 1
        for (int t = 1; t < NT; t += 2) {
            PSTEPX(pB0, pB1, pA0, pA1, t);
            if (t + 1 < NT) PSTEPX(pA0, pA1, pB0, pB1, t + 1);
        }
        pdrain(o, pB0, pB1, l, lds + PVV + vs_prv + vlane);
        PWAITBAR(0);
#undef PSTEPX
#undef PROT
#undef DMAV
#undef DMAK
#undef PGLDS
        l += __shfl_xor(l, 32);
        const float inv = 1.0f / l;
        int lane2 = lane; asm volatile("" : "+v"(lane2));
        const int r32b = lane2 & 31, hib = lane2 >> 5;
        float* o1p = (float*)(ws + WS_O1) + ((size_t)(unit * 8 + wid) * 64 + lane2) * 64;
        if (c == 0) {
#pragma unroll
            for (int dt = 0; dt < 4; ++dt)
#pragma unroll
                for (int r = 0; r < 16; ++r) o1p[dt * 16 + r] = o[dt][r] * inv;
        } else {
            bf16_t* Ob = (bf16_t*)(ws + WS_OB) + (size_t)(row0 + wid * 32 + r32b) * 1024 + ocol + 4 * hib;
            float ss = 0.f;
#pragma unroll
            for (int dt = 0; dt < 4; ++dt)
#pragma unroll
                for (int r = 0; r < 16; ++r) { const float v = o1p[dt * 16 + r] - lam * (o[dt][r] * inv); o[dt][r] = v; ss += v * v; }
            ss += __shfl_xor(ss, 32);
            const float rn = (1.0f - LAM_INIT) / sqrtf(ss * (1.0f / 128.0f) + LN_EPS);
#pragma unroll
            for (int dt = 0; dt < 4; ++dt)
#pragma unroll
                for (int g4 = 0; g4 < 4; ++g4) { const int d0 = 32 * dt + 8 * g4; const f32x4 sg = *(const f32x4*)(p.in[I_SUBG] + d0 + 4 * hib);
                    u32x2 w; w.x = cvtpk(o[dt][4 * g4] * rn * sg.x, o[dt][4 * g4 + 1] * rn * sg.y); w.y = cvtpk(o[dt][4 * g4 + 2] * rn * sg.z, o[dt][4 * g4 + 3] * rn * sg.w);
                    *(u32x2*)(Ob + d0) = w; }
        }
    }
}
}

template <bool DUAL, bool BKN, class LA, class LB, class EP>
DI void ngemm_tile(float* As, float* Bs, float* Bs2, int K, const LA& la, const LB& lb, const LB& lb2, const EP& ep) {
    const int tid = threadIdx.x, ty = tid >> 4, tx = tid & 15;
    float acc[4][4], acc2[4][4];
#pragma unroll
    for (int i = 0; i < 4; ++i)
#pragma unroll
        for (int j = 0; j < 4; ++j) { acc[i][j] = 0.f; acc2[i][j] = 0.f; }
    for (int kc = 0; kc < K; kc += 32) {
        __syncthreads();
#pragma unroll
        for (int j = 0; j < 8; ++j) { const int i = tid + 512 * j, k = i & 31, r = i >> 5; As[k * 132 + r] = la(r, kc + k); }
#pragma unroll
        for (int j = 0; j < 4; ++j) { const int i = tid + 512 * j; int k, n; if (BKN) { n = i & 63; k = i >> 6; } else { k = i & 31; n = i >> 5; }
            Bs[k * 68 + n] = lb(kc + k, n); if (DUAL) Bs2[k * 68 + n] = lb2(kc + k, n); }
        __syncthreads();
#pragma unroll 8
        for (int k = 0; k < 32; ++k) {
            const f32x4 a = *(const f32x4*)&As[k * 132 + ty * 4]; const f32x4 b = *(const f32x4*)&Bs[k * 68 + tx * 4];
#pragma unroll
            for (int i = 0; i < 4; ++i)
#pragma unroll
                for (int j = 0; j < 4; ++j) acc[i][j] += a[i] * b[j];
            if (DUAL) { const f32x4 b2 = *(const f32x4*)&Bs2[k * 68 + tx * 4];
#pragma unroll
                for (int i = 0; i < 4; ++i)
#pragma unroll
                    for (int j = 0; j < 4; ++j) acc2[i][j] += a[i] * b2[j]; }
        }
    }
#pragma unroll
    for (int i = 0; i < 4; ++i)
#pragma unroll
        for (int j = 0; j < 4; ++j) ep(ty * 4 + i, tx * 4 + j, acc[i][j], acc2[i][j]);
}

struct LA_bf { const bf16_t* A; int lda; DI float operator()(int r, int k) const { return bf2f(A[(size_t)r * lda + k]); } };
struct LB_bf { const bf16_t* B; int ldb; DI float operator()(int k, int n) const { return bf2f(B[(size_t)n * ldb + k]); } };
struct EP_inproj { unsigned char* ws; int m0, n0;
    DI void operator()(int r, int n, float v, float) const { const int row = m0 + r, c = n0 + n; bf16_t* dst;
        if (c < 512) dst = (bf16_t*)(ws + WS_QB) + (size_t)row * 512 + c; else if (c < 1024) dst = (bf16_t*)(ws + WS_KB) + (size_t)row * 512 + (c - 512);
        else if (c < 1536) dst = (bf16_t*)(ws + WS_VB) + (size_t)row * 512 + (c - 1024); else if (c < 1792) dst = (bf16_t*)(ws + WS_MQB) + (size_t)row * 256 + (c - 1536);
        else dst = (bf16_t*)(ws + WS_ZB) + (size_t)row * 512 + (c - 1792);
        *dst = (bf16_t)f2bf(v); } };
struct EP_bf { bf16_t* C; int ldc; int m0, n0; DI void operator()(int r, int n, float v, float) const { C[(size_t)(m0 + r) * ldc + n0 + n] = (bf16_t)f2bf(v); } };
struct EP_f32 { float* C; int ldc; int m0, n0; DI void operator()(int r, int n, float v, float) const { C[(size_t)(m0 + r) * ldc + n0 + n] = v; } };

struct LA_dft { const float* ct; int s0; DI float operator()(int r, int k) const { const int sp = s0 + r, s = k & 4095; const int idx = (s * sp) & 4095;
    return (k < 4096) ? ct[idx] : -ct[(idx - 1024) & 4095]; } };
struct LB_z { const bf16_t* Z; int n0; DI float operator()(int k, int n) const { return bf2f(Z[(size_t)(k & 4095) * 512 + (k >> 12) * 256 + n0 + n]); } };
struct EP_ob { bf16_t* O; int row0, col0; DI void operator()(int r, int n, float v, float) const { O[(size_t)(row0 + r) * 1024 + col0 + n] = (bf16_t)f2bf(v); } };
DI void nfourier_phase(const Params& p, float* As, float* Bs, int bid, int nb) {
    unsigned char* ws = p.ws; const float* ct = (const float*)(ws + WS_COSTAB);
    const int nT = NB * 32 * 4;
    for (int t = bid; t < nT; t += nb) {
        const int b = t / 128, q = t % 128, s0 = (q / 4) * 128, n0 = (q % 4) * 64;
        LA_dft la{ct, s0}; LB_z lb{(const bf16_t*)(ws + WS_ZB) + (size_t)b * SEQ * 512, n0}; EP_ob ep{(bf16_t*)(ws + WS_OB), b * SEQ + s0, 512 + n0};
        ngemm_tile<false, true>(As, Bs, Bs, 8192, la, lb, lb, ep);
    }
}

constexpr int P5_WA = 0, P5_WB = 131072, P5_LG = P5_WB + 16384;
DI void p4_ln1_router(const Params& p, __attribute__((address_space(3))) unsigned char* lds, int gw, int NGW, int wave, int lane) {
    typedef __attribute__((address_space(3))) unsigned char* lptr;
    unsigned char* ws = p.ws;
    const bf16_t* Aout = (const bf16_t*)(ws + WS_AOUT); const float* st0 = (const float*)(ws + WS_STATS0); bf16_t* H1 = (bf16_t*)(ws + WS_XN);
    const float* WR = (const float*)(ws + WS_WR); unsigned* cnt = (unsigned*)(ws + WS_CTL) + CW_CNT; int* info = (int*)(ws + WS_TOKINFO); int* list = (int*)(ws + WS_LIST);
    __attribute__((address_space(3))) float* lg = (__attribute__((address_space(3))) float*)(lds + P5_LG) + wave * (8 * 36);
    __syncthreads();
#pragma unroll
    for (int i = 0; i < 18; ++i) { const int pc = wave * 18 + i, e = pc >> 2, part = pc & 3;
        const lptr dst = (e < 4) ? (lds + P5_WB + e * 4096 + part * 1024) : (lds + P5_WA + (e - 4) * 4096 + part * 1024);
        att::glds16_asm(WR + (size_t)e * 1024 + part * 256 + lane * 4, (unsigned)__builtin_amdgcn_readfirstlane((int)(unsigned)(unsigned long)dst)); }
    const f32x4* __restrict__ g0p = (const f32x4*)p.in[I_LN0G] + lane; const f32x4* __restrict__ b0p = (const f32x4*)p.in[I_LN0B] + lane;
    const f32x4* __restrict__ g1p = (const f32x4*)p.in[I_LN1G] + lane; const f32x4* __restrict__ b1p = (const f32x4*)p.in[I_LN1B] + lane;
    for (int grp = gw; grp < NTOK / 8; grp += NGW) {
        f32x4 hv[8][4];
        f32x4 cx[4]; u32x2 ca[4];
        { const int row = grp * 8; const f32x4* __restrict__ xr = (const f32x4*)(p.in[I_X] + (size_t)row * DM) + lane; const u32x2* __restrict__ ar = (const u32x2*)(Aout + (size_t)row * DM) + lane;
#pragma unroll
          for (int j = 0; j < 4; ++j) { cx[j] = xr[64 * j]; ca[j] = ar[64 * j]; } }
#pragma unroll
        for (int r = 0; r < 8; ++r) {
            const int row = grp * 8 + r;
            f32x4 nx[4], pg[4], pb[4], qg[4], qb[4]; u32x2 na[4];
#pragma unroll
            for (int j = 0; j < 4; ++j) { pg[j] = g0p[64 * j]; pb[j] = b0p[64 * j]; }
#pragma unroll
            for (int j = 0; j < 4; ++j) { qg[j] = g1p[64 * j]; qb[j] = b1p[64 * j]; }
            if (r < 7) { const f32x4* __restrict__ xr = (const f32x4*)(p.in[I_X] + (size_t)(row + 1) * DM) + lane; const u32x2* __restrict__ ar = (const u32x2*)(Aout + (size_t)(row + 1) * DM) + lane;
#pragma unroll
                for (int j = 0; j < 4; ++j) { nx[j] = xr[64 * j]; na[j] = ar[64 * j]; } }
            const float mu0 = st0[2 * row], rs0 = st0[2 * row + 1];
            float s = 0.f;
#pragma unroll
            for (int j = 0; j < 4; ++j) { const f32x4 h0 = (cx[j] - mu0) * rs0 * pg[j] + pb[j];
                const f32x4 av = {__uint_as_float(ca[j].x << 16), __uint_as_float(ca[j].x & 0xffff0000u), __uint_as_float(ca[j].y << 16), __uint_as_float(ca[j].y & 0xffff0000u)};
                hv[r][j] = h0 * ALPHA + av; s += (hv[r][j].x + hv[r][j].y) + (hv[r][j].z + hv[r][j].w); }
            const float mean = wave_sum2(s) * (1.f / DM); float s2 = 0.f;
#pragma unroll
            for (int j = 0; j < 4; ++j) { hv[r][j] = hv[r][j] - mean; s2 += (hv[r][j].x * hv[r][j].x + hv[r][j].y * hv[r][j].y) + (hv[r][j].z * hv[r][j].z + hv[r][j].w * hv[r][j].w); }
            const float rstd = 1.f / sqrtf(wave_sum2(s2) * (1.f / DM) + LN_EPS);
            u32x2 wv[4];
#pragma unroll
            for (int j = 0; j < 4; ++j) { hv[r][j] = hv[r][j] * rstd * qg[j] + qb[j]; wv[j].x = pk2(hv[r][j].x, hv[r][j].y); wv[j].y = pk2(hv[r][j].z, hv[r][j].w); }
            u32x2* __restrict__ o8 = (u32x2*)(H1 + (size_t)row * DM) + lane;
#pragma unroll
            for (int j = 0; j < 4; ++j) o8[64 * j] = wv[j];
            if (r < 7) {
#pragma unroll
                for (int j = 0; j < 4; ++j) { cx[j] = nx[j]; ca[j] = na[j]; } }
        }
        if (grp == gw) { asm volatile("s_waitcnt vmcnt(0)" ::: "memory"); __syncthreads(); }
        const bool b3 = (lane >> 3) & 1;
#pragma unroll 4
        for (int e = 0; e < 36; ++e) {
            const lptr wb = (e < 4) ? (lds + P5_WB + e * 4096) : (lds + P5_WA + (e - 4) * 4096);
            const __attribute__((address_space(3))) f32x4* wr = (const __attribute__((address_space(3))) f32x4*)wb + lane;
            const f32x4 w0 = wr[0], w1 = wr[64], w2 = wr[128], w3 = wr[192];
            float part[8];
#pragma unroll
            for (int r = 0; r < 8; ++r) { const f32x4 t = hv[r][0] * w0 + hv[r][1] * w1 + hv[r][2] * w2 + hv[r][3] * w3; part[r] = (t.x + t.y) + (t.z + t.w); }
            float q[4], q2[2];
#pragma unroll
            for (int r = 0; r < 4; ++r) { auto sw = __builtin_amdgcn_permlane32_swap(__float_as_uint(part[r]), __float_as_uint(part[r + 4]), false, false); q[r] = __uint_as_float(sw[0]) + __uint_as_float(sw[1]); }
#pragma unroll
            for (int r = 0; r < 2; ++r) { auto sw = __builtin_amdgcn_permlane16_swap(__float_as_uint(q[r]), __float_as_uint(q[r + 2]), false, false); q2[r] = __uint_as_float(sw[0]) + __uint_as_float(sw[1]); }
            const float snd = b3 ? q2[0] : q2[1], kp = b3 ? q2[1] : q2[0];
            float q3 = kp + dppf<0x128>(snd);
            q3 += dppf<0xB1>(q3); q3 += dppf<0x4E>(q3); q3 += dppf<0x141>(q3);
            if ((lane & 7) == 0) lg[(lane >> 3) * 36 + e] = q3;
        }
        asm volatile("s_waitcnt lgkmcnt(0)" ::: "memory");
        __attribute__((address_space(3))) unsigned* lcnt = (__attribute__((address_space(3))) unsigned*)(lds + P5_LG + 8 * 8 * 36 * 4);
        if (threadIdx.x < 32) lcnt[threadIdx.x] = 0u;
        __syncthreads();
        int e0 = 0, e1 = 0; unsigned r0 = 0, r1 = 0; float w0 = 0.f, w1 = 0.f;
        if (lane < 8) {
            const __attribute__((address_space(3))) float* L = lg + lane * 36;
            float gl[4]; int gs = 0; float gm;
#pragma unroll
            for (int j = 0; j < 4; ++j) gl[j] = L[j] + p.in[I_BG][j];
            gm = gl[0];
#pragma unroll
            for (int j = 1; j < 4; ++j) if (gl[j] > gm) { gm = gl[j]; gs = j; }
            float den = 0.f;
#pragma unroll
            for (int j = 0; j < 4; ++j) den += expf(gl[j] - gm);
            const float gate = 1.0f / den;
            float v0 = -1e30f, v1 = -1e30f; int i0 = 0, i1 = 0;
#pragma unroll
            for (int j = 0; j < 8; ++j) { const float v = L[4 + gs * 8 + j] + p.in[I_BRT][gs * 8 + j];
                if (v > v0) { v1 = v0; i1 = i0; v0 = v; i0 = j; } else if (v > v1) { v1 = v; i1 = j; } }
            const float ex = expf(v1 - v0); w0 = gate / (1.f + ex); w1 = gate * ex / (1.f + ex);
            e0 = gs * 8 + i0; e1 = gs * 8 + i1;
            r0 = __hip_atomic_fetch_add(lcnt + e0, 1u, __ATOMIC_RELAXED, __HIP_MEMORY_SCOPE_WORKGROUP); r1 = __hip_atomic_fetch_add(lcnt + e1, 1u, __ATOMIC_RELAXED, __HIP_MEMORY_SCOPE_WORKGROUP);
        }
        __syncthreads();
        if (threadIdx.x < 32) { const unsigned c = lcnt[threadIdx.x]; lcnt[32 + threadIdx.x] = c ? atomicAdd(cnt + threadIdx.x * CNT_STRIDE, c) : 0u; }
        __syncthreads();
        if (lane < 8) {
            const int row = grp * 8 + lane;
            const unsigned p0 = lcnt[32 + e0] + r0, p1 = lcnt[32 + e1] + r1;
            list[e0 * NTOK + p0] = row; list[e1 * NTOK + p1] = row;
            int* ii = info + (size_t)row * 8; ii[0] = e0; ii[1] = (int)p0; ii[2] = __float_as_int(w0); ii[3] = e1; ii[4] = (int)p1; ii[5] = __float_as_int(w1);
        }
        asm volatile("s_waitcnt lgkmcnt(0)" ::: "memory");
    }
    __syncthreads();
}

struct LA_gather { const bf16_t* H; const int* tok; DI float operator()(int r, int k) const { return bf2f(H[(size_t)tok[r] * 1024 + k]); } };
struct EP_hid { bf16_t* HID; int slot0, nvalid, n0; DI void operator()(int r, int n, float v1, float v3) const { if (r < nvalid) { const float s = v1 / (1.0f + expf(-v1)); HID[(size_t)(slot0 + r) * 256 + n0 + n] = (bf16_t)f2bf(s * v3); } } };
struct EP_y { bf16_t* Y; int slot0, nvalid, n0; DI void operator()(int r, int n, float v, float) const { if (r < nvalid) Y[(size_t)(slot0 + r) * 1024 + n0 + n] = (bf16_t)f2bf(v); } };
DI void nmoe_phase(const Params& p, int which, float* ldsf, int bid, int nb) {
    float* As = ldsf; float* Bs = ldsf + 32 * 132; float* Bs2 = Bs + 32 * 68; int* s_tok = (int*)(Bs2 + 32 * 68); int* s_cnt = s_tok + 128; int* s_tpre = s_cnt + 32; int* s_base = s_tpre + 33;
    unsigned char* ws = p.ws; const unsigned* cnt = (const unsigned*)(ws + WS_CTL) + CW_CNT; const int* list = (const int*)(ws + WS_LIST);
    const int tid = threadIdx.x;
    if (tid == 0) { int tp = 0, bs = 0; for (int e = 0; e < 32; ++e) { const int c = (int)cnt[e * CNT_STRIDE]; s_cnt[e] = c; s_tpre[e] = tp; s_base[e] = bs; tp += (c + 127) >> 7; bs += (c + 255) & ~255; } s_tpre[32] = tp; s_base[32] = bs; }
    __syncthreads();
    const int NT = which == 0 ? 4 : 16, total = s_tpre[32] * NT;
    for (int u = bid; u < total; u += nb) {
        const int T = u / NT, nt = u % NT; int e = 0; while (s_tpre[e + 1] <= T) ++e;
        const int mt = T - s_tpre[e], nvalid = min(128, s_cnt[e] - mt * 128), slot0 = s_base[e] + mt * 128;
        if (which == 0) {
            __syncthreads();
            if (tid < 128) s_tok[tid] = (tid < nvalid) ? list[e * NTOK + mt * 128 + tid] : 0;
            __syncthreads();
            const int j0 = nt * 64;
            const int r1 = e * 512 + (j0 >> 7) * 256 + (j0 & 127);
            LA_gather la{(const bf16_t*)(ws + WS_XN), s_tok}; LB_bf lb{(const bf16_t*)(ws + WS_W13T) + (size_t)r1 * 1024, 1024}; LB_bf lb2{(const bf16_t*)(ws + WS_W13T) + (size_t)(r1 + 128) * 1024, 1024};
            EP_hid ep{(bf16_t*)(ws + WS_OB), slot0, nvalid, j0};
            ngemm_tile<true, false>(As, Bs, Bs2, 1024, la, lb, lb2, ep);
        } else {
            LA_bf la{(const bf16_t*)(ws + WS_OB) + (size_t)slot0 * 256, 256}; LB_bf lb{(const bf16_t*)(ws + WS_W2T) + (size_t)(e * 1024 + nt * 64) * 256, 256};
            EP_y ep{(bf16_t*)(ws + WS_Y), slot0, nvalid, nt * 64};
            ngemm_tile<false, false>(As, Bs, Bs, 256, la, lb, lb, ep);
        }
    }
}

DI void p7_final(const Params& p, int gw, int NGW, int lane) {
    unsigned char* ws = p.ws; const unsigned* cnt = (const unsigned*)(ws + WS_CTL) + CW_CNT; const int* info = (const int*)(ws + WS_TOKINFO);
    const bf16_t* H1 = (const bf16_t*)(ws + WS_XN); const bf16_t* Y = (const bf16_t*)(ws + WS_Y);
    int base;
    { const int c = lane < 32 ? (int)cnt[lane * CNT_STRIDE] : 0; const int r = (c + 255) & ~255; int inc = r;
#pragma unroll
      for (int o = 1; o < 32; o <<= 1) { const int t = __shfl_up(inc, o); if ((lane & 31) >= o) inc += t; }
      base = inc - r; }
    for (int row = gw; row < NTOK; row += NGW) {
        const int* ii = info + (size_t)row * 8;
        const int e0 = ii[0], p0 = ii[1], e1 = ii[3], p1 = ii[4]; const float w0 = __int_as_float(ii[2]), w1 = __int_as_float(ii[5]);
        const size_t s0 = (size_t)(__shfl(base, e0) + p0), s1 = (size_t)(__shfl(base, e1) + p1);
        const u32x2* h8 = (const u32x2*)(H1 + (size_t)row * DM) + lane; const u32x2* y0 = (const u32x2*)(Y + s0 * DM) + lane; const u32x2* y1 = (const u32x2*)(Y + s1 * DM) + lane;
        f32x4 v[4]; float s = 0.f;
#pragma unroll
        for (int j = 0; j < 4; ++j) { const u32x2 a = h8[64 * j], b = y0[64 * j], c = y1[64 * j];
            v[j].x = ALPHA * __uint_as_float(a.x << 16) + w0 * __uint_as_float(b.x << 16) + w1 * __uint_as_float(c.x << 16);
            v[j].y = ALPHA * __uint_as_float(a.x & 0xffff0000u) + w0 * __uint_as_float(b.x & 0xffff0000u) + w1 * __uint_as_float(c.x & 0xffff0000u);
            v[j].z = ALPHA * __uint_as_float(a.y << 16) + w0 * __uint_as_float(b.y << 16) + w1 * __uint_as_float(c.y << 16);
            v[j].w = ALPHA * __uint_as_float(a.y & 0xffff0000u) + w0 * __uint_as_float(b.y & 0xffff0000u) + w1 * __uint_as_float(c.y & 0xffff0000u);
            s += (v[j].x + v[j].y) + (v[j].z + v[j].w); }
        const float mean = wave_sum(s) * (1.f / DM); float s2 = 0.f;
#pragma unroll
        for (int j = 0; j < 4; ++j) { v[j] = v[j] - mean; s2 += (v[j].x * v[j].x + v[j].y * v[j].y) + (v[j].z * v[j].z + v[j].w * v[j].w); }
        const float rstd = 1.f / sqrtf(wave_sum(s2) * (1.f / DM) + LN_EPS);
        f32x4* o = (f32x4*)(p.out + (size_t)row * DM) + lane;
#pragma unroll
        for (int j = 0; j < 4; ++j) { const f32x4 g = ((const f32x4*)p.in[I_LN2G])[lane + 64 * j], bb = ((const f32x4*)p.in[I_LN2B])[lane + 64 * j]; o[64 * j] = v[j] * rstd * g + bb; }
    }
}


#define LAS __attribute__((address_space(3)))
#define XB_TMO      128
#define XB_XCNT(j)  (256  + 64 * (j))
#define XB_XSUB(j)  (1280 + 64 * (j))
#define XB_XGEN(j)  (2304 + 64 * (j))
#define XB_TOP      3328
#define XB_TOPGEN   3392
#define XCD_BAR_WORDS 3456
#define XB_SPIN_CAP (1u << 18)

__device__ __forceinline__ unsigned xb_ld(unsigned* p)              { return __hip_atomic_load(p, __ATOMIC_RELAXED, __HIP_MEMORY_SCOPE_AGENT); }
__device__ __forceinline__ unsigned xb_add(unsigned* p, unsigned v) { return __hip_atomic_fetch_add(p, v, __ATOMIC_RELAXED, __HIP_MEMORY_SCOPE_AGENT); }
__device__ __forceinline__ unsigned xb_xcc_id() { return (unsigned)__builtin_amdgcn_s_getreg((3 << 11) | 20) & 0xFu; }
#define XB_SPIN(cond, bar) do { unsigned _sp = 0; while (cond) { __builtin_amdgcn_s_sleep(1); \
    if ((++_sp & 255u) == 0u) { if (xb_ld(&(bar)[XB_TMO])) break; if (_sp > XB_SPIN_CAP) { atomicAdd(&(bar)[XB_TMO], 1u); break; } } } } while (0)

struct XcdBarrier {
    unsigned* bar; unsigned x;
    volatile LAS unsigned* st;
};

__device__ __forceinline__ XcdBarrier xcd_barrier_post(unsigned* bar, volatile LAS unsigned* st) {
    XcdBarrier b; b.bar = bar; b.x = xb_xcc_id(); b.st = st;
    if (threadIdx.x == 0) (void)xb_add(&bar[XB_XCNT(b.x)], 1u);
    return b;
}
__device__ __forceinline__ void xcd_barrier_complete(unsigned* bar, unsigned x, unsigned& nloc, unsigned& nx) {
    const unsigned G = gridDim.x * gridDim.y * gridDim.z;
    unsigned sum, cnt, mine, sp = 0u;
    for (;;) {
        sum = 0u; cnt = 0u; mine = 0u;
#pragma unroll
        for (unsigned j = 0; j < 16; ++j) { const unsigned c = xb_ld(&bar[XB_XCNT(j)]); sum += c; cnt += (c > 0u) ? 1u : 0u; mine = (j == x) ? c : mine; }
        if (sum == G) break;
        __builtin_amdgcn_s_sleep(1);
        if ((++sp & 255u) == 0u) { if (xb_ld(&bar[XB_TMO])) break; if (sp > XB_SPIN_CAP) { atomicAdd(&bar[XB_TMO], 1u); break; } }
    }
    nloc = mine > 0u ? mine : 1u; nx = cnt > 0u ? cnt : 1u;
}

__device__ __forceinline__ void xcd_barrier(const XcdBarrier& b) {
    asm volatile("s_waitcnt vmcnt(0)" ::: "memory");
    __syncthreads();
    if (threadIdx.x == 0) {
        unsigned* bar = b.bar;
        __builtin_amdgcn_s_waitcnt(0);
        unsigned nloc = b.st[0], nx = b.st[1];
        if (nloc == 0u) { xcd_barrier_complete(bar, b.x, nloc, nx); b.st[0] = nloc; b.st[1] = nx; }
        const unsigned old = xb_add(&bar[XB_XSUB(b.x)], 1u);
        const unsigned gen = old / nloc;
        if (old + 1u == (gen + 1u) * nloc) {
            __builtin_amdgcn_fence(__ATOMIC_RELEASE, "agent");
            asm volatile("s_waitcnt vmcnt(0)" ::: "memory");
            const unsigned og = xb_add(&bar[XB_TOP], 1u);
            const unsigned tg = og / nx;
            if (og + 1u == (tg + 1u) * nx) xb_add(&bar[XB_TOPGEN], 1u);
            else XB_SPIN(xb_ld(&bar[XB_TOPGEN]) == tg, bar);
            __builtin_amdgcn_fence(__ATOMIC_ACQUIRE, "agent");
            xb_add(&bar[XB_XGEN(b.x)], 1u);
            asm volatile("s_waitcnt vmcnt(0)" ::: "memory");
        } else {
            XB_SPIN(xb_ld(&bar[XB_XGEN(b.x)]) == gen, bar);
            __builtin_amdgcn_fence(__ATOMIC_ACQUIRE, "agent");
            asm volatile("s_waitcnt vmcnt(0)" ::: "memory");
        }
    }
    __syncthreads();
}


namespace fft {
using att::bf16x8; using att::s16x4; using att::f32x16; using att::vtr; using att::cvtpk; using att::glds16_asm;
constexpr int XP = 1088, XOFF = 0, UOFF = 64 * XP, FOFF = UOFF + 32768;
template <int STAGE>
DI void fft_unit(ALAS unsigned char* lds, const Params& p, int unit, int wid, int lane) {
    constexpr int M = STAGE == 1 ? 128 : 64, MT = M / 32, CH = M * 16;
    unsigned char* ws = p.ws;
    const int tid = threadIdx.x, r32 = lane & 31, hi = lane >> 5;
    const int b = unit >> 6, u6 = unit & 63;
    const unsigned lbase = (unsigned)(unsigned long)lds;
    __syncthreads();
    { const bf16_t* Fsrc = (const bf16_t*)(ws + (STAGE == 1 ? WS_F1L : WS_F2L));
#pragma unroll
      for (int i = 0; i < MT; ++i) { const int pc = wid * MT + i; glds16_asm(Fsrc + pc * 512 + lane * 8, (unsigned)__builtin_amdgcn_readfirstlane((int)(lbase + FOFF + pc * 1024))); } }
    if (STAGE == 1) {
        const bf16_t* U = (const bf16_t*)(ws + WS_ZB);
#pragma unroll
        for (int i = 0; i < 4; ++i) { const int pc = wid * 4 + i, row = 2 * pc + hi;
            glds16_asm(U + ((size_t)b * SEQ + 64 * row + u6) * 256 + r32 * 8, (unsigned)__builtin_amdgcn_readfirstlane((int)(lbase + UOFF + pc * 1024))); }
        const int g = wid >> 1, nh = wid & 1;
        const bf16_t* GT = (const bf16_t*)(ws + WS_GT) + (size_t)(g * 128 + 64 * nh + r32) * 64 + 8 * hi;
        bf16x8 gb[2][4];
#pragma unroll
        for (int nt = 0; nt < 2; ++nt)
#pragma unroll
            for (int ks = 0; ks < 4; ++ks) gb[nt][ks] = *(const bf16x8*)(GT + nt * 32 * 64 + ks * 16);
        asm volatile("s_waitcnt vmcnt(0)" ::: "memory");
        __syncthreads();
        f32x16 zz[2][2];
#pragma unroll
        for (int mt = 0; mt < 2; ++mt)
#pragma unroll
            for (int nt = 0; nt < 2; ++nt)
#pragma unroll
                for (int r = 0; r < 16; ++r) zz[mt][nt][r] = 0.f;
#pragma unroll
        for (int ks = 0; ks < 4; ++ks) {
#pragma unroll
            for (int mt = 0; mt < 2; ++mt) { const bf16x8 ua = *(const ALAS bf16x8*)(lds + UOFF + (32 * mt + r32) * 512 + (g * 64 + 16 * ks + 8 * hi) * 2);
#pragma unroll
                for (int nt = 0; nt < 2; ++nt) zz[mt][nt] = ATT_MFMA(ua, gb[nt][ks], zz[mt][nt]); }
        }
#pragma unroll
        for (int mt = 0; mt < 2; ++mt)
#pragma unroll
            for (int nt = 0; nt < 2; ++nt)
#pragma unroll
                for (int r = 0; r < 16; ++r) { const int s1 = 32 * mt + (r & 3) + 8 * (r >> 2) + 4 * hi;
                    *(ALAS bf16_t*)(lds + XOFF + s1 * XP + (nh * 256 + g * 64 + 32 * nt + r32) * 2) = (bf16_t)f2bf(zz[mt][nt][r]); }
        __syncthreads();
    } else {
        const bf16_t* src = (const bf16_t*)(ws + WS_ZS1) + ((size_t)(b * 64 + u6) * 64) * 512;
#pragma unroll
        for (int i = 0; i < 8; ++i) { const int row = wid + 8 * i;
            glds16_asm(src + (size_t)row * 512 + lane * 8, (unsigned)__builtin_amdgcn_readfirstlane((int)(lbase + XOFF + row * XP))); }
        asm volatile("s_waitcnt vmcnt(0)" ::: "memory");
        __syncthreads();
    }
    f32x16 acc[MT];
#pragma unroll
    for (int mt = 0; mt < MT; ++mt)
#pragma unroll
        for (int r = 0; r < 16; ++r) acc[mt][r] = 0.f;
    const ALAS unsigned char* xb = lds + XOFF + (8 * hi + ((lane & 15) >> 2)) * XP + (32 * wid + 16 * ((lane >> 4) & 1) + 4 * (lane & 3)) * 2;
    const ALAS unsigned char* fb = lds + FOFF + hi * CH + r32 * 16;
#pragma unroll
    for (int ks = 0; ks < 8; ++ks) {
        const ALAS unsigned char* bp = xb + (16 * (ks & 3)) * XP + (ks >> 2) * 512;
        const s16x4 lo = vtr(bp), hh = vtr(bp + 4 * XP);
        const bf16x8 bfr = __builtin_shufflevector(lo, hh, 0, 1, 2, 3, 4, 5, 6, 7);
#pragma unroll
        for (int mt = 0; mt < MT; ++mt) { const bf16x8 afr = *(const ALAS bf16x8*)(fb + (2 * ks) * CH + mt * 512); acc[mt] = ATT_MFMA(afr, bfr, acc[mt]); }
    }
    __syncthreads();
    const int col = 32 * wid + r32;
    if (STAGE == 1) {
#pragma unroll
        for (int mt = 0; mt < 2; ++mt)
#pragma unroll
            for (int r = 0; r < 16; ++r) { const int s1p = 32 * mt + (r & 3) + 8 * (r >> 2) + 4 * hi;
                const float x = (float)((s1p * u6) & 4095) * (1.0f / 4096.0f); const float ct = __builtin_amdgcn_cosf(x), st = __builtin_amdgcn_sinf(x);
                const float yr = acc[mt][r], yi = acc[mt + 2][r];
                *(ALAS bf16_t*)(lds + XOFF + s1p * 1024 + col * 2) = (bf16_t)f2bf(yr * ct + yi * st);
                *(ALAS bf16_t*)(lds + XOFF + s1p * 1024 + 512 + col * 2) = (bf16_t)f2bf(yi * ct - yr * st); }
        __syncthreads();
        bf16_t* dst = (bf16_t*)(ws + WS_ZS1);
#pragma unroll
        for (int i = 0; i < 8; ++i) { const int row = i * 8 + (tid >> 6), ch = tid & 63;
            const u32x4 v = *(const ALAS u32x4*)(lds + XOFF + row * 1024 + ch * 16);
            *(u32x4*)(dst + ((size_t)(b * 64 + row) * 64 + u6) * 512 + ch * 8) = v; }
    } else {
#pragma unroll
        for (int mt = 0; mt < 2; ++mt)
#pragma unroll
            for (int r = 0; r < 16; ++r) { const int s2p = 32 * mt + (r & 3) + 8 * (r >> 2) + 4 * hi;
                *(ALAS bf16_t*)(lds + XOFF + s2p * 512 + col * 2) = (bf16_t)f2bf(acc[mt][r]); }
        __syncthreads();
        bf16_t* dst = (bf16_t*)(ws + WS_OB);
#pragma unroll
        for (int i = 0; i < 4; ++i) { const int row = i * 16 + (tid >> 5), ch = tid & 31;
            const u32x4 v = *(const ALAS u32x4*)(lds + XOFF + row * 512 + ch * 16);
            *(u32x4*)(dst + ((size_t)b * SEQ + u6 + 64 * row) * 1024 + 512 + ch * 8) = v; }
    }
    __syncthreads();
}
}


DI void memkv_unit(__attribute__((address_space(3))) unsigned char* lds, const Params& p, int unit, int wid, int lane) {
    using att::bf16x8; using att::f32x16;
    unsigned char* ws = p.ws; const int tid = threadIdx.x, r32 = lane & 31, hi = lane >> 5;
    const int mt = unit >> 3, nt = unit & 7;
    const bf16_t* A = (const bf16_t*)(ws + WS_MEMB) + (size_t)(32 * mt + r32) * 1024 + 128 * wid + 8 * hi;
    const bf16_t* B = (const bf16_t*)(ws + WS_WMT) + (size_t)(64 * nt + r32) * 1024 + 128 * wid + 8 * hi;
    f32x16 acc0, acc1;
#pragma unroll
    for (int r = 0; r < 16; ++r) { acc0[r] = 0.f; acc1[r] = 0.f; }
#pragma unroll
    for (int ks = 0; ks < 8; ++ks) { const bf16x8 a = *(const bf16x8*)(A + 16 * ks), b0 = *(const bf16x8*)(B + 16 * ks), b1 = *(const bf16x8*)(B + 32 * 1024 + 16 * ks);
        acc0 = ATT_MFMA(a, b0, acc0); acc1 = ATT_MFMA(a, b1, acc1); }
    __attribute__((address_space(3))) float* red = (__attribute__((address_space(3))) float*)lds;
    __syncthreads();
#pragma unroll
    for (int r = 0; r < 16; ++r) { red[((wid * 2 + 0) * 16 + r) * 64 + lane] = acc0[r]; red[((wid * 2 + 1) * 16 + r) * 64 + lane] = acc1[r]; }
    __syncthreads();
    __attribute__((address_space(3))) float* fin = red + 8 * 2 * 16 * 64;
    bf16_t* MKV = (bf16_t*)(ws + WS_MKV);
#pragma unroll
    for (int i = 0; i < 4; ++i) { const int o = tid + 512 * i, ct = o >> 10, reg = (o >> 6) & 15, ln = o & 63; float v = 0.f;
#pragma unroll
        for (int w = 0; w < 8; ++w) v += red[((w * 2 + ct) * 16 + reg) * 64 + ln];
        const int row = (reg & 3) + 8 * (reg >> 2) + 4 * (ln >> 5), col = 32 * ct + (ln & 31);
        const unsigned hb = f2bf(v); MKV[(size_t)(32 * mt + row) * 512 + 64 * nt + col] = (bf16_t)hb; fin[row * 64 + col] = __uint_as_float(hb << 16); }
    __syncthreads();
    if (nt < 4 && tid < 64) {
        float s = 0.f;
        if (tid < 32) { for (int c = 0; c < 64; ++c) { const float f = fin[tid * 64 + c]; s += f * f; } }
#pragma unroll
        for (int o = 1; o < 64; o <<= 1) s = fmaxf(s, __shfl_xor(s, o));
        if (tid == 0) atomicMax((unsigned*)(ws + WS_CTL) + CW_KMAXM + ((32 * mt) / MEMLEN) * 4 + nt, __float_as_uint(s));
    }
    __syncthreads();
}

constexpr int LDS_BYTES = 163840;
constexpr int LDSCTL_OFF = 163840 - 4096, MISC_OFF = LDSCTL_OFF + 320;
constexpr int CW_BAR = 4096;
struct Args { Params p; int ph_lo, ph_hi; };
__global__ void __launch_bounds__(512, 2) mk_fwd(Args a) {
    extern __shared__ __attribute__((aligned(16))) unsigned char smem[];
    LAS unsigned char* lds = (LAS unsigned char*)smem;
    const int tid = threadIdx.x, lane = tid & 63, wave = __builtin_amdgcn_readfirstlane(tid >> 6);
    const int G = gridDim.x, bx = blockIdx.x, vcu = (G % 8 == 0) ? (bx % 8) * (G / 8) + bx / 8 : bx;
    const int lo = a.ph_lo, hi = a.ph_hi;
    unsigned char* ws = a.p.ws;
    volatile LAS unsigned* MISC = (volatile LAS unsigned*)(lds + MISC_OFF);
    for (int u = tid; u < (LDS_BYTES - LDSCTL_OFF) / 4; u += 512) ((LAS unsigned*)(lds + LDSCTL_OFF))[u] = 0u;
    __syncthreads();
    XcdBarrier bar = xcd_barrier_post((unsigned*)(ws + WS_CTL) + CW_BAR, MISC + 8);
#ifndef PHMASK
#define PHMASK 0xffff
#endif
#define IN(k) (((PHMASK >> (k)) & 1) && lo <= (k) && (k) < hi)
#define SEAM(k) do { if (IN(k) && IN((k) + 1)) xcd_barrier(bar); } while (0)
#ifndef REPMASK
#define REPMASK 0
#endif
    int one_ = 1; asm volatile("" : "+s"(one_));
#define REP(k) _Pragma("unroll 1") for (int rep_ = 0; rep_ < (((REPMASK >> (k)) & 1) ? one_ + 1 : 1); ++rep_)
    int kDM = DM, kDE = DEXP; asm volatile("" : "+s"(kDM), "+s"(kDE));
    if (IN(0)) REP(0) { p0_prologue(a.p, (float*)smem, vcu * 8 + wave, G * 8, wave, lane); }
    SEAM(0);
    if (IN(1)) REP(1) {
        { pg8::Gemm g{(const bf16_t*)(ws + WS_XN), (const bf16_t*)(ws + WS_WINT), NTOK, NIN, kDM}; pg8::StaticOrder S; S.init(NTOK, NIN, G, bx);
          pg8::EpiInproj E{ws}; pg8::gemm_phase<pg8::EpiInproj, pg8::StaticOrder, true, true>(lds, g, S, E); }
    }
    SEAM(1);
    if (IN(2)) REP(2) { kmax_phase(a.p, vcu * 8 + wave, G * 8, lane); for (int u = vcu; u < 256; u += G) memkv_unit(lds, a.p, u, wave, lane); for (int u = vcu; u < 256; u += G) fft::fft_unit<1>(lds, a.p, u, wave, lane); }
    SEAM(2);
    if (IN(3)) REP(3) {
        for (int u = vcu; u < 256; u += G) {
            const unsigned* ctl = (const unsigned*)(ws + WS_CTL); const int bh2 = (u >> 4) * 2; const float* rb = a.p.in[I_RELB];
            float babs = 0.f; for (int i = 0; i < 32; ++i) babs = fmaxf(babs, fabsf(rb[i * 4 + ((u >> 4) & 3)]));
            const float cs = sqrtf(fmaxf(__uint_as_float(ctl[CW_QMAX + bh2]) * __uint_as_float(ctl[CW_KMAX + bh2]), __uint_as_float(ctl[CW_QMAX + bh2 + 1]) * __uint_as_float(ctl[CW_KMAX + bh2 + 1]))) + 2.f * babs * LOG2E;
            int lane_u = lane; asm volatile("" : "+v"(lane_u));
            if (cs < 100.f) att::attn_pipe(lds, a.p, u, wave, lane_u);
            else att::attn_unit<128, true>(lds, a.p, u, wave, lane_u);
        }
        { int lane_b = lane; asm volatile("" : "+v"(lane_b)); for (int u = vcu; u < 256; u += G) att::attn_unit<64, false>(lds, a.p, u, wave, lane_b); }
        { int lane_c = lane; asm volatile("" : "+v"(lane_c)); for (int u = vcu; u < 256; u += G) fft::fft_unit<2>(lds, a.p, u, wave, lane_c); }
    }
    SEAM(3);
    if (IN(4)) REP(4) {
        pg8::Gemm g{(const bf16_t*)(ws + WS_OB), (const bf16_t*)(ws + WS_WOT), NTOK, DM, kDM}; pg8::StaticOrder S; S.init(NTOK, DM, G, bx);
        pg8::EpiBf16Plain E{(bf16_t*)(ws + WS_AOUT), DM}; pg8::gemm_phase<pg8::EpiBf16Plain, pg8::StaticOrder, true, true>(lds, g, S, E);
    }
    SEAM(4);
    if (IN(5)) { p4_ln1_router(a.p, lds, vcu * 8 + wave, G * 8, wave, lane); }
    SEAM(5);
    LAS int* mtab = (LAS int*)(lds + LDSCTL_OFF + 1024);
    if (IN(6) || IN(7)) {
        if (tid == 0) { const unsigned* cnt = (const unsigned*)(ws + WS_CTL) + CW_CNT; int tp = 0;
            for (int e = 0; e < 32; ++e) { const int c = (int)cnt[e * CNT_STRIDE]; mtab[e] = tp; mtab[33 + e] = c; tp += (c + 255) >> 8; } mtab[32] = tp; }
        __syncthreads();
    }
    if (IN(6)) REP(6) {
        pg8::Gemm g{(const bf16_t*)(ws + WS_XN), (const bf16_t*)(ws + WS_W13T), 0, 0, kDM}; pg8::MoeOrder S{mtab, (const int*)(ws + WS_LIST), G, bx, 1};
        pg8::EpiSwiglu E{(bf16_t*)(ws + WS_OB)}; pg8::gemm_phase<pg8::EpiSwiglu, pg8::MoeOrder, true, true, true>(lds, g, S, E);
    }
    SEAM(6);
    if (IN(7)) REP(7) {
        pg8::Gemm g{(const bf16_t*)(ws + WS_OB), (const bf16_t*)(ws + WS_W2T), 0, 0, kDE}; pg8::MoeOrder S{mtab, (const int*)(ws + WS_LIST), G, bx, 2};
        pg8::EpiDown E{(bf16_t*)(ws + WS_Y)}; pg8::gemm_phase<pg8::EpiDown, pg8::MoeOrder, true, true, false>(lds, g, S, E);
    }
    SEAM(7);
    if (IN(8)) REP(8) { p7_final(a.p, vcu * 8 + wave, G * 8, lane); }
#undef IN
#undef SEAM
}

#ifndef N_LAUNCH_SPLIT
#define N_LAUNCH_SPLIT 0
#endif
extern "C" void kernel_launch(void* const* d_in, const int* in_sizes, int n_in, void* d_out, int out_size, void* d_ws, size_t ws_size, hipStream_t stream) {
    Params p{};
    for (int i = 0; i < 25; ++i) p.in[i] = (const float*)d_in[i];
    p.out = (float*)d_out; p.ws = (unsigned char*)d_ws;
    static int grid = 0;
    if (!grid) {
        (void)hipFuncSetAttribute((const void*)mk_fwd, hipFuncAttributeMaxDynamicSharedMemorySize, LDS_BYTES);
        int dev = 0, cus = 0, per_cu = 0;
        (void)hipGetDevice(&dev); (void)hipDeviceGetAttribute(&cus, hipDeviceAttributeMultiprocessorCount, dev);
        (void)hipOccupancyMaxActiveBlocksPerMultiprocessor(&per_cu, (const void*)mk_fwd, 512, LDS_BYTES);
        if (per_cu < 1) per_cu = 1;
        grid = cus * 1;
        if (grid > 256) grid = 256;
        (void)hipGetLastError();
    }
    (void)hipMemsetAsync((char*)d_ws + WS_CTL, 0, CTL_BYTES, stream);
    Args a{}; a.p = p;
#if N_LAUNCH_SPLIT
    for (int k = 0; k < 9; ++k) { a.ph_lo = k; a.ph_hi = k + 1; hipLaunchKernelGGL(mk_fwd, dim3(grid), dim3(512), LDS_BYTES, stream, a); }
#else
    a.ph_lo = 0; a.ph_hi = 9;
    void* kargs[] = {&a};
    (void)hipLaunchCooperativeKernel((const void*)mk_fwd, dim3(grid), dim3(512), kargs, LDS_BYTES, stream);
#ifdef PROBE_PHASE
    a.ph_lo = PROBE_PHASE; a.ph_hi = PROBE_PHASE + 1;
    hipLaunchKernelGGL(mk_fwd, dim3(grid), dim3(512), LDS_BYTES, stream, a);
#endif
#endif
}
```
